# Optimizing an MI355X kernel written in HIP

```python
import math
import jax, jax.numpy as jnp
from jax import lax
import numpy as np

D_MODEL = 1024
BATCH = 4
SEQ = 4096
DEPTH = 1

DA_HEADS = 4
DA_HALF = 64
DA_VDIM = 2 * DA_HALF
DA_WIDTH = DA_HEADS * DA_VDIM
ROPE_THETA = 500000.0
ROPE_DIM = DA_HALF // 4
QBLK = 128
RET_HEADS = 4
RET_KDIM = 128
RET_VDIM = 128
RET_WIDTH = RET_HEADS * RET_VDIM
RET_THETA = 10000.0
RCHUNK = 128
SPLIT_SIZES = [DA_WIDTH, DA_WIDTH, DA_WIDTH,
               RET_HEADS * RET_KDIM, RET_HEADS * RET_KDIM, RET_WIDTH, RET_WIDTH,
               D_MODEL, D_MODEL]
IN_COLS = sum(SPLIT_SIZES)
N_GROUPS = 4
EXPERTS_PER_GROUP = 8
N_EXPERTS = N_GROUPS * EXPERTS_PER_GROUP
TOP_K = 2
EXPERT_FF = 512
MOE_BLOCK = 128
EPS = 1e-6

kernel_name = "hybrid_diffattn_retention_hiermoe"


def rms_norm(x, g):
    xf = x.astype(jnp.float32)
    y = xf * lax.rsqrt(jnp.mean(xf * xf, axis=-1, keepdims=True) + EPS)
    return (y * g.astype(jnp.float32)).astype(x.dtype)


def apply_rope(x, positions, rot_dim, theta):
    half = rot_dim // 2
    freqs = jnp.power(jnp.float32(theta), -2.0 * jnp.arange(half, dtype=jnp.float32) / rot_dim)
    ang = positions.astype(jnp.float32)[..., None] * freqs
    ang = ang.reshape(ang.shape[:2] + (1,) * (x.ndim - 3) + (half,))
    cos, sin = jnp.cos(ang), jnp.sin(ang)
    xf = x.astype(jnp.float32)
    x1, x2, rest = xf[..., :half], xf[..., half:rot_dim], xf[..., rot_dim:]
    out = jnp.concatenate([x1 * cos - x2 * sin, x2 * cos + x1 * sin, rest], axis=-1)
    return out.astype(x.dtype)


def diff_attention(q, k, v, lam):
    B, S, H, _, d = q.shape
    nb = S // QBLK
    scale = 1.0 / math.sqrt(d)
    qb = q.reshape(B, nb, QBLK, H, 2, d).transpose(1, 0, 2, 3, 4, 5)
    kpos = jnp.arange(S)

    def one_block(args):
        qblk, i = args
        s = jnp.einsum('bqhcd,bkhcd->bhcqk', qblk, k).astype(jnp.float32) * scale
        qpos = i * QBLK + jnp.arange(QBLK)
        mask = kpos[None, :] <= qpos[:, None]
        p = jax.nn.softmax(jnp.where(mask, s, -jnp.inf), axis=-1)
        a = p[:, :, 0] - lam * p[:, :, 1]
        return jnp.einsum('bhqk,bkhe->bqhe', a.astype(v.dtype), v)

    o = lax.map(one_block, (qb, jnp.arange(nb)))
    return o.transpose(1, 0, 2, 3, 4).reshape(B, S, H, v.shape[-1])


def retention(q, k, v):
    B, S, H, dk = q.shape
    dv = v.shape[-1]
    C = RCHUNK
    nc = S // C
    log_g = jnp.log1p(-jnp.exp2(-5.0 - jnp.arange(H, dtype=jnp.float32)))
    idx = jnp.arange(C, dtype=jnp.float32)
    rel = idx[:, None] - idx[None, :]
    dmask = jnp.where(rel[None] >= 0, jnp.exp(jnp.maximum(rel, 0.0)[None] * log_g[:, None, None]), 0.0)
    zeta = jnp.exp((C - 1 - idx)[None, :] * log_g[:, None])
    xi = jnp.exp((idx + 1.0)[None, :] * log_g[:, None])
    g_chunk = jnp.exp(C * log_g)
    qc = q.reshape(B, nc, C, H, dk)
    kc = k.reshape(B, nc, C, H, dk)
    vc = v.reshape(B, nc, C, H, dv)
    s = jnp.einsum('bnihd,bnjhd->bnhij', qc, kc) * dmask
    o_intra = jnp.einsum('bnhij,bnjhe->bnihe', s, vc)
    kv = jnp.einsum('bnjhd,hj,bnjhe->nbhde', kc, zeta, vc)

    def step(r, kv_n):
        return g_chunk[None, :, None, None] * r + kv_n, r

    _, r_prev = lax.scan(step, jnp.zeros((B, H, dk, dv), jnp.float32), kv)
    o_cross = jnp.einsum('bnihd,hi,nbhde->bnihe', qc, xi, r_prev)
    return (o_intra + o_cross).reshape(B, S, H, dv)


def hier_moe(h, w_gr, b_gr, w_er, b_er, w_gate, w_up, w_down):
    B, S, D = h.shape
    N = B * S
    hf = h.reshape(N, D)
    gl = (hf @ w_gr + b_gr).astype(jnp.float32)
    g_idx = jnp.argmax(gl, axis=-1)
    p_g = jnp.take_along_axis(jax.nn.softmax(gl, axis=-1), g_idx[:, None], axis=1)[:, 0]
    el = (hf @ w_er + b_er).astype(jnp.float32).reshape(N, N_GROUPS, EXPERTS_PER_GROUP)
    el_sel = jnp.take_along_axis(el, g_idx[:, None, None], axis=1)[:, 0]
    top_v, top_i = lax.top_k(el_sel, TOP_K)
    w = jax.nn.softmax(top_v, axis=-1) * p_g[:, None]
    e_flat = (g_idx[:, None] * EXPERTS_PER_GROUP + top_i).reshape(-1).astype(jnp.int32)
    w_flat = w.reshape(-1)
    NK = N * TOP_K
    order = jnp.argsort(e_flat)
    e_s = e_flat[order]
    t_s = (order // TOP_K).astype(jnp.int32)
    w_s = w_flat[order]
    counts = jnp.zeros((N_EXPERTS,), jnp.int32).at[e_flat].add(1)
    padded = ((counts + MOE_BLOCK - 1) // MOE_BLOCK) * MOE_BLOCK
    pad_end = jnp.cumsum(padded)
    pad_start = pad_end - padded
    start = jnp.cumsum(counts) - counts
    dest = pad_start[e_s] + jnp.arange(NK, dtype=jnp.int32) - start[e_s]
    P = NK + N_EXPERTS * MOE_BLOCK
    nblk = P // MOE_BLOCK
    row_tok = jnp.zeros((P,), jnp.int32).at[dest].set(t_s)
    row_w = jnp.zeros((P,), jnp.float32).at[dest].set(w_s)
    blk_expert = jnp.clip(jnp.searchsorted(pad_end, jnp.arange(nblk, dtype=jnp.int32) * MOE_BLOCK, side='right'),
                          0, N_EXPERTS - 1)
    xs = hf[row_tok].reshape(nblk, MOE_BLOCK, D)

    def expert_block(args):
        xb, eid = args
        a = xb @ w_gate[eid]
        u = xb @ w_up[eid]
        return (jax.nn.silu(a) * u) @ w_down[eid]

    ys = lax.map(expert_block, (xs, blk_expert)).reshape(P, D)
    out = jnp.zeros((N, D), h.dtype).at[row_tok].add(ys * row_w[:, None].astype(h.dtype))
    return out.reshape(B, S, D)


def setup_inputs(seed: int = 0) -> dict:
    key = jax.random.key(seed)
    ks = jax.random.split(key, 24)
    nrm = lambda k, shape, fan: jax.random.normal(k, shape, jnp.float32) * fan ** -0.5
    gain = lambda k, shape: 1.0 + 0.02 * jax.random.normal(k, shape, jnp.float32)
    L = DEPTH
    x = jax.random.normal(ks[0], (BATCH, SEQ, D_MODEL), jnp.float32)
    offsets = jax.random.randint(ks[1], (BATCH, 1), 0, 1024, jnp.int32)
    positions = (offsets + jnp.arange(SEQ, dtype=jnp.int32)[None, :]).astype(jnp.int32)
    return {
        "x": x,
        "positions": positions,
        "norm1_g": gain(ks[2], (L, D_MODEL)),
        "w_in": nrm(ks[3], (L, D_MODEL, IN_COLS), D_MODEL),
        "q_norm_g": gain(ks[4], (L, DA_HALF)),
        "k_norm_g": gain(ks[5], (L, DA_HALF)),
        "lambda_q1": 0.1 * jax.random.normal(ks[6], (L, DA_HALF), jnp.float32),
        "lambda_k1": 0.1 * jax.random.normal(ks[7], (L, DA_HALF), jnp.float32),
        "lambda_q2": 0.1 * jax.random.normal(ks[8], (L, DA_HALF), jnp.float32),
        "lambda_k2": 0.1 * jax.random.normal(ks[9], (L, DA_HALF), jnp.float32),
        "diff_subln_g": gain(ks[10], (L, DA_VDIM)),
        "ret_gn_g": gain(ks[11], (L, RET_WIDTH)),
        "ret_gn_b": 0.02 * jax.random.normal(ks[12], (L, RET_WIDTH), jnp.float32),
        "w_branch_a": nrm(ks[13], (L, DA_WIDTH, D_MODEL), DA_WIDTH),
        "w_branch_b": nrm(ks[14], (L, RET_WIDTH, D_MODEL), RET_WIDTH),
        "w_out": nrm(ks[15], (L, D_MODEL, D_MODEL), D_MODEL),
        "norm2_g": gain(ks[16], (L, D_MODEL)),
        "w_group_router": nrm(ks[17], (L, D_MODEL, N_GROUPS), D_MODEL),
        "b_group_router": 0.01 * jax.random.normal(ks[18], (L, N_GROUPS), jnp.float32),
        "w_expert_router": nrm(ks[19], (L, D_MODEL, N_EXPERTS), D_MODEL),
        "b_expert_router": 0.01 * jax.random.normal(ks[20], (L, N_EXPERTS), jnp.float32),
        "w_gate": nrm(ks[21], (L, N_EXPERTS, D_MODEL, EXPERT_FF), D_MODEL),
        "w_up": nrm(ks[22], (L, N_EXPERTS, D_MODEL, EXPERT_FF), D_MODEL),
        "w_down": nrm(ks[23], (L, N_EXPERTS, EXPERT_FF, D_MODEL), EXPERT_FF),
    }


def reference(x, positions, norm1_g, w_in, q_norm_g, k_norm_g, lambda_q1, lambda_k1, lambda_q2, lambda_k2,
              diff_subln_g, ret_gn_g, ret_gn_b, w_branch_a, w_branch_b, w_out, norm2_g,
              w_group_router, b_group_router, w_expert_router, b_expert_router, w_gate, w_up, w_down):
    B, S, D = x.shape
    split_idx = np.cumsum(SPLIT_SIZES)[:-1].tolist()
    for l in range(DEPTH):
        lam_init = 0.8 - 0.6 * math.exp(-0.3 * l)
        h = rms_norm(x, norm1_g[l])
        qa, ka, va, qb, kb, vb, gb, gate_a, gate_b = jnp.split(h @ w_in[l], split_idx, axis=-1)
        qa = apply_rope(rms_norm(qa.reshape(B, S, DA_HEADS, 2, DA_HALF), q_norm_g[l]), positions, ROPE_DIM, ROPE_THETA)
        ka = apply_rope(rms_norm(ka.reshape(B, S, DA_HEADS, 2, DA_HALF), k_norm_g[l]), positions, ROPE_DIM, ROPE_THETA)
        va = va.reshape(B, S, DA_HEADS, DA_VDIM)
        lam = (jnp.exp(jnp.sum(lambda_q1[l].astype(jnp.float32) * lambda_k1[l].astype(jnp.float32)))
               - jnp.exp(jnp.sum(lambda_q2[l].astype(jnp.float32) * lambda_k2[l].astype(jnp.float32)))
               + lam_init)
        oa = rms_norm(diff_attention(qa, ka, va, lam), diff_subln_g[l]) * (1.0 - lam_init)
        ya = oa.reshape(B, S, DA_WIDTH) @ w_branch_a[l]
        qr = apply_rope(qb.reshape(B, S, RET_HEADS, RET_KDIM), positions, RET_KDIM, RET_THETA).astype(jnp.float32)
        kr = apply_rope(kb.reshape(B, S, RET_HEADS, RET_KDIM), positions, RET_KDIM, RET_THETA).astype(jnp.float32) * RET_KDIM ** -0.5
        vr = vb.reshape(B, S, RET_HEADS, RET_VDIM).astype(jnp.float32)
        ob = retention(qr, kr, vr)
        mu = jnp.mean(ob, axis=-1, keepdims=True)
        var = jnp.mean(jnp.square(ob - mu), axis=-1, keepdims=True)
        ob = ((ob - mu) * lax.rsqrt(var + EPS)).reshape(B, S, RET_WIDTH)
        ob = (ob * ret_gn_g[l].astype(jnp.float32) + ret_gn_b[l].astype(jnp.float32)).astype(x.dtype)
        yb = (jax.nn.silu(gb) * ob) @ w_branch_b[l]
        merged = jax.nn.sigmoid(gate_a) * ya + jax.nn.sigmoid(gate_b) * yb
        x = x + merged @ w_out[l]
        h2 = rms_norm(x, norm2_g[l])
        x = x + hier_moe(h2, w_group_router[l], b_group_router[l], w_expert_router[l], b_expert_router[l],
                         w_gate[l], w_up[l], w_down[l])
    return x
```

```cpp
#include <hip/hip_runtime.h>
#include <cstdio>
#include <cstdint>

namespace pg8 {
#define PG8_LAS __attribute__((address_space(3)))
typedef unsigned short bf16_t;
typedef short bf16x8 __attribute__((ext_vector_type(8)));
typedef float f32x4 __attribute__((ext_vector_type(4)));
typedef unsigned u32x4 __attribute__((ext_vector_type(4)));
constexpr int BM = 256, BK = 64, HALF = 128, HTB = HALF * BK * 2  , STAGE_BYTES = 8 * HTB, NXCD = 8, WGM = 8;

__host__ __device__ __forceinline__ int lds_byte(int r, int c) { const int st = (r >> 4) * 2 + (c >> 5), rr = r & 15, cc = c & 31, ob = rr * 64 + cc * 2; return st * 1024 + (ob ^ (((ob >> 9) & 1) << 5)); }
__host__ __device__ __forceinline__ void stage_rc(int b, int& R, int& C) { const int st = b / 1024, sb = b % 1024, swz = sb ^ (((sb >> 9) & 1) << 5); R = (st >> 1) * 16 + swz / 64; C = (st & 1) * 32 + (swz % 64) / 2; }
__host__ __device__ __forceinline__ int perm32(int rho) { const int n = rho >> 4, i = rho & 15; return 8 * (i >> 2) + 4 * n + (i & 3); }

struct Unit { int pm, pn; };
struct Gemm { const bf16_t* A; const bf16_t* Bt; int M, N, K; };

struct StaticOrder {
    int nM, nN, nwg, G, c;
    __host__ __device__ void init(int M, int N, int G_, int c_) { nM = M / BM; nN = N / BM; nwg = nM * nN; G = G_; c = c_; }
    __host__ __device__ bool next(int i, Unit& u) const {
        const long L = (long)i * G + c; if (L >= nwg) return false;
        int wgid = (int)L; { const int q = nwg / NXCD, r = nwg % NXCD, xcd = wgid % NXCD, off = wgid / NXCD; wgid = (xcd < r ? xcd * (q + 1) : r * (q + 1) + (xcd - r) * q) + off; }
        const int nig = WGM * nN, gid = wgid / nig, fm = gid * WGM, gsz = (nM - fm) < WGM ? (nM - fm) : WGM;
        u.pm = fm + ((wgid % nig) % gsz); u.pn = (wgid % nig) / gsz; return true;
    }
    __device__ __forceinline__ void a_ready(const Unit&) const {}
    __device__ __forceinline__ void done(const Unit&) const {}
};

__device__ __forceinline__ unsigned cvt_pk_bf16(float lo, float hi) { unsigned r; asm volatile("v_cvt_pk_bf16_f32 %0, %1, %2" : "=v"(r) : "v"(lo), "v"(hi)); return r; }
typedef float f32x2 __attribute__((ext_vector_type(2)));
__device__ __forceinline__ f32x2 gelu_pk(f32x2 v) {
    const f32x2 av = __builtin_elementwise_abs(v), d = av * 0.2316418882f + 1.0f;
    f32x2 t; t.x = __builtin_amdgcn_rcpf(d.x); t.y = __builtin_amdgcn_rcpf(d.y);
    f32x2 q = t * 0.5307027145f + (-0.7265760135f); q = q * t + 0.7107068705f; q = q * t + (-0.142248368f); q = q * t + 0.127414796f; q = q * t;
    const f32x2 s = (v * v) * (-0.72134752044f);
    f32x2 e; e.x = __builtin_amdgcn_exp2f(s.x); e.y = __builtin_amdgcn_exp2f(s.y);
    const f32x2 m = v * (q * e), r = v - m;
    f32x2 o; o.x = v.x < 0.f ? m.x : r.x; o.y = v.y < 0.f ? m.y : r.y; return o;
}

template <int ACT  > struct EpiBf16 {
    static constexpr bool PERM = true, AFTER_DRAIN = false; static_assert(ACT == 0 || ACT == 1, "EpiBf16: ACT is 0 (none) or 1 (gelu_pk)");
    bf16_t* O; int ldc; const float* bias; int split_cols; size_t split_stride; float scale0;
    __device__ __forceinline__ void operator()(const f32x4 (&acc)[2][2][4][2], const Unit& u, int wr, int wc, int fr, int fq) const {
        const int row0 = u.pm * BM + wr * 64 + fr; int colt = u.pn * BM; bf16_t* base = O;
        float sc = 1.f; if (split_cols) { const int t = colt / split_cols; base += (size_t)t * split_stride; colt -= t * split_cols; if (t == 0) sc = scale0; }
        const int col0 = colt + wc * 32 + 8 * fq, bcol0 = u.pn * BM + wc * 32 + 8 * fq;
        f32x4 bv[2][2];
#pragma unroll
        for (int bj = 0; bj < 2; ++bj)
#pragma unroll
            for (int n = 0; n < 2; ++n) bv[bj][n] = bias ? *(const f32x4*)(bias + bcol0 + bj * HALF + 4 * n) : (f32x4){0.f, 0.f, 0.f, 0.f};
#pragma unroll
        for (int ai = 0; ai < 2; ++ai)
#pragma unroll
            for (int m = 0; m < 4; ++m) { bf16_t* rowp = base + (size_t)(row0 + ai * HALF + m * 16) * ldc + col0;
#pragma unroll
                for (int bj = 0; bj < 2; ++bj) { f32x4 v0 = acc[ai][bj][m][0] + bv[bj][0], v1 = acc[ai][bj][m][1] + bv[bj][1];
                    if (ACT == 1) { f32x2 a = gelu_pk((f32x2){v0[0], v0[1]}), b = gelu_pk((f32x2){v0[2], v0[3]}), c = gelu_pk((f32x2){v1[0], v1[1]}), d = gelu_pk((f32x2){v1[2], v1[3]});
                        v0 = (f32x4){a.x, a.y, b.x, b.y}; v1 = (f32x4){c.x, c.y, d.x, d.y}; }
                    v0 = v0 * sc; v1 = v1 * sc; u32x4 w; w.x = cvt_pk_bf16(v0[0], v0[1]); w.y = cvt_pk_bf16(v0[2], v0[3]); w.z = cvt_pk_bf16(v1[0], v1[1]); w.w = cvt_pk_bf16(v1[2], v1[3]);
                    *(u32x4*)(rowp + bj * HALF) = w; } }
    }
};

template <class Epi, class Sched, bool ALIGN_EPI = false, bool SP2 = false>
__device__ __forceinline__ void gemm_phase(PG8_LAS unsigned char* lds, const Gemm g, const Sched& S, const Epi& E) {
    const int tid = threadIdx.x, wid = __builtin_amdgcn_readfirstlane(tid >> 6), lane = tid & 63, wr = wid >> 2, wc = wid & 3, fr = lane & 15, fq = lane >> 4;
    const int K = g.K, nt = K / BK;
    unsigned voffA[2], voffB[2];
#pragma unroll
    for (int i = 0; i < 2; ++i) { int R, C; stage_rc(tid * 16 + i * 8192, R, C); const int Rb = Epi::PERM ? ((R & ~31) + perm32(R & 31)) : R;
        voffA[i] = (unsigned)(R * K + C) * 2u; voffB[i] = (unsigned)(Rb * K + C) * 2u; }
    const size_t kstep = (size_t)(BK * 2);
    const size_t hstep = (size_t)HALF * K * 2;
    const size_t tstep = 2 * hstep;
    const unsigned ldsw = (unsigned)wid * 1024u;
    const int aoff = lds_byte(wr * 64 + fr, fq * 8), boff = lds_byte(wc * 32 + fr, fq * 8);
#define PG8_SA(b, h) (((b) * 2 + (h)) * HTB)
#define PG8_SB(b, h) ((4 + (b) * 2 + (h)) * HTB)
#define PG8_STAGE(bufoff, gbase, voff) do { _Pragma("unroll") for (int _i = 0; _i < 2; ++_i) \
        __builtin_amdgcn_global_load_lds((const unsigned*)((const char*)(gbase) + (voff)[_i]), (PG8_LAS unsigned*)(lds + (bufoff) + ldsw + _i * 8192), 16, 0, 0); } while (0)
#define PG8_LDA(dst, b, h) do { _Pragma("unroll") for (int m = 0; m < 4; ++m) _Pragma("unroll") for (int k = 0; k < 2; ++k) dst[m][k] = *(const PG8_LAS bf16x8*)(lds + PG8_SA(b, h) + aoff + m * 2048 + k * 1024); } while (0)
#define PG8_LDB(dst, b, h) do { _Pragma("unroll") for (int n = 0; n < 2; ++n) _Pragma("unroll") for (int k = 0; k < 2; ++k) dst[n][k] = *(const PG8_LAS bf16x8*)(lds + PG8_SB(b, h) + boff + n * 2048 + k * 1024); } while (0)
#define PG8_MMA(ai, bj, At, Bt) do { __builtin_amdgcn_s_setprio(1); _Pragma("unroll") for (int m = 0; m < 4; ++m) _Pragma("unroll") for (int n = 0; n < 2; ++n) _Pragma("unroll") for (int k = 0; k < 2; ++k) \
        acc[ai][bj][m][n] = __builtin_amdgcn_mfma_f32_16x16x32_bf16(Bt[n][k], At[m][k], acc[ai][bj][m][n], 0, 0, 0); __builtin_amdgcn_s_setprio(0); } while (0)
#define PG8_WAIT_V(n) asm volatile("s_waitcnt vmcnt(" #n ")" ::: "memory")
#define PG8_WAIT_L(n) asm volatile("s_waitcnt lgkmcnt(" #n ")" ::: "memory")
#define PG8_BAR __builtin_amdgcn_s_barrier()
#define PG8_SCHED __builtin_amdgcn_sched_barrier(0)
    Unit cur, nxt; int ui = 0;
    if (!S.next(0, cur)) return;
    f32x4 acc[2][2][4][2];
#pragma unroll
    for (int a = 0; a < 2; ++a)
#pragma unroll
        for (int b = 0; b < 2; ++b)
#pragma unroll
            for (int m = 0; m < 4; ++m)
#pragma unroll
                for (int n = 0; n < 2; ++n) acc[a][b][m][n] = (f32x4){0.f, 0.f, 0.f, 0.f};
    bf16x8 At[4][2], B0[2][2], B1[2][2];
    const char* cA = (const char*)g.A + (size_t)cur.pm * tstep; const char* cB = (const char*)g.Bt + (size_t)cur.pn * tstep;
    S.a_ready(cur);
    if constexpr (SP2) {
        PG8_STAGE(PG8_SB(0, 0), cB, voffB); PG8_STAGE(PG8_SB(0, 1), cB + hstep, voffB); PG8_STAGE(PG8_SA(0, 0), cA, voffA); PG8_STAGE(PG8_SA(0, 1), cA + hstep, voffA);
        if (wr == 1) PG8_BAR;
        PG8_WAIT_V(2); PG8_BAR;
        PG8_STAGE(PG8_SB(1, 0), cB + kstep, voffB); PG8_STAGE(PG8_SA(1, 0), cA + kstep, voffA); PG8_STAGE(PG8_SB(1, 1), cB + hstep + kstep, voffB);
        PG8_WAIT_V(6); PG8_BAR;
    } else {
        PG8_STAGE(PG8_SB(0, 0), cB, voffB); PG8_STAGE(PG8_SA(0, 0), cA, voffA); PG8_STAGE(PG8_SB(0, 1), cB + hstep, voffB); PG8_STAGE(PG8_SA(0, 1), cA + hstep, voffA);
        if (wr == 1) PG8_BAR;
        PG8_WAIT_V(4); PG8_BAR;
        PG8_STAGE(PG8_SB(1, 0), cB + kstep, voffB); PG8_STAGE(PG8_SA(1, 0), cA + kstep, voffA); PG8_STAGE(PG8_SB(1, 1), cB + hstep + kstep, voffB);
        PG8_WAIT_V(6); PG8_BAR;
    }
    for (;;) {
        const bool has_next = S.next(ui + 1, nxt);
        const char* nA = has_next ? (const char*)g.A + (size_t)nxt.pm * tstep : cA; const char* nB = has_next ? (const char*)g.Bt + (size_t)nxt.pn * tstep : cB;
        for (int t = 0; t < nt; t += 2) {
            const bool last = (t == nt - 2);
            const char* a1 = cA + (size_t)(t + 1) * kstep;
            const char* a2 = last ? nA : cA + (size_t)(t + 2) * kstep; const char* b2 = last ? nB : cB + (size_t)(t + 2) * kstep;
            const char* a3 = a2 + kstep; const char* b3 = b2 + kstep;
            if (last && has_next) S.a_ready(nxt);
            if constexpr (SP2) {
            PG8_LDB(B0, 0, 0); PG8_LDB(B1, 0, 1); PG8_SCHED; PG8_LDA(At, 0, 0); PG8_STAGE(PG8_SA(1, 1), a1 + hstep, voffA);
            PG8_WAIT_V(8); PG8_WAIT_L(0); PG8_BAR; PG8_MMA(0, 0, At, B0); PG8_MMA(0, 1, At, B1); PG8_BAR; PG8_SCHED;
            PG8_LDA(At, 0, 1); PG8_STAGE(PG8_SB(0, 0), b2, voffB); PG8_STAGE(PG8_SB(0, 1), b2 + hstep, voffB); PG8_STAGE(PG8_SA(0, 0), a2, voffA);
            PG8_WAIT_V(8); PG8_WAIT_L(0); PG8_BAR; PG8_MMA(1, 0, At, B0); PG8_MMA(1, 1, At, B1); PG8_BAR; PG8_SCHED;
            PG8_LDB(B0, 1, 0); PG8_LDB(B1, 1, 1); PG8_SCHED; PG8_LDA(At, 1, 0); PG8_STAGE(PG8_SA(0, 1), a2 + hstep, voffA);
            PG8_WAIT_V(8); PG8_WAIT_L(0); PG8_BAR; PG8_MMA(0, 0, At, B0); PG8_MMA(0, 1, At, B1); PG8_BAR; PG8_SCHED;
            PG8_LDA(At, 1, 1); PG8_STAGE(PG8_SB(1, 0), b3, voffB); PG8_STAGE(PG8_SB(1, 1), b3 + hstep, voffB); PG8_STAGE(PG8_SA(1, 0), a3, voffA);
            PG8_WAIT_V(8); PG8_WAIT_L(0); PG8_BAR; PG8_MMA(1, 0, At, B0); PG8_MMA(1, 1, At, B1); PG8_BAR; PG8_SCHED;
            } else {
            PG8_LDB(B0, 0, 0); PG8_SCHED; PG8_LDA(At, 0, 0); PG8_STAGE(PG8_SA(1, 1), a1 + hstep, voffA);
            PG8_WAIT_L(8); PG8_BAR; PG8_WAIT_L(0); PG8_MMA(0, 0, At, B0); PG8_BAR; PG8_SCHED;
            PG8_LDB(B1, 0, 1); PG8_STAGE(PG8_SB(0, 0), b2, voffB);
            PG8_BAR; PG8_WAIT_L(0); PG8_MMA(0, 1, At, B1); PG8_BAR;
            PG8_LDA(At, 0, 1); PG8_STAGE(PG8_SA(0, 0), a2, voffA);
            PG8_BAR; PG8_WAIT_L(0); PG8_MMA(1, 0, At, B0); PG8_BAR; PG8_SCHED;
            PG8_STAGE(PG8_SB(0, 1), b2 + hstep, voffB);
            PG8_WAIT_V(6); PG8_BAR; PG8_MMA(1, 1, At, B1); PG8_BAR;
            PG8_LDB(B0, 1, 0); PG8_SCHED; PG8_LDA(At, 1, 0); PG8_STAGE(PG8_SA(0, 1), a2 + hstep, voffA);
            PG8_WAIT_L(8); PG8_BAR; PG8_WAIT_L(0); PG8_MMA(0, 0, At, B0); PG8_BAR; PG8_SCHED;
            PG8_LDB(B1, 1, 1); PG8_STAGE(PG8_SB(1, 0), b3, voffB);
            PG8_BAR; PG8_WAIT_L(0); PG8_MMA(0, 1, At, B1); PG8_BAR;
            PG8_LDA(At, 1, 1); PG8_STAGE(PG8_SA(1, 0), a3, voffA);
            PG8_BAR; PG8_WAIT_L(0); PG8_MMA(1, 0, At, B0); PG8_BAR; PG8_SCHED;
            PG8_STAGE(PG8_SB(1, 1), b3 + hstep, voffB);
            PG8_WAIT_V(6); PG8_BAR; PG8_MMA(1, 1, At, B1); PG8_BAR;
            }
        }
        if constexpr (ALIGN_EPI) { if (wr == 0) PG8_BAR; }
        if constexpr (!Epi::AFTER_DRAIN) { E(acc, cur, wr, wc, fr, fq); S.done(cur); }
        if (!has_next) break;
#pragma unroll
        for (int a = 0; a < 2; ++a)
#pragma unroll
            for (int b = 0; b < 2; ++b)
#pragma unroll
                for (int m = 0; m < 4; ++m)
#pragma unroll
                    for (int n = 0; n < 2; ++n) acc[a][b][m][n] = (f32x4){0.f, 0.f, 0.f, 0.f};
        cur = nxt; cA = nA; cB = nB; ++ui;
        if constexpr (ALIGN_EPI) { if (wr == 1) PG8_BAR; }
    }
    PG8_WAIT_V(0);
    if constexpr (!ALIGN_EPI) { if (wr == 0) PG8_BAR; }
    PG8_BAR;
    if constexpr (Epi::AFTER_DRAIN) { E.fused(acc, cur, wr, wc, fr, fq, lds, wid, lane); S.done(cur); }
#undef PG8_SA
#undef PG8_SB
#undef PG8_STAGE
#undef PG8_LDA
#undef PG8_LDB
#undef PG8_MMA
#undef PG8_WAIT_V
#undef PG8_WAIT_L
#undef PG8_BAR
#undef PG8_SCHED
}
}

#ifndef PG8_SP2
#define PG8_SP2 true
#endif

#include <hip/hip_bf16.h>
#include <cmath>
namespace attn_body {
using bf16=__hip_bfloat16;
using bf16x8=__attribute__((ext_vector_type(8)))short;
using s16x4=__attribute__((ext_vector_type(4)))short;
using f32x16=__attribute__((ext_vector_type(16)))float;
using u32x4=__attribute__((ext_vector_type(4)))unsigned;
constexpr int BATCH=4,NHEAD=16,SEQ=4096,D=64,PQ=512,PO=1024;
constexpr int NW=8,QBLK=32,QB=QBLK*NW,KVBLK=64,NQB=SEQ/QB;
constexpr int ATTN_UNIT_ROWS=QB;
__device__ __forceinline__ int crow(int r,int hi){return (r&3)+8*(r>>2)+4*hi;}
#define SBAR() __builtin_amdgcn_sched_barrier(0)
__device__ __forceinline__ void cmask(f32x16&p0,f32x16&p1,int jb,int qrel,int hi){
  const float NEG=-INFINITY; int kb=64*jb+4*hi;
  #pragma unroll
  for(int r=0;r<16;++r){int kv=kb+(r&3)+8*(r>>2); if(kv>qrel)p0[r]=NEG; if(kv+32>qrel)p1[r]=NEG;}
}

constexpr int NSLOT=3, SLOTB=8192;
constexpr int LDS_K=0, LDS_V=NSLOT*SLOTB, LDS_WS=2*NSLOT*SLOTB, LDS_OST=LDS_WS+NW*64*4, LDS_BYTES=LDS_OST+NW*4096;
constexpr float C2=0.125f*1.4426950408889634f;
__device__ __forceinline__ void glds16(const void*gsrc,unsigned lds_dst){unsigned keep;
  asm volatile("s_mov_b32 %0, m0\n\ts_mov_b32 m0, %2\n\ts_nop 0\n\tglobal_load_lds_dwordx4 %1, off\n\ts_mov_b32 m0, %0":"=&s"(keep):"v"(gsrc),"s"(lds_dst):"memory");}
__device__ __forceinline__ float max3f(float a,float b,float c){float r;asm("v_max3_f32 %0, %1, %2, %3":"=v"(r):"v"(a),"v"(b),"v"(c));return r;}
__device__ __forceinline__ float max2f(float a,float b){float r;asm("v_max_f32_e32 %0, %1, %2":"=v"(r):"v"(a),"v"(b));return r;}
__device__ __forceinline__ float fadd_s(float a,float b){float r;asm("v_add_f32_e32 %0, %1, %2":"=v"(r):"v"(a),"v"(b));return r;}
__device__ __forceinline__ float fsub_s(float a,float b){float r;asm("v_sub_f32_e32 %0, %1, %2":"=v"(r):"v"(a),"v"(b));return r;}
typedef float f32x2_t __attribute__((ext_vector_type(2))); typedef __bf16 bf16x2_t __attribute__((ext_vector_type(2)));
__device__ __forceinline__ unsigned cvtpk_s(float lo,float hi){f32x2_t v={lo,hi};bf16x2_t b=__builtin_convertvector(v,bf16x2_t);return __builtin_bit_cast(unsigned,b);}
#define WAIT_BAR(N) asm volatile("s_waitcnt vmcnt(" #N ") lgkmcnt(0)\n\ts_barrier":::"memory")

__device__ __forceinline__ void qkt(f32x16&p0,f32x16&p1,const char*Kslot,const bf16x8*qr,const f32x16&negm,int r32,int hi){
  const char*kb=Kslot+hi*1024+r32*16;
  #pragma unroll
  for(int d0=0;d0<4;++d0){
    const bf16x8 b0=*reinterpret_cast<const bf16x8*>(kb+d0*2048);
    const bf16x8 b1=*reinterpret_cast<const bf16x8*>(kb+d0*2048+512);
    if(d0==0){p0=__builtin_amdgcn_mfma_f32_32x32x16_bf16(b0,qr[0],negm,0,0,0);p1=__builtin_amdgcn_mfma_f32_32x32x16_bf16(b1,qr[0],negm,0,0,0);}
    else{p0=__builtin_amdgcn_mfma_f32_32x32x16_bf16(b0,qr[d0],p0,0,0,0);p1=__builtin_amdgcn_mfma_f32_32x32x16_bf16(b1,qr[d0],p1,0,0,0);}}
}
typedef __attribute__((address_space(3))) const char* lds_cptr;
typedef short v4i16_t __attribute__((ext_vector_type(4)));
__device__ __forceinline__ void kload8(bf16x8*kf,lds_cptr kp){
  kf[0]=*(const __attribute__((address_space(3))) bf16x8*)(kp);      kf[1]=*(const __attribute__((address_space(3))) bf16x8*)(kp+512);
  kf[2]=*(const __attribute__((address_space(3))) bf16x8*)(kp+2048); kf[3]=*(const __attribute__((address_space(3))) bf16x8*)(kp+2560);
  kf[4]=*(const __attribute__((address_space(3))) bf16x8*)(kp+4096); kf[5]=*(const __attribute__((address_space(3))) bf16x8*)(kp+4608);
  kf[6]=*(const __attribute__((address_space(3))) bf16x8*)(kp+6144); kf[7]=*(const __attribute__((address_space(3))) bf16x8*)(kp+6656);
}
__device__ __forceinline__ void kload2(bf16x8*kf,lds_cptr kp,int j){ kf[2*j]=*(const __attribute__((address_space(3))) bf16x8*)(kp+j*2048); kf[2*j+1]=*(const __attribute__((address_space(3))) bf16x8*)(kp+j*2048+512); }
__device__ __forceinline__ s16x4 vtr(lds_cptr p){ return __builtin_bit_cast(s16x4,__builtin_amdgcn_ds_read_tr16_b64_v4i16((__attribute__((address_space(3))) v4i16_t*)p)); }
__device__ __forceinline__ float rowmax(const f32x16&p0,const f32x16&p1){
  float a=max3f(p0[0],p0[1],p1[0]),b=max3f(p0[2],p0[3],p1[1]);a=max3f(a,p1[2],p1[3]);
  #pragma unroll
  for(int r=4;r<16;r+=4){a=max3f(a,p0[r],p0[r+1]);b=max3f(b,p0[r+2],p0[r+3]);a=max3f(a,p1[r],p1[r+1]);b=max3f(b,p1[r+2],p1[r+3]);}
  const float m=max2f(a,b);
  auto rr=__builtin_amdgcn_permlane32_swap(__float_as_uint(m),__float_as_uint(m),false,false);
  return max2f(__uint_as_float(rr[0]),__uint_as_float(rr[1]));
}
__device__ __forceinline__ void pv(f32x16*o,int vb,bf16x8 pa0,bf16x8 pa1,bf16x8 pa2,bf16x8 pa3){
  #pragma unroll
  for(int d0=0;d0<2;++d0){s16x4 lo[4],hi[4];
    #pragma unroll
    for(int ks=0;ks<4;++ks){
      asm volatile("ds_read_b64_tr_b16 %0,%1 offset:%c2":"=&v"(lo[ks]):"v"(vb),"i"(d0*4096+ks*1024):"memory");
      asm volatile("ds_read_b64_tr_b16 %0,%1 offset:%c2":"=&v"(hi[ks]):"v"(vb),"i"(d0*4096+ks*1024+512):"memory");}
    asm volatile("s_waitcnt lgkmcnt(0)":::"memory");SBAR();
    #define PK(k) (bf16x8){lo[k][0],lo[k][1],lo[k][2],lo[k][3],hi[k][0],hi[k][1],hi[k][2],hi[k][3]}
    o[d0]=__builtin_amdgcn_mfma_f32_32x32x16_bf16(pa0,PK(0),o[d0],0,0,0);
    o[d0]=__builtin_amdgcn_mfma_f32_32x32x16_bf16(pa1,PK(1),o[d0],0,0,0);
    o[d0]=__builtin_amdgcn_mfma_f32_32x32x16_bf16(pa2,PK(2),o[d0],0,0,0);
    o[d0]=__builtin_amdgcn_mfma_f32_32x32x16_bf16(pa3,PK(3),o[d0],0,0,0);
    #undef PK
  }
}

#ifndef ATTN_STORE16
#define ATTN_STORE16(p,v) (*(u32x4*)(p)=(v))
#endif
template<int THRL> __device__ __forceinline__ void attn_unit(int b,int h,int qb,const bf16*Q,const bf16*__restrict__ K,const bf16*__restrict__ V,bf16*O,char*shm){
  const int tid=threadIdx.x,lane=tid&63,r32=lane&31,hi=lane>>5; const int wid=__builtin_amdgcn_readfirstlane(tid>>6);
  const long rowbase=(long)b*SEQ; const int q0=qb*QB;
  const int qkc=(h>>1)*D, vcol=(h>>2)*128+(h&1)*D;
  const bf16*Qw=Q+(rowbase+q0+wid*QBLK)*PQ+qkc;
  const bf16*Kh=K+rowbase*PQ+qkc,*Vh=V+rowbase*PQ+vcol;
  const unsigned lds0=(unsigned)(uintptr_t)shm;
  float*wsf=(float*)(shm+LDS_WS)+wid*64;
  const bf16*ksrc=Kh+(long)lane*PQ+wid*8;
  const bf16*vsrc=Vh+(long)(16*(wid&3)+(lane>>2))*PQ+(wid>>2)*32+(lane&3)*8;
  const unsigned kdst=lds0+LDS_K+wid*1024, vdst=lds0+LDS_V+wid*1024;
  #define DMA_K(t,slot) glds16(ksrc+(long)(t)*KVBLK*PQ,(unsigned)__builtin_amdgcn_readfirstlane(kdst+(slot)))
  #define DMA_V(t,slot) glds16(vsrc+(long)(t)*KVBLK*PQ,(unsigned)__builtin_amdgcn_readfirstlane(vdst+(slot)))
  const int vb0=(int)(lds0+LDS_V)+((lane>>4)&1)*32+(lane&3)*8+(4*hi+((lane&15)>>2))*64;
  const char*Kbase=shm+LDS_K; bf16x8 kf[8];
  const lds_cptr shm3=(lds_cptr)shm; const lds_cptr kp0=shm3+LDS_K+hi*1024+r32*16; const lds_cptr vp0=shm3+LDS_V+((lane>>4)&1)*32+(lane&3)*8+(4*hi+((lane&15)>>2))*64;
  const int NT=(q0+QB)/KVBLK;
  DMA_K(0,0);DMA_V(0,0);DMA_K(1,SLOTB);
  bf16x8 qr[4];
  #pragma unroll
  for(int d0=0;d0<4;++d0)qr[d0]=*reinterpret_cast<const bf16x8*>(&Qw[(long)r32*PQ+d0*16+hi*8]);
  float mhat=0.f,l_reg=0.f;f32x16 o[2];o[0]=f32x16{};o[1]=f32x16{};f32x16 negm=f32x16{};asm volatile("":"+v"(negm));
  const int qrel=wid*QBLK+r32;
  #define CMASK(P0,P1,t) do{int jb_=(t)-(NT-4); if(jb_>=0)cmask(P0,P1,jb_,qrel,hi);}while(0)
  bool resc=false;
  #define START(P0,P1) do{ const float rm=rowmax(P0,P1); resc=false; \
    { const float dl=rm; mhat=fadd_s(mhat,dl); \
      _Pragma("unroll") for(int r=0;r<16;++r){P0[r]=fsub_s(P0[r],dl);P1[r]=fsub_s(P1[r],dl);} \
      _Pragma("unroll") for(int r=0;r<16;++r)negm[r]=-mhat; asm volatile("":"+v"(negm)); } \
    _Pragma("unroll") for(int r=0;r<16;++r)P0[r]=__builtin_amdgcn_exp2f(P0[r]); }while(0)
  #define RESC() do{ if(resc){ asm volatile("s_waitcnt lgkmcnt(0)":::"memory"); \
      _Pragma("unroll") for(int d_=0;d_<2;++d_) _Pragma("unroll") for(int r=0;r<16;++r)o[d_][r]*=wsf[crow(r,hi)]; } }while(0)
  f32x16 pA0,pA1,pB0,pB1;
  int sl_prev=0,sl_cur=0,sl_next=SLOTB;
  #define ROT() do{sl_prev=sl_cur;sl_cur=sl_next;sl_next=(sl_next==(NSLOT-1)*SLOTB)?0:sl_next+SLOTB;}while(0)
  DMA_K(2,2*SLOTB);
  WAIT_BAR(3);
  qkt(pA0,pA1,Kbase,qr,negm,r32,hi);asm volatile("s_nop 15\n\ts_nop 7":"+v"(pA0),"+v"(pA1));CMASK(pA0,pA1,0);
  START(pA0,pA1);
  _Pragma("unroll") for(int r=0;r<16;++r)pA1[r]=__builtin_amdgcn_exp2f(pA1[r]);
  WAIT_BAR(0);
  DMA_K(3,0);DMA_V(1,SLOTB);
  ROT();
  kload8(kf,kp0+sl_cur);
  WAIT_BAR(2);
  s16x4 vlo[8],vhi[8]; u32x4 pw0,pw1,pw2,pw3;
  #define PKW(P,B) cvtpk_s(P[B],P[B+1])
  #define PAF(k) __builtin_bit_cast(bf16x8,pw##k)
  #define VFR(i) (bf16x8){vlo[i][0],vlo[i][1],vlo[i][2],vlo[i][3],vhi[i][0],vhi[i][1],vhi[i][2],vhi[i][3]}
  #define PIN(x) asm volatile("":"+v"(x))
  #define MX3(a,b,c) __builtin_fmaxf(__builtin_fmaxf((a),(b)),(c))
  #define GAPA(MF,A0,A1,A2,A3,W0,W1,PW) do{ MF; sacc+=A0; sacc+=A1; sacc+=A2; sacc+=A3; PIN(sacc); W0; W1; PIN(PW); SBAR(); }while(0)
  #define EX(v) __builtin_amdgcn_exp2f(v)
  #define GAPB(MF,X,B) do{ MF; X[B]=EX(X[B]); X[B+1]=EX(X[B+1]); X[B+2]=EX(X[B+2]); X[B+3]=EX(X[B+3]); PIN(X); SBAR(); }while(0)
  #define VRD(i) do{ vlo[i]=vtr(vp_+(((i)>>2)*4096+((i)&3)*1024)); vhi[i]=vtr(vp_+(((i)>>2)*4096+((i)&3)*1024+512)); }while(0)
  #define KRD(G,j) do{ if(G){ kload2(kf,kp0+sl_next,j); SBAR(); } }while(0)
  #define STEP(C0,C1,P0,P1,t,GK,GV,GL) do{ SBAR(); \
    const lds_cptr vp_=vp0+sl_prev; \
    VRD(0); SBAR(); float sacc=(P0[0]+P0[1]); \
    GAPA(C0=__builtin_amdgcn_mfma_f32_32x32x16_bf16(kf[0],qr[0],negm,0,0,0), P0[2],P0[3],P0[4],P0[5],     pw0[0]=PKW(P0,0), pw0[1]=PKW(P0,2), pw0); \
    VRD(4); SBAR(); GAPA(C1=__builtin_amdgcn_mfma_f32_32x32x16_bf16(kf[1],qr[0],negm,0,0,0), P0[6],P0[7],P0[8],P0[9],     pw0[2]=PKW(P0,4), pw0[3]=PKW(P0,6), pw0); \
    VRD(1); SBAR(); GAPA(C0=__builtin_amdgcn_mfma_f32_32x32x16_bf16(kf[2],qr[1],C0,0,0,0),   P0[10],P0[11],P0[12],P0[13], pw1[0]=PKW(P0,8), pw1[1]=PKW(P0,10), pw1); \
    VRD(5); SBAR(); GAPA(C1=__builtin_amdgcn_mfma_f32_32x32x16_bf16(kf[3],qr[1],C1,0,0,0),   P0[14],P0[15],P1[0],P1[1],   pw1[2]=PKW(P0,12),pw1[3]=PKW(P0,14), pw1); \
    VRD(2); SBAR(); GAPA(C0=__builtin_amdgcn_mfma_f32_32x32x16_bf16(kf[4],qr[2],C0,0,0,0),   P1[2],P1[3],P1[4],P1[5],     pw2[0]=PKW(P1,0), pw2[1]=PKW(P1,2), pw2); \
    VRD(6); SBAR(); GAPA(C1=__builtin_amdgcn_mfma_f32_32x32x16_bf16(kf[5],qr[2],C1,0,0,0),   P1[6],P1[7],P1[8],P1[9],     pw2[2]=PKW(P1,4), pw2[3]=PKW(P1,6), pw2); \
    VRD(3); SBAR(); GAPA(C0=__builtin_amdgcn_mfma_f32_32x32x16_bf16(kf[6],qr[3],C0,0,0,0),   P1[10],P1[11],P1[12],P1[13], pw3[0]=PKW(P1,8), pw3[1]=PKW(P1,10), pw3); \
    VRD(7); SBAR(); GAPA(C1=__builtin_amdgcn_mfma_f32_32x32x16_bf16(kf[7],qr[3],C1,0,0,0),   P1[14],P1[15],0.f,0.f,       pw3[2]=PKW(P1,12),pw3[3]=PKW(P1,14), pw3); \
    l_reg+=sacc; \
    if(GK){DMA_K((t)+3,sl_cur);} if(GV){DMA_V((t)+1,sl_next);} \
    CMASK(C0,C1,t); \
    { float a=MX3(C0[0],C0[1],C1[0]),b=MX3(C0[2],C0[3],C1[1]); a=MX3(a,C1[2],C1[3]); \
      _Pragma("unroll") for(int r=4;r<16;r+=4){a=MX3(a,C0[r],C0[r+1]);b=MX3(b,C0[r+2],C0[r+3]);a=MX3(a,C1[r],C1[r+1]);b=MX3(b,C1[r+2],C1[r+3]);} \
      float rm=__builtin_fmaxf(a,b); { auto rr=__builtin_amdgcn_permlane32_swap(__float_as_uint(rm),__float_as_uint(rm),false,false); rm=__builtin_fmaxf(__uint_as_float(rr[0]),__uint_as_float(rr[1])); } \
      resc=false; \
      if(__builtin_expect(__any(rm>(float)THRL),0)){ const float dl=__builtin_fmaxf(rm,0.f); mhat+=dl; \
        _Pragma("unroll") for(int r=0;r<16;++r){C0[r]-=dl;C1[r]-=dl;} \
        _Pragma("unroll") for(int r=0;r<16;++r)negm[r]=-mhat; asm volatile("":"+v"(negm)); \
        const float f=__builtin_amdgcn_exp2f(-dl); l_reg*=f; if(hi==0)wsf[r32]=f; resc=true; } } \
    SBAR(); \
    GAPB(o[0]=__builtin_amdgcn_mfma_f32_32x32x16_bf16(PAF(0),VFR(0),o[0],0,0,0), C0,0); \
    GAPB(o[1]=__builtin_amdgcn_mfma_f32_32x32x16_bf16(PAF(0),VFR(4),o[1],0,0,0), C0,4); \
    KRD(GL,0); GAPB(o[0]=__builtin_amdgcn_mfma_f32_32x32x16_bf16(PAF(1),VFR(1),o[0],0,0,0), C0,8); \
    KRD(GL,1); GAPB(o[1]=__builtin_amdgcn_mfma_f32_32x32x16_bf16(PAF(1),VFR(5),o[1],0,0,0), C0,12); \
    KRD(GL,2); GAPB(o[0]=__builtin_amdgcn_mfma_f32_32x32x16_bf16(PAF(2),VFR(2),o[0],0,0,0), C1,0); \
    KRD(GL,3); GAPB(o[1]=__builtin_amdgcn_mfma_f32_32x32x16_bf16(PAF(2),VFR(6),o[1],0,0,0), C1,4); \
    GAPB(o[0]=__builtin_amdgcn_mfma_f32_32x32x16_bf16(PAF(3),VFR(3),o[0],0,0,0), C1,8); \
    GAPB(o[1]=__builtin_amdgcn_mfma_f32_32x32x16_bf16(PAF(3),VFR(7),o[1],0,0,0), C1,12); \
    }while(0)
  int t=1;
  #undef CMASK
  #define CMASK(P0,P1,t) do{}while(0)
  for(;t+5<NT;t+=2){
    STEP(pB0,pB1,pA0,pA1,t,true,true,true);     WAIT_BAR(2); RESC(); ROT();
    STEP(pA0,pA1,pB0,pB1,t+1,true,true,true);   WAIT_BAR(2); RESC(); ROT();
  }
  #undef CMASK
  #define CMASK(P0,P1,t) do{int jb_=(t)-(NT-4); if(jb_>=0)cmask(P0,P1,jb_,qrel,hi);}while(0)
  #define ENDW(tt) do{ if((tt)+3<NT){WAIT_BAR(2);} else if((tt)+2<NT){WAIT_BAR(1);} else {WAIT_BAR(0);} }while(0)
  for(;t+1<NT;t+=2){
    STEP(pB0,pB1,pA0,pA1,t,(t+3<NT),(t+1<NT),(t+1<NT));       ENDW(t);   RESC(); ROT();
    STEP(pA0,pA1,pB0,pB1,t+1,(t+4<NT),(t+2<NT),(t+2<NT));     ENDW(t+1); RESC(); ROT();
  }
  STEP(pB0,pB1,pA0,pA1,NT-1,false,false,false); RESC();
  { float sacc=pB0[0]+pB0[1]; _Pragma("unroll") for(int r=2;r<16;++r)sacc+=pB0[r]; _Pragma("unroll") for(int r=0;r<16;++r)sacc+=pB1[r]; l_reg+=sacc;
    pw0=(u32x4){PKW(pB0,0),PKW(pB0,2),PKW(pB0,4),PKW(pB0,6)};pw1=(u32x4){PKW(pB0,8),PKW(pB0,10),PKW(pB0,12),PKW(pB0,14)};pw2=(u32x4){PKW(pB1,0),PKW(pB1,2),PKW(pB1,4),PKW(pB1,6)};pw3=(u32x4){PKW(pB1,8),PKW(pB1,10),PKW(pB1,12),PKW(pB1,14)};
    SBAR(); pv(o,vb0+sl_cur,PAF(0),PAF(1),PAF(2),PAF(3)); }
  #undef PKW
  #undef PAF
  #undef VFR
  #undef PIN
  #undef MX3
  #undef GAPA
  #undef GAPB
  #undef EX
  #undef VRD
  #undef KRD
  #undef STEP
  #undef ENDW
  {auto rr=__builtin_amdgcn_permlane32_swap(__float_as_uint(l_reg),__float_as_uint(l_reg),false,false);l_reg=__uint_as_float(rr[0])+__uint_as_float(rr[1]);}
  if(hi==0)wsf[32+r32]=l_reg;asm volatile("s_waitcnt lgkmcnt(0)":::"memory");
  float rli[16];
  #pragma unroll
  for(int r=0;r<16;++r)rli[r]=__builtin_amdgcn_rcpf(wsf[32+crow(r,hi)]);
  bf16*Ow=O+(rowbase+q0+wid*QBLK)*PO+h*D;
  { bf16*stg=(bf16*)(shm+LDS_OST)+wid*2048;
    #pragma unroll
    for(int r=0;r<16;++r){const int orow=crow(r,hi);
      #pragma unroll
      for(int d0=0;d0<2;++d0)stg[orow*64+d0*32+r32]=__float2bfloat16(o[d0][r]*rli[r]);}
    asm volatile("s_waitcnt lgkmcnt(0)":::"memory");
    #pragma unroll
    for(int i=0;i<4;++i){const int row=i*8+(lane>>3),ch=lane&7; const u32x4 v=*(const u32x4*)(stg+row*64+ch*8); ATTN_STORE16(Ow+(long)row*PO+ch*8,v);} }
  asm volatile("s_waitcnt lgkmcnt(0)\n\ts_barrier":::"memory");
  #undef DMA_K
  #undef DMA_V
  #undef CMASK
  #undef START
  #undef RESC
  #undef ROT
}
constexpr int ATTN_LDS_BYTES=LDS_BYTES;
struct AttnTensors { const bf16* Q; const bf16* K; const bf16* V; bf16* O; };
struct AttnUnit { int bh; int qb; };
struct StaticOrder {
  int vcu;
  __device__ __forceinline__ explicit StaticOrder(int grid,int block):vcu((block%8)*(grid/8)+block/8){}
  __device__ __forceinline__ bool next(int i,AttnUnit&u)const{ if(i>=4)return false; const int s=vcu&3; u.bh=vcu>>2; u.qb=(i==0)?s:(i==1)?7-s:(i==2)?8+s:15-s; return true; }
  __device__ __forceinline__ void a_ready(const AttnUnit&)const{}
  __device__ __forceinline__ void done(const AttnUnit&)const{}
};
template<class Sched,int THRL=8> __device__ __forceinline__ void attn_phase(char*lds,const AttnTensors&T,const Sched&S){
  AttnUnit u;
  for(int i=0;S.next(i,u);++i){ S.a_ready(u); attn_unit<THRL>(u.bh/NHEAD,u.bh%NHEAD,u.qb,T.Q,T.K,T.V,T.O,lds); S.done(u); }
}
#undef SBAR
#undef WAIT_BAR
}

#define GAS __attribute__((address_space(1)))
#define LAS __attribute__((address_space(3)))
typedef unsigned short bf16;
typedef unsigned v4u __attribute__((ext_vector_type(4)));
typedef float f32x4 __attribute__((ext_vector_type(4)));
typedef short bf16x8 __attribute__((ext_vector_type(8)));
typedef GAS unsigned gu32;
typedef GAS unsigned long long gu64;
#define RLX_AGENT __ATOMIC_RELAXED, __HIP_MEMORY_SCOPE_AGENT
#define LDS_WAIT() asm volatile("s_waitcnt lgkmcnt(0)" ::: "memory")
#define VM_WAIT() asm volatile("s_waitcnt vmcnt(0)" ::: "memory")
__device__ __forceinline__ unsigned long long rt() { return __builtin_amdgcn_s_memrealtime(); }
__device__ __forceinline__ unsigned f2bf(float f) { unsigned u = __builtin_bit_cast(unsigned, f); return (u + 0x7fffu + ((u >> 16) & 1u)) >> 16; }
__device__ __forceinline__ unsigned pk2(float lo, float hi) { return f2bf(lo) | (f2bf(hi) << 16); }

#define XB_TMO      128
#define XB_XCNT(j)  (256  + 64 * (j))
#define XB_XSUB(j)  (1280 + 64 * (j))
#define XB_XGEN(j)  (2304 + 64 * (j))
#define XB_TOP      3328
#define XB_TOPGEN   3392
#define XCD_BAR_WORDS 3456
#define XB_SPIN_CAP (1u << 18)

__device__ __forceinline__ unsigned xb_ld(unsigned* p)              { return __hip_atomic_load(p, __ATOMIC_RELAXED, __HIP_MEMORY_SCOPE_AGENT); }
__device__ __forceinline__ unsigned xb_add(unsigned* p, unsigned v) { return __hip_atomic_fetch_add(p, v, __ATOMIC_RELAXED, __HIP_MEMORY_SCOPE_AGENT); }
__device__ __forceinline__ unsigned xb_xcc_id() { return (unsigned)__builtin_amdgcn_s_getreg((3 << 11) | 20) & 0xFu; }
#define XB_SPIN(cond, bar) do { unsigned _sp = 0; while (cond) { __builtin_amdgcn_s_sleep(1); \
    if ((++_sp & 255u) == 0u) { if (xb_ld(&(bar)[XB_TMO])) break; if (_sp > XB_SPIN_CAP) { atomicAdd(&(bar)[XB_TMO], 1u); break; } } } } while (0)

struct XcdBarrier {
    unsigned* bar; unsigned x;
    volatile LAS unsigned* st;
};

__device__ __forceinline__ XcdBarrier xcd_barrier_post(unsigned* bar, volatile LAS unsigned* st) {
    XcdBarrier b; b.bar = bar; b.x = xb_xcc_id(); b.st = st;
    if (threadIdx.x == 0) (void)xb_add(&bar[XB_XCNT(b.x)], 1u);
    return b;
}
__device__ __forceinline__ void xcd_barrier_complete(unsigned* bar, unsigned x, unsigned& nloc, unsigned& nx) {
    const unsigned G = gridDim.x * gridDim.y * gridDim.z;
    unsigned sum, cnt, mine, sp = 0u;
    for (;;) {
        sum = 0u; cnt = 0u; mine = 0u;
#pragma unroll
        for (unsigned j = 0; j < 16; ++j) { const unsigned c = xb_ld(&bar[XB_XCNT(j)]); sum += c; cnt += (c > 0u) ? 1u : 0u; mine = (j == x) ? c : mine; }
        if (sum == G) break;
        __builtin_amdgcn_s_sleep(1);
        if ((++sp & 255u) == 0u) { if (xb_ld(&bar[XB_TMO])) break; if (sp > XB_SPIN_CAP) { atomicAdd(&bar[XB_TMO], 1u); break; } }
    }
    nloc = mine > 0u ? mine : 1u; nx = cnt > 0u ? cnt : 1u;
}

__device__ __forceinline__ void xcd_barrier(const XcdBarrier& b) {
    asm volatile("s_waitcnt vmcnt(0)" ::: "memory");
    __syncthreads();
    if (threadIdx.x == 0) {
        unsigned* bar = b.bar;
        __builtin_amdgcn_s_waitcnt(0);
        unsigned nloc = b.st[0], nx = b.st[1];
        if (nloc == 0u) { xcd_barrier_complete(bar, b.x, nloc, nx); b.st[0] = nloc; b.st[1] = nx; }
        const unsigned old = xb_add(&bar[XB_XSUB(b.x)], 1u);
        const unsigned gen = old / nloc;
        if (old + 1u == (gen + 1u) * nloc) {
            __builtin_amdgcn_fence(__ATOMIC_RELEASE, "agent");
            asm volatile("s_waitcnt vmcnt(0)" ::: "memory");
            const unsigned og = xb_add(&bar[XB_TOP], 1u);
            const unsigned tg = og / nx;
            if (og + 1u == (tg + 1u) * nx) xb_add(&bar[XB_TOPGEN], 1u);
            else XB_SPIN(xb_ld(&bar[XB_TOPGEN]) == tg, bar);
            __builtin_amdgcn_fence(__ATOMIC_ACQUIRE, "agent");
            xb_add(&bar[XB_XGEN(b.x)], 1u);
            asm volatile("s_waitcnt vmcnt(0)" ::: "memory");
        } else {
            XB_SPIN(xb_ld(&bar[XB_XGEN(b.x)]) == gen, bar);
            __builtin_amdgcn_fence(__ATOMIC_ACQUIRE, "agent");
            asm volatile("s_waitcnt vmcnt(0)" ::: "memory");
        }
    }
    __syncthreads();
}


constexpr int NWAVES = 8;
constexpr int BATCH = 4, SEQ = 4096, DM = 1024, M = BATCH * SEQ, IN_COLS = 5632, NEXP = 32, EFF = 512;
constexpr float EPS = 1e-6f;
constexpr float LAM_INIT = 0.2f;
constexpr int MAXROWS = 2 * M + NEXP * 255;
#ifndef MK_PER_PHASE
#define MK_PER_PHASE 0
#endif
constexpr int N_PHASES = 13;

constexpr size_t MiB = 1u << 20;
constexpr size_t WS_CTL = 0, CTL_ZERO_BYTES = 1 * MiB;
constexpr size_t WS_WIN = 1 * MiB, WS_WA = 12 * MiB, WS_WB = 13 * MiB, WS_WOUT = 14 * MiB;
constexpr size_t WS_TABA = 16 * MiB, WS_TABB = 17 * MiB, WS_WRP = 25 * MiB;
constexpr size_t WS_H = 26 * MiB;
constexpr size_t WS_P = 58 * MiB, PBUF = 16 * MiB;
constexpr size_t WS_OA = 234 * MiB, WS_OB = 250 * MiB;
constexpr size_t WS_T = 58 * MiB, WS_MERGED = 122 * MiB;
constexpr size_t WS_XS = 58 * MiB, WS_HMID = 138 * MiB, WS_WGU = 178 * MiB, WS_WD = 242 * MiB;
constexpr size_t WS_ENT_TOK = 274 * MiB, WS_ENT_W = 276 * MiB, WS_ROW_TOK = 278 * MiB, WS_ROW_W = 278 * MiB + 512 * 1024, WS_END = 279 * MiB;
static_assert((size_t)MAXROWS * 1024 * 2 <= WS_HMID - WS_XS && (size_t)MAXROWS * 512 * 2 <= WS_WGU - WS_HMID && (size_t)MAXROWS * 4 <= 512 * 1024, "ws map");
constexpr int CW_TMO = 0, CW_CODE = 1, CW_CNT = 64, CW_BAR = 4096;

constexpr int RING_OFF = 0, RING_BYTES = 131072;
constexpr int LDSCTL_OFF = RING_BYTES, MISC_OFF = LDSCTL_OFF + 320;
constexpr int LDS_BYTES = 147456;
constexpr int MI_CNT = 16, MI_TP = 48;


struct Frame {
    LAS unsigned char* lds;
    volatile LAS unsigned* MISC;
    gu32* ctl;
    int tid, lane, wave;
    int vcu, G;
    const float* in[24]; float* out; unsigned char* ws;
};
__device__ __forceinline__ float bflo(unsigned w) { return __uint_as_float(w << 16); }
__device__ __forceinline__ float bfhi(unsigned w) { return __uint_as_float(w & 0xffff0000u); }
__device__ __forceinline__ float wave_sum(float v) {
#pragma unroll
    for (int o = 1; o < 64; o <<= 1) v += __shfl_xor(v, o);
    return v;
}
__device__ __forceinline__ float sigmoidf_(float x) { return 1.0f / (1.0f + __expf(-x)); }
__device__ __forceinline__ float siluf_(float x) { return x / (1.0f + __expf(-x)); }
__device__ __forceinline__ void unpack8(const v4u r, float (&x)[8]) {
    x[0] = bflo(r.x); x[1] = bfhi(r.x); x[2] = bflo(r.y); x[3] = bfhi(r.y); x[4] = bflo(r.z); x[5] = bfhi(r.z); x[6] = bflo(r.w); x[7] = bfhi(r.w);
}
__device__ __forceinline__ v4u pack8(const float (&x)[8]) { v4u o; o.x = pk2(x[0], x[1]); o.y = pk2(x[2], x[3]); o.z = pk2(x[4], x[5]); o.w = pk2(x[6], x[7]); return o; }

__device__ __forceinline__ void transpose_item(const float* W, int N, bf16* WT, int ldt, int koff, int mode, LAS float* scr, int kb, int nb, int lane) {
    const int k0 = 64 * kb, n0 = 32 * nb;
#pragma unroll 8
    for (int i = 0; i < 32; ++i) { const int kk = 2 * i + (lane >> 5); scr[kk * 33 + (lane & 31)] = W[(size_t)(k0 + kk) * N + n0 + (lane & 31)]; }
    LDS_WAIT(); asm volatile("" ::: "memory");
    const int c = lane & 7;
#pragma unroll
    for (int j = 0; j < 4; ++j) { const int n = (lane >> 3) + 8 * j; const LAS float* s = scr + (8 * c) * 33 + n;
        v4u o; o.x = pk2(s[0 * 33], s[1 * 33]); o.y = pk2(s[2 * 33], s[3 * 33]); o.z = pk2(s[4 * 33], s[5 * 33]); o.w = pk2(s[6 * 33], s[7 * 33]);
        const int nn = n0 + n; const int row = mode == 0 ? nn : ((nn >> 2) * 8 + (mode == 2 ? 4 : 0) + (nn & 3));
        *(GAS v4u*)(WT + (size_t)row * ldt + koff + k0 + 8 * c) = o; }
    LDS_WAIT(); asm volatile("" ::: "memory");
}
__device__ __forceinline__ void sincos_acc(float ang, float& s, float& c) {
    const double t = (double)ang * 0.15915494309189535; const double fr = t - __builtin_rint(t);
    const float r = (float)(fr * 6.283185307179586);
    s = sinf(r); c = cosf(r);
}
__device__ __forceinline__ void p0_prologue(Frame& F) {
    LAS float* scr = (LAS float*)(F.lds + RING_OFF + F.wave * 16384);
    const int gw = F.vcu * NWAVES + F.wave, NGW = F.G * NWAVES;
    unsigned char* ws = F.ws;
    constexpr int I_IN = (DM / 64) * (IN_COLS / 32), I_A = (512 / 64) * (DM / 32), I_OUT = (DM / 64) * (DM / 32);
    for (int it = gw; it < I_IN + 2 * I_A + I_OUT; it += NGW) {
        int r = it;
        if (r < I_IN) { transpose_item(F.in[3], IN_COLS, (bf16*)(ws + WS_WIN), DM, 0, 0, scr, r / (IN_COLS / 32), r % (IN_COLS / 32), F.lane); continue; } r -= I_IN;
        if (r < I_A) { transpose_item(F.in[13], DM, (bf16*)(ws + WS_WA), 512, 0, 0, scr, r / (DM / 32), r % (DM / 32), F.lane); continue; } r -= I_A;
        if (r < I_A) { transpose_item(F.in[14], DM, (bf16*)(ws + WS_WB), 512, 0, 0, scr, r / (DM / 32), r % (DM / 32), F.lane); continue; } r -= I_A;
        transpose_item(F.in[15], DM, (bf16*)(ws + WS_WOUT), DM, 0, 0, scr, r / (DM / 32), r % (DM / 32), F.lane);
    }
    {
        const float* wgr = F.in[17]; const float* wer = F.in[19]; f32x4* Wp4 = (f32x4*)(ws + WS_WRP);
        for (int idx = gw * 64 + F.lane; idx < 64 * 3 * 64; idx += NGW * 64) {
            const int l = idx & 63, st = idx >> 6, t = st % 3, s = st / 3, col = l & 15, q = l >> 4;
            f32x4 v;
#pragma unroll
            for (int j = 0; j < 4; ++j) { const int k = 16 * s + 4 * q + j; v[j] = (t == 0) ? (col < 4 ? wgr[k * 4 + col] : 0.f) : wer[k * 32 + (t - 1) * 16 + col]; }
            Wp4[idx] = v;
        }
    }
    {
        const int* pos = (const int*)F.in[1]; float* tabA = (float*)(ws + WS_TABA); float* tabB = (float*)(ws + WS_TABB);
        const float fB = powf(10000.0f, -(float)F.lane * (1.0f / 64.0f)), fA = powf(500000.0f, -(float)(F.lane & 7) * 0.125f);
        for (int tk = gw; tk < M; tk += NGW) {
            const float p = (float)pos[tk]; float s, c;
            sincos_acc(p * fB, s, c); tabB[(size_t)tk * 128 + F.lane] = c; tabB[(size_t)tk * 128 + 64 + F.lane] = s;
            if (F.lane < 8) { sincos_acc(p * fA, s, c); tabA[(size_t)tk * 16 + F.lane] = c; tabA[(size_t)tk * 16 + 8 + F.lane] = s; }
        }
    }
    {
        const float* g = F.in[2]; bf16* H = (bf16*)(ws + WS_H);
        f32x4 gv[4];
#pragma unroll
        for (int j = 0; j < 4; ++j) gv[j] = ((const f32x4*)g)[F.lane + 64 * j];
        for (int m = gw; m < M; m += NGW) {
            const GAS f32x4* xr = (const GAS f32x4*)(F.in[0] + (size_t)m * DM) + F.lane;
            f32x4 v[4]; float s = 0.f;
#pragma unroll
            for (int j = 0; j < 4; ++j) { v[j] = xr[64 * j]; s += (v[j].x * v[j].x + v[j].y * v[j].y) + (v[j].z * v[j].z + v[j].w * v[j].w); }
            const float rstd = rsqrtf(wave_sum(s) * (1.f / DM) + EPS);
            GAS unsigned long long* o8 = (GAS unsigned long long*)(H + (size_t)m * DM) + F.lane;
#pragma unroll
            for (int j = 0; j < 4; ++j) o8[64 * j] = (unsigned long long)pk2(v[j].x * rstd * gv[j].x, v[j].y * rstd * gv[j].y) | ((unsigned long long)pk2(v[j].z * rstd * gv[j].z, v[j].w * rstd * gv[j].w) << 32);
        }
    }
}

__device__ __forceinline__ void p2_post(Frame& F) {
    const int gw = F.vcu * NWAVES + F.wave, NGW = F.G * NWAVES, lane = F.lane;
    unsigned char* ws = F.ws;
    const float* tabA = (const float*)(ws + WS_TABA); const float* tabB = (const float*)(ws + WS_TABB);
    constexpr float C2 = 0.125f * 1.4426950408889634f;
    const int sub = lane & 7;
    float qg[8], kg[8];
#pragma unroll
    for (int t = 0; t < 8; ++t) { qg[t] = F.in[4][sub * 8 + t]; kg[t] = F.in[5][sub * 8 + t]; }
    for (int tk = gw; tk < M; tk += NGW) {
        float ca[8], sa[8];
#pragma unroll
        for (int t = 0; t < 8; ++t) { ca[t] = tabA[(size_t)tk * 16 + t]; sa[t] = tabA[(size_t)tk * 16 + 8 + t]; }
#pragma unroll
        for (int which = 0; which < 2; ++which) {
            GAS v4u* p = (GAS v4u*)((bf16*)(ws + WS_P + (size_t)which * PBUF) + (size_t)tk * 512 + lane * 8);
            float x[8]; unpack8(*p, x);
            float ss = 0.f;
#pragma unroll
            for (int t = 0; t < 8; ++t) ss += x[t] * x[t];
            ss += __shfl_xor(ss, 1); ss += __shfl_xor(ss, 2); ss += __shfl_xor(ss, 4);
            const float rstd = rsqrtf(ss * (1.f / 64.f) + EPS);
            float y[8];
#pragma unroll
            for (int t = 0; t < 8; ++t) y[t] = x[t] * rstd * (which == 0 ? qg[t] : kg[t]);
#pragma unroll
            for (int t = 0; t < 8; ++t) { const float o = __shfl_xor(y[t], 1);
                if (sub == 0) y[t] = y[t] * ca[t] - o * sa[t]; else if (sub == 1) y[t] = y[t] * ca[t] + o * sa[t]; }
            if (which == 0) {
#pragma unroll
                for (int t = 0; t < 8; ++t) y[t] *= C2;
            }
            *p = pack8(y);
        }
        const int i0 = (lane & 7) * 8;
        float cb[8], sb[8];
#pragma unroll
        for (int t = 0; t < 8; ++t) { cb[t] = tabB[(size_t)tk * 128 + i0 + t]; sb[t] = tabB[(size_t)tk * 128 + 64 + i0 + t]; }
#pragma unroll
        for (int which = 0; which < 2; ++which) {
            GAS v4u* p = (GAS v4u*)((bf16*)(ws + WS_P + (size_t)(3 + which) * PBUF) + (size_t)tk * 512 + lane * 8);
            float x[8]; unpack8(*p, x); float y[8];
#pragma unroll
            for (int t = 0; t < 8; ++t) { const float o = __shfl_xor(x[t], 8);
                y[t] = (lane & 8) ? (x[t] * cb[t] + o * sb[t]) : (x[t] * cb[t] - o * sb[t]);
                if (which == 1) y[t] *= 0.08838834764831845f; }
            *p = pack8(y);
        }
    }
}

__device__ __forceinline__ int rt_off(int row, int kb) { return row * 256 + ((((kb >> 4) ^ (row & 15)) << 4) | (kb & 15)); }
__device__ __forceinline__ bf16x8 rt_frag(const LAS unsigned char* tile, int r0, int ks, int lane) {
    return *(const LAS bf16x8*)(tile + rt_off(r0 + (lane & 15), ks * 64 + 16 * (lane >> 4)));
}
__device__ __forceinline__ float log2_gamma(int h) { return log2f(1.0f - exp2f(-5.0f - (float)h)); }

__device__ __forceinline__ void ret_kv_item(Frame& F, int item) {
    const int bh = item >> 5, n = item & 31, b = bh >> 2, h = bh & 3, tid = F.tid, lane = F.lane, w = F.wave;
    const size_t tok0 = (size_t)b * SEQ + (size_t)n * 128;
    const bf16* kr = (const bf16*)(F.ws + WS_P + 4 * PBUF); const bf16* vr = (const bf16*)(F.ws + WS_P + 5 * PBUF);
    float* RS = F.out + (size_t)item * 16384;
    LAS unsigned char* Kt = F.lds; LAS unsigned char* Vt = F.lds + 32768;
    const float lg = log2_gamma(h);
#pragma unroll
    for (int it = 0; it < 4; ++it) {
        const int idx = tid + it * 512, j = idx & 127, ch = idx >> 7;
        const v4u kv = *(const GAS v4u*)(kr + (tok0 + j) * 512 + h * 128 + ch * 8);
        const v4u vv = *(const GAS v4u*)(vr + (tok0 + j) * 512 + h * 128 + ch * 8);
        float kx[8], vx[8]; unpack8(kv, kx); unpack8(vv, vx);
        const float z = exp2f((float)(127 - j) * lg);
#pragma unroll
        for (int t = 0; t < 8; ++t) {
            *(LAS unsigned short*)(Kt + rt_off(ch * 8 + t, j * 2)) = (unsigned short)f2bf(kx[t]);
            *(LAS unsigned short*)(Vt + rt_off(ch * 8 + t, j * 2)) = (unsigned short)f2bf(vx[t] * z);
        }
    }
    __syncthreads();
    f32x4 acc[8];
#pragma unroll
    for (int dt = 0; dt < 8; ++dt) acc[dt] = (f32x4){0.f, 0.f, 0.f, 0.f};
#pragma unroll
    for (int ks = 0; ks < 4; ++ks) {
        const bf16x8 a = rt_frag(Vt, 16 * w, ks, lane);
#pragma unroll
        for (int dt = 0; dt < 8; ++dt) { const bf16x8 bb = rt_frag(Kt, 16 * dt, ks, lane); acc[dt] = __builtin_amdgcn_mfma_f32_16x16x32_bf16(bb, a, acc[dt], 0, 0, 0); }
    }
    const int e = 16 * w + (lane & 15), q = lane >> 4;
#pragma unroll
    for (int dt = 0; dt < 8; ++dt) *(GAS f32x4*)(RS + (size_t)e * 128 + 16 * dt + 4 * q) = acc[dt];
    __syncthreads();
}
__device__ __forceinline__ void p4_scan(Frame& F) {
    const int gid = F.vcu * (NWAVES * 64) + F.tid, NT = F.G * NWAVES * 64;
    for (int idx = gid; idx < 16 * 4096; idx += NT) {
        const int bh = idx >> 12, off = idx & 4095, h = bh & 3;
        const float g = exp2f(128.0f * log2_gamma(h));
        f32x4 r = (f32x4){0.f, 0.f, 0.f, 0.f};
        GAS f32x4* p = (GAS f32x4*)(F.out + (size_t)bh * 32 * 16384) + off;
        for (int n = 0; n < 32; ++n) { const f32x4 t = p[(size_t)n * 4096]; p[(size_t)n * 4096] = r; r = r * g + t; }
    }
}
__device__ __forceinline__ void ret_out_item(Frame& F, int item) {
    const int bh = item >> 5, n = item & 31, b = bh >> 2, h = bh & 3, tid = F.tid, lane = F.lane, w = F.wave;
    const size_t tok0 = (size_t)b * SEQ + (size_t)n * 128;
    const bf16* qr = (const bf16*)(F.ws + WS_P + 3 * PBUF); const bf16* kr = (const bf16*)(F.ws + WS_P + 4 * PBUF); const bf16* vr = (const bf16*)(F.ws + WS_P + 5 * PBUF);
    const bf16* gb = (const bf16*)(F.ws + WS_P + 6 * PBUF); bf16* obg = (bf16*)(F.ws + WS_OB);
    const float* RS = F.out + (size_t)item * 16384;
    LAS unsigned char* Qs = F.lds; LAS unsigned char* Ks = F.lds + 32768; LAS unsigned char* Vt = F.lds + 65536; LAS unsigned char* Rt = F.lds + 98304;
    const float lg = log2_gamma(h);
#pragma unroll
    for (int it = 0; it < 4; ++it) {
        const int idx = tid + it * 512;
        { const int row = idx >> 4, ch = idx & 15;
          *(LAS v4u*)(Qs + rt_off(row, ch * 16)) = *(const GAS v4u*)(qr + (tok0 + row) * 512 + h * 128 + ch * 8);
          *(LAS v4u*)(Ks + rt_off(row, ch * 16)) = *(const GAS v4u*)(kr + (tok0 + row) * 512 + h * 128 + ch * 8);
          const f32x4 r0 = *(const GAS f32x4*)(RS + (size_t)row * 128 + ch * 8), r1 = *(const GAS f32x4*)(RS + (size_t)row * 128 + ch * 8 + 4);
          v4u o; o.x = pk2(r0.x, r0.y); o.y = pk2(r0.z, r0.w); o.z = pk2(r1.x, r1.y); o.w = pk2(r1.z, r1.w);
          *(LAS v4u*)(Rt + rt_off(row, ch * 16)) = o; }
        { const int j = idx & 127, ch = idx >> 7;
          const v4u vv = *(const GAS v4u*)(vr + (tok0 + j) * 512 + h * 128 + ch * 8);
          *(LAS unsigned short*)(Vt + rt_off(ch * 8 + 0, j * 2)) = (unsigned short)(vv.x & 0xffffu); *(LAS unsigned short*)(Vt + rt_off(ch * 8 + 1, j * 2)) = (unsigned short)(vv.x >> 16);
          *(LAS unsigned short*)(Vt + rt_off(ch * 8 + 2, j * 2)) = (unsigned short)(vv.y & 0xffffu); *(LAS unsigned short*)(Vt + rt_off(ch * 8 + 3, j * 2)) = (unsigned short)(vv.y >> 16);
          *(LAS unsigned short*)(Vt + rt_off(ch * 8 + 4, j * 2)) = (unsigned short)(vv.z & 0xffffu); *(LAS unsigned short*)(Vt + rt_off(ch * 8 + 5, j * 2)) = (unsigned short)(vv.z >> 16);
          *(LAS unsigned short*)(Vt + rt_off(ch * 8 + 6, j * 2)) = (unsigned short)(vv.w & 0xffffu); *(LAS unsigned short*)(Vt + rt_off(ch * 8 + 7, j * 2)) = (unsigned short)(vv.w >> 16); }
    }
    __syncthreads();
    const int i = 16 * w + (lane & 15), q = lane >> 4;
    f32x4 sacc[8];
#pragma unroll
    for (int jt = 0; jt < 8; ++jt) sacc[jt] = (f32x4){0.f, 0.f, 0.f, 0.f};
#pragma unroll
    for (int ks = 0; ks < 4; ++ks) {
        const bf16x8 a = rt_frag(Qs, 16 * w, ks, lane);
#pragma unroll
        for (int jt = 0; jt < 8; ++jt) { const bf16x8 bb = rt_frag(Ks, 16 * jt, ks, lane); sacc[jt] = __builtin_amdgcn_mfma_f32_16x16x32_bf16(bb, a, sacc[jt], 0, 0, 0); }
    }
    __syncthreads();
#pragma unroll
    for (int jt = 0; jt < 8; ++jt) {
        float v[4];
#pragma unroll
        for (int t = 0; t < 4; ++t) { const int j = 16 * jt + 4 * q + t; v[t] = (i >= j) ? sacc[jt][t] * exp2f((float)(i - j) * lg) : 0.f; }
        *(LAS unsigned long long*)(Ks + rt_off(i, (16 * jt + 4 * q) * 2)) = (unsigned long long)pk2(v[0], v[1]) | ((unsigned long long)pk2(v[2], v[3]) << 32);
    }
    __syncthreads();
    f32x4 a1[8], a2[8];
#pragma unroll
    for (int et = 0; et < 8; ++et) { a1[et] = (f32x4){0.f, 0.f, 0.f, 0.f}; a2[et] = (f32x4){0.f, 0.f, 0.f, 0.f}; }
#pragma unroll
    for (int ks = 0; ks < 4; ++ks) {
        const bf16x8 aS = rt_frag(Ks, 16 * w, ks, lane), aQ = rt_frag(Qs, 16 * w, ks, lane);
#pragma unroll
        for (int et = 0; et < 8; ++et) {
            const bf16x8 bV = rt_frag(Vt, 16 * et, ks, lane), bR = rt_frag(Rt, 16 * et, ks, lane);
            a1[et] = __builtin_amdgcn_mfma_f32_16x16x32_bf16(bV, aS, a1[et], 0, 0, 0);
            a2[et] = __builtin_amdgcn_mfma_f32_16x16x32_bf16(bR, aQ, a2[et], 0, 0, 0);
        }
    }
    const float xi = exp2f((float)(i + 1) * lg);
    float s = 0.f;
#pragma unroll
    for (int et = 0; et < 8; ++et) { a1[et] = a1[et] + a2[et] * xi; s += (a1[et][0] + a1[et][1]) + (a1[et][2] + a1[et][3]); }
    s += __shfl_xor(s, 16); s += __shfl_xor(s, 32);
    const float mu = s * (1.f / 128.f); float vq = 0.f;
#pragma unroll
    for (int et = 0; et < 8; ++et) { const f32x4 d = a1[et] - mu; vq += (d[0] * d[0] + d[1] * d[1]) + (d[2] * d[2] + d[3] * d[3]); }
    vq += __shfl_xor(vq, 16); vq += __shfl_xor(vq, 32);
    const float rstd = rsqrtf(vq * (1.f / 128.f) + EPS);
    const float* gng = F.in[11] + h * 128; const float* gnb = F.in[12] + h * 128;
#pragma unroll
    for (int et = 0; et < 8; ++et) {
        const int e = 16 * et + 4 * q;
        const f32x4 gg = *(const f32x4*)(gng + e), bb = *(const f32x4*)(gnb + e);
        const unsigned long long gw8 = *(const GAS unsigned long long*)(gb + (tok0 + i) * 512 + h * 128 + e);
        const float g0 = bflo((unsigned)gw8), g1 = bfhi((unsigned)gw8), g2 = bflo((unsigned)(gw8 >> 32)), g3 = bfhi((unsigned)(gw8 >> 32));
        const f32x4 y = (a1[et] - mu) * rstd * gg + bb;
        *(GAS unsigned long long*)(obg + (tok0 + i) * 512 + h * 128 + e) =
            (unsigned long long)pk2(y[0] * siluf_(g0), y[1] * siluf_(g1)) | ((unsigned long long)pk2(y[2] * siluf_(g2), y[3] * siluf_(g3)) << 32);
    }
    __syncthreads();
}
__device__ __forceinline__ void p5_attn_combine(Frame& F) {
    const int gw = F.vcu * NWAVES + F.wave, NGW = F.G * NWAVES, lane = F.lane;
    const float s1 = wave_sum(F.in[6][lane] * F.in[7][lane]), s2 = wave_sum(F.in[8][lane] * F.in[9][lane]);
    const float lam = expf(s1) - expf(s2) + LAM_INIT;
    const bf16* AO = (const bf16*)(F.ws + WS_H); bf16* oa = (bf16*)(F.ws + WS_OA);
    const int h = lane >> 4, e0 = (lane & 15) * 8, vhalf = e0 >> 6, d = e0 & 63;
    float g[8];
#pragma unroll
    for (int t = 0; t < 8; ++t) g[t] = F.in[10][e0 + t] * (1.0f - LAM_INIT);
    for (int tk = gw; tk < M; tk += NGW) {
        float x0[8], x1[8];
        unpack8(*(const GAS v4u*)(AO + (size_t)tk * 1024 + (h * 4 + vhalf) * 64 + d), x0);
        unpack8(*(const GAS v4u*)(AO + (size_t)tk * 1024 + (h * 4 + 2 + vhalf) * 64 + d), x1);
        float y[8], ss = 0.f;
#pragma unroll
        for (int t = 0; t < 8; ++t) { y[t] = x0[t] - lam * x1[t]; ss += y[t] * y[t]; }
        ss += __shfl_xor(ss, 1); ss += __shfl_xor(ss, 2); ss += __shfl_xor(ss, 4); ss += __shfl_xor(ss, 8);
        const float rstd = rsqrtf(ss * (1.f / 128.f) + EPS);
#pragma unroll
        for (int t = 0; t < 8; ++t) y[t] = y[t] * rstd * g[t];
        *(GAS v4u*)(oa + (size_t)tk * 512 + h * 128 + e0) = pack8(y);
    }
}

struct EpiGateA {
    static constexpr bool PERM = false, AFTER_DRAIN = false;
    float* T; const bf16* g0; const bf16* g1;
    __device__ __forceinline__ void operator()(const f32x4 (&acc)[2][2][4][2], const pg8::Unit& u, int wr, int wc, int fr, int fq) const {
        const int row0 = u.pm * 256 + wr * 64 + fr, col0 = u.pn * 256 + wc * 32 + 4 * fq;
#pragma unroll
        for (int ai = 0; ai < 2; ++ai)
#pragma unroll
            for (int m = 0; m < 4; ++m) { const size_t row = (size_t)(row0 + ai * 128 + m * 16);
#pragma unroll
                for (int bj = 0; bj < 2; ++bj)
#pragma unroll
                    for (int n = 0; n < 2; ++n) { const int col = col0 + bj * 128 + n * 16;
                        const unsigned long long gw8 = *(const GAS unsigned long long*)((col < 512 ? g0 : g1) + row * 512 + (col & 511));
                        f32x4 s; s[0] = sigmoidf_(bflo((unsigned)gw8)); s[1] = sigmoidf_(bfhi((unsigned)gw8)); s[2] = sigmoidf_(bflo((unsigned)(gw8 >> 32))); s[3] = sigmoidf_(bfhi((unsigned)(gw8 >> 32)));
                        *(GAS f32x4*)(T + row * 1024 + col) = s * acc[ai][bj][m][n]; } }
    }
};
struct EpiMerge {
    static constexpr bool PERM = false, AFTER_DRAIN = false;
    const float* T; bf16* O; const bf16* g0; const bf16* g1;
    __device__ __forceinline__ void operator()(const f32x4 (&acc)[2][2][4][2], const pg8::Unit& u, int wr, int wc, int fr, int fq) const {
        const int row0 = u.pm * 256 + wr * 64 + fr, col0 = u.pn * 256 + wc * 32 + 4 * fq;
#pragma unroll
        for (int ai = 0; ai < 2; ++ai)
#pragma unroll
            for (int m = 0; m < 4; ++m) { const size_t row = (size_t)(row0 + ai * 128 + m * 16);
#pragma unroll
                for (int bj = 0; bj < 2; ++bj)
#pragma unroll
                    for (int n = 0; n < 2; ++n) { const int col = col0 + bj * 128 + n * 16;
                        const unsigned long long gw8 = *(const GAS unsigned long long*)((col < 512 ? g0 : g1) + row * 512 + (col & 511));
                        f32x4 s; s[0] = sigmoidf_(bflo((unsigned)gw8)); s[1] = sigmoidf_(bfhi((unsigned)gw8)); s[2] = sigmoidf_(bflo((unsigned)(gw8 >> 32))); s[3] = sigmoidf_(bfhi((unsigned)(gw8 >> 32)));
                        const f32x4 v = *(const GAS f32x4*)(T + row * 1024 + col) + s * acc[ai][bj][m][n];
                        *(GAS unsigned long long*)(O + row * 1024 + col) = (unsigned long long)pk2(v[0], v[1]) | ((unsigned long long)pk2(v[2], v[3]) << 32); } }
    }
};
struct EpiResid {
    static constexpr bool PERM = false, AFTER_DRAIN = false;
    const float* X; float* O;
    __device__ __forceinline__ void operator()(const f32x4 (&acc)[2][2][4][2], const pg8::Unit& u, int wr, int wc, int fr, int fq) const {
        const int row0 = u.pm * 256 + wr * 64 + fr, col0 = u.pn * 256 + wc * 32 + 4 * fq;
#pragma unroll
        for (int ai = 0; ai < 2; ++ai)
#pragma unroll
            for (int m = 0; m < 4; ++m) { const size_t row = (size_t)(row0 + ai * 128 + m * 16);
#pragma unroll
                for (int bj = 0; bj < 2; ++bj)
#pragma unroll
                    for (int n = 0; n < 2; ++n) { const int col = col0 + bj * 128 + n * 16;
                        *(GAS f32x4*)(O + row * 1024 + col) = *(const GAS f32x4*)(X + row * 1024 + col) + acc[ai][bj][m][n]; } }
    }
};
struct EpiSwiGLU {
    static constexpr bool PERM = true, AFTER_DRAIN = false;
    bf16* Hm;
    __device__ __forceinline__ void operator()(const f32x4 (&acc)[2][2][4][2], const pg8::Unit& u, int wr, int wc, int fr, int fq) const {
        const int row0 = u.pm * 256 + wr * 64 + fr, j0 = (u.pn & 3) * 128 + wc * 16 + 4 * fq;
#pragma unroll
        for (int ai = 0; ai < 2; ++ai)
#pragma unroll
            for (int m = 0; m < 4; ++m) { const size_t row = (size_t)(row0 + ai * 128 + m * 16);
#pragma unroll
                for (int bj = 0; bj < 2; ++bj) { const f32x4 a = acc[ai][bj][m][0], uu = acc[ai][bj][m][1];
                    *(GAS unsigned long long*)(Hm + row * 512 + j0 + bj * 64) =
                        (unsigned long long)pk2(siluf_(a[0]) * uu[0], siluf_(a[1]) * uu[1]) | ((unsigned long long)pk2(siluf_(a[2]) * uu[2], siluf_(a[3]) * uu[3]) << 32); } }
    }
};
struct EpiScatter {
    static constexpr bool PERM = false, AFTER_DRAIN = false;
    float* O; const int* row_tok; const float* row_w;
    __device__ __forceinline__ void operator()(const f32x4 (&acc)[2][2][4][2], const pg8::Unit& u, int wr, int wc, int fr, int fq) const {
        const int row0 = u.pm * 256 + wr * 64 + fr, col0 = (u.pn & 3) * 256 + wc * 32 + 4 * fq;
#pragma unroll
        for (int ai = 0; ai < 2; ++ai)
#pragma unroll
            for (int m = 0; m < 4; ++m) { const int row = row0 + ai * 128 + m * 16; const int tok = row_tok[row]; const float w = row_w[row];
                if (tok >= 0) {
#pragma unroll
                    for (int bj = 0; bj < 2; ++bj)
#pragma unroll
                        for (int n = 0; n < 2; ++n) { float* o = O + (size_t)tok * 1024 + col0 + bj * 128 + n * 16;
#pragma unroll
                            for (int t = 0; t < 4; ++t) atomicAdd(o + t, w * acc[ai][bj][m][n][t]); } } }
    }
};
struct GroupedOrder {
    const volatile LAS unsigned* tp; int G, c;
    __device__ __forceinline__ bool next(int i, pg8::Unit& u) const {
        const int L = i * G + c; const int total = (int)tp[32] * 4; if (L >= total) return false;
        const int T = L >> 2; int e = 0;
#pragma unroll 1
        for (int k = 1; k < 32; ++k) e += (T >= (int)tp[k]) ? 1 : 0;
        u.pm = T; u.pn = e * 4 + (L & 3); return true;
    }
    __device__ __forceinline__ void a_ready(const pg8::Unit&) const {}
    __device__ __forceinline__ void done(const pg8::Unit&) const {}
};

__device__ __forceinline__ void p9_router(Frame& F) {
    const int gw = F.vcu * NWAVES + F.wave, NGW = F.G * NWAVES, lane = F.lane;
    unsigned char* ws = F.ws;
    LAS float* scr = (LAS float*)(F.lds + RING_OFF + F.wave * 16384);
    LAS float* Lg = (LAS float*)(F.lds + RING_OFF + F.wave * 16384 + 12288);
    const float* X1 = F.out; bf16* H = (bf16*)(ws + WS_H); const float* g2 = F.in[16];
    const f32x4* Wp4 = (const f32x4*)(ws + WS_WRP);
    int* ent_tok = (int*)(ws + WS_ENT_TOK); float* ent_w = (float*)(ws + WS_ENT_W);
    f32x4 gv[4];
#pragma unroll
    for (int j = 0; j < 4; ++j) gv[j] = ((const f32x4*)g2)[lane + 64 * j];
    for (int item = gw; item < M / 16; item += NGW) {
        const int tok0 = item * 16; float myrstd = 0.f;
        for (int r = 0; r < 16; ++r) {
            const GAS f32x4* xr = (const GAS f32x4*)(X1 + (size_t)(tok0 + r) * DM) + lane;
            f32x4 v[4]; float s = 0.f;
#pragma unroll
            for (int j = 0; j < 4; ++j) { v[j] = xr[64 * j]; s += (v[j].x * v[j].x + v[j].y * v[j].y) + (v[j].z * v[j].z + v[j].w * v[j].w); }
            const float rstd = rsqrtf(wave_sum(s) * (1.f / DM) + EPS);
            GAS unsigned long long* o8 = (GAS unsigned long long*)(H + (size_t)(tok0 + r) * DM) + lane;
#pragma unroll
            for (int j = 0; j < 4; ++j) o8[64 * j] = (unsigned long long)pk2(v[j].x * rstd * gv[j].x, v[j].y * rstd * gv[j].y) | ((unsigned long long)pk2(v[j].z * rstd * gv[j].z, v[j].w * rstd * gv[j].w) << 32);
            if ((lane & 15) == r) myrstd = rstd;
        }
        f32x4 acc[3];
#pragma unroll
        for (int t = 0; t < 3; ++t) acc[t] = (f32x4){0.f, 0.f, 0.f, 0.f};
        const float* xa = X1 + (size_t)(tok0 + (lane & 15)) * DM + 4 * (lane >> 4);
        const float* ga = g2 + 4 * (lane >> 4);
#pragma unroll 2
        for (int s = 0; s < 64; ++s) {
            const f32x4 xv = *(const GAS f32x4*)(xa + 16 * s), gq = *(const f32x4*)(ga + 16 * s);
            const f32x4 a = xv * gq * myrstd;
#pragma unroll
            for (int t = 0; t < 3; ++t) { const f32x4 wv = Wp4[(s * 3 + t) * 64 + lane];
#pragma unroll
                for (int j = 0; j < 4; ++j) acc[t] = __builtin_amdgcn_mfma_f32_16x16x4f32(a[j], wv[j], acc[t], 0, 0, 0); }
        }
#pragma unroll
        for (int t = 0; t < 3; ++t)
#pragma unroll
            for (int r = 0; r < 4; ++r) Lg[(4 * (lane >> 4) + r) * 48 + t * 16 + (lane & 15)] = acc[t][r];
        LDS_WAIT(); asm volatile("" ::: "memory");
        if (lane < 16) {
            const int tok = tok0 + lane; const LAS float* Lr = Lg + lane * 48;
            float gl[4];
#pragma unroll
            for (int k = 0; k < 4; ++k) gl[k] = Lr[k] + F.in[18][k];
            int gi = 0; float mx = gl[0];
#pragma unroll
            for (int k = 1; k < 4; ++k) if (gl[k] > mx) { mx = gl[k]; gi = k; }
            float se = 0.f;
#pragma unroll
            for (int k = 0; k < 4; ++k) se += __expf(gl[k] - mx);
            const float pg = 1.0f / se;
            float v0 = -3.0e38f, v1 = -3.0e38f; int i0 = 0, i1 = 0;
#pragma unroll
            for (int k = 0; k < 8; ++k) { const float el = Lr[16 + gi * 8 + k] + F.in[20][gi * 8 + k];
                if (el > v0) { v1 = v0; i1 = i0; v0 = el; i0 = k; } else if (el > v1) { v1 = el; i1 = k; } }
            const float w0 = pg / (1.0f + __expf(v1 - v0)), w1 = pg - w0;
            const int e0 = gi * 8 + i0, e1 = gi * 8 + i1;
            const unsigned p0 = atomicAdd((unsigned*)(F.ctl + CW_CNT) + e0, 1u); ent_tok[(size_t)e0 * M + p0] = tok; ent_w[(size_t)e0 * M + p0] = w0;
            const unsigned p1 = atomicAdd((unsigned*)(F.ctl + CW_CNT) + e1, 1u); ent_tok[(size_t)e1 * M + p1] = tok; ent_w[(size_t)e1 * M + p1] = w1;
        }
        LDS_WAIT(); asm volatile("" ::: "memory");
    }
    for (int it = gw; it < NEXP * 768; it += NGW) {
        const int e = it / 768, r = it % 768;
        if (r < 256) transpose_item(F.in[21] + (size_t)e * DM * EFF, EFF, (bf16*)(ws + WS_WGU) + (size_t)e * 1024 * 1024, 1024, 0, 1, scr, r / 16, r % 16, lane);
        else if (r < 512) transpose_item(F.in[22] + (size_t)e * DM * EFF, EFF, (bf16*)(ws + WS_WGU) + (size_t)e * 1024 * 1024, 1024, 0, 2, scr, (r - 256) / 16, (r - 256) % 16, lane);
        else transpose_item(F.in[23] + (size_t)e * EFF * DM, DM, (bf16*)(ws + WS_WD) + (size_t)e * 1024 * 512, 512, 0, 0, scr, (r - 512) / 32, (r - 512) % 32, lane);
    }
}
__device__ __forceinline__ void load_expert_tables(Frame& F) {
    if (F.tid < 32) F.MISC[MI_CNT + F.tid] = __hip_atomic_load(F.ctl + CW_CNT + F.tid, RLX_AGENT);
    __syncthreads();
    if (F.tid == 0) { unsigned a = 0; for (int e = 0; e < 32; ++e) { F.MISC[MI_TP + e] = a; a += (F.MISC[MI_CNT + e] + 255u) >> 8; } F.MISC[MI_TP + 32] = a; }
    __syncthreads();
}
__device__ __forceinline__ void p10_gather(Frame& F) {
    const int gw = F.vcu * NWAVES + F.wave, NGW = F.G * NWAVES, lane = F.lane;
    unsigned char* ws = F.ws;
    const bf16* H = (const bf16*)(ws + WS_H); bf16* xs = (bf16*)(ws + WS_XS);
    const int* ent_tok = (const int*)(ws + WS_ENT_TOK); const float* ent_w = (const float*)(ws + WS_ENT_W);
    int* row_tok = (int*)(ws + WS_ROW_TOK); float* row_w = (float*)(ws + WS_ROW_W);
    const int total = (int)F.MISC[MI_TP + 32] * 256;
    for (int row = gw; row < total; row += NGW) {
        const int T = row >> 8; int e = 0;
#pragma unroll 1
        for (int k = 1; k < 32; ++k) e += (T >= (int)F.MISC[MI_TP + k]) ? 1 : 0;
        const int r = row - (int)F.MISC[MI_TP + e] * 256, c = (int)F.MISC[MI_CNT + e];
        v4u a = (v4u){0u, 0u, 0u, 0u}, b2 = (v4u){0u, 0u, 0u, 0u}; int tok = -1; float w = 0.f;
        if (r < c) { tok = ent_tok[(size_t)e * M + r]; w = ent_w[(size_t)e * M + r];
            a = *(const GAS v4u*)(H + (size_t)tok * DM + lane * 8); b2 = *(const GAS v4u*)(H + (size_t)tok * DM + 512 + lane * 8); }
        *(GAS v4u*)(xs + (size_t)row * DM + lane * 8) = a; *(GAS v4u*)(xs + (size_t)row * DM + 512 + lane * 8) = b2;
        if (lane == 0) { row_tok[row] = tok; row_w[row] = w; }
    }
}

struct Args { const void* in[24]; float* out; unsigned char* ws; int ph_lo, ph_hi; };
__global__ void __launch_bounds__(NWAVES * 64, 2) mk_fwd(Args args) {
    extern __shared__ __attribute__((aligned(16))) unsigned char lds[];
    Frame F;
    F.lds = (LAS unsigned char*)lds;
    F.MISC = (volatile LAS unsigned*)(F.lds + MISC_OFF);
    F.tid = threadIdx.x; F.lane = F.tid & 63; F.wave = __builtin_amdgcn_readfirstlane(F.tid >> 6);
    F.G = gridDim.x; { const int bx = blockIdx.x; F.vcu = (F.G % 8 == 0) ? (bx % 8) * (F.G / 8) + bx / 8 : bx; }
    unsigned char* ws = args.ws; F.ws = ws; F.out = args.out;
    F.ctl = (gu32*)(ws + WS_CTL);
#pragma unroll
    for (int i = 0; i < 24; ++i) F.in[i] = (const float*)args.in[i];
    for (int u = F.tid; u < (LDS_BYTES - LDSCTL_OFF) / 4; u += NWAVES * 64) ((LAS unsigned*)(F.lds + LDSCTL_OFF))[u] = 0u;
    __syncthreads();
    XcdBarrier bar; bar.bar = (unsigned*)(F.ctl + CW_BAR); bar.x = 0; bar.st = nullptr;
#if !MK_PER_PHASE
    bar = xcd_barrier_post((unsigned*)(F.ctl + CW_BAR), F.MISC + 8);
#endif
    const int lo = args.ph_lo, hi = args.ph_hi;
#define IN(k) (lo <= (k) && (k) < hi)
#define SEAM(k) do { if (IN(k) && IN((k) + 1)) xcd_barrier(bar); } while (0)

    if (IN(0)) { p0_prologue(F); } SEAM(0);
    if (IN(1)) {
        pg8::Gemm g{(const pg8::bf16_t*)(ws + WS_H), (const pg8::bf16_t*)(ws + WS_WIN), M, IN_COLS, DM}; pg8::StaticOrder S; S.init(M, IN_COLS, F.G, (int)blockIdx.x);
        pg8::EpiBf16<0> E{(pg8::bf16_t*)(ws + WS_P), 512, nullptr, 512, (size_t)PBUF / 2, 1.0f};
        pg8::gemm_phase<pg8::EpiBf16<0>, pg8::StaticOrder, true, true>(F.lds + RING_OFF, g, S, E);
    } SEAM(1);
    if (IN(2)) { p2_post(F); } SEAM(2);
    if (IN(3)) {
        const attn_body::AttnTensors AT{(const attn_body::bf16*)(ws + WS_P), (const attn_body::bf16*)(ws + WS_P + PBUF), (const attn_body::bf16*)(ws + WS_P + 2 * PBUF), (attn_body::bf16*)(ws + WS_H)};
        const attn_body::StaticOrder S((int)F.G, (int)blockIdx.x);
        attn_body::attn_phase<attn_body::StaticOrder>((char*)lds + RING_OFF, AT, S);
        __syncthreads();
        for (int item = F.vcu; item < 512; item += F.G) ret_kv_item(F, item);
    } SEAM(3);
    if (IN(4)) { p4_scan(F); } SEAM(4);
    if (IN(5)) { for (int item = F.vcu; item < 512; item += F.G) ret_out_item(F, item); p5_attn_combine(F); } SEAM(5);
    if (IN(6)) {
        pg8::Gemm g{(const pg8::bf16_t*)(ws + WS_OA), (const pg8::bf16_t*)(ws + WS_WA), M, DM, 512}; pg8::StaticOrder S; S.init(M, DM, F.G, (int)blockIdx.x);
        EpiGateA E{(float*)(ws + WS_T), (const bf16*)(ws + WS_P + 7 * PBUF), (const bf16*)(ws + WS_P + 8 * PBUF)};
        pg8::gemm_phase<EpiGateA, pg8::StaticOrder, true, true>(F.lds + RING_OFF, g, S, E);
    } SEAM(6);
    if (IN(7)) {
        pg8::Gemm g{(const pg8::bf16_t*)(ws + WS_OB), (const pg8::bf16_t*)(ws + WS_WB), M, DM, 512}; pg8::StaticOrder S; S.init(M, DM, F.G, (int)blockIdx.x);
        EpiMerge E{(const float*)(ws + WS_T), (bf16*)(ws + WS_MERGED), (const bf16*)(ws + WS_P + 9 * PBUF), (const bf16*)(ws + WS_P + 10 * PBUF)};
        pg8::gemm_phase<EpiMerge, pg8::StaticOrder, true, true>(F.lds + RING_OFF, g, S, E);
    } SEAM(7);
    if (IN(8)) {
        pg8::Gemm g{(const pg8::bf16_t*)(ws + WS_MERGED), (const pg8::bf16_t*)(ws + WS_WOUT), M, DM, DM}; pg8::StaticOrder S; S.init(M, DM, F.G, (int)blockIdx.x);
        EpiResid E{F.in[0], F.out};
        pg8::gemm_phase<EpiResid, pg8::StaticOrder, true, true>(F.lds + RING_OFF, g, S, E);
    } SEAM(8);
    if (IN(9)) { p9_router(F); } SEAM(9);
    if (IN(10)) { load_expert_tables(F); p10_gather(F); } SEAM(10);
    if (IN(11)) {
        load_expert_tables(F);
        pg8::Gemm g{(const pg8::bf16_t*)(ws + WS_XS), (const pg8::bf16_t*)(ws + WS_WGU), MAXROWS, NEXP * 1024, DM}; GroupedOrder S{F.MISC + MI_TP, F.G, (int)blockIdx.x};
        EpiSwiGLU E{(bf16*)(ws + WS_HMID)};
        pg8::gemm_phase<EpiSwiGLU, GroupedOrder, true, true>(F.lds + RING_OFF, g, S, E);
    } SEAM(11);
    if (IN(12)) {
        load_expert_tables(F);
        pg8::Gemm g{(const pg8::bf16_t*)(ws + WS_HMID), (const pg8::bf16_t*)(ws + WS_WD), MAXROWS, NEXP * 1024, EFF}; GroupedOrder S{F.MISC + MI_TP, F.G, (int)blockIdx.x};
        EpiScatter E{F.out, (const int*)(ws + WS_ROW_TOK), (const float*)(ws + WS_ROW_W)};
        pg8::gemm_phase<EpiScatter, GroupedOrder, true, true>(F.lds + RING_OFF, g, S, E);
    }
#undef IN
#undef SEAM
}

extern "C" void kernel_launch(void* const* d_in, const int* in_sizes, int n_in, void* d_out, int out_size, void* d_ws, size_t ws_size, hipStream_t stream) {
    static int grid = 0;
    if (grid == 0) {
        if (n_in != 24 || in_sizes[0] != M * DM || out_size != M * DM || ws_size < WS_END) { fprintf(stderr, "kernel_launch: unexpected shapes/workspace (n_in %d, ws %zu); nothing launched\n", n_in, ws_size); grid = -1; return; }
        int dev = 0, cus = 0, per_cu = 0;
        if (hipGetDevice(&dev) != hipSuccess || hipDeviceGetAttribute(&cus, hipDeviceAttributeMultiprocessorCount, dev) != hipSuccess) { grid = -1; return; }
        if (hipFuncSetAttribute((const void*)mk_fwd, hipFuncAttributeMaxDynamicSharedMemorySize, LDS_BYTES) != hipSuccess) { fprintf(stderr, "kernel_launch: hipFuncSetAttribute failed\n"); grid = -1; return; }
        if (hipOccupancyMaxActiveBlocksPerMultiprocessor(&per_cu, (const void*)mk_fwd, NWAVES * 64, LDS_BYTES) != hipSuccess || per_cu < 1) fprintf(stderr, "kernel_launch: occupancy query reports %d\n", per_cu);
        (void)hipGetLastError();
        grid = cus;
    }
    if (grid < 0) return;
    if (hipMemsetAsync((char*)d_ws + WS_CTL, 0, CTL_ZERO_BYTES, stream) != hipSuccess) return;
    Args a{};
    for (int i = 0; i < 24; ++i) a.in[i] = d_in[i];
    a.out = (float*)d_out; a.ws = (unsigned char*)d_ws;
#if MK_PER_PHASE
    for (int p = 0; p < N_PHASES; ++p) { a.ph_lo = p; a.ph_hi = p + 1; hipLaunchKernelGGL(mk_fwd, dim3(grid), dim3(NWAVES * 64), LDS_BYTES, stream, a); }
#else
    a.ph_lo = 0; a.ph_hi = N_PHASES;
    hipLaunchKernelGGL(mk_fwd, dim3(grid), dim3(NWAVES * 64), LDS_BYTES, stream, a);
#endif
}
```

```cpp
#include <hip/hip_runtime.h>
#include <cstdio>
#include <cstdint>

namespace pg8 {
#define PG8_LAS __attribute__((address_space(3)))
typedef unsigned short bf16_t;
typedef short bf16x8 __attribute__((ext_vector_type(8)));
typedef float f32x4 __attribute__((ext_vector_type(4)));
typedef unsigned u32x4 __attribute__((ext_vector_type(4)));
constexpr int BM = 256, BK = 64, HALF = 128, HTB = HALF * BK * 2  , STAGE_BYTES = 8 * HTB, NXCD = 8, WGM = 8;

__host__ __device__ __forceinline__ int lds_byte(int r, int c) { const int st = (r >> 4) * 2 + (c >> 5), rr = r & 15, cc = c & 31, ob = rr * 64 + cc * 2; return st * 1024 + (ob ^ (((ob >> 9) & 1) << 5)); }
__host__ __device__ __forceinline__ void stage_rc(int b, int& R, int& C) { const int st = b / 1024, sb = b % 1024, swz = sb ^ (((sb >> 9) & 1) << 5); R = (st >> 1) * 16 + swz / 64; C = (st & 1) * 32 + (swz % 64) / 2; }
__host__ __device__ __forceinline__ int perm32(int rho) { const int n = rho >> 4, i = rho & 15; return 8 * (i >> 2) + 4 * n + (i & 3); }

struct Unit { int pm, pn; };
struct Gemm { const bf16_t* A; const bf16_t* Bt; int M, N, K; };

struct StaticOrder {
    int nM, nN, nwg, G, c;
    __host__ __device__ void init(int M, int N, int G_, int c_) { nM = M / BM; nN = N / BM; nwg = nM * nN; G = G_; c = c_; }
    __host__ __device__ bool next(int i, Unit& u) const {
        const long L = (long)i * G + c; if (L >= nwg) return false;
        int wgid = (int)L; { const int q = nwg / NXCD, r = nwg % NXCD, xcd = wgid % NXCD, off = wgid / NXCD; wgid = (xcd < r ? xcd * (q + 1) : r * (q + 1) + (xcd - r) * q) + off; }
        const int nig = WGM * nN, gid = wgid / nig, fm = gid * WGM, gsz = (nM - fm) < WGM ? (nM - fm) : WGM;
        u.pm = fm + ((wgid % nig) % gsz); u.pn = (wgid % nig) / gsz; return true;
    }
    __device__ __forceinline__ void a_ready(const Unit&) const {}
    __device__ __forceinline__ void done(const Unit&) const {}
};

__device__ __forceinline__ unsigned cvt_pk_bf16(float lo, float hi) { unsigned r; asm volatile("v_cvt_pk_bf16_f32 %0, %1, %2" : "=v"(r) : "v"(lo), "v"(hi)); return r; }
typedef float f32x2 __attribute__((ext_vector_type(2)));
__device__ __forceinline__ f32x2 gelu_pk(f32x2 v) {
    const f32x2 av = __builtin_elementwise_abs(v), d = av * 0.2316418882f + 1.0f;
    f32x2 t; t.x = __builtin_amdgcn_rcpf(d.x); t.y = __builtin_amdgcn_rcpf(d.y);
    f32x2 q = t * 0.5307027145f + (-0.7265760135f); q = q * t + 0.7107068705f; q = q * t + (-0.142248368f); q = q * t + 0.127414796f; q = q * t;
    const f32x2 s = (v * v) * (-0.72134752044f);
    f32x2 e; e.x = __builtin_amdgcn_exp2f(s.x); e.y = __builtin_amdgcn_exp2f(s.y);
    const f32x2 m = v * (q * e), r = v - m;
    f32x2 o; o.x = v.x < 0.f ? m.x : r.x; o.y = v.y < 0.f ? m.y : r.y; return o;
}

template <int ACT  > struct EpiBf16 {
    static constexpr bool PERM = true, AFTER_DRAIN = false; static_assert(ACT == 0 || ACT == 1, "EpiBf16: ACT is 0 (none) or 1 (gelu_pk)");
    bf16_t* O; int ldc; const float* bias; int split_cols; size_t split_stride; float scale0;
    __device__ __forceinline__ void operator()(const f32x4 (&acc)[2][2][4][2], const Unit& u, int wr, int wc, int fr, int fq) const {
        const int row0 = u.pm * BM + wr * 64 + fr; int colt = u.pn * BM; bf16_t* base = O;
        float sc = 1.f; if (split_cols) { const int t = colt / split_cols; base += (size_t)t * split_stride; colt -= t * split_cols; if (t == 0) sc = scale0; }
        const int col0 = colt + wc * 32 + 8 * fq, bcol0 = u.pn * BM + wc * 32 + 8 * fq;
        f32x4 bv[2][2];
#pragma unroll
        for (int bj = 0; bj < 2; ++bj)
#pragma unroll
            for (int n = 0; n < 2; ++n) bv[bj][n] = bias ? *(const f32x4*)(bias + bcol0 + bj * HALF + 4 * n) : (f32x4){0.f, 0.f, 0.f, 0.f};
#pragma unroll
        for (int ai = 0; ai < 2; ++ai)
#pragma unroll
            for (int m = 0; m < 4; ++m) { bf16_t* rowp = base + (size_t)(row0 + ai * HALF + m * 16) * ldc + col0;
#pragma unroll
                for (int bj = 0; bj < 2; ++bj) { f32x4 v0 = acc[ai][bj][m][0] + bv[bj][0], v1 = acc[ai][bj][m][1] + bv[bj][1];
                    if (ACT == 1) { f32x2 a = gelu_pk((f32x2){v0[0], v0[1]}), b = gelu_pk((f32x2){v0[2], v0[3]}), c = gelu_pk((f32x2){v1[0], v1[1]}), d = gelu_pk((f32x2){v1[2], v1[3]});
                        v0 = (f32x4){a.x, a.y, b.x, b.y}; v1 = (f32x4){c.x, c.y, d.x, d.y}; }
                    v0 = v0 * sc; v1 = v1 * sc; u32x4 w; w.x = cvt_pk_bf16(v0[0], v0[1]); w.y = cvt_pk_bf16(v0[2], v0[3]); w.z = cvt_pk_bf16(v1[0], v1[1]); w.w = cvt_pk_bf16(v1[2], v1[3]);
                    *(u32x4*)(rowp + bj * HALF) = w; } }
    }
};

template <class Epi, class Sched, bool ALIGN_EPI = false, bool SP2 = false>
__device__ __forceinline__ void gemm_phase(PG8_LAS unsigned char* lds, const Gemm g, const Sched& S, const Epi& E) {
    const int tid = threadIdx.x, wid = __builtin_amdgcn_readfirstlane(tid >> 6), lane = tid & 63, wr = wid >> 2, wc = wid & 3, fr = lane & 15, fq = lane >> 4;
    const int K = g.K, nt = K / BK;
    unsigned voffA[2], voffB[2];
#pragma unroll
    for (int i = 0; i < 2; ++i) { int R, C; stage_rc(tid * 16 + i * 8192, R, C); const int Rb = Epi::PERM ? ((R & ~31) + perm32(R & 31)) : R;
        voffA[i] = (unsigned)(R * K + C) * 2u; voffB[i] = (unsigned)(Rb * K + C) * 2u; }
    const size_t kstep = (size_t)(BK * 2);
    const size_t hstep = (size_t)HALF * K * 2;
    const size_t tstep = 2 * hstep;
    const unsigned ldsw = (unsigned)wid * 1024u;
    const int aoff = lds_byte(wr * 64 + fr, fq * 8), boff = lds_byte(wc * 32 + fr, fq * 8);
#define PG8_SA(b, h) (((b) * 2 + (h)) * HTB)
#define PG8_SB(b, h) ((4 + (b) * 2 + (h)) * HTB)
#define PG8_STAGE(bufoff, gbase, voff) do { _Pragma("unroll") for (int _i = 0; _i < 2; ++_i) \
        __builtin_amdgcn_global_load_lds((const unsigned*)((const char*)(gbase) + (voff)[_i]), (PG8_LAS unsigned*)(lds + (bufoff) + ldsw + _i * 8192), 16, 0, 0); } while (0)
#define PG8_LDA(dst, b, h) do { _Pragma("unroll") for (int m = 0; m < 4; ++m) _Pragma("unroll") for (int k = 0; k < 2; ++k) dst[m][k] = *(const PG8_LAS bf16x8*)(lds + PG8_SA(b, h) + aoff + m * 2048 + k * 1024); } while (0)
#define PG8_LDB(dst, b, h) do { _Pragma("unroll") for (int n = 0; n < 2; ++n) _Pragma("unroll") for (int k = 0; k < 2; ++k) dst[n][k] = *(const PG8_LAS bf16x8*)(lds + PG8_SB(b, h) + boff + n * 2048 + k * 1024); } while (0)
#define PG8_MMA(ai, bj, At, Bt) do { __builtin_amdgcn_s_setprio(1); _Pragma("unroll") for (int m = 0; m < 4; ++m) _Pragma("unroll") for (int n = 0; n < 2; ++n) _Pragma("unroll") for (int k = 0; k < 2; ++k) \
        acc[ai][bj][m][n] = __builtin_amdgcn_mfma_f32_16x16x32_bf16(Bt[n][k], At[m][k], acc[ai][bj][m][n], 0, 0, 0); __builtin_amdgcn_s_setprio(0); } while (0)
#define PG8_WAIT_V(n) asm volatile("s_waitcnt vmcnt(" #n ")" ::: "memory")
#define PG8_WAIT_L(n) asm volatile("s_waitcnt lgkmcnt(" #n ")" ::: "memory")
#define PG8_BAR __builtin_amdgcn_s_barrier()
#define PG8_SCHED __builtin_amdgcn_sched_barrier(0)
    Unit cur, nxt; int ui = 0;
    if (!S.next(0, cur)) return;
    f32x4 acc[2][2][4][2];
#pragma unroll
    for (int a = 0; a < 2; ++a)
#pragma unroll
        for (int b = 0; b < 2; ++b)
#pragma unroll
            for (int m = 0; m < 4; ++m)
#pragma unroll
                for (int n = 0; n < 2; ++n) acc[a][b][m][n] = (f32x4){0.f, 0.f, 0.f, 0.f};
    bf16x8 At[4][2], B0[2][2], B1[2][2];
    const char* cA = (const char*)g.A + (size_t)cur.pm * tstep; const char* cB = (const char*)g.Bt + (size_t)cur.pn * tstep;
    S.a_ready(cur);
    if constexpr (SP2) {
        PG8_STAGE(PG8_SB(0, 0), cB, voffB); PG8_STAGE(PG8_SB(0, 1), cB + hstep, voffB); PG8_STAGE(PG8_SA(0, 0), cA, voffA); PG8_STAGE(PG8_SA(0, 1), cA + hstep, voffA);
        if (wr == 1) PG8_BAR;
        PG8_WAIT_V(2); PG8_BAR;
        PG8_STAGE(PG8_SB(1, 0), cB + kstep, voffB); PG8_STAGE(PG8_SA(1, 0), cA + kstep, voffA); PG8_STAGE(PG8_SB(1, 1), cB + hstep + kstep, voffB);
        PG8_WAIT_V(6); PG8_BAR;
    } else {
        PG8_STAGE(PG8_SB(0, 0), cB, voffB); PG8_STAGE(PG8_SA(0, 0), cA, voffA); PG8_STAGE(PG8_SB(0, 1), cB + hstep, voffB); PG8_STAGE(PG8_SA(0, 1), cA + hstep, voffA);
        if (wr == 1) PG8_BAR;
        PG8_WAIT_V(4); PG8_BAR;
        PG8_STAGE(PG8_SB(1, 0), cB + kstep, voffB); PG8_STAGE(PG8_SA(1, 0), cA + kstep, voffA); PG8_STAGE(PG8_SB(1, 1), cB + hstep + kstep, voffB);
        PG8_WAIT_V(6); PG8_BAR;
    }
    for (;;) {
        const bool has_next = S.next(ui + 1, nxt);
        const char* nA = has_next ? (const char*)g.A + (size_t)nxt.pm * tstep : cA; const char* nB = has_next ? (const char*)g.Bt + (size_t)nxt.pn * tstep : cB;
        for (int t = 0; t < nt; t += 2) {
            const bool last = (t == nt - 2);
            const char* a1 = cA + (size_t)(t + 1) * kstep;
            const char* a2 = last ? nA : cA + (size_t)(t + 2) * kstep; const char* b2 = last ? nB : cB + (size_t)(t + 2) * kstep;
            const char* a3 = a2 + kstep; const char* b3 = b2 + kstep;
            if (last && has_next) S.a_ready(nxt);
            if constexpr (SP2) {
            PG8_LDB(B0, 0, 0); PG8_LDB(B1, 0, 1); PG8_SCHED; PG8_LDA(At, 0, 0); PG8_STAGE(PG8_SA(1, 1), a1 + hstep, voffA);
            PG8_WAIT_V(8); PG8_WAIT_L(0); PG8_BAR; PG8_MMA(0, 0, At, B0); PG8_MMA(0, 1, At, B1); PG8_BAR; PG8_SCHED;
            PG8_LDA(At, 0, 1); PG8_STAGE(PG8_SB(0, 0), b2, voffB); PG8_STAGE(PG8_SB(0, 1), b2 + hstep, voffB); PG8_STAGE(PG8_SA(0, 0), a2, voffA);
            PG8_WAIT_V(8); PG8_WAIT_L(0); PG8_BAR; PG8_MMA(1, 0, At, B0); PG8_MMA(1, 1, At, B1); PG8_BAR; PG8_SCHED;
            PG8_LDB(B0, 1, 0); PG8_LDB(B1, 1, 1); PG8_SCHED; PG8_LDA(At, 1, 0); PG8_STAGE(PG8_SA(0, 1), a2 + hstep, voffA);
            PG8_WAIT_V(8); PG8_WAIT_L(0); PG8_BAR; PG8_MMA(0, 0, At, B0); PG8_MMA(0, 1, At, B1); PG8_BAR; PG8_SCHED;
            PG8_LDA(At, 1, 1); PG8_STAGE(PG8_SB(1, 0), b3, voffB); PG8_STAGE(PG8_SB(1, 1), b3 + hstep, voffB); PG8_STAGE(PG8_SA(1, 0), a3, voffA);
            PG8_WAIT_V(8); PG8_WAIT_L(0); PG8_BAR; PG8_MMA(1, 0, At, B0); PG8_MMA(1, 1, At, B1); PG8_BAR; PG8_SCHED;
            } else {
            PG8_LDB(B0, 0, 0); PG8_SCHED; PG8_LDA(At, 0, 0); PG8_STAGE(PG8_SA(1, 1), a1 + hstep, voffA);
            PG8_WAIT_L(8); PG8_BAR; PG8_WAIT_L(0); PG8_MMA(0, 0, At, B0); PG8_BAR; PG8_SCHED;
            PG8_LDB(B1, 0, 1); PG8_STAGE(PG8_SB(0, 0), b2, voffB);
            PG8_BAR; PG8_WAIT_L(0); PG8_MMA(0, 1, At, B1); PG8_BAR;
            PG8_LDA(At, 0, 1); PG8_STAGE(PG8_SA(0, 0), a2, voffA);
            PG8_BAR; PG8_WAIT_L(0); PG8_MMA(1, 0, At, B0); PG8_BAR; PG8_SCHED;
            PG8_STAGE(PG8_SB(0, 1), b2 + hstep, voffB);
            PG8_WAIT_V(6); PG8_BAR; PG8_MMA(1, 1, At, B1); PG8_BAR;
            PG8_LDB(B0, 1, 0); PG8_SCHED; PG8_LDA(At, 1, 0); PG8_STAGE(PG8_SA(0, 1), a2 + hstep, voffA);
            PG8_WAIT_L(8); PG8_BAR; PG8_WAIT_L(0); PG8_MMA(0, 0, At, B0); PG8_BAR; PG8_SCHED;
            PG8_LDB(B1, 1, 1); PG8_STAGE(PG8_SB(1, 0), b3, voffB);
            PG8_BAR; PG8_WAIT_L(0); PG8_MMA(0, 1, At, B1); PG8_BAR;
            PG8_LDA(At, 1, 1); PG8_STAGE(PG8_SA(1, 0), a3, voffA);
            PG8_BAR; PG8_WAIT_L(0); PG8_MMA(1, 0, At, B0); PG8_BAR; PG8_SCHED;
            PG8_STAGE(PG8_SB(1, 1), b3 + hstep, voffB);
            PG8_WAIT_V(6); PG8_BAR; PG8_MMA(1, 1, At, B1); PG8_BAR;
            }
        }
        if constexpr (ALIGN_EPI) { if (wr == 0) PG8_BAR; }
        if constexpr (!Epi::AFTER_DRAIN) { E(acc, cur, wr, wc, fr, fq); S.done(cur); }
        if (!has_next) break;
#pragma unroll
        for (int a = 0; a < 2; ++a)
#pragma unroll
            for (int b = 0; b < 2; ++b)
#pragma unroll
                for (int m = 0; m < 4; ++m)
#pragma unroll
                    for (int n = 0; n < 2; ++n) acc[a][b][m][n] = (f32x4){0.f, 0.f, 0.f, 0.f};
        cur = nxt; cA = nA; cB = nB; ++ui;
        if constexpr (ALIGN_EPI) { if (wr == 1) PG8_BAR; }
    }
    PG8_WAIT_V(0);
    if constexpr (!ALIGN_EPI) { if (wr == 0) PG8_BAR; }
    PG8_BAR;
    if constexpr (Epi::AFTER_DRAIN) { E.fused(acc, cur, wr, wc, fr, fq, lds, wid, lane); S.done(cur); }
#undef PG8_SA
#undef PG8_SB
#undef PG8_STAGE
#undef PG8_LDA
#undef PG8_LDB
#undef PG8_MMA
#undef PG8_WAIT_V
#undef PG8_WAIT_L
#undef PG8_BAR
#undef PG8_SCHED
}
}

#ifndef PG8_SP2
#define PG8_SP2 true
#endif

#include <hip/hip_bf16.h>
#include <cmath>
namespace attn_body {
using bf16=__hip_bfloat16;
using bf16x8=__attribute__((ext_vector_type(8)))short;
using s16x4=__attribute__((ext_vector_type(4)))short;
using f32x16=__attribute__((ext_vector_type(16)))float;
using u32x4=__attribute__((ext_vector_type(4)))unsigned;
constexpr int BATCH=4,NHEAD=16,SEQ=4096,D=64,PQ=512,PO=1024;
constexpr int NW=8,QBLK=32,QB=QBLK*NW,KVBLK=64,NQB=SEQ/QB;
constexpr int ATTN_UNIT_ROWS=QB;
__device__ __forceinline__ int crow(int r,int hi){return (r&3)+8*(r>>2)+4*hi;}
#define SBAR() __builtin_amdgcn_sched_barrier(0)
__device__ __forceinline__ void cmask(f32x16&p0,f32x16&p1,int jb,int qrel,int hi){
  const float NEG=-INFINITY; int kb=64*jb+4*hi;
  #pragma unroll
  for(int r=0;r<16;++r){int kv=kb+(r&3)+8*(r>>2); if(kv>qrel)p0[r]=NEG; if(kv+32>qrel)p1[r]=NEG;}
}

constexpr int NSLOT=3, SLOTB=8192;
constexpr int LDS_K=0, LDS_V=NSLOT*SLOTB, LDS_WS=2*NSLOT*SLOTB, LDS_OST=LDS_WS+NW*64*4, LDS_BYTES=LDS_OST+NW*4096;
constexpr float C2=0.125f*1.4426950408889634f;
__device__ __forceinline__ void glds16(const void*gsrc,unsigned lds_dst){unsigned keep;
  asm volatile("s_mov_b32 %0, m0\n\ts_mov_b32 m0, %2\n\ts_nop 0\n\tglobal_load_lds_dwordx4 %1, off\n\ts_mov_b32 m0, %0":"=&s"(keep):"v"(gsrc),"s"(lds_dst):"memory");}
__device__ __forceinline__ float max3f(float a,float b,float c){float r;asm("v_max3_f32 %0, %1, %2, %3":"=v"(r):"v"(a),"v"(b),"v"(c));return r;}
__device__ __forceinline__ float max2f(float a,float b){float r;asm("v_max_f32_e32 %0, %1, %2":"=v"(r):"v"(a),"v"(b));return r;}
__device__ __forceinline__ float fadd_s(float a,float b){float r;asm("v_add_f32_e32 %0, %1, %2":"=v"(r):"v"(a),"v"(b));return r;}
__device__ __forceinline__ float fsub_s(float a,float b){float r;asm("v_sub_f32_e32 %0, %1, %2":"=v"(r):"v"(a),"v"(b));return r;}
typedef float f32x2_t __attribute__((ext_vector_type(2))); typedef __bf16 bf16x2_t __attribute__((ext_vector_type(2)));
__device__ __forceinline__ unsigned cvtpk_s(float lo,float hi){f32x2_t v={lo,hi};bf16x2_t b=__builtin_convertvector(v,bf16x2_t);return __builtin_bit_cast(unsigned,b);}
#define WAIT_BAR(N) asm volatile("s_waitcnt vmcnt(" #N ") lgkmcnt(0)\n\ts_barrier":::"memory")

__device__ __forceinline__ void qkt(f32x16&p0,f32x16&p1,const char*Kslot,const bf16x8*qr,const f32x16&negm,int r32,int hi){
  const char*kb=Kslot+hi*1024+r32*16;
  #pragma unroll
  for(int d0=0;d0<4;++d0){
    const bf16x8 b0=*reinterpret_cast<const bf16x8*>(kb+d0*2048);
    const bf16x8 b1=*reinterpret_cast<const bf16x8*>(kb+d0*2048+512);
    if(d0==0){p0=__builtin_amdgcn_mfma_f32_32x32x16_bf16(b0,qr[0],negm,0,0,0);p1=__builtin_amdgcn_mfma_f32_32x32x16_bf16(b1,qr[0],negm,0,0,0);}
    else{p0=__builtin_amdgcn_mfma_f32_32x32x16_bf16(b0,qr[d0],p0,0,0,0);p1=__builtin_amdgcn_mfma_f32_32x32x16_bf16(b1,qr[d0],p1,0,0,0);}}
}
typedef __attribute__((address_space(3))) const char* lds_cptr;
typedef short v4i16_t __attribute__((ext_vector_type(4)));
__device__ __forceinline__ void kload8(bf16x8*kf,lds_cptr kp){
  kf[0]=*(const __attribute__((address_space(3))) bf16x8*)(kp);      kf[1]=*(const __attribute__((address_space(3))) bf16x8*)(kp+512);
  kf[2]=*(const __attribute__((address_space(3))) bf16x8*)(kp+2048); kf[3]=*(const __attribute__((address_space(3))) bf16x8*)(kp+2560);
  kf[4]=*(const __attribute__((address_space(3))) bf16x8*)(kp+4096); kf[5]=*(const __attribute__((address_space(3))) bf16x8*)(kp+4608);
  kf[6]=*(const __attribute__((address_space(3))) bf16x8*)(kp+6144); kf[7]=*(const __attribute__((address_space(3))) bf16x8*)(kp+6656);
}
__device__ __forceinline__ void kload2(bf16x8*kf,lds_cptr kp,int j){ kf[2*j]=*(const __attribute__((address_space(3))) bf16x8*)(kp+j*2048); kf[2*j+1]=*(const __attribute__((address_space(3))) bf16x8*)(kp+j*2048+512); }
__device__ __forceinline__ s16x4 vtr(lds_cptr p){ return __builtin_bit_cast(s16x4,__builtin_amdgcn_ds_read_tr16_b64_v4i16((__attribute__((address_space(3))) v4i16_t*)p)); }
__device__ __forceinline__ float rowmax(const f32x16&p0,const f32x16&p1){
  float a=max3f(p0[0],p0[1],p1[0]),b=max3f(p0[2],p0[3],p1[1]);a=max3f(a,p1[2],p1[3]);
  #pragma unroll
  for(int r=4;r<16;r+=4){a=max3f(a,p0[r],p0[r+1]);b=max3f(b,p0[r+2],p0[r+3]);a=max3f(a,p1[r],p1[r+1]);b=max3f(b,p1[r+2],p1[r+3]);}
  const float m=max2f(a,b);
  auto rr=__builtin_amdgcn_permlane32_swap(__float_as_uint(m),__float_as_uint(m),false,false);
  return max2f(__uint_as_float(rr[0]),__uint_as_float(rr[1]));
}
__device__ __forceinline__ void pv(f32x16*o,int vb,bf16x8 pa0,bf16x8 pa1,bf16x8 pa2,bf16x8 pa3){
  #pragma unroll
  for(int d0=0;d0<2;++d0){s16x4 lo[4],hi[4];
    #pragma unroll
    for(int ks=0;ks<4;++ks){
      asm volatile("ds_read_b64_tr_b16 %0,%1 offset:%c2":"=&v"(lo[ks]):"v"(vb),"i"(d0*4096+ks*1024):"memory");
      asm volatile("ds_read_b64_tr_b16 %0,%1 offset:%c2":"=&v"(hi[ks]):"v"(vb),"i"(d0*4096+ks*1024+512):"memory");}
    asm volatile("s_waitcnt lgkmcnt(0)":::"memory");SBAR();
    #define PK(k) (bf16x8){lo[k][0],lo[k][1],lo[k][2],lo[k][3],hi[k][0],hi[k][1],hi[k][2],hi[k][3]}
    o[d0]=__builtin_amdgcn_mfma_f32_32x32x16_bf16(pa0,PK(0),o[d0],0,0,0);
    o[d0]=__builtin_amdgcn_mfma_f32_32x32x16_bf16(pa1,PK(1),o[d0],0,0,0);
    o[d0]=__builtin_amdgcn_mfma_f32_32x32x16_bf16(pa2,PK(2),o[d0],0,0,0);
    o[d0]=__builtin_amdgcn_mfma_f32_32x32x16_bf16(pa3,PK(3),o[d0],0,0,0);
    #undef PK
  }
}

#ifndef ATTN_STORE16
#define ATTN_STORE16(p,v) (*(u32x4*)(p)=(v))
#endif
template<int THRL> __device__ __forceinline__ void attn_unit(int b,int h,int qb,const bf16*Q,const bf16*__restrict__ K,const bf16*__restrict__ V,bf16*O,char*shm){
  const int tid=threadIdx.x,lane=tid&63,r32=lane&31,hi=lane>>5; const int wid=__builtin_amdgcn_readfirstlane(tid>>6);
  const long rowbase=(long)b*SEQ; const int q0=qb*QB;
  const int qkc=(h>>1)*D, vcol=(h>>2)*128+(h&1)*D;
  const bf16*Qw=Q+(rowbase+q0+wid*QBLK)*PQ+qkc;
  const bf16*Kh=K+rowbase*PQ+qkc,*Vh=V+rowbase*PQ+vcol;
  const unsigned lds0=(unsigned)(uintptr_t)shm;
  float*wsf=(float*)(shm+LDS_WS)+wid*64;
  const bf16*ksrc=Kh+(long)lane*PQ+wid*8;
  const bf16*vsrc=Vh+(long)(16*(wid&3)+(lane>>2))*PQ+(wid>>2)*32+(lane&3)*8;
  const unsigned kdst=lds0+LDS_K+wid*1024, vdst=lds0+LDS_V+wid*1024;
  #define DMA_K(t,slot) glds16(ksrc+(long)(t)*KVBLK*PQ,(unsigned)__builtin_amdgcn_readfirstlane(kdst+(slot)))
  #define DMA_V(t,slot) glds16(vsrc+(long)(t)*KVBLK*PQ,(unsigned)__builtin_amdgcn_readfirstlane(vdst+(slot)))
  const int vb0=(int)(lds0+LDS_V)+((lane>>4)&1)*32+(lane&3)*8+(4*hi+((lane&15)>>2))*64;
  const char*Kbase=shm+LDS_K; bf16x8 kf[8];
  const lds_cptr shm3=(lds_cptr)shm; const lds_cptr kp0=shm3+LDS_K+hi*1024+r32*16; const lds_cptr vp0=shm3+LDS_V+((lane>>4)&1)*32+(lane&3)*8+(4*hi+((lane&15)>>2))*64;
  const int NT=(q0+QB)/KVBLK;
  DMA_K(0,0);DMA_V(0,0);DMA_K(1,SLOTB);
  bf16x8 qr[4];
  #pragma unroll
  for(int d0=0;d0<4;++d0)qr[d0]=*reinterpret_cast<const bf16x8*>(&Qw[(long)r32*PQ+d0*16+hi*8]);
  float mhat=0.f,l_reg=0.f;f32x16 o[2];o[0]=f32x16{};o[1]=f32x16{};f32x16 negm=f32x16{};asm volatile("":"+v"(negm));
  const int qrel=wid*QBLK+r32;
  #define CMASK(P0,P1,t) do{int jb_=(t)-(NT-4); if(jb_>=0)cmask(P0,P1,jb_,qrel,hi);}while(0)
  bool resc=false;
  #define START(P0,P1) do{ const float rm=rowmax(P0,P1); resc=false; \
    { const float dl=rm; mhat=fadd_s(mhat,dl); \
      _Pragma("unroll") for(int r=0;r<16;++r){P0[r]=fsub_s(P0[r],dl);P1[r]=fsub_s(P1[r],dl);} \
      _Pragma("unroll") for(int r=0;r<16;++r)negm[r]=-mhat; asm volatile("":"+v"(negm)); } \
    _Pragma("unroll") for(int r=0;r<16;++r)P0[r]=__builtin_amdgcn_exp2f(P0[r]); }while(0)
  #define RESC() do{ if(resc){ asm volatile("s_waitcnt lgkmcnt(0)":::"memory"); \
      _Pragma("unroll") for(int d_=0;d_<2;++d_) _Pragma("unroll") for(int r=0;r<16;++r)o[d_][r]*=wsf[crow(r,hi)]; } }while(0)
  f32x16 pA0,pA1,pB0,pB1;
  int sl_prev=0,sl_cur=0,sl_next=SLOTB;
  #define ROT() do{sl_prev=sl_cur;sl_cur=sl_next;sl_next=(sl_next==(NSLOT-1)*SLOTB)?0:sl_next+SLOTB;}while(0)
  DMA_K(2,2*SLOTB);
  WAIT_BAR(3);
  qkt(pA0,pA1,Kbase,qr,negm,r32,hi);asm volatile("s_nop 15\n\ts_nop 7":"+v"(pA0),"+v"(pA1));CMASK(pA0,pA1,0);
  START(pA0,pA1);
  _Pragma("unroll") for(int r=0;r<16;++r)pA1[r]=__builtin_amdgcn_exp2f(pA1[r]);
  WAIT_BAR(0);
  DMA_K(3,0);DMA_V(1,SLOTB);
  ROT();
  kload8(kf,kp0+sl_cur);
  WAIT_BAR(2);
  s16x4 vlo[8],vhi[8]; u32x4 pw0,pw1,pw2,pw3;
  #define PKW(P,B) cvtpk_s(P[B],P[B+1])
  #define PAF(k) __builtin_bit_cast(bf16x8,pw##k)
  #define VFR(i) (bf16x8){vlo[i][0],vlo[i][1],vlo[i][2],vlo[i][3],vhi[i][0],vhi[i][1],vhi[i][2],vhi[i][3]}
  #define PIN(x) asm volatile("":"+v"(x))
  #define MX3(a,b,c) __builtin_fmaxf(__builtin_fmaxf((a),(b)),(c))
  #define GAPA(MF,A0,A1,A2,A3,W0,W1,PW) do{ MF; sacc+=A0; sacc+=A1; sacc+=A2; sacc+=A3; PIN(sacc); W0; W1; PIN(PW); SBAR(); }while(0)
  #define EX(v) __builtin_amdgcn_exp2f(v)
  #define GAPB(MF,X,B) do{ MF; X[B]=EX(X[B]); X[B+1]=EX(X[B+1]); X[B+2]=EX(X[B+2]); X[B+3]=EX(X[B+3]); PIN(X); SBAR(); }while(0)
  #define VRD(i) do{ vlo[i]=vtr(vp_+(((i)>>2)*4096+((i)&3)*1024)); vhi[i]=vtr(vp_+(((i)>>2)*4096+((i)&3)*1024+512)); }while(0)
  #define KRD(G,j) do{ if(G){ kload2(kf,kp0+sl_next,j); SBAR(); } }while(0)
  #define STEP(C0,C1,P0,P1,t,GK,GV,GL) do{ SBAR(); \
    const lds_cptr vp_=vp0+sl_prev; \
    VRD(0); SBAR(); float sacc=(P0[0]+P0[1]); \
    GAPA(C0=__builtin_amdgcn_mfma_f32_32x32x16_bf16(kf[0],qr[0],negm,0,0,0), P0[2],P0[3],P0[4],P0[5],     pw0[0]=PKW(P0,0), pw0[1]=PKW(P0,2), pw0); \
    VRD(4); SBAR(); GAPA(C1=__builtin_amdgcn_mfma_f32_32x32x16_bf16(kf[1],qr[0],negm,0,0,0), P0[6],P0[7],P0[8],P0[9],     pw0[2]=PKW(P0,4), pw0[3]=PKW(P0,6), pw0); \
    VRD(1); SBAR(); GAPA(C0=__builtin_amdgcn_mfma_f32_32x32x16_bf16(kf[2],qr[1],C0,0,0,0),   P0[10],P0[11],P0[12],P0[13], pw1[0]=PKW(P0,8), pw1[1]=PKW(P0,10), pw1); \
    VRD(5); SBAR(); GAPA(C1=__builtin_amdgcn_mfma_f32_32x32x16_bf16(kf[3],qr[1],C1,0,0,0),   P0[14],P0[15],P1[0],P1[1],   pw1[2]=PKW(P0,12),pw1[3]=PKW(P0,14), pw1); \
    VRD(2); SBAR(); GAPA(C0=__builtin_amdgcn_mfma_f32_32x32x16_bf16(kf[4],qr[2],C0,0,0,0),   P1[2],P1[3],P1[4],P1[5],     pw2[0]=PKW(P1,0), pw2[1]=PKW(P1,2), pw2); \
    VRD(6); SBAR(); GAPA(C1=__builtin_amdgcn_mfma_f32_32x32x16_bf16(kf[5],qr[2],C1,0,0,0),   P1[6],P1[7],P1[8],P1[9],     pw2[2]=PKW(P1,4), pw2[3]=PKW(P1,6), pw2); \
    VRD(3); SBAR(); GAPA(C0=__builtin_amdgcn_mfma_f32_32x32x16_bf16(kf[6],qr[3],C0,0,0,0),   P1[10],P1[11],P1[12],P1[13], pw3[0]=PKW(P1,8), pw3[1]=PKW(P1,10), pw3); \
    VRD(7); SBAR(); GAPA(C1=__builtin_amdgcn_mfma_f32_32x32x16_bf16(kf[7],qr[3],C1,0,0,0),   P1[14],P1[15],0.f,0.f,       pw3[2]=PKW(P1,12),pw3[3]=PKW(P1,14), pw3); \
    l_reg+=sacc; \
    if(GK){DMA_K((t)+3,sl_cur);} if(GV){DMA_V((t)+1,sl_next);} \
    CMASK(C0,C1,t); \
    { float a=MX3(C0[0],C0[1],C1[0]),b=MX3(C0[2],C0[3],C1[1]); a=MX3(a,C1[2],C1[3]); \
      _Pragma("unroll") for(int r=4;r<16;r+=4){a=MX3(a,C0[r],C0[r+1]);b=MX3(b,C0[r+2],C0[r+3]);a=MX3(a,C1[r],C1[r+1]);b=MX3(b,C1[r+2],C1[r+3]);} \
      float rm=__builtin_fmaxf(a,b); { auto rr=__builtin_amdgcn_permlane32_swap(__float_as_uint(rm),__float_as_uint(rm),false,false); rm=__builtin_fmaxf(__uint_as_float(rr[0]),__uint_as_float(rr[1])); } \
      resc=false; \
      if(__builtin_expect(__any(rm>(float)THRL),0)){ const float dl=__builtin_fmaxf(rm,0.f); mhat+=dl; \
        _Pragma("unroll") for(int r=0;r<16;++r){C0[r]-=dl;C1[r]-=dl;} \
        _Pragma("unroll") for(int r=0;r<16;++r)negm[r]=-mhat; asm volatile("":"+v"(negm)); \
        const float f=__builtin_amdgcn_exp2f(-dl); l_reg*=f; if(hi==0)wsf[r32]=f; resc=true; } } \
    SBAR(); \
    GAPB(o[0]=__builtin_amdgcn_mfma_f32_32x32x16_bf16(PAF(0),VFR(0),o[0],0,0,0), C0,0); \
    GAPB(o[1]=__builtin_amdgcn_mfma_f32_32x32x16_bf16(PAF(0),VFR(4),o[1],0,0,0), C0,4); \
    KRD(GL,0); GAPB(o[0]=__builtin_amdgcn_mfma_f32_32x32x16_bf16(PAF(1),VFR(1),o[0],0,0,0), C0,8); \
    KRD(GL,1); GAPB(o[1]=__builtin_amdgcn_mfma_f32_32x32x16_bf16(PAF(1),VFR(5),o[1],0,0,0), C0,12); \
    KRD(GL,2); GAPB(o[0]=__builtin_amdgcn_mfma_f32_32x32x16_bf16(PAF(2),VFR(2),o[0],0,0,0), C1,0); \
    KRD(GL,3); GAPB(o[1]=__builtin_amdgcn_mfma_f32_32x32x16_bf16(PAF(2),VFR(6),o[1],0,0,0), C1,4); \
    GAPB(o[0]=__builtin_amdgcn_mfma_f32_32x32x16_bf16(PAF(3),VFR(3),o[0],0,0,0), C1,8); \
    GAPB(o[1]=__builtin_amdgcn_mfma_f32_32x32x16_bf16(PAF(3),VFR(7),o[1],0,0,0), C1,12); \
    }while(0)
  int t=1;
  #undef CMASK
  #define CMASK(P0,P1,t) do{}while(0)
  for(;t+5<NT;t+=2){
    STEP(pB0,pB1,pA0,pA1,t,true,true,true);     WAIT_BAR(2); RESC(); ROT();
    STEP(pA0,pA1,pB0,pB1,t+1,true,true,true);   WAIT_BAR(2); RESC(); ROT();
  }
  #undef CMASK
  #define CMASK(P0,P1,t) do{int jb_=(t)-(NT-4); if(jb_>=0)cmask(P0,P1,jb_,qrel,hi);}while(0)
  #define ENDW(tt) do{ if((tt)+3<NT){WAIT_BAR(2);} else if((tt)+2<NT){WAIT_BAR(1);} else {WAIT_BAR(0);} }while(0)
  for(;t+1<NT;t+=2){
    STEP(pB0,pB1,pA0,pA1,t,(t+3<NT),(t+1<NT),(t+1<NT));       ENDW(t);   RESC(); ROT();
    STEP(pA0,pA1,pB0,pB1,t+1,(t+4<NT),(t+2<NT),(t+2<NT));     ENDW(t+1); RESC(); ROT();
  }
  STEP(pB0,pB1,pA0,pA1,NT-1,false,false,false); RESC();
  { float sacc=pB0[0]+pB0[1]; _Pragma("unroll") for(int r=2;r<16;++r)sacc+=pB0[r]; _Pragma("unroll") for(int r=0;r<16;++r)sacc+=pB1[r]; l_reg+=sacc;
    pw0=(u32x4){PKW(pB0,0),PKW(pB0,2),PKW(pB0,4),PKW(pB0,6)};pw1=(u32x4){PKW(pB0,8),PKW(pB0,10),PKW(pB0,12),PKW(pB0,14)};pw2=(u32x4){PKW(pB1,0),PKW(pB1,2),PKW(pB1,4),PKW(pB1,6)};pw3=(u32x4){PKW(pB1,8),PKW(pB1,10),PKW(pB1,12),PKW(pB1,14)};
    SBAR(); pv(o,vb0+sl_cur,PAF(0),PAF(1),PAF(2),PAF(3)); }
  #undef PKW
  #undef PAF
  #undef VFR
  #undef PIN
  #undef MX3
  #undef GAPA
  #undef GAPB
  #undef EX
  #undef VRD
  #undef KRD
  #undef STEP
  #undef ENDW
  {auto rr=__builtin_amdgcn_permlane32_swap(__float_as_uint(l_reg),__float_as_uint(l_reg),false,false);l_reg=__uint_as_float(rr[0])+__uint_as_float(rr[1]);}
  if(hi==0)wsf[32+r32]=l_reg;asm volatile("s_waitcnt lgkmcnt(0)":::"memory");
  float rli[16];
  #pragma unroll
  for(int r=0;r<16;++r)rli[r]=__builtin_amdgcn_rcpf(wsf[32+crow(r,hi)]);
  bf16*Ow=O+(rowbase+q0+wid*QBLK)*PO+h*D;
  { bf16*stg=(bf16*)(shm+LDS_OST)+wid*2048;
    #pragma unroll
    for(int r=0;r<16;++r){const int orow=crow(r,hi);
      #pragma unroll
      for(int d0=0;d0<2;++d0)stg[orow*64+d0*32+r32]=__float2bfloat16(o[d0][r]*rli[r]);}
    asm volatile("s_waitcnt lgkmcnt(0)":::"memory");
    #pragma unroll
    for(int i=0;i<4;++i){const int row=i*8+(lane>>3),ch=lane&7; const u32x4 v=*(const u32x4*)(stg+row*64+ch*8); ATTN_STORE16(Ow+(long)row*PO+ch*8,v);} }
  asm volatile("s_waitcnt lgkmcnt(0)\n\ts_barrier":::"memory");
  #undef DMA_K
  #undef DMA_V
  #undef CMASK
  #undef START
  #undef RESC
  #undef ROT
}
constexpr int ATTN_LDS_BYTES=LDS_BYTES;
struct AttnTensors { const bf16* Q; const bf16* K; const bf16* V; bf16* O; };
struct AttnUnit { int bh; int qb; };
struct StaticOrder {
  int vcu;
  __device__ __forceinline__ explicit StaticOrder(int grid,int block):vcu((block%8)*(grid/8)+block/8){}
  __device__ __forceinline__ bool next(int i,AttnUnit&u)const{ if(i>=4)return false; const int s=vcu&3; u.bh=vcu>>2; u.qb=(i==0)?s:(i==1)?7-s:(i==2)?8+s:15-s; return true; }
  __device__ __forceinline__ void a_ready(const AttnUnit&)const{}
  __device__ __forceinline__ void done(const AttnUnit&)const{}
};
template<class Sched,int THRL=8> __device__ __forceinline__ void attn_phase(char*lds,const AttnTensors&T,const Sched&S){
  AttnUnit u;
  for(int i=0;S.next(i,u);++i){ S.a_ready(u); attn_unit<THRL>(u.bh/NHEAD,u.bh%NHEAD,u.qb,T.Q,T.K,T.V,T.O,lds); S.done(u); }
}
#undef SBAR
#undef WAIT_BAR
}

#define GAS __attribute__((address_space(1)))
#define LAS __attribute__((address_space(3)))
typedef unsigned short bf16;
typedef unsigned v4u __attribute__((ext_vector_type(4)));
typedef float f32x4 __attribute__((ext_vector_type(4)));
typedef short bf16x8 __attribute__((ext_vector_type(8)));
typedef GAS unsigned gu32;
typedef GAS unsigned long long gu64;
#define RLX_AGENT __ATOMIC_RELAXED, __HIP_MEMORY_SCOPE_AGENT
#define LDS_WAIT() asm volatile("s_waitcnt lgkmcnt(0)" ::: "memory")
#define VM_WAIT() asm volatile("s_waitcnt vmcnt(0)" ::: "memory")
__device__ __forceinline__ unsigned long long rt() { return __builtin_amdgcn_s_memrealtime(); }
__device__ __forceinline__ unsigned f2bf(float f) { unsigned u = __builtin_bit_cast(unsigned, f); return (u + 0x7fffu + ((u >> 16) & 1u)) >> 16; }
__device__ __forceinline__ unsigned pk2(float lo, float hi) { return f2bf(lo) | (f2bf(hi) << 16); }

#define XB_TMO      128
#define XB_XCNT(j)  (256  + 64 * (j))
#define XB_XSUB(j)  (1280 + 64 * (j))
#define XB_XGEN(j)  (2304 + 64 * (j))
#define XB_TOP      3328
#define XB_TOPGEN   3392
#define XCD_BAR_WORDS 3456
#define XB_SPIN_CAP (1u << 18)

__device__ __forceinline__ unsigned xb_ld(unsigned* p)              { return __hip_atomic_load(p, __ATOMIC_RELAXED, __HIP_MEMORY_SCOPE_AGENT); }
__device__ __forceinline__ unsigned xb_add(unsigned* p, unsigned v) { return __hip_atomic_fetch_add(p, v, __ATOMIC_RELAXED, __HIP_MEMORY_SCOPE_AGENT); }
__device__ __forceinline__ unsigned xb_xcc_id() { return (unsigned)__builtin_amdgcn_s_getreg((3 << 11) | 20) & 0xFu; }
#define XB_SPIN(cond, bar) do { unsigned _sp = 0; while (cond) { __builtin_amdgcn_s_sleep(1); \
    if ((++_sp & 255u) == 0u) { if (xb_ld(&(bar)[XB_TMO])) break; if (_sp > XB_SPIN_CAP) { atomicAdd(&(bar)[XB_TMO], 1u); break; } } } } while (0)

struct XcdBarrier {
    unsigned* bar; unsigned x;
    volatile LAS unsigned* st;
};

__device__ __forceinline__ XcdBarrier xcd_barrier_post(unsigned* bar, volatile LAS unsigned* st) {
    XcdBarrier b; b.bar = bar; b.x = xb_xcc_id(); b.st = st;
    if (threadIdx.x == 0) (void)xb_add(&bar[XB_XCNT(b.x)], 1u);
    return b;
}
__device__ __forceinline__ void xcd_barrier_complete(unsigned* bar, unsigned x, unsigned& nloc, unsigned& nx) {
    const unsigned G = gridDim.x * gridDim.y * gridDim.z;
    unsigned sum, cnt, mine, sp = 0u;
    for (;;) {
        sum = 0u; cnt = 0u; mine = 0u;
#pragma unroll
        for (unsigned j = 0; j < 16; ++j) { const unsigned c = xb_ld(&bar[XB_XCNT(j)]); sum += c; cnt += (c > 0u) ? 1u : 0u; mine = (j == x) ? c : mine; }
        if (sum == G) break;
        __builtin_amdgcn_s_sleep(1);
        if ((++sp & 255u) == 0u) { if (xb_ld(&bar[XB_TMO])) break; if (sp > XB_SPIN_CAP) { atomicAdd(&bar[XB_TMO], 1u); break; } }
    }
    nloc = mine > 0u ? mine : 1u; nx = cnt > 0u ? cnt : 1u;
}

__device__ __forceinline__ void xcd_barrier(const XcdBarrier& b) {
    asm volatile("s_waitcnt vmcnt(0)" ::: "memory");
    __syncthreads();
    if (threadIdx.x == 0) {
        unsigned* bar = b.bar;
        __builtin_amdgcn_s_waitcnt(0);
        unsigned nloc = b.st[0], nx = b.st[1];
        if (nloc == 0u) { xcd_barrier_complete(bar, b.x, nloc, nx); b.st[0] = nloc; b.st[1] = nx; }
        const unsigned old = xb_add(&bar[XB_XSUB(b.x)], 1u);
        const unsigned gen = old / nloc;
        if (old + 1u == (gen + 1u) * nloc) {
            __builtin_amdgcn_fence(__ATOMIC_RELEASE, "agent");
            asm volatile("s_waitcnt vmcnt(0)" ::: "memory");
            const unsigned og = xb_add(&bar[XB_TOP], 1u);
            const unsigned tg = og / nx;
            if (og + 1u == (tg + 1u) * nx) xb_add(&bar[XB_TOPGEN], 1u);
            else XB_SPIN(xb_ld(&bar[XB_TOPGEN]) == tg, bar);
            __builtin_amdgcn_fence(__ATOMIC_ACQUIRE, "agent");
            xb_add(&bar[XB_XGEN(b.x)], 1u);
            asm volatile("s_waitcnt vmcnt(0)" ::: "memory");
        } else {
            XB_SPIN(xb_ld(&bar[XB_XGEN(b.x)]) == gen, bar);
            __builtin_amdgcn_fence(__ATOMIC_ACQUIRE, "agent");
            asm volatile("s_waitcnt vmcnt(0)" ::: "memory");
        }
    }
    __syncthreads();
}


constexpr int NWAVES = 8;
constexpr int BATCH = 4, SEQ = 4096, DM = 1024, M = BATCH * SEQ, IN_COLS = 5632, NEXP = 32, EFF = 512;
constexpr float EPS = 1e-6f;
constexpr float LAM_INIT = 0.2f;
constexpr int MAXROWS = 2 * M + NEXP * 255;
#ifndef MK_PER_PHASE
#define MK_PER_PHASE 0
#endif
constexpr int N_PHASES = 14;

constexpr size_t MiB = 1u << 20;
constexpr size_t WS_CTL = 0, CTL_ZERO_BYTES = 1 * MiB;
constexpr size_t WS_WIN = 1 * MiB, WS_WA = 12 * MiB, WS_WB = 13 * MiB, WS_WOUT = 14 * MiB;
constexpr size_t WS_TABA = 16 * MiB, WS_TABB = 17 * MiB, WS_WRP = 25 * MiB;
constexpr size_t WS_H = 26 * MiB;
constexpr size_t WS_P = 58 * MiB, PBUF = 16 * MiB;
constexpr size_t WS_OA = 234 * MiB, WS_OB = 250 * MiB;
constexpr size_t WS_T = 58 * MiB, WS_MERGED = 122 * MiB;
constexpr size_t WS_Y = 58 * MiB;
constexpr size_t WS_XS = 58 * MiB, WS_HMID = 138 * MiB, WS_WGU = 178 * MiB, WS_WD = 242 * MiB;
constexpr size_t WS_ENT_TOK = 274 * MiB, WS_ENT_W = 276 * MiB, WS_ROW_TOK = 278 * MiB, WS_ROW_W = 278 * MiB + 512 * 1024, WS_END = 279 * MiB;
static_assert((size_t)MAXROWS * 1024 * 2 <= WS_HMID - WS_XS && (size_t)MAXROWS * 512 * 2 <= WS_WGU - WS_HMID && (size_t)MAXROWS * 4 <= 512 * 1024, "ws map");
constexpr int CW_TMO = 0, CW_CODE = 1, CW_CNT = 64, CW_BAR = 4096;

constexpr int RING_OFF = 0, RING_BYTES = 131072;
constexpr int LDSCTL_OFF = RING_BYTES, MISC_OFF = LDSCTL_OFF + 320;
constexpr int LDS_BYTES = 147456;
constexpr int MI_CNT = 16, MI_TP = 48;


struct Frame {
    LAS unsigned char* lds;
    volatile LAS unsigned* MISC;
    gu32* ctl;
    int tid, lane, wave;
    int vcu, G;
    const float* in[24]; float* out; unsigned char* ws;
};
__device__ __forceinline__ float bflo(unsigned w) { return __uint_as_float(w << 16); }
__device__ __forceinline__ float bfhi(unsigned w) { return __uint_as_float(w & 0xffff0000u); }
__device__ __forceinline__ float wave_sum(float v) {
#pragma unroll
    for (int o = 1; o < 64; o <<= 1) v += __shfl_xor(v, o);
    return v;
}
__device__ __forceinline__ float sigmoidf_(float x) { return 1.0f / (1.0f + __expf(-x)); }
__device__ __forceinline__ float siluf_(float x) { return x / (1.0f + __expf(-x)); }
__device__ __forceinline__ void unpack8(const v4u r, float (&x)[8]) {
    x[0] = bflo(r.x); x[1] = bfhi(r.x); x[2] = bflo(r.y); x[3] = bfhi(r.y); x[4] = bflo(r.z); x[5] = bfhi(r.z); x[6] = bflo(r.w); x[7] = bfhi(r.w);
}
__device__ __forceinline__ v4u pack8(const float (&x)[8]) { v4u o; o.x = pk2(x[0], x[1]); o.y = pk2(x[2], x[3]); o.z = pk2(x[4], x[5]); o.w = pk2(x[6], x[7]); return o; }

__device__ __forceinline__ void transpose_item(const float* W, int N, bf16* WT, int ldt, int koff, int mode, LAS float* scr, int kb, int nb, int lane) {
    const int k0 = 64 * kb, n0 = 32 * nb;
#pragma unroll 8
    for (int i = 0; i < 32; ++i) { const int kk = 2 * i + (lane >> 5); scr[kk * 33 + (lane & 31)] = W[(size_t)(k0 + kk) * N + n0 + (lane & 31)]; }
    LDS_WAIT(); asm volatile("" ::: "memory");
    const int c = lane & 7;
#pragma unroll
    for (int j = 0; j < 4; ++j) { const int n = (lane >> 3) + 8 * j; const LAS float* s = scr + (8 * c) * 33 + n;
        v4u o; o.x = pk2(s[0 * 33], s[1 * 33]); o.y = pk2(s[2 * 33], s[3 * 33]); o.z = pk2(s[4 * 33], s[5 * 33]); o.w = pk2(s[6 * 33], s[7 * 33]);
        const int nn = n0 + n; const int row = mode == 0 ? nn : ((nn >> 2) * 8 + (mode == 2 ? 4 : 0) + (nn & 3));
        *(GAS v4u*)(WT + (size_t)row * ldt + koff + k0 + 8 * c) = o; }
    LDS_WAIT(); asm volatile("" ::: "memory");
}
__device__ __forceinline__ void sincos_acc(float ang, float& s, float& c) {
    const double t = (double)ang * 0.15915494309189535; const double fr = t - __builtin_rint(t);
    const float r = (float)(fr * 6.283185307179586);
    s = sinf(r); c = cosf(r);
}
__device__ __forceinline__ void p0_prologue(Frame& F) {
    LAS float* scr = (LAS float*)(F.lds + RING_OFF + F.wave * 16384);
    const int gw = F.vcu * NWAVES + F.wave, NGW = F.G * NWAVES;
    unsigned char* ws = F.ws;
    constexpr int I_IN = (DM / 64) * (IN_COLS / 32), I_A = (512 / 64) * (DM / 32), I_OUT = (DM / 64) * (DM / 32);
    for (int it = gw; it < I_IN + 2 * I_A + I_OUT; it += NGW) {
        int r = it;
        if (r < I_IN) { transpose_item(F.in[3], IN_COLS, (bf16*)(ws + WS_WIN), DM, 0, 0, scr, r / (IN_COLS / 32), r % (IN_COLS / 32), F.lane); continue; } r -= I_IN;
        if (r < I_A) { transpose_item(F.in[13], DM, (bf16*)(ws + WS_WA), 512, 0, 0, scr, r / (DM / 32), r % (DM / 32), F.lane); continue; } r -= I_A;
        if (r < I_A) { transpose_item(F.in[14], DM, (bf16*)(ws + WS_WB), 512, 0, 0, scr, r / (DM / 32), r % (DM / 32), F.lane); continue; } r -= I_A;
        transpose_item(F.in[15], DM, (bf16*)(ws + WS_WOUT), DM, 0, 0, scr, r / (DM / 32), r % (DM / 32), F.lane);
    }
    {
        const float* wgr = F.in[17]; const float* wer = F.in[19]; f32x4* Wp4 = (f32x4*)(ws + WS_WRP);
        for (int idx = gw * 64 + F.lane; idx < 64 * 3 * 64; idx += NGW * 64) {
            const int l = idx & 63, st = idx >> 6, t = st % 3, s = st / 3, col = l & 15, q = l >> 4;
            f32x4 v;
#pragma unroll
            for (int j = 0; j < 4; ++j) { const int k = 16 * s + 4 * q + j; v[j] = (t == 0) ? (col < 4 ? wgr[k * 4 + col] : 0.f) : wer[k * 32 + (t - 1) * 16 + col]; }
            Wp4[idx] = v;
        }
    }
    {
        const int* pos = (const int*)F.in[1]; float* tabA = (float*)(ws + WS_TABA); float* tabB = (float*)(ws + WS_TABB);
        const float fB = powf(10000.0f, -(float)F.lane * (1.0f / 64.0f)), fA = powf(500000.0f, -(float)(F.lane & 7) * 0.125f);
        for (int tk = gw; tk < M; tk += NGW) {
            const float p = (float)pos[tk]; float s, c;
            sincos_acc(p * fB, s, c); tabB[(size_t)tk * 128 + F.lane] = c; tabB[(size_t)tk * 128 + 64 + F.lane] = s;
            if (F.lane < 8) { sincos_acc(p * fA, s, c); tabA[(size_t)tk * 16 + F.lane] = c; tabA[(size_t)tk * 16 + 8 + F.lane] = s; }
        }
    }
    {
        const float* g = F.in[2]; bf16* H = (bf16*)(ws + WS_H);
        f32x4 gv[4];
#pragma unroll
        for (int j = 0; j < 4; ++j) gv[j] = ((const f32x4*)g)[F.lane + 64 * j];
        for (int m = gw; m < M; m += NGW) {
            const GAS f32x4* xr = (const GAS f32x4*)(F.in[0] + (size_t)m * DM) + F.lane;
            f32x4 v[4]; float s = 0.f;
#pragma unroll
            for (int j = 0; j < 4; ++j) { v[j] = xr[64 * j]; s += (v[j].x * v[j].x + v[j].y * v[j].y) + (v[j].z * v[j].z + v[j].w * v[j].w); }
            const float rstd = rsqrtf(wave_sum(s) * (1.f / DM) + EPS);
            GAS unsigned long long* o8 = (GAS unsigned long long*)(H + (size_t)m * DM) + F.lane;
#pragma unroll
            for (int j = 0; j < 4; ++j) o8[64 * j] = (unsigned long long)pk2(v[j].x * rstd * gv[j].x, v[j].y * rstd * gv[j].y) | ((unsigned long long)pk2(v[j].z * rstd * gv[j].z, v[j].w * rstd * gv[j].w) << 32);
        }
    }
}

__device__ __forceinline__ void p2_post(Frame& F) {
    const int gw = F.vcu * NWAVES + F.wave, NGW = F.G * NWAVES, lane = F.lane;
    unsigned char* ws = F.ws;
    const float* tabA = (const float*)(ws + WS_TABA); const float* tabB = (const float*)(ws + WS_TABB);
    constexpr float C2 = 0.125f * 1.4426950408889634f;
    const int sub = lane & 7;
    float qg[8], kg[8];
#pragma unroll
    for (int t = 0; t < 8; ++t) { qg[t] = F.in[4][sub * 8 + t]; kg[t] = F.in[5][sub * 8 + t]; }
    for (int tk = gw; tk < M; tk += NGW) {
        float ca[8], sa[8];
#pragma unroll
        for (int t = 0; t < 8; ++t) { ca[t] = tabA[(size_t)tk * 16 + t]; sa[t] = tabA[(size_t)tk * 16 + 8 + t]; }
#pragma unroll
        for (int which = 0; which < 2; ++which) {
            GAS v4u* p = (GAS v4u*)((bf16*)(ws + WS_P + (size_t)which * PBUF) + (size_t)tk * 512 + lane * 8);
            float x[8]; unpack8(*p, x);
            float ss = 0.f;
#pragma unroll
            for (int t = 0; t < 8; ++t) ss += x[t] * x[t];
            ss += __shfl_xor(ss, 1); ss += __shfl_xor(ss, 2); ss += __shfl_xor(ss, 4);
            const float rstd = rsqrtf(ss * (1.f / 64.f) + EPS);
            float y[8];
#pragma unroll
            for (int t = 0; t < 8; ++t) y[t] = x[t] * rstd * (which == 0 ? qg[t] : kg[t]);
#pragma unroll
            for (int t = 0; t < 8; ++t) { const float o = __shfl_xor(y[t], 1);
                if (sub == 0) y[t] = y[t] * ca[t] - o * sa[t]; else if (sub == 1) y[t] = y[t] * ca[t] + o * sa[t]; }
            if (which == 0) {
#pragma unroll
                for (int t = 0; t < 8; ++t) y[t] *= C2;
            }
            *p = pack8(y);
        }
        const int i0 = (lane & 7) * 8;
        float cb[8], sb[8];
#pragma unroll
        for (int t = 0; t < 8; ++t) { cb[t] = tabB[(size_t)tk * 128 + i0 + t]; sb[t] = tabB[(size_t)tk * 128 + 64 + i0 + t]; }
#pragma unroll
        for (int which = 0; which < 2; ++which) {
            GAS v4u* p = (GAS v4u*)((bf16*)(ws + WS_P + (size_t)(3 + which) * PBUF) + (size_t)tk * 512 + lane * 8);
            float x[8]; unpack8(*p, x); float y[8];
#pragma unroll
            for (int t = 0; t < 8; ++t) { const float o = __shfl_xor(x[t], 8);
                y[t] = (lane & 8) ? (x[t] * cb[t] + o * sb[t]) : (x[t] * cb[t] - o * sb[t]);
                if (which == 1) y[t] *= 0.08838834764831845f; }
            *p = pack8(y);
        }
    }
}

__device__ __forceinline__ int rt_off(int row, int kb) { return row * 256 + ((((kb >> 4) ^ (row & 15)) << 4) | (kb & 15)); }
__device__ __forceinline__ bf16x8 rt_frag(const LAS unsigned char* tile, int r0, int ks, int lane) {
    return *(const LAS bf16x8*)(tile + rt_off(r0 + (lane & 15), ks * 64 + 16 * (lane >> 4)));
}
__device__ __forceinline__ float log2_gamma(int h) { return log2f(1.0f - exp2f(-5.0f - (float)h)); }

__device__ __forceinline__ void ret_kv_item(Frame& F, int item) {
    const int bh = item >> 5, n = item & 31, b = bh >> 2, h = bh & 3, tid = F.tid, lane = F.lane, w = F.wave;
    const size_t tok0 = (size_t)b * SEQ + (size_t)n * 128;
    const bf16* kr = (const bf16*)(F.ws + WS_P + 4 * PBUF); const bf16* vr = (const bf16*)(F.ws + WS_P + 5 * PBUF);
    float* RS = F.out + (size_t)item * 16384;
    LAS unsigned char* Kt = F.lds; LAS unsigned char* Vt = F.lds + 32768;
    const float lg = log2_gamma(h);
#pragma unroll
    for (int it = 0; it < 4; ++it) {
        const int idx = tid + it * 512, j = idx & 127, ch = idx >> 7;
        const v4u kv = *(const GAS v4u*)(kr + (tok0 + j) * 512 + h * 128 + ch * 8);
        const v4u vv = *(const GAS v4u*)(vr + (tok0 + j) * 512 + h * 128 + ch * 8);
        float kx[8], vx[8]; unpack8(kv, kx); unpack8(vv, vx);
        const float z = exp2f((float)(127 - j) * lg);
#pragma unroll
        for (int t = 0; t < 8; ++t) {
            *(LAS unsigned short*)(Kt + rt_off(ch * 8 + t, j * 2)) = (unsigned short)f2bf(kx[t]);
            *(LAS unsigned short*)(Vt + rt_off(ch * 8 + t, j * 2)) = (unsigned short)f2bf(vx[t] * z);
        }
    }
    __syncthreads();
    f32x4 acc[8];
#pragma unroll
    for (int dt = 0; dt < 8; ++dt) acc[dt] = (f32x4){0.f, 0.f, 0.f, 0.f};
#pragma unroll
    for (int ks = 0; ks < 4; ++ks) {
        const bf16x8 a = rt_frag(Vt, 16 * w, ks, lane);
#pragma unroll
        for (int dt = 0; dt < 8; ++dt) { const bf16x8 bb = rt_frag(Kt, 16 * dt, ks, lane); acc[dt] = __builtin_amdgcn_mfma_f32_16x16x32_bf16(bb, a, acc[dt], 0, 0, 0); }
    }
    const int e = 16 * w + (lane & 15), q = lane >> 4;
#pragma unroll
    for (int dt = 0; dt < 8; ++dt) *(GAS f32x4*)(RS + (size_t)e * 128 + 16 * dt + 4 * q) = acc[dt];
    __syncthreads();
}
__device__ __forceinline__ void p4_scan(Frame& F) {
    const int gid = F.vcu * (NWAVES * 64) + F.tid, NT = F.G * NWAVES * 64;
    for (int idx = gid; idx < 16 * 4096; idx += NT) {
        const int bh = idx >> 12, off = idx & 4095, h = bh & 3;
        const float g = exp2f(128.0f * log2_gamma(h));
        f32x4 r = (f32x4){0.f, 0.f, 0.f, 0.f};
        GAS f32x4* p = (GAS f32x4*)(F.out + (size_t)bh * 32 * 16384) + off;
        for (int n = 0; n < 32; ++n) { const f32x4 t = p[(size_t)n * 4096]; p[(size_t)n * 4096] = r; r = r * g + t; }
    }
}
__device__ __forceinline__ void ret_out_item(Frame& F, int item) {
    const int bh = item >> 5, n = item & 31, b = bh >> 2, h = bh & 3, tid = F.tid, lane = F.lane, w = F.wave;
    const size_t tok0 = (size_t)b * SEQ + (size_t)n * 128;
    const bf16* qr = (const bf16*)(F.ws + WS_P + 3 * PBUF); const bf16* kr = (const bf16*)(F.ws + WS_P + 4 * PBUF); const bf16* vr = (const bf16*)(F.ws + WS_P + 5 * PBUF);
    const bf16* gb = (const bf16*)(F.ws + WS_P + 6 * PBUF); bf16* obg = (bf16*)(F.ws + WS_OB);
    const float* RS = F.out + (size_t)item * 16384;
    LAS unsigned char* Qs = F.lds; LAS unsigned char* Ks = F.lds + 32768; LAS unsigned char* Vt = F.lds + 65536; LAS unsigned char* Rt = F.lds + 98304;
    const float lg = log2_gamma(h);
#pragma unroll
    for (int it = 0; it < 4; ++it) {
        const int idx = tid + it * 512;
        { const int row = idx >> 4, ch = idx & 15;
          *(LAS v4u*)(Qs + rt_off(row, ch * 16)) = *(const GAS v4u*)(qr + (tok0 + row) * 512 + h * 128 + ch * 8);
          *(LAS v4u*)(Ks + rt_off(row, ch * 16)) = *(const GAS v4u*)(kr + (tok0 + row) * 512 + h * 128 + ch * 8);
          const f32x4 r0 = *(const GAS f32x4*)(RS + (size_t)row * 128 + ch * 8), r1 = *(const GAS f32x4*)(RS + (size_t)row * 128 + ch * 8 + 4);
          v4u o; o.x = pk2(r0.x, r0.y); o.y = pk2(r0.z, r0.w); o.z = pk2(r1.x, r1.y); o.w = pk2(r1.z, r1.w);
          *(LAS v4u*)(Rt + rt_off(row, ch * 16)) = o; }
        { const int j = idx & 127, ch = idx >> 7;
          const v4u vv = *(const GAS v4u*)(vr + (tok0 + j) * 512 + h * 128 + ch * 8);
          *(LAS unsigned short*)(Vt + rt_off(ch * 8 + 0, j * 2)) = (unsigned short)(vv.x & 0xffffu); *(LAS unsigned short*)(Vt + rt_off(ch * 8 + 1, j * 2)) = (unsigned short)(vv.x >> 16);
          *(LAS unsigned short*)(Vt + rt_off(ch * 8 + 2, j * 2)) = (unsigned short)(vv.y & 0xffffu); *(LAS unsigned short*)(Vt + rt_off(ch * 8 + 3, j * 2)) = (unsigned short)(vv.y >> 16);
          *(LAS unsigned short*)(Vt + rt_off(ch * 8 + 4, j * 2)) = (unsigned short)(vv.z & 0xffffu); *(LAS unsigned short*)(Vt + rt_off(ch * 8 + 5, j * 2)) = (unsigned short)(vv.z >> 16);
          *(LAS unsigned short*)(Vt + rt_off(ch * 8 + 6, j * 2)) = (unsigned short)(vv.w & 0xffffu); *(LAS unsigned short*)(Vt + rt_off(ch * 8 + 7, j * 2)) = (unsigned short)(vv.w >> 16); }
    }
    __syncthreads();
    const int i = 16 * w + (lane & 15), q = lane >> 4;
    f32x4 sacc[8];
#pragma unroll
    for (int jt = 0; jt < 8; ++jt) sacc[jt] = (f32x4){0.f, 0.f, 0.f, 0.f};
#pragma unroll
    for (int ks = 0; ks < 4; ++ks) {
        const bf16x8 a = rt_frag(Qs, 16 * w, ks, lane);
#pragma unroll
        for (int jt = 0; jt < 8; ++jt) { const bf16x8 bb = rt_frag(Ks, 16 * jt, ks, lane); sacc[jt] = __builtin_amdgcn_mfma_f32_16x16x32_bf16(bb, a, sacc[jt], 0, 0, 0); }
    }
    __syncthreads();
#pragma unroll
    for (int jt = 0; jt < 8; ++jt) {
        float v[4];
#pragma unroll
        for (int t = 0; t < 4; ++t) { const int j = 16 * jt + 4 * q + t; v[t] = (i >= j) ? sacc[jt][t] * exp2f((float)(i - j) * lg) : 0.f; }
        *(LAS unsigned long long*)(Ks + rt_off(i, (16 * jt + 4 * q) * 2)) = (unsigned long long)pk2(v[0], v[1]) | ((unsigned long long)pk2(v[2], v[3]) << 32);
    }
    __syncthreads();
    f32x4 a1[8], a2[8];
#pragma unroll
    for (int et = 0; et < 8; ++et) { a1[et] = (f32x4){0.f, 0.f, 0.f, 0.f}; a2[et] = (f32x4){0.f, 0.f, 0.f, 0.f}; }
#pragma unroll
    for (int ks = 0; ks < 4; ++ks) {
        const bf16x8 aS = rt_frag(Ks, 16 * w, ks, lane), aQ = rt_frag(Qs, 16 * w, ks, lane);
#pragma unroll
        for (int et = 0; et < 8; ++et) {
            const bf16x8 bV = rt_frag(Vt, 16 * et, ks, lane), bR = rt_frag(Rt, 16 * et, ks, lane);
            a1[et] = __builtin_amdgcn_mfma_f32_16x16x32_bf16(bV, aS, a1[et], 0, 0, 0);
            a2[et] = __builtin_amdgcn_mfma_f32_16x16x32_bf16(bR, aQ, a2[et], 0, 0, 0);
        }
    }
    const float xi = exp2f((float)(i + 1) * lg);
    float s = 0.f;
#pragma unroll
    for (int et = 0; et < 8; ++et) { a1[et] = a1[et] + a2[et] * xi; s += (a1[et][0] + a1[et][1]) + (a1[et][2] + a1[et][3]); }
    s += __shfl_xor(s, 16); s += __shfl_xor(s, 32);
    const float mu = s * (1.f / 128.f); float vq = 0.f;
#pragma unroll
    for (int et = 0; et < 8; ++et) { const f32x4 d = a1[et] - mu; vq += (d[0] * d[0] + d[1] * d[1]) + (d[2] * d[2] + d[3] * d[3]); }
    vq += __shfl_xor(vq, 16); vq += __shfl_xor(vq, 32);
    const float rstd = rsqrtf(vq * (1.f / 128.f) + EPS);
    const float* gng = F.in[11] + h * 128; const float* gnb = F.in[12] + h * 128;
#pragma unroll
    for (int et = 0; et < 8; ++et) {
        const int e = 16 * et + 4 * q;
        const f32x4 gg = *(const f32x4*)(gng + e), bb = *(const f32x4*)(gnb + e);
        const unsigned long long gw8 = *(const GAS unsigned long long*)(gb + (tok0 + i) * 512 + h * 128 + e);
        const float g0 = bflo((unsigned)gw8), g1 = bfhi((unsigned)gw8), g2 = bflo((unsigned)(gw8 >> 32)), g3 = bfhi((unsigned)(gw8 >> 32));
        const f32x4 y = (a1[et] - mu) * rstd * gg + bb;
        *(GAS unsigned long long*)(obg + (tok0 + i) * 512 + h * 128 + e) =
            (unsigned long long)pk2(y[0] * siluf_(g0), y[1] * siluf_(g1)) | ((unsigned long long)pk2(y[2] * siluf_(g2), y[3] * siluf_(g3)) << 32);
    }
    __syncthreads();
}
__device__ __forceinline__ void p5_attn_combine(Frame& F) {
    const int gw = F.vcu * NWAVES + F.wave, NGW = F.G * NWAVES, lane = F.lane;
    const float s1 = wave_sum(F.in[6][lane] * F.in[7][lane]), s2 = wave_sum(F.in[8][lane] * F.in[9][lane]);
    const float lam = expf(s1) - expf(s2) + LAM_INIT;
    const bf16* AO = (const bf16*)(F.ws + WS_H); bf16* oa = (bf16*)(F.ws + WS_OA);
    const int h = lane >> 4, e0 = (lane & 15) * 8, vhalf = e0 >> 6, d = e0 & 63;
    float g[8];
#pragma unroll
    for (int t = 0; t < 8; ++t) g[t] = F.in[10][e0 + t] * (1.0f - LAM_INIT);
    for (int tk = gw; tk < M; tk += NGW) {
        float x0[8], x1[8];
        unpack8(*(const GAS v4u*)(AO + (size_t)tk * 1024 + (h * 4 + vhalf) * 64 + d), x0);
        unpack8(*(const GAS v4u*)(AO + (size_t)tk * 1024 + (h * 4 + 2 + vhalf) * 64 + d), x1);
        float y[8], ss = 0.f;
#pragma unroll
        for (int t = 0; t < 8; ++t) { y[t] = x0[t] - lam * x1[t]; ss += y[t] * y[t]; }
        ss += __shfl_xor(ss, 1); ss += __shfl_xor(ss, 2); ss += __shfl_xor(ss, 4); ss += __shfl_xor(ss, 8);
        const float rstd = rsqrtf(ss * (1.f / 128.f) + EPS);
#pragma unroll
        for (int t = 0; t < 8; ++t) y[t] = y[t] * rstd * g[t];
        *(GAS v4u*)(oa + (size_t)tk * 512 + h * 128 + e0) = pack8(y);
    }
}

struct EpiGateA {
    static constexpr bool PERM = false, AFTER_DRAIN = false;
    float* T; const bf16* g0; const bf16* g1;
    __device__ __forceinline__ void operator()(const f32x4 (&acc)[2][2][4][2], const pg8::Unit& u, int wr, int wc, int fr, int fq) const {
        const int row0 = u.pm * 256 + wr * 64 + fr, col0 = u.pn * 256 + wc * 32 + 4 * fq;
#pragma unroll
        for (int ai = 0; ai < 2; ++ai)
#pragma unroll
            for (int m = 0; m < 4; ++m) { const size_t row = (size_t)(row0 + ai * 128 + m * 16);
#pragma unroll
                for (int bj = 0; bj < 2; ++bj)
#pragma unroll
                    for (int n = 0; n < 2; ++n) { const int col = col0 + bj * 128 + n * 16;
                        const unsigned long long gw8 = *(const GAS unsigned long long*)((col < 512 ? g0 : g1) + row * 512 + (col & 511));
                        f32x4 s; s[0] = sigmoidf_(bflo((unsigned)gw8)); s[1] = sigmoidf_(bfhi((unsigned)gw8)); s[2] = sigmoidf_(bflo((unsigned)(gw8 >> 32))); s[3] = sigmoidf_(bfhi((unsigned)(gw8 >> 32)));
                        *(GAS f32x4*)(T + row * 1024 + col) = s * acc[ai][bj][m][n]; } }
    }
};
struct EpiMerge {
    static constexpr bool PERM = false, AFTER_DRAIN = false;
    const float* T; bf16* O; const bf16* g0; const bf16* g1;
    __device__ __forceinline__ void operator()(const f32x4 (&acc)[2][2][4][2], const pg8::Unit& u, int wr, int wc, int fr, int fq) const {
        const int row0 = u.pm * 256 + wr * 64 + fr, col0 = u.pn * 256 + wc * 32 + 4 * fq;
#pragma unroll
        for (int ai = 0; ai < 2; ++ai)
#pragma unroll
            for (int m = 0; m < 4; ++m) { const size_t row = (size_t)(row0 + ai * 128 + m * 16);
#pragma unroll
                for (int bj = 0; bj < 2; ++bj)
#pragma unroll
                    for (int n = 0; n < 2; ++n) { const int col = col0 + bj * 128 + n * 16;
                        const unsigned long long gw8 = *(const GAS unsigned long long*)((col < 512 ? g0 : g1) + row * 512 + (col & 511));
                        f32x4 s; s[0] = sigmoidf_(bflo((unsigned)gw8)); s[1] = sigmoidf_(bfhi((unsigned)gw8)); s[2] = sigmoidf_(bflo((unsigned)(gw8 >> 32))); s[3] = sigmoidf_(bfhi((unsigned)(gw8 >> 32)));
                        const f32x4 v = *(const GAS f32x4*)(T + row * 1024 + col) + s * acc[ai][bj][m][n];
                        *(GAS unsigned long long*)(O + row * 1024 + col) = (unsigned long long)pk2(v[0], v[1]) | ((unsigned long long)pk2(v[2], v[3]) << 32); } }
    }
};
struct EpiResid {
    static constexpr bool PERM = false, AFTER_DRAIN = false;
    const float* X; float* O;
    __device__ __forceinline__ void operator()(const f32x4 (&acc)[2][2][4][2], const pg8::Unit& u, int wr, int wc, int fr, int fq) const {
        const int row0 = u.pm * 256 + wr * 64 + fr, col0 = u.pn * 256 + wc * 32 + 4 * fq;
#pragma unroll
        for (int ai = 0; ai < 2; ++ai)
#pragma unroll
            for (int m = 0; m < 4; ++m) { const size_t row = (size_t)(row0 + ai * 128 + m * 16);
#pragma unroll
                for (int bj = 0; bj < 2; ++bj)
#pragma unroll
                    for (int n = 0; n < 2; ++n) { const int col = col0 + bj * 128 + n * 16;
                        *(GAS f32x4*)(O + row * 1024 + col) = *(const GAS f32x4*)(X + row * 1024 + col) + acc[ai][bj][m][n]; } }
    }
};
struct EpiSwiGLU {
    static constexpr bool PERM = true, AFTER_DRAIN = false;
    bf16* Hm;
    __device__ __forceinline__ void operator()(const f32x4 (&acc)[2][2][4][2], const pg8::Unit& u, int wr, int wc, int fr, int fq) const {
        const int row0 = u.pm * 256 + wr * 64 + fr, j0 = (u.pn & 3) * 128 + wc * 16 + 4 * fq;
#pragma unroll
        for (int ai = 0; ai < 2; ++ai)
#pragma unroll
            for (int m = 0; m < 4; ++m) { const size_t row = (size_t)(row0 + ai * 128 + m * 16);
#pragma unroll
                for (int bj = 0; bj < 2; ++bj) { const f32x4 a = acc[ai][bj][m][0], uu = acc[ai][bj][m][1];
                    *(GAS unsigned long long*)(Hm + row * 512 + j0 + bj * 64) =
                        (unsigned long long)pk2(siluf_(a[0]) * uu[0], siluf_(a[1]) * uu[1]) | ((unsigned long long)pk2(siluf_(a[2]) * uu[2], siluf_(a[3]) * uu[3]) << 32); } }
    }
};
struct EpiY {
    static constexpr bool PERM = true, AFTER_DRAIN = false;
    bf16* Y; const int* row_tok; const float* row_w;
    __device__ __forceinline__ void operator()(const f32x4 (&acc)[2][2][4][2], const pg8::Unit& u, int wr, int wc, int fr, int fq) const {
        const int row0 = u.pm * 256 + wr * 64 + fr, col0 = (u.pn & 3) * 256 + wc * 32 + 8 * fq;
#pragma unroll
        for (int ai = 0; ai < 2; ++ai)
#pragma unroll
            for (int m = 0; m < 4; ++m) { const int row = row0 + ai * 128 + m * 16; const int tk2 = row_tok[row]; const float w = row_w[row];
                if (tk2 >= 0) { bf16* o = Y + ((size_t)(tk2 & 1) * M + (size_t)(tk2 >> 1)) * 1024 + col0;
#pragma unroll
                    for (int bj = 0; bj < 2; ++bj) { const f32x4 v0 = acc[ai][bj][m][0] * w, v1 = acc[ai][bj][m][1] * w;
                        v4u o4; o4.x = pk2(v0[0], v0[1]); o4.y = pk2(v0[2], v0[3]); o4.z = pk2(v1[0], v1[1]); o4.w = pk2(v1[2], v1[3]);
                        *(GAS v4u*)(o + bj * 128) = o4; } } }
    }
};
struct GroupedOrder {
    const volatile LAS unsigned* tp; int G, c;
    __device__ __forceinline__ bool next(int i, pg8::Unit& u) const {
        const int L = i * G + c; const int total = (int)tp[32] * 4; if (L >= total) return false;
        const int T = L >> 2; int e = 0;
#pragma unroll 1
        for (int k = 1; k < 32; ++k) e += (T >= (int)tp[k]) ? 1 : 0;
        u.pm = T; u.pn = e * 4 + (L & 3); return true;
    }
    __device__ __forceinline__ void a_ready(const pg8::Unit&) const {}
    __device__ __forceinline__ void done(const pg8::Unit&) const {}
};

__device__ __forceinline__ void p9_router(Frame& F) {
    const int gw = F.vcu * NWAVES + F.wave, NGW = F.G * NWAVES, lane = F.lane;
    unsigned char* ws = F.ws;
    LAS float* scr = (LAS float*)(F.lds + RING_OFF + F.wave * 16384);
    LAS float* Lg = (LAS float*)(F.lds + RING_OFF + F.wave * 16384 + 12288);
    const float* X1 = F.out; bf16* H = (bf16*)(ws + WS_H); const float* g2 = F.in[16];
    const f32x4* Wp4 = (const f32x4*)(ws + WS_WRP);
    int* ent_tok = (int*)(ws + WS_ENT_TOK); float* ent_w = (float*)(ws + WS_ENT_W);
    f32x4 gv[4];
#pragma unroll
    for (int j = 0; j < 4; ++j) gv[j] = ((const f32x4*)g2)[lane + 64 * j];
    for (int item = gw; item < M / 16; item += NGW) {
        const int tok0 = item * 16; float myrstd = 0.f;
        for (int r = 0; r < 16; ++r) {
            const GAS f32x4* xr = (const GAS f32x4*)(X1 + (size_t)(tok0 + r) * DM) + lane;
            f32x4 v[4]; float s = 0.f;
#pragma unroll
            for (int j = 0; j < 4; ++j) { v[j] = xr[64 * j]; s += (v[j].x * v[j].x + v[j].y * v[j].y) + (v[j].z * v[j].z + v[j].w * v[j].w); }
            const float rstd = rsqrtf(wave_sum(s) * (1.f / DM) + EPS);
            GAS unsigned long long* o8 = (GAS unsigned long long*)(H + (size_t)(tok0 + r) * DM) + lane;
#pragma unroll
            for (int j = 0; j < 4; ++j) o8[64 * j] = (unsigned long long)pk2(v[j].x * rstd * gv[j].x, v[j].y * rstd * gv[j].y) | ((unsigned long long)pk2(v[j].z * rstd * gv[j].z, v[j].w * rstd * gv[j].w) << 32);
            if ((lane & 15) == r) myrstd = rstd;
        }
        f32x4 acc[3];
#pragma unroll
        for (int t = 0; t < 3; ++t) acc[t] = (f32x4){0.f, 0.f, 0.f, 0.f};
        const float* xa = X1 + (size_t)(tok0 + (lane & 15)) * DM + 4 * (lane >> 4);
        const float* ga = g2 + 4 * (lane >> 4);
#pragma unroll 2
        for (int s = 0; s < 64; ++s) {
            const f32x4 xv = *(const GAS f32x4*)(xa + 16 * s), gq = *(const f32x4*)(ga + 16 * s);
            const f32x4 a = xv * gq * myrstd;
#pragma unroll
            for (int t = 0; t < 3; ++t) { const f32x4 wv = Wp4[(s * 3 + t) * 64 + lane];
#pragma unroll
                for (int j = 0; j < 4; ++j) acc[t] = __builtin_amdgcn_mfma_f32_16x16x4f32(a[j], wv[j], acc[t], 0, 0, 0); }
        }
#pragma unroll
        for (int t = 0; t < 3; ++t)
#pragma unroll
            for (int r = 0; r < 4; ++r) Lg[(4 * (lane >> 4) + r) * 48 + t * 16 + (lane & 15)] = acc[t][r];
        LDS_WAIT(); asm volatile("" ::: "memory");
        if (lane < 16) {
            const int tok = tok0 + lane; const LAS float* Lr = Lg + lane * 48;
            float gl[4];
#pragma unroll
            for (int k = 0; k < 4; ++k) gl[k] = Lr[k] + F.in[18][k];
            int gi = 0; float mx = gl[0];
#pragma unroll
            for (int k = 1; k < 4; ++k) if (gl[k] > mx) { mx = gl[k]; gi = k; }
            float se = 0.f;
#pragma unroll
            for (int k = 0; k < 4; ++k) se += __expf(gl[k] - mx);
            const float pg = 1.0f / se;
            float v0 = -3.0e38f, v1 = -3.0e38f; int i0 = 0, i1 = 0;
#pragma unroll
            for (int k = 0; k < 8; ++k) { const float el = Lr[16 + gi * 8 + k] + F.in[20][gi * 8 + k];
                if (el > v0) { v1 = v0; i1 = i0; v0 = el; i0 = k; } else if (el > v1) { v1 = el; i1 = k; } }
            const float w0 = pg / (1.0f + __expf(v1 - v0)), w1 = pg - w0;
            const int e0 = gi * 8 + i0, e1 = gi * 8 + i1;
            const unsigned p0 = atomicAdd((unsigned*)(F.ctl + CW_CNT) + e0, 1u); ent_tok[(size_t)e0 * M + p0] = tok * 2; ent_w[(size_t)e0 * M + p0] = w0;
            const unsigned p1 = atomicAdd((unsigned*)(F.ctl + CW_CNT) + e1, 1u); ent_tok[(size_t)e1 * M + p1] = tok * 2 + 1; ent_w[(size_t)e1 * M + p1] = w1;
        }
        LDS_WAIT(); asm volatile("" ::: "memory");
    }
    for (int it = gw; it < NEXP * 768; it += NGW) {
        const int e = it / 768, r = it % 768;
        if (r < 256) transpose_item(F.in[21] + (size_t)e * DM * EFF, EFF, (bf16*)(ws + WS_WGU) + (size_t)e * 1024 * 1024, 1024, 0, 1, scr, r / 16, r % 16, lane);
        else if (r < 512) transpose_item(F.in[22] + (size_t)e * DM * EFF, EFF, (bf16*)(ws + WS_WGU) + (size_t)e * 1024 * 1024, 1024, 0, 2, scr, (r - 256) / 16, (r - 256) % 16, lane);
        else transpose_item(F.in[23] + (size_t)e * EFF * DM, DM, (bf16*)(ws + WS_WD) + (size_t)e * 1024 * 512, 512, 0, 0, scr, (r - 512) / 32, (r - 512) % 32, lane);
    }
}
__device__ __forceinline__ void load_expert_tables(Frame& F) {
    if (F.tid < 32) F.MISC[MI_CNT + F.tid] = __hip_atomic_load(F.ctl + CW_CNT + F.tid, RLX_AGENT);
    __syncthreads();
    if (F.tid == 0) { unsigned a = 0; for (int e = 0; e < 32; ++e) { F.MISC[MI_TP + e] = a; a += (F.MISC[MI_CNT + e] + 255u) >> 8; } F.MISC[MI_TP + 32] = a; }
    __syncthreads();
}
__device__ __forceinline__ void p10_gather(Frame& F) {
    const int gw = F.vcu * NWAVES + F.wave, NGW = F.G * NWAVES, lane = F.lane;
    unsigned char* ws = F.ws;
    const bf16* H = (const bf16*)(ws + WS_H); bf16* xs = (bf16*)(ws + WS_XS);
    const int* ent_tok = (const int*)(ws + WS_ENT_TOK); const float* ent_w = (const float*)(ws + WS_ENT_W);
    int* row_tok = (int*)(ws + WS_ROW_TOK); float* row_w = (float*)(ws + WS_ROW_W);
    const int total = (int)F.MISC[MI_TP + 32] * 256;
    for (int row = gw; row < total; row += NGW) {
        const int T = row >> 8; int e = 0;
#pragma unroll 1
        for (int k = 1; k < 32; ++k) e += (T >= (int)F.MISC[MI_TP + k]) ? 1 : 0;
        const int r = row - (int)F.MISC[MI_TP + e] * 256, c = (int)F.MISC[MI_CNT + e];
        v4u a = (v4u){0u, 0u, 0u, 0u}, b2 = (v4u){0u, 0u, 0u, 0u}; int tok = -1; float w = 0.f;
        if (r < c) { tok = ent_tok[(size_t)e * M + r]; w = ent_w[(size_t)e * M + r];
            a = *(const GAS v4u*)(H + (size_t)(tok >> 1) * DM + lane * 8); b2 = *(const GAS v4u*)(H + (size_t)(tok >> 1) * DM + 512 + lane * 8); }
        *(GAS v4u*)(xs + (size_t)row * DM + lane * 8) = a; *(GAS v4u*)(xs + (size_t)row * DM + 512 + lane * 8) = b2;
        if (lane == 0) { row_tok[row] = tok; row_w[row] = w; }
    }
}

struct Args { const void* in[24]; float* out; unsigned char* ws; int ph_lo, ph_hi; };
__global__ void __launch_bounds__(NWAVES * 64, 2) mk_fwd(Args args) {
    extern __shared__ __attribute__((aligned(16))) unsigned char lds[];
    Frame F;
    F.lds = (LAS unsigned char*)lds;
    F.MISC = (volatile LAS unsigned*)(F.lds + MISC_OFF);
    F.tid = threadIdx.x; F.lane = F.tid & 63; F.wave = __builtin_amdgcn_readfirstlane(F.tid >> 6);
    F.G = gridDim.x; { const int bx = blockIdx.x; F.vcu = (F.G % 8 == 0) ? (bx % 8) * (F.G / 8) + bx / 8 : bx; }
    unsigned char* ws = args.ws; F.ws = ws; F.out = args.out;
    F.ctl = (gu32*)(ws + WS_CTL);
#pragma unroll
    for (int i = 0; i < 24; ++i) F.in[i] = (const float*)args.in[i];
    for (int u = F.tid; u < (LDS_BYTES - LDSCTL_OFF) / 4; u += NWAVES * 64) ((LAS unsigned*)(F.lds + LDSCTL_OFF))[u] = 0u;
    __syncthreads();
    XcdBarrier bar; bar.bar = (unsigned*)(F.ctl + CW_BAR); bar.x = 0; bar.st = nullptr;
#if !MK_PER_PHASE
    bar = xcd_barrier_post((unsigned*)(F.ctl + CW_BAR), F.MISC + 8);
#endif
    const int lo = args.ph_lo, hi = args.ph_hi;
#define IN(k) (lo <= (k) && (k) < hi)
#define SEAM(k) do { if (IN(k) && IN((k) + 1)) xcd_barrier(bar); } while (0)

    if (IN(0)) { p0_prologue(F); } SEAM(0);
    if (IN(1)) {
        pg8::Gemm g{(const pg8::bf16_t*)(ws + WS_H), (const pg8::bf16_t*)(ws + WS_WIN), M, IN_COLS, DM}; pg8::StaticOrder S; S.init(M, IN_COLS, F.G, (int)blockIdx.x);
        pg8::EpiBf16<0> E{(pg8::bf16_t*)(ws + WS_P), 512, nullptr, 512, (size_t)PBUF / 2, 1.0f};
        pg8::gemm_phase<pg8::EpiBf16<0>, pg8::StaticOrder, true, true>(F.lds + RING_OFF, g, S, E);
    } SEAM(1);
    if (IN(2)) { p2_post(F); } SEAM(2);
    if (IN(3)) {
        const attn_body::AttnTensors AT{(const attn_body::bf16*)(ws + WS_P), (const attn_body::bf16*)(ws + WS_P + PBUF), (const attn_body::bf16*)(ws + WS_P + 2 * PBUF), (attn_body::bf16*)(ws + WS_H)};
        const attn_body::StaticOrder S((int)F.G, (int)blockIdx.x);
        attn_body::attn_phase<attn_body::StaticOrder>((char*)lds + RING_OFF, AT, S);
        __syncthreads();
        for (int item = F.vcu; item < 512; item += F.G) ret_kv_item(F, item);
    } SEAM(3);
    if (IN(4)) { p4_scan(F); } SEAM(4);
    if (IN(5)) { for (int item = F.vcu; item < 512; item += F.G) ret_out_item(F, item); p5_attn_combine(F); } SEAM(5);
    if (IN(6)) {
        pg8::Gemm g{(const pg8::bf16_t*)(ws + WS_OA), (const pg8::bf16_t*)(ws + WS_WA), M, DM, 512}; pg8::StaticOrder S; S.init(M, DM, F.G, (int)blockIdx.x);
        EpiGateA E{(float*)(ws + WS_T), (const bf16*)(ws + WS_P + 7 * PBUF), (const bf16*)(ws + WS_P + 8 * PBUF)};
        pg8::gemm_phase<EpiGateA, pg8::StaticOrder, true, true>(F.lds + RING_OFF, g, S, E);
    } SEAM(6);
    if (IN(7)) {
        pg8::Gemm g{(const pg8::bf16_t*)(ws + WS_OB), (const pg8::bf16_t*)(ws + WS_WB), M, DM, 512}; pg8::StaticOrder S; S.init(M, DM, F.G, (int)blockIdx.x);
        EpiMerge E{(const float*)(ws + WS_T), (bf16*)(ws + WS_MERGED), (const bf16*)(ws + WS_P + 9 * PBUF), (const bf16*)(ws + WS_P + 10 * PBUF)};
        pg8::gemm_phase<EpiMerge, pg8::StaticOrder, true, true>(F.lds + RING_OFF, g, S, E);
    } SEAM(7);
    if (IN(8)) {
        pg8::Gemm g{(const pg8::bf16_t*)(ws + WS_MERGED), (const pg8::bf16_t*)(ws + WS_WOUT), M, DM, DM}; pg8::StaticOrder S; S.init(M, DM, F.G, (int)blockIdx.x);
        EpiResid E{F.in[0], F.out};
        pg8::gemm_phase<EpiResid, pg8::StaticOrder, true, true>(F.lds + RING_OFF, g, S, E);
    } SEAM(8);
    if (IN(9)) { p9_router(F); } SEAM(9);
    if (IN(10)) { load_expert_tables(F); p10_gather(F); } SEAM(10);
    if (IN(11)) {
        load_expert_tables(F);
        pg8::Gemm g{(const pg8::bf16_t*)(ws + WS_XS), (const pg8::bf16_t*)(ws + WS_WGU), MAXROWS, NEXP * 1024, DM}; GroupedOrder S{F.MISC + MI_TP, F.G, (int)blockIdx.x};
        EpiSwiGLU E{(bf16*)(ws + WS_HMID)};
        pg8::gemm_phase<EpiSwiGLU, GroupedOrder, true, true>(F.lds + RING_OFF, g, S, E);
    } SEAM(11);
    if (IN(12)) {
        load_expert_tables(F);
        pg8::Gemm g{(const pg8::bf16_t*)(ws + WS_HMID), (const pg8::bf16_t*)(ws + WS_WD), MAXROWS, NEXP * 1024, EFF}; GroupedOrder S{F.MISC + MI_TP, F.G, (int)blockIdx.x};
        EpiY E{(bf16*)(ws + WS_Y), (const int*)(ws + WS_ROW_TOK), (const float*)(ws + WS_ROW_W)};
        pg8::gemm_phase<EpiY, GroupedOrder, true, true>(F.lds + RING_OFF, g, S, E);
    } SEAM(12);
    if (IN(13)) {
        const int gid = F.vcu * (NWAVES * 64) + F.tid, NT = F.G * NWAVES * 64;
        const bf16* Y0 = (const bf16*)(ws + WS_Y); const bf16* Y1 = Y0 + (size_t)M * 1024;
        for (int idx = gid; idx < M * 1024 / 8; idx += NT) {
            GAS f32x4* o = (GAS f32x4*)F.out + (size_t)idx * 2;
            f32x4 a = o[0], b2 = o[1]; float y0[8], y1[8];
            unpack8(*(const GAS v4u*)(Y0 + (size_t)idx * 8), y0); unpack8(*(const GAS v4u*)(Y1 + (size_t)idx * 8), y1);
            a[0] += y0[0] + y1[0]; a[1] += y0[1] + y1[1]; a[2] += y0[2] + y1[2]; a[3] += y0[3] + y1[3];
            b2[0] += y0[4] + y1[4]; b2[1] += y0[5] + y1[5]; b2[2] += y0[6] + y1[6]; b2[3] += y0[7] + y1[7];
            o[0] = a; o[1] = b2;
        }
    }
#undef IN
#undef SEAM
}

extern "C" void kernel_launch(void* const* d_in, const int* in_sizes, int n_in, void* d_out, int out_size, void* d_ws, size_t ws_size, hipStream_t stream) {
    static int grid = 0;
    if (grid == 0) {
        if (n_in != 24 || in_sizes[0] != M * DM || out_size != M * DM || ws_size < WS_END) { fprintf(stderr, "kernel_launch: unexpected shapes/workspace (n_in %d, ws %zu); nothing launched\n", n_in, ws_size); grid = -1; return; }
        int dev = 0, cus = 0, per_cu = 0;
        if (hipGetDevice(&dev) != hipSuccess || hipDeviceGetAttribute(&cus, hipDeviceAttributeMultiprocessorCount, dev) != hipSuccess) { grid = -1; return; }
        if (hipFuncSetAttribute((const void*)mk_fwd, hipFuncAttributeMaxDynamicSharedMemorySize, LDS_BYTES) != hipSuccess) { fprintf(stderr, "kernel_launch: hipFuncSetAttribute failed\n"); grid = -1; return; }
        if (hipOccupancyMaxActiveBlocksPerMultiprocessor(&per_cu, (const void*)mk_fwd, NWAVES * 64, LDS_BYTES) != hipSuccess || per_cu < 1) fprintf(stderr, "kernel_launch: occupancy query reports %d\n", per_cu);
        (void)hipGetLastError();
        grid = cus;
    }
    if (grid < 0) return;
    if (hipMemsetAsync((char*)d_ws + WS_CTL, 0, CTL_ZERO_BYTES, stream) != hipSuccess) return;
    Args a{};
    for (int i = 0; i < 24; ++i) a.in[i] = d_in[i];
    a.out = (float*)d_out; a.ws = (unsigned char*)d_ws;
#if MK_PER_PHASE
    for (int p = 0; p < N_PHASES; ++p) { a.ph_lo = p; a.ph_hi = p + 1; hipLaunchKernelGGL(mk_fwd, dim3(grid), dim3(NWAVES * 64), LDS_BYTES, stream, a); }
#else
    a.ph_lo = 0; a.ph_hi = N_PHASES;
    hipLaunchKernelGGL(mk_fwd, dim3(grid), dim3(NWAVES * 64), LDS_BYTES, stream, a);
#endif
}
```

```cpp
#include <hip/hip_runtime.h>
#include <cstdio>
#include <cstdint>

namespace pg8 {
#define PG8_LAS __attribute__((address_space(3)))
typedef unsigned short bf16_t;
typedef short bf16x8 __attribute__((ext_vector_type(8)));
typedef float f32x4 __attribute__((ext_vector_type(4)));
typedef unsigned u32x4 __attribute__((ext_vector_type(4)));
constexpr int BM = 256, BK = 64, HALF = 128, HTB = HALF * BK * 2  , STAGE_BYTES = 8 * HTB, NXCD = 8, WGM = 8;

__host__ __device__ __forceinline__ int lds_byte(int r, int c) { const int st = (r >> 4) * 2 + (c >> 5), rr = r & 15, cc = c & 31, ob = rr * 64 + cc * 2; return st * 1024 + (ob ^ (((ob >> 9) & 1) << 5)); }
__host__ __device__ __forceinline__ void stage_rc(int b, int& R, int& C) { const int st = b / 1024, sb = b % 1024, swz = sb ^ (((sb >> 9) & 1) << 5); R = (st >> 1) * 16 + swz / 64; C = (st & 1) * 32 + (swz % 64) / 2; }
__host__ __device__ __forceinline__ int perm32(int rho) { const int n = rho >> 4, i = rho & 15; return 8 * (i >> 2) + 4 * n + (i & 3); }

struct Unit { int pm, pn, e, ti; };
struct Gemm { const bf16_t* A; const bf16_t* Bt; int M, N, K; };

struct StaticOrder {
    static constexpr bool GATHER = false;
    int nM, nN, nwg, G, c;
    __host__ __device__ void init(int M, int N, int G_, int c_) { nM = M / BM; nN = N / BM; nwg = nM * nN; G = G_; c = c_; }
    __host__ __device__ bool next(int i, Unit& u) const {
        const long L = (long)i * G + c; if (L >= nwg) return false;
        int wgid = (int)L; { const int q = nwg / NXCD, r = nwg % NXCD, xcd = wgid % NXCD, off = wgid / NXCD; wgid = (xcd < r ? xcd * (q + 1) : r * (q + 1) + (xcd - r) * q) + off; }
        const int nig = WGM * nN, gid = wgid / nig, fm = gid * WGM, gsz = (nM - fm) < WGM ? (nM - fm) : WGM;
        u.pm = fm + ((wgid % nig) % gsz); u.pn = (wgid % nig) / gsz; return true;
    }
    __device__ __forceinline__ void a_ready(const Unit&) const {}
    __device__ __forceinline__ void done(const Unit&) const {}
};

__device__ __forceinline__ unsigned cvt_pk_bf16(float lo, float hi) { unsigned r; asm volatile("v_cvt_pk_bf16_f32 %0, %1, %2" : "=v"(r) : "v"(lo), "v"(hi)); return r; }
typedef float f32x2 __attribute__((ext_vector_type(2)));
__device__ __forceinline__ f32x2 gelu_pk(f32x2 v) {
    const f32x2 av = __builtin_elementwise_abs(v), d = av * 0.2316418882f + 1.0f;
    f32x2 t; t.x = __builtin_amdgcn_rcpf(d.x); t.y = __builtin_amdgcn_rcpf(d.y);
    f32x2 q = t * 0.5307027145f + (-0.7265760135f); q = q * t + 0.7107068705f; q = q * t + (-0.142248368f); q = q * t + 0.127414796f; q = q * t;
    const f32x2 s = (v * v) * (-0.72134752044f);
    f32x2 e; e.x = __builtin_amdgcn_exp2f(s.x); e.y = __builtin_amdgcn_exp2f(s.y);
    const f32x2 m = v * (q * e), r = v - m;
    f32x2 o; o.x = v.x < 0.f ? m.x : r.x; o.y = v.y < 0.f ? m.y : r.y; return o;
}

template <int ACT  > struct EpiBf16 {
    static constexpr bool PERM = true, AFTER_DRAIN = false; static_assert(ACT == 0 || ACT == 1, "EpiBf16: ACT is 0 (none) or 1 (gelu_pk)");
    bf16_t* O; int ldc; const float* bias; int split_cols; size_t split_stride; float scale0;
    __device__ __forceinline__ void operator()(const f32x4 (&acc)[2][2][4][2], const Unit& u, int wr, int wc, int fr, int fq) const {
        const int row0 = u.pm * BM + wr * 64 + fr; int colt = u.pn * BM; bf16_t* base = O;
        float sc = 1.f; if (split_cols) { const int t = colt / split_cols; base += (size_t)t * split_stride; colt -= t * split_cols; if (t == 0) sc = scale0; }
        const int col0 = colt + wc * 32 + 8 * fq, bcol0 = u.pn * BM + wc * 32 + 8 * fq;
        f32x4 bv[2][2];
#pragma unroll
        for (int bj = 0; bj < 2; ++bj)
#pragma unroll
            for (int n = 0; n < 2; ++n) bv[bj][n] = bias ? *(const f32x4*)(bias + bcol0 + bj * HALF + 4 * n) : (f32x4){0.f, 0.f, 0.f, 0.f};
#pragma unroll
        for (int ai = 0; ai < 2; ++ai)
#pragma unroll
            for (int m = 0; m < 4; ++m) { bf16_t* rowp = base + (size_t)(row0 + ai * HALF + m * 16) * ldc + col0;
#pragma unroll
                for (int bj = 0; bj < 2; ++bj) { f32x4 v0 = acc[ai][bj][m][0] + bv[bj][0], v1 = acc[ai][bj][m][1] + bv[bj][1];
                    if (ACT == 1) { f32x2 a = gelu_pk((f32x2){v0[0], v0[1]}), b = gelu_pk((f32x2){v0[2], v0[3]}), c = gelu_pk((f32x2){v1[0], v1[1]}), d = gelu_pk((f32x2){v1[2], v1[3]});
                        v0 = (f32x4){a.x, a.y, b.x, b.y}; v1 = (f32x4){c.x, c.y, d.x, d.y}; }
                    v0 = v0 * sc; v1 = v1 * sc; u32x4 w; w.x = cvt_pk_bf16(v0[0], v0[1]); w.y = cvt_pk_bf16(v0[2], v0[3]); w.z = cvt_pk_bf16(v1[0], v1[1]); w.w = cvt_pk_bf16(v1[2], v1[3]);
                    *(u32x4*)(rowp + bj * HALF) = w; } }
    }
};

template <class Epi, class Sched, bool ALIGN_EPI = false, bool SP2 = false>
__device__ __forceinline__ void gemm_phase(PG8_LAS unsigned char* lds, const Gemm g, const Sched& S, const Epi& E) {
    const int tid = threadIdx.x, wid = __builtin_amdgcn_readfirstlane(tid >> 6), lane = tid & 63, wr = wid >> 2, wc = wid & 3, fr = lane & 15, fq = lane >> 4;
    const int K = g.K, nt = K / BK;
    unsigned voffB[2], vA0[2], vA1[2], nA0[2], nA1[2]; int Rr[2], Cc[2];
#pragma unroll
    for (int i = 0; i < 2; ++i) { int R, C; stage_rc(tid * 16 + i * 8192, R, C); const int Rb = Epi::PERM ? ((R & ~31) + perm32(R & 31)) : R;
        Rr[i] = R; Cc[i] = C; vA0[i] = vA1[i] = nA0[i] = nA1[i] = (unsigned)(R * K + C) * 2u; voffB[i] = (unsigned)(Rb * K + C) * 2u; }
#define PG8_GOFF(u, d0, d1) do { if constexpr (Sched::GATHER) { _Pragma("unroll") for (int _i = 0; _i < 2; ++_i) { d0[_i] = S.arow_off(u, Rr[_i]) + (unsigned)Cc[_i] * 2u; d1[_i] = S.arow_off(u, HALF + Rr[_i]) + (unsigned)Cc[_i] * 2u; } } } while (0)
    const size_t kstep = (size_t)(BK * 2);
    const size_t hstep = (size_t)HALF * K * 2;
    const size_t hstepA = Sched::GATHER ? (size_t)0 : hstep;
    const size_t tstep = 2 * hstep;
    const unsigned ldsw = (unsigned)wid * 1024u;
    const int aoff = lds_byte(wr * 64 + fr, fq * 8), boff = lds_byte(wc * 32 + fr, fq * 8);
#define PG8_SA(b, h) (((b) * 2 + (h)) * HTB)
#define PG8_SB(b, h) ((4 + (b) * 2 + (h)) * HTB)
#define PG8_STAGE(bufoff, gbase, voff) do { _Pragma("unroll") for (int _i = 0; _i < 2; ++_i) \
        __builtin_amdgcn_global_load_lds((const unsigned*)((const char*)(gbase) + (voff)[_i]), (PG8_LAS unsigned*)(lds + (bufoff) + ldsw + _i * 8192), 16, 0, 0); } while (0)
#define PG8_LDA(dst, b, h) do { _Pragma("unroll") for (int m = 0; m < 4; ++m) _Pragma("unroll") for (int k = 0; k < 2; ++k) dst[m][k] = *(const PG8_LAS bf16x8*)(lds + PG8_SA(b, h) + aoff + m * 2048 + k * 1024); } while (0)
#define PG8_LDB(dst, b, h) do { _Pragma("unroll") for (int n = 0; n < 2; ++n) _Pragma("unroll") for (int k = 0; k < 2; ++k) dst[n][k] = *(const PG8_LAS bf16x8*)(lds + PG8_SB(b, h) + boff + n * 2048 + k * 1024); } while (0)
#define PG8_MMA(ai, bj, At, Bt) do { __builtin_amdgcn_s_setprio(1); _Pragma("unroll") for (int m = 0; m < 4; ++m) _Pragma("unroll") for (int n = 0; n < 2; ++n) _Pragma("unroll") for (int k = 0; k < 2; ++k) \
        acc[ai][bj][m][n] = __builtin_amdgcn_mfma_f32_16x16x32_bf16(Bt[n][k], At[m][k], acc[ai][bj][m][n], 0, 0, 0); __builtin_amdgcn_s_setprio(0); } while (0)
#define PG8_WAIT_V(n) asm volatile("s_waitcnt vmcnt(" #n ")" ::: "memory")
#define PG8_WAIT_L(n) asm volatile("s_waitcnt lgkmcnt(" #n ")" ::: "memory")
#define PG8_BAR __builtin_amdgcn_s_barrier()
#define PG8_SCHED __builtin_amdgcn_sched_barrier(0)
    Unit cur, nxt; int ui = 0;
    if (!S.next(0, cur)) return;
    f32x4 acc[2][2][4][2];
#pragma unroll
    for (int a = 0; a < 2; ++a)
#pragma unroll
        for (int b = 0; b < 2; ++b)
#pragma unroll
            for (int m = 0; m < 4; ++m)
#pragma unroll
                for (int n = 0; n < 2; ++n) acc[a][b][m][n] = (f32x4){0.f, 0.f, 0.f, 0.f};
    bf16x8 At[4][2], B0[2][2], B1[2][2];
    const char* cA = (const char*)g.A + (Sched::GATHER ? (size_t)0 : (size_t)cur.pm * tstep); const char* cB = (const char*)g.Bt + (size_t)cur.pn * tstep;
    PG8_GOFF(cur, vA0, vA1);
    S.a_ready(cur);
    if constexpr (SP2) {
        PG8_STAGE(PG8_SB(0, 0), cB, voffB); PG8_STAGE(PG8_SB(0, 1), cB + hstep, voffB); PG8_STAGE(PG8_SA(0, 0), cA, vA0); PG8_STAGE(PG8_SA(0, 1), cA + hstepA, vA1);
        if (wr == 1) PG8_BAR;
        PG8_WAIT_V(2); PG8_BAR;
        PG8_STAGE(PG8_SB(1, 0), cB + kstep, voffB); PG8_STAGE(PG8_SA(1, 0), cA + kstep, vA0); PG8_STAGE(PG8_SB(1, 1), cB + hstep + kstep, voffB);
        PG8_WAIT_V(6); PG8_BAR;
    } else {
        PG8_STAGE(PG8_SB(0, 0), cB, voffB); PG8_STAGE(PG8_SA(0, 0), cA, vA0); PG8_STAGE(PG8_SB(0, 1), cB + hstep, voffB); PG8_STAGE(PG8_SA(0, 1), cA + hstepA, vA1);
        if (wr == 1) PG8_BAR;
        PG8_WAIT_V(4); PG8_BAR;
        PG8_STAGE(PG8_SB(1, 0), cB + kstep, voffB); PG8_STAGE(PG8_SA(1, 0), cA + kstep, vA0); PG8_STAGE(PG8_SB(1, 1), cB + hstep + kstep, voffB);
        PG8_WAIT_V(6); PG8_BAR;
    }
    for (;;) {
        const bool has_next = S.next(ui + 1, nxt);
        const char* nA = has_next ? (const char*)g.A + (Sched::GATHER ? (size_t)0 : (size_t)nxt.pm * tstep) : cA; const char* nB = has_next ? (const char*)g.Bt + (size_t)nxt.pn * tstep : cB;
        if constexpr (Sched::GATHER) { if (has_next) { PG8_GOFF(nxt, nA0, nA1); } else {
#pragma unroll
            for (int _i = 0; _i < 2; ++_i) { nA0[_i] = vA0[_i]; nA1[_i] = vA1[_i]; } } }
        for (int t = 0; t < nt; t += 2) {
            const bool last = (t == nt - 2);
            const char* a1 = cA + (size_t)(t + 1) * kstep;
            const char* a2 = last ? nA : cA + (size_t)(t + 2) * kstep; const char* b2 = last ? nB : cB + (size_t)(t + 2) * kstep;
            const char* a3 = a2 + kstep; const char* b3 = b2 + kstep;
            if (last && has_next) S.a_ready(nxt);
            unsigned wA0[2], wA1[2];
#pragma unroll
            for (int _i = 0; _i < 2; ++_i) { wA0[_i] = (Sched::GATHER && last) ? nA0[_i] : vA0[_i]; wA1[_i] = (Sched::GATHER && last) ? nA1[_i] : vA1[_i]; }
            if constexpr (SP2) {
            PG8_LDB(B0, 0, 0); PG8_LDB(B1, 0, 1); PG8_SCHED; PG8_LDA(At, 0, 0); PG8_STAGE(PG8_SA(1, 1), a1 + hstepA, vA1);
            PG8_WAIT_V(8); PG8_WAIT_L(0); PG8_BAR; PG8_MMA(0, 0, At, B0); PG8_MMA(0, 1, At, B1); PG8_BAR; PG8_SCHED;
            PG8_LDA(At, 0, 1); PG8_STAGE(PG8_SB(0, 0), b2, voffB); PG8_STAGE(PG8_SB(0, 1), b2 + hstep, voffB); PG8_STAGE(PG8_SA(0, 0), a2, wA0);
            PG8_WAIT_V(8); PG8_WAIT_L(0); PG8_BAR; PG8_MMA(1, 0, At, B0); PG8_MMA(1, 1, At, B1); PG8_BAR; PG8_SCHED;
            PG8_LDB(B0, 1, 0); PG8_LDB(B1, 1, 1); PG8_SCHED; PG8_LDA(At, 1, 0); PG8_STAGE(PG8_SA(0, 1), a2 + hstepA, wA1);
            PG8_WAIT_V(8); PG8_WAIT_L(0); PG8_BAR; PG8_MMA(0, 0, At, B0); PG8_MMA(0, 1, At, B1); PG8_BAR; PG8_SCHED;
            PG8_LDA(At, 1, 1); PG8_STAGE(PG8_SB(1, 0), b3, voffB); PG8_STAGE(PG8_SB(1, 1), b3 + hstep, voffB); PG8_STAGE(PG8_SA(1, 0), a3, wA0);
            PG8_WAIT_V(8); PG8_WAIT_L(0); PG8_BAR; PG8_MMA(1, 0, At, B0); PG8_MMA(1, 1, At, B1); PG8_BAR; PG8_SCHED;
            } else {
            PG8_LDB(B0, 0, 0); PG8_SCHED; PG8_LDA(At, 0, 0); PG8_STAGE(PG8_SA(1, 1), a1 + hstepA, vA1);
            PG8_WAIT_L(8); PG8_BAR; PG8_WAIT_L(0); PG8_MMA(0, 0, At, B0); PG8_BAR; PG8_SCHED;
            PG8_LDB(B1, 0, 1); PG8_STAGE(PG8_SB(0, 0), b2, voffB);
            PG8_BAR; PG8_WAIT_L(0); PG8_MMA(0, 1, At, B1); PG8_BAR;
            PG8_LDA(At, 0, 1); PG8_STAGE(PG8_SA(0, 0), a2, wA0);
            PG8_BAR; PG8_WAIT_L(0); PG8_MMA(1, 0, At, B0); PG8_BAR; PG8_SCHED;
            PG8_STAGE(PG8_SB(0, 1), b2 + hstep, voffB);
            PG8_WAIT_V(6); PG8_BAR; PG8_MMA(1, 1, At, B1); PG8_BAR;
            PG8_LDB(B0, 1, 0); PG8_SCHED; PG8_LDA(At, 1, 0); PG8_STAGE(PG8_SA(0, 1), a2 + hstepA, wA1);
            PG8_WAIT_L(8); PG8_BAR; PG8_WAIT_L(0); PG8_MMA(0, 0, At, B0); PG8_BAR; PG8_SCHED;
            PG8_LDB(B1, 1, 1); PG8_STAGE(PG8_SB(1, 0), b3, voffB);
            PG8_BAR; PG8_WAIT_L(0); PG8_MMA(0, 1, At, B1); PG8_BAR;
            PG8_LDA(At, 1, 1); PG8_STAGE(PG8_SA(1, 0), a3, wA0);
            PG8_BAR; PG8_WAIT_L(0); PG8_MMA(1, 0, At, B0); PG8_BAR; PG8_SCHED;
            PG8_STAGE(PG8_SB(1, 1), b3 + hstep, voffB);
            PG8_WAIT_V(6); PG8_BAR; PG8_MMA(1, 1, At, B1); PG8_BAR;
            }
        }
        if constexpr (ALIGN_EPI) { if (wr == 0) PG8_BAR; }
        if constexpr (!Epi::AFTER_DRAIN) { E(acc, cur, wr, wc, fr, fq); S.done(cur); }
        if (!has_next) break;
#pragma unroll
        for (int a = 0; a < 2; ++a)
#pragma unroll
            for (int b = 0; b < 2; ++b)
#pragma unroll
                for (int m = 0; m < 4; ++m)
#pragma unroll
                    for (int n = 0; n < 2; ++n) acc[a][b][m][n] = (f32x4){0.f, 0.f, 0.f, 0.f};
        cur = nxt; cA = nA; cB = nB; ++ui;
#pragma unroll
        for (int _i = 0; _i < 2; ++_i) { vA0[_i] = nA0[_i]; vA1[_i] = nA1[_i]; }
        if constexpr (ALIGN_EPI) { if (wr == 1) PG8_BAR; }
    }
    PG8_WAIT_V(0);
    if constexpr (!ALIGN_EPI) { if (wr == 0) PG8_BAR; }
    PG8_BAR;
    if constexpr (Epi::AFTER_DRAIN) { E.fused(acc, cur, wr, wc, fr, fq, lds, wid, lane); S.done(cur); }
#undef PG8_GOFF
#undef PG8_SA
#undef PG8_SB
#undef PG8_STAGE
#undef PG8_LDA
#undef PG8_LDB
#undef PG8_MMA
#undef PG8_WAIT_V
#undef PG8_WAIT_L
#undef PG8_BAR
#undef PG8_SCHED
}
}

#ifndef PG8_SP2
#define PG8_SP2 true
#endif

#include <hip/hip_bf16.h>
#include <cmath>
namespace attn_body {
using bf16=__hip_bfloat16;
using bf16x8=__attribute__((ext_vector_type(8)))short;
using s16x4=__attribute__((ext_vector_type(4)))short;
using f32x16=__attribute__((ext_vector_type(16)))float;
using u32x4=__attribute__((ext_vector_type(4)))unsigned;
constexpr int BATCH=4,NHEAD=16,SEQ=4096,D=64,PQ=512,PO=1024;
constexpr int NW=8,QBLK=32,QB=QBLK*NW,KVBLK=64,NQB=SEQ/QB;
constexpr int ATTN_UNIT_ROWS=QB;
__device__ __forceinline__ int crow(int r,int hi){return (r&3)+8*(r>>2)+4*hi;}
#define SBAR() __builtin_amdgcn_sched_barrier(0)
__device__ __forceinline__ void cmask(f32x16&p0,f32x16&p1,int jb,int qrel,int hi){
  const float NEG=-INFINITY; int kb=64*jb+4*hi;
  #pragma unroll
  for(int r=0;r<16;++r){int kv=kb+(r&3)+8*(r>>2); if(kv>qrel)p0[r]=NEG; if(kv+32>qrel)p1[r]=NEG;}
}

constexpr int NSLOT=3, SLOTB=8192;
constexpr int LDS_K=0, LDS_V=NSLOT*SLOTB, LDS_WS=2*NSLOT*SLOTB, LDS_OST=LDS_WS+NW*64*4, LDS_BYTES=LDS_OST+NW*4096;
constexpr float C2=0.125f*1.4426950408889634f;
__device__ __forceinline__ void glds16(const void*gsrc,unsigned lds_dst){unsigned keep;
  asm volatile("s_mov_b32 %0, m0\n\ts_mov_b32 m0, %2\n\ts_nop 0\n\tglobal_load_lds_dwordx4 %1, off\n\ts_mov_b32 m0, %0":"=&s"(keep):"v"(gsrc),"s"(lds_dst):"memory");}
__device__ __forceinline__ float max3f(float a,float b,float c){float r;asm("v_max3_f32 %0, %1, %2, %3":"=v"(r):"v"(a),"v"(b),"v"(c));return r;}
__device__ __forceinline__ float max2f(float a,float b){float r;asm("v_max_f32_e32 %0, %1, %2":"=v"(r):"v"(a),"v"(b));return r;}
__device__ __forceinline__ float fadd_s(float a,float b){float r;asm("v_add_f32_e32 %0, %1, %2":"=v"(r):"v"(a),"v"(b));return r;}
__device__ __forceinline__ float fsub_s(float a,float b){float r;asm("v_sub_f32_e32 %0, %1, %2":"=v"(r):"v"(a),"v"(b));return r;}
typedef float f32x2_t __attribute__((ext_vector_type(2))); typedef __bf16 bf16x2_t __attribute__((ext_vector_type(2)));
__device__ __forceinline__ unsigned cvtpk_s(float lo,float hi){f32x2_t v={lo,hi};bf16x2_t b=__builtin_convertvector(v,bf16x2_t);return __builtin_bit_cast(unsigned,b);}
#define WAIT_BAR(N) asm volatile("s_waitcnt vmcnt(" #N ") lgkmcnt(0)\n\ts_barrier":::"memory")

__device__ __forceinline__ void qkt(f32x16&p0,f32x16&p1,const char*Kslot,const bf16x8*qr,const f32x16&negm,int r32,int hi){
  const char*kb=Kslot+hi*1024+r32*16;
  #pragma unroll
  for(int d0=0;d0<4;++d0){
    const bf16x8 b0=*reinterpret_cast<const bf16x8*>(kb+d0*2048);
    const bf16x8 b1=*reinterpret_cast<const bf16x8*>(kb+d0*2048+512);
    if(d0==0){p0=__builtin_amdgcn_mfma_f32_32x32x16_bf16(b0,qr[0],negm,0,0,0);p1=__builtin_amdgcn_mfma_f32_32x32x16_bf16(b1,qr[0],negm,0,0,0);}
    else{p0=__builtin_amdgcn_mfma_f32_32x32x16_bf16(b0,qr[d0],p0,0,0,0);p1=__builtin_amdgcn_mfma_f32_32x32x16_bf16(b1,qr[d0],p1,0,0,0);}}
}
typedef __attribute__((address_space(3))) const char* lds_cptr;
typedef short v4i16_t __attribute__((ext_vector_type(4)));
__device__ __forceinline__ void kload8(bf16x8*kf,lds_cptr kp){
  kf[0]=*(const __attribute__((address_space(3))) bf16x8*)(kp);      kf[1]=*(const __attribute__((address_space(3))) bf16x8*)(kp+512);
  kf[2]=*(const __attribute__((address_space(3))) bf16x8*)(kp+2048); kf[3]=*(const __attribute__((address_space(3))) bf16x8*)(kp+2560);
  kf[4]=*(const __attribute__((address_space(3))) bf16x8*)(kp+4096); kf[5]=*(const __attribute__((address_space(3))) bf16x8*)(kp+4608);
  kf[6]=*(const __attribute__((address_space(3))) bf16x8*)(kp+6144); kf[7]=*(const __attribute__((address_space(3))) bf16x8*)(kp+6656);
}
__device__ __forceinline__ void kload2(bf16x8*kf,lds_cptr kp,int j){ kf[2*j]=*(const __attribute__((address_space(3))) bf16x8*)(kp+j*2048); kf[2*j+1]=*(const __attribute__((address_space(3))) bf16x8*)(kp+j*2048+512); }
__device__ __forceinline__ s16x4 vtr(lds_cptr p){ return __builtin_bit_cast(s16x4,__builtin_amdgcn_ds_read_tr16_b64_v4i16((__attribute__((address_space(3))) v4i16_t*)p)); }
__device__ __forceinline__ float rowmax(const f32x16&p0,const f32x16&p1){
  float a=max3f(p0[0],p0[1],p1[0]),b=max3f(p0[2],p0[3],p1[1]);a=max3f(a,p1[2],p1[3]);
  #pragma unroll
  for(int r=4;r<16;r+=4){a=max3f(a,p0[r],p0[r+1]);b=max3f(b,p0[r+2],p0[r+3]);a=max3f(a,p1[r],p1[r+1]);b=max3f(b,p1[r+2],p1[r+3]);}
  const float m=max2f(a,b);
  auto rr=__builtin_amdgcn_permlane32_swap(__float_as_uint(m),__float_as_uint(m),false,false);
  return max2f(__uint_as_float(rr[0]),__uint_as_float(rr[1]));
}
__device__ __forceinline__ void pv(f32x16*o,int vb,bf16x8 pa0,bf16x8 pa1,bf16x8 pa2,bf16x8 pa3){
  #pragma unroll
  for(int d0=0;d0<2;++d0){s16x4 lo[4],hi[4];
    #pragma unroll
    for(int ks=0;ks<4;++ks){
      asm volatile("ds_read_b64_tr_b16 %0,%1 offset:%c2":"=&v"(lo[ks]):"v"(vb),"i"(d0*4096+ks*1024):"memory");
      asm volatile("ds_read_b64_tr_b16 %0,%1 offset:%c2":"=&v"(hi[ks]):"v"(vb),"i"(d0*4096+ks*1024+512):"memory");}
    asm volatile("s_waitcnt lgkmcnt(0)":::"memory");SBAR();
    #define PK(k) (bf16x8){lo[k][0],lo[k][1],lo[k][2],lo[k][3],hi[k][0],hi[k][1],hi[k][2],hi[k][3]}
    o[d0]=__builtin_amdgcn_mfma_f32_32x32x16_bf16(pa0,PK(0),o[d0],0,0,0);
    o[d0]=__builtin_amdgcn_mfma_f32_32x32x16_bf16(pa1,PK(1),o[d0],0,0,0);
    o[d0]=__builtin_amdgcn_mfma_f32_32x32x16_bf16(pa2,PK(2),o[d0],0,0,0);
    o[d0]=__builtin_amdgcn_mfma_f32_32x32x16_bf16(pa3,PK(3),o[d0],0,0,0);
    #undef PK
  }
}

#ifndef ATTN_STORE16
#define ATTN_STORE16(p,v) (*(u32x4*)(p)=(v))
#endif
template<int THRL> __device__ __forceinline__ void attn_unit(int b,int h,int qb,const bf16*Q,const bf16*__restrict__ K,const bf16*__restrict__ V,bf16*O,char*shm){
  const int tid=threadIdx.x,lane=tid&63,r32=lane&31,hi=lane>>5; const int wid=__builtin_amdgcn_readfirstlane(tid>>6);
  const long rowbase=(long)b*SEQ; const int q0=qb*QB;
  const int qkc=(h>>1)*D, vcol=(h>>2)*128+(h&1)*D;
  const bf16*Qw=Q+(rowbase+q0+wid*QBLK)*PQ+qkc;
  const bf16*Kh=K+rowbase*PQ+qkc,*Vh=V+rowbase*PQ+vcol;
  const unsigned lds0=(unsigned)(uintptr_t)shm;
  float*wsf=(float*)(shm+LDS_WS)+wid*64;
  const bf16*ksrc=Kh+(long)lane*PQ+wid*8;
  const bf16*vsrc=Vh+(long)(16*(wid&3)+(lane>>2))*PQ+(wid>>2)*32+(lane&3)*8;
  const unsigned kdst=lds0+LDS_K+wid*1024, vdst=lds0+LDS_V+wid*1024;
  #define DMA_K(t,slot) glds16(ksrc+(long)(t)*KVBLK*PQ,(unsigned)__builtin_amdgcn_readfirstlane(kdst+(slot)))
  #define DMA_V(t,slot) glds16(vsrc+(long)(t)*KVBLK*PQ,(unsigned)__builtin_amdgcn_readfirstlane(vdst+(slot)))
  const int vb0=(int)(lds0+LDS_V)+((lane>>4)&1)*32+(lane&3)*8+(4*hi+((lane&15)>>2))*64;
  const char*Kbase=shm+LDS_K; bf16x8 kf[8];
  const lds_cptr shm3=(lds_cptr)shm; const lds_cptr kp0=shm3+LDS_K+hi*1024+r32*16; const lds_cptr vp0=shm3+LDS_V+((lane>>4)&1)*32+(lane&3)*8+(4*hi+((lane&15)>>2))*64;
  const int NT=(q0+QB)/KVBLK;
  DMA_K(0,0);DMA_V(0,0);DMA_K(1,SLOTB);
  bf16x8 qr[4];
  #pragma unroll
  for(int d0=0;d0<4;++d0)qr[d0]=*reinterpret_cast<const bf16x8*>(&Qw[(long)r32*PQ+d0*16+hi*8]);
  float mhat=0.f,l_reg=0.f;f32x16 o[2];o[0]=f32x16{};o[1]=f32x16{};f32x16 negm=f32x16{};asm volatile("":"+v"(negm));
  const int qrel=wid*QBLK+r32;
  #define CMASK(P0,P1,t) do{int jb_=(t)-(NT-4); if(jb_>=0)cmask(P0,P1,jb_,qrel,hi);}while(0)
  bool resc=false;
  #define START(P0,P1) do{ const float rm=rowmax(P0,P1); resc=false; \
    { const float dl=rm; mhat=fadd_s(mhat,dl); \
      _Pragma("unroll") for(int r=0;r<16;++r){P0[r]=fsub_s(P0[r],dl);P1[r]=fsub_s(P1[r],dl);} \
      _Pragma("unroll") for(int r=0;r<16;++r)negm[r]=-mhat; asm volatile("":"+v"(negm)); } \
    _Pragma("unroll") for(int r=0;r<16;++r)P0[r]=__builtin_amdgcn_exp2f(P0[r]); }while(0)
  #define RESC() do{ if(resc){ asm volatile("s_waitcnt lgkmcnt(0)":::"memory"); \
      _Pragma("unroll") for(int d_=0;d_<2;++d_) _Pragma("unroll") for(int r=0;r<16;++r)o[d_][r]*=wsf[crow(r,hi)]; } }while(0)
  f32x16 pA0,pA1,pB0,pB1;
  int sl_prev=0,sl_cur=0,sl_next=SLOTB;
  #define ROT() do{sl_prev=sl_cur;sl_cur=sl_next;sl_next=(sl_next==(NSLOT-1)*SLOTB)?0:sl_next+SLOTB;}while(0)
  DMA_K(2,2*SLOTB);
  WAIT_BAR(3);
  qkt(pA0,pA1,Kbase,qr,negm,r32,hi);asm volatile("s_nop 15\n\ts_nop 7":"+v"(pA0),"+v"(pA1));CMASK(pA0,pA1,0);
  START(pA0,pA1);
  _Pragma("unroll") for(int r=0;r<16;++r)pA1[r]=__builtin_amdgcn_exp2f(pA1[r]);
  WAIT_BAR(0);
  DMA_K(3,0);DMA_V(1,SLOTB);
  ROT();
  kload8(kf,kp0+sl_cur);
  WAIT_BAR(2);
  s16x4 vlo[8],vhi[8]; u32x4 pw0,pw1,pw2,pw3;
  #define PKW(P,B) cvtpk_s(P[B],P[B+1])
  #define PAF(k) __builtin_bit_cast(bf16x8,pw##k)
  #define VFR(i) (bf16x8){vlo[i][0],vlo[i][1],vlo[i][2],vlo[i][3],vhi[i][0],vhi[i][1],vhi[i][2],vhi[i][3]}
  #define PIN(x) asm volatile("":"+v"(x))
  #define MX3(a,b,c) __builtin_fmaxf(__builtin_fmaxf((a),(b)),(c))
  #define GAPA(MF,A0,A1,A2,A3,W0,W1,PW) do{ MF; sacc+=A0; sacc+=A1; sacc+=A2; sacc+=A3; PIN(sacc); W0; W1; PIN(PW); SBAR(); }while(0)
  #define EX(v) __builtin_amdgcn_exp2f(v)
  #define GAPB(MF,X,B) do{ MF; X[B]=EX(X[B]); X[B+1]=EX(X[B+1]); X[B+2]=EX(X[B+2]); X[B+3]=EX(X[B+3]); PIN(X); SBAR(); }while(0)
  #define VRD(i) do{ vlo[i]=vtr(vp_+(((i)>>2)*4096+((i)&3)*1024)); vhi[i]=vtr(vp_+(((i)>>2)*4096+((i)&3)*1024+512)); }while(0)
  #define KRD(G,j) do{ if(G){ kload2(kf,kp0+sl_next,j); SBAR(); } }while(0)
  #define STEP(C0,C1,P0,P1,t,GK,GV,GL) do{ SBAR(); \
    const lds_cptr vp_=vp0+sl_prev; \
    VRD(0); SBAR(); float sacc=(P0[0]+P0[1]); \
    GAPA(C0=__builtin_amdgcn_mfma_f32_32x32x16_bf16(kf[0],qr[0],negm,0,0,0), P0[2],P0[3],P0[4],P0[5],     pw0[0]=PKW(P0,0), pw0[1]=PKW(P0,2), pw0); \
    VRD(4); SBAR(); GAPA(C1=__builtin_amdgcn_mfma_f32_32x32x16_bf16(kf[1],qr[0],negm,0,0,0), P0[6],P0[7],P0[8],P0[9],     pw0[2]=PKW(P0,4), pw0[3]=PKW(P0,6), pw0); \
    VRD(1); SBAR(); GAPA(C0=__builtin_amdgcn_mfma_f32_32x32x16_bf16(kf[2],qr[1],C0,0,0,0),   P0[10],P0[11],P0[12],P0[13], pw1[0]=PKW(P0,8), pw1[1]=PKW(P0,10), pw1); \
    VRD(5); SBAR(); GAPA(C1=__builtin_amdgcn_mfma_f32_32x32x16_bf16(kf[3],qr[1],C1,0,0,0),   P0[14],P0[15],P1[0],P1[1],   pw1[2]=PKW(P0,12),pw1[3]=PKW(P0,14), pw1); \
    VRD(2); SBAR(); GAPA(C0=__builtin_amdgcn_mfma_f32_32x32x16_bf16(kf[4],qr[2],C0,0,0,0),   P1[2],P1[3],P1[4],P1[5],     pw2[0]=PKW(P1,0), pw2[1]=PKW(P1,2), pw2); \
    VRD(6); SBAR(); GAPA(C1=__builtin_amdgcn_mfma_f32_32x32x16_bf16(kf[5],qr[2],C1,0,0,0),   P1[6],P1[7],P1[8],P1[9],     pw2[2]=PKW(P1,4), pw2[3]=PKW(P1,6), pw2); \
    VRD(3); SBAR(); GAPA(C0=__builtin_amdgcn_mfma_f32_32x32x16_bf16(kf[6],qr[3],C0,0,0,0),   P1[10],P1[11],P1[12],P1[13], pw3[0]=PKW(P1,8), pw3[1]=PKW(P1,10), pw3); \
    VRD(7); SBAR(); GAPA(C1=__builtin_amdgcn_mfma_f32_32x32x16_bf16(kf[7],qr[3],C1,0,0,0),   P1[14],P1[15],0.f,0.f,       pw3[2]=PKW(P1,12),pw3[3]=PKW(P1,14), pw3); \
    l_reg+=sacc; \
    if(GK){DMA_K((t)+3,sl_cur);} if(GV){DMA_V((t)+1,sl_next);} \
    CMASK(C0,C1,t); \
    { float a=MX3(C0[0],C0[1],C1[0]),b=MX3(C0[2],C0[3],C1[1]); a=MX3(a,C1[2],C1[3]); \
      _Pragma("unroll") for(int r=4;r<16;r+=4){a=MX3(a,C0[r],C0[r+1]);b=MX3(b,C0[r+2],C0[r+3]);a=MX3(a,C1[r],C1[r+1]);b=MX3(b,C1[r+2],C1[r+3]);} \
      float rm=__builtin_fmaxf(a,b); { auto rr=__builtin_amdgcn_permlane32_swap(__float_as_uint(rm),__float_as_uint(rm),false,false); rm=__builtin_fmaxf(__uint_as_float(rr[0]),__uint_as_float(rr[1])); } \
      resc=false; \
      if(__builtin_expect(__any(rm>(float)THRL),0)){ const float dl=__builtin_fmaxf(rm,0.f); mhat+=dl; \
        _Pragma("unroll") for(int r=0;r<16;++r){C0[r]-=dl;C1[r]-=dl;} \
        _Pragma("unroll") for(int r=0;r<16;++r)negm[r]=-mhat; asm volatile("":"+v"(negm)); \
        const float f=__builtin_amdgcn_exp2f(-dl); l_reg*=f; if(hi==0)wsf[r32]=f; resc=true; } } \
    SBAR(); \
    GAPB(o[0]=__builtin_amdgcn_mfma_f32_32x32x16_bf16(PAF(0),VFR(0),o[0],0,0,0), C0,0); \
    GAPB(o[1]=__builtin_amdgcn_mfma_f32_32x32x16_bf16(PAF(0),VFR(4),o[1],0,0,0), C0,4); \
    KRD(GL,0); GAPB(o[0]=__builtin_amdgcn_mfma_f32_32x32x16_bf16(PAF(1),VFR(1),o[0],0,0,0), C0,8); \
    KRD(GL,1); GAPB(o[1]=__builtin_amdgcn_mfma_f32_32x32x16_bf16(PAF(1),VFR(5),o[1],0,0,0), C0,12); \
    KRD(GL,2); GAPB(o[0]=__builtin_amdgcn_mfma_f32_32x32x16_bf16(PAF(2),VFR(2),o[0],0,0,0), C1,0); \
    KRD(GL,3); GAPB(o[1]=__builtin_amdgcn_mfma_f32_32x32x16_bf16(PAF(2),VFR(6),o[1],0,0,0), C1,4); \
    GAPB(o[0]=__builtin_amdgcn_mfma_f32_32x32x16_bf16(PAF(3),VFR(3),o[0],0,0,0), C1,8); \
    GAPB(o[1]=__builtin_amdgcn_mfma_f32_32x32x16_bf16(PAF(3),VFR(7),o[1],0,0,0), C1,12); \
    }while(0)
  int t=1;
  #undef CMASK
  #define CMASK(P0,P1,t) do{}while(0)
  for(;t+5<NT;t+=2){
    STEP(pB0,pB1,pA0,pA1,t,true,true,true);     WAIT_BAR(2); RESC(); ROT();
    STEP(pA0,pA1,pB0,pB1,t+1,true,true,true);   WAIT_BAR(2); RESC(); ROT();
  }
  #undef CMASK
  #define CMASK(P0,P1,t) do{int jb_=(t)-(NT-4); if(jb_>=0)cmask(P0,P1,jb_,qrel,hi);}while(0)
  #define ENDW(tt) do{ if((tt)+3<NT){WAIT_BAR(2);} else if((tt)+2<NT){WAIT_BAR(1);} else {WAIT_BAR(0);} }while(0)
  for(;t+1<NT;t+=2){
    STEP(pB0,pB1,pA0,pA1,t,(t+3<NT),(t+1<NT),(t+1<NT));       ENDW(t);   RESC(); ROT();
    STEP(pA0,pA1,pB0,pB1,t+1,(t+4<NT),(t+2<NT),(t+2<NT));     ENDW(t+1); RESC(); ROT();
  }
  STEP(pB0,pB1,pA0,pA1,NT-1,false,false,false); RESC();
  { float sacc=pB0[0]+pB0[1]; _Pragma("unroll") for(int r=2;r<16;++r)sacc+=pB0[r]; _Pragma("unroll") for(int r=0;r<16;++r)sacc+=pB1[r]; l_reg+=sacc;
    pw0=(u32x4){PKW(pB0,0),PKW(pB0,2),PKW(pB0,4),PKW(pB0,6)};pw1=(u32x4){PKW(pB0,8),PKW(pB0,10),PKW(pB0,12),PKW(pB0,14)};pw2=(u32x4){PKW(pB1,0),PKW(pB1,2),PKW(pB1,4),PKW(pB1,6)};pw3=(u32x4){PKW(pB1,8),PKW(pB1,10),PKW(pB1,12),PKW(pB1,14)};
    SBAR(); pv(o,vb0+sl_cur,PAF(0),PAF(1),PAF(2),PAF(3)); }
  #undef PKW
  #undef PAF
  #undef VFR
  #undef PIN
  #undef MX3
  #undef GAPA
  #undef GAPB
  #undef EX
  #undef VRD
  #undef KRD
  #undef STEP
  #undef ENDW
  {auto rr=__builtin_amdgcn_permlane32_swap(__float_as_uint(l_reg),__float_as_uint(l_reg),false,false);l_reg=__uint_as_float(rr[0])+__uint_as_float(rr[1]);}
  if(hi==0)wsf[32+r32]=l_reg;asm volatile("s_waitcnt lgkmcnt(0)":::"memory");
  float rli[16];
  #pragma unroll
  for(int r=0;r<16;++r)rli[r]=__builtin_amdgcn_rcpf(wsf[32+crow(r,hi)]);
  bf16*Ow=O+(rowbase+q0+wid*QBLK)*PO+h*D;
  { bf16*stg=(bf16*)(shm+LDS_OST)+wid*2048;
    #pragma unroll
    for(int r=0;r<16;++r){const int orow=crow(r,hi);
      #pragma unroll
      for(int d0=0;d0<2;++d0)stg[orow*64+d0*32+r32]=__float2bfloat16(o[d0][r]*rli[r]);}
    asm volatile("s_waitcnt lgkmcnt(0)":::"memory");
    #pragma unroll
    for(int i=0;i<4;++i){const int row=i*8+(lane>>3),ch=lane&7; const u32x4 v=*(const u32x4*)(stg+row*64+ch*8); ATTN_STORE16(Ow+(long)row*PO+ch*8,v);} }
  asm volatile("s_waitcnt lgkmcnt(0)\n\ts_barrier":::"memory");
  #undef DMA_K
  #undef DMA_V
  #undef CMASK
  #undef START
  #undef RESC
  #undef ROT
}
constexpr int ATTN_LDS_BYTES=LDS_BYTES;
struct AttnTensors { const bf16* Q; const bf16* K; const bf16* V; bf16* O; };
struct AttnUnit { int bh; int qb; };
struct StaticOrder {
  int vcu;
  __device__ __forceinline__ explicit StaticOrder(int grid,int block):vcu((block%8)*(grid/8)+block/8){}
  __device__ __forceinline__ bool next(int i,AttnUnit&u)const{ if(i>=4)return false; const int s=vcu&3; u.bh=vcu>>2; u.qb=(i==0)?s:(i==1)?7-s:(i==2)?8+s:15-s; return true; }
  __device__ __forceinline__ void a_ready(const AttnUnit&)const{}
  __device__ __forceinline__ void done(const AttnUnit&)const{}
};
template<class Sched,int THRL=8> __device__ __forceinline__ void attn_phase(char*lds,const AttnTensors&T,const Sched&S){
  AttnUnit u;
  for(int i=0;S.next(i,u);++i){ S.a_ready(u); attn_unit<THRL>(u.bh/NHEAD,u.bh%NHEAD,u.qb,T.Q,T.K,T.V,T.O,lds); S.done(u); }
}
#undef SBAR
#undef WAIT_BAR
}

#define GAS __attribute__((address_space(1)))
#define LAS __attribute__((address_space(3)))
typedef unsigned short bf16;
typedef unsigned v4u __attribute__((ext_vector_type(4)));
typedef float f32x4 __attribute__((ext_vector_type(4)));
typedef short bf16x8 __attribute__((ext_vector_type(8)));
typedef GAS unsigned gu32;
typedef GAS unsigned long long gu64;
#define RLX_AGENT __ATOMIC_RELAXED, __HIP_MEMORY_SCOPE_AGENT
#define LDS_WAIT() asm volatile("s_waitcnt lgkmcnt(0)" ::: "memory")
#define VM_WAIT() asm volatile("s_waitcnt vmcnt(0)" ::: "memory")
__device__ __forceinline__ unsigned long long rt() { return __builtin_amdgcn_s_memrealtime(); }
__device__ __forceinline__ unsigned f2bf(float f) { unsigned u = __builtin_bit_cast(unsigned, f); return (u + 0x7fffu + ((u >> 16) & 1u)) >> 16; }
__device__ __forceinline__ unsigned pk2(float lo, float hi) { return f2bf(lo) | (f2bf(hi) << 16); }

#define XB_TMO      128
#define XB_XCNT(j)  (256  + 64 * (j))
#define XB_XSUB(j)  (1280 + 64 * (j))
#define XB_XGEN(j)  (2304 + 64 * (j))
#define XB_TOP      3328
#define XB_TOPGEN   3392
#define XCD_BAR_WORDS 3456
#define XB_SPIN_CAP (1u << 18)

__device__ __forceinline__ unsigned xb_ld(unsigned* p)              { return __hip_atomic_load(p, __ATOMIC_RELAXED, __HIP_MEMORY_SCOPE_AGENT); }
__device__ __forceinline__ unsigned xb_add(unsigned* p, unsigned v) { return __hip_atomic_fetch_add(p, v, __ATOMIC_RELAXED, __HIP_MEMORY_SCOPE_AGENT); }
__device__ __forceinline__ unsigned xb_xcc_id() { return (unsigned)__builtin_amdgcn_s_getreg((3 << 11) | 20) & 0xFu; }
#define XB_SPIN(cond, bar) do { unsigned _sp = 0; while (cond) { __builtin_amdgcn_s_sleep(1); \
    if ((++_sp & 255u) == 0u) { if (xb_ld(&(bar)[XB_TMO])) break; if (_sp > XB_SPIN_CAP) { atomicAdd(&(bar)[XB_TMO], 1u); break; } } } } while (0)

struct XcdBarrier {
    unsigned* bar; unsigned x;
    volatile LAS unsigned* st;
};

__device__ __forceinline__ XcdBarrier xcd_barrier_post(unsigned* bar, volatile LAS unsigned* st) {
    XcdBarrier b; b.bar = bar; b.x = xb_xcc_id(); b.st = st;
    if (threadIdx.x == 0) (void)xb_add(&bar[XB_XCNT(b.x)], 1u);
    return b;
}
__device__ __forceinline__ void xcd_barrier_complete(unsigned* bar, unsigned x, unsigned& nloc, unsigned& nx) {
    const unsigned G = gridDim.x * gridDim.y * gridDim.z;
    unsigned sum, cnt, mine, sp = 0u;
    for (;;) {
        sum = 0u; cnt = 0u; mine = 0u;
#pragma unroll
        for (unsigned j = 0; j < 16; ++j) { const unsigned c = xb_ld(&bar[XB_XCNT(j)]); sum += c; cnt += (c > 0u) ? 1u : 0u; mine = (j == x) ? c : mine; }
        if (sum == G) break;
        __builtin_amdgcn_s_sleep(1);
        if ((++sp & 255u) == 0u) { if (xb_ld(&bar[XB_TMO])) break; if (sp > XB_SPIN_CAP) { atomicAdd(&bar[XB_TMO], 1u); break; } }
    }
    nloc = mine > 0u ? mine : 1u; nx = cnt > 0u ? cnt : 1u;
}

__device__ __forceinline__ void xcd_barrier(const XcdBarrier& b) {
    asm volatile("s_waitcnt vmcnt(0)" ::: "memory");
    __syncthreads();
    if (threadIdx.x == 0) {
        unsigned* bar = b.bar;
        __builtin_amdgcn_s_waitcnt(0);
        unsigned nloc = b.st[0], nx = b.st[1];
        if (nloc == 0u) { xcd_barrier_complete(bar, b.x, nloc, nx); b.st[0] = nloc; b.st[1] = nx; }
        const unsigned old = xb_add(&bar[XB_XSUB(b.x)], 1u);
        const unsigned gen = old / nloc;
        if (old + 1u == (gen + 1u) * nloc) {
            __builtin_amdgcn_fence(__ATOMIC_RELEASE, "agent");
            asm volatile("s_waitcnt vmcnt(0)" ::: "memory");
            const unsigned og = xb_add(&bar[XB_TOP], 1u);
            const unsigned tg = og / nx;
            if (og + 1u == (tg + 1u) * nx) xb_add(&bar[XB_TOPGEN], 1u);
            else XB_SPIN(xb_ld(&bar[XB_TOPGEN]) == tg, bar);
            __builtin_amdgcn_fence(__ATOMIC_ACQUIRE, "agent");
            xb_add(&bar[XB_XGEN(b.x)], 1u);
            asm volatile("s_waitcnt vmcnt(0)" ::: "memory");
        } else {
            XB_SPIN(xb_ld(&bar[XB_XGEN(b.x)]) == gen, bar);
            __builtin_amdgcn_fence(__ATOMIC_ACQUIRE, "agent");
            asm volatile("s_waitcnt vmcnt(0)" ::: "memory");
        }
    }
    __syncthreads();
}


constexpr int NWAVES = 8;
constexpr int BATCH = 4, SEQ = 4096, DM = 1024, M = BATCH * SEQ, IN_COLS = 5632, NEXP = 32, EFF = 512;
constexpr float EPS = 1e-6f;
constexpr float LAM_INIT = 0.2f;
constexpr int MAXROWS = 2 * M + NEXP * 255;
#ifndef MK_PER_PHASE
#define MK_PER_PHASE 0
#endif
constexpr int N_PHASES = 13;
#ifndef PROBE_A
#define PROBE_A -1
#endif
#ifndef PROBE_B
#define PROBE_B -1
#endif
constexpr bool PROBING = (PROBE_A >= 0) || (PROBE_B >= 0);
constexpr int MI_TS = 128;

constexpr size_t MiB = 1u << 20;
constexpr size_t WS_CTL = 0, CTL_ZERO_BYTES = 1 * MiB;
constexpr size_t WS_WIN = 1 * MiB, WS_WA = 12 * MiB, WS_WB = 13 * MiB, WS_WOUT = 14 * MiB;
constexpr size_t WS_TABA = 16 * MiB, WS_TABB = 17 * MiB, WS_WRP = 25 * MiB;
constexpr size_t WS_H = 26 * MiB;
constexpr size_t WS_P = 58 * MiB, PBUF = 16 * MiB;
constexpr size_t WS_OA = 234 * MiB, WS_OB = 250 * MiB;
constexpr size_t WS_T = 58 * MiB, WS_MERGED = 122 * MiB;
constexpr size_t WS_Y = 58 * MiB;
constexpr size_t WS_XS = 58 * MiB, WS_HMID = 138 * MiB, WS_WGU = 178 * MiB, WS_WD = 242 * MiB;
constexpr size_t WS_ENT_TOK = 274 * MiB, WS_ENT_W = 276 * MiB, WS_ROW_TOK = 278 * MiB, WS_ROW_W = 278 * MiB + 512 * 1024, WS_END = 279 * MiB;
static_assert((size_t)MAXROWS * 1024 * 2 <= WS_HMID - WS_XS && (size_t)MAXROWS * 512 * 2 <= WS_WGU - WS_HMID && (size_t)MAXROWS * 4 <= 512 * 1024, "ws map");
constexpr int CW_TMO = 0, CW_CODE = 1, CW_CNT = 64, CW_BAR = 4096;

constexpr int RING_OFF = 0, RING_BYTES = 131072;
constexpr int LDSCTL_OFF = RING_BYTES, MISC_OFF = LDSCTL_OFF + 320;
constexpr int LDS_BYTES = 147456;
constexpr int MI_CNT = 16, MI_TP = 48;


struct Frame {
    LAS unsigned char* lds;
    volatile LAS unsigned* MISC;
    gu32* ctl;
    int tid, lane, wave;
    int vcu, G;
    const float* in[24]; float* out; unsigned char* ws;
};
__device__ __forceinline__ float bflo(unsigned w) { return __uint_as_float(w << 16); }
__device__ __forceinline__ float bfhi(unsigned w) { return __uint_as_float(w & 0xffff0000u); }
__device__ __forceinline__ float wave_sum(float v) {
#pragma unroll
    for (int o = 1; o < 64; o <<= 1) v += __shfl_xor(v, o);
    return v;
}
__device__ __forceinline__ float sigmoidf_(float x) { return 1.0f / (1.0f + __expf(-x)); }
__device__ __forceinline__ float siluf_(float x) { return x / (1.0f + __expf(-x)); }
__device__ __forceinline__ void unpack8(const v4u r, float (&x)[8]) {
    x[0] = bflo(r.x); x[1] = bfhi(r.x); x[2] = bflo(r.y); x[3] = bfhi(r.y); x[4] = bflo(r.z); x[5] = bfhi(r.z); x[6] = bflo(r.w); x[7] = bfhi(r.w);
}
__device__ __forceinline__ v4u pack8(const float (&x)[8]) { v4u o; o.x = pk2(x[0], x[1]); o.y = pk2(x[2], x[3]); o.z = pk2(x[4], x[5]); o.w = pk2(x[6], x[7]); return o; }

__device__ __forceinline__ void transpose_item(const float* W, int N, bf16* WT, int ldt, int koff, int mode, LAS float* scr, int kb, int nb, int lane) {
    const int k0 = 64 * kb, n0 = 32 * nb;
#pragma unroll 8
    for (int i = 0; i < 32; ++i) { const int kk = 2 * i + (lane >> 5); scr[kk * 33 + (lane & 31)] = W[(size_t)(k0 + kk) * N + n0 + (lane & 31)]; }
    LDS_WAIT(); asm volatile("" ::: "memory");
    const int c = lane & 7;
#pragma unroll
    for (int j = 0; j < 4; ++j) { const int n = (lane >> 3) + 8 * j; const LAS float* s = scr + (8 * c) * 33 + n;
        v4u o; o.x = pk2(s[0 * 33], s[1 * 33]); o.y = pk2(s[2 * 33], s[3 * 33]); o.z = pk2(s[4 * 33], s[5 * 33]); o.w = pk2(s[6 * 33], s[7 * 33]);
        const int nn = n0 + n; const int row = mode == 0 ? nn : ((nn >> 2) * 8 + (mode == 2 ? 4 : 0) + (nn & 3));
        *(GAS v4u*)(WT + (size_t)row * ldt + koff + k0 + 8 * c) = o; }
    LDS_WAIT(); asm volatile("" ::: "memory");
}
__device__ __forceinline__ void sincos_acc(float ang, float& s, float& c) {
    const double t = (double)ang * 0.15915494309189535; const double fr = t - __builtin_rint(t);
    const float r = (float)(fr * 6.283185307179586);
    s = sinf(r); c = cosf(r);
}
__device__ __forceinline__ void p0_prologue(Frame& F) {
    LAS float* scr = (LAS float*)(F.lds + RING_OFF + F.wave * 16384);
    const int gw = F.vcu * NWAVES + F.wave, NGW = F.G * NWAVES;
    unsigned char* ws = F.ws;
    constexpr int I_IN = (DM / 64) * (IN_COLS / 32), I_A = (512 / 64) * (DM / 32), I_OUT = (DM / 64) * (DM / 32);
    for (int it = gw; it < I_IN + 2 * I_A + I_OUT; it += NGW) {
        int r = it;
        if (r < I_IN) { transpose_item(F.in[3], IN_COLS, (bf16*)(ws + WS_WIN), DM, 0, 0, scr, r / (IN_COLS / 32), r % (IN_COLS / 32), F.lane); continue; } r -= I_IN;
        if (r < I_A) { transpose_item(F.in[13], DM, (bf16*)(ws + WS_WA), 512, 0, 0, scr, r / (DM / 32), r % (DM / 32), F.lane); continue; } r -= I_A;
        if (r < I_A) { transpose_item(F.in[14], DM, (bf16*)(ws + WS_WB), 512, 0, 0, scr, r / (DM / 32), r % (DM / 32), F.lane); continue; } r -= I_A;
        transpose_item(F.in[15], DM, (bf16*)(ws + WS_WOUT), DM, 0, 0, scr, r / (DM / 32), r % (DM / 32), F.lane);
    }
    {
        const float* wgr = F.in[17]; const float* wer = F.in[19]; f32x4* Wp4 = (f32x4*)(ws + WS_WRP);
        for (int idx = gw * 64 + F.lane; idx < 64 * 3 * 64; idx += NGW * 64) {
            const int l = idx & 63, st = idx >> 6, t = st % 3, s = st / 3, col = l & 15, q = l >> 4;
            f32x4 v;
#pragma unroll
            for (int j = 0; j < 4; ++j) { const int k = 16 * s + 4 * q + j; v[j] = (t == 0) ? (col < 4 ? wgr[k * 4 + col] : 0.f) : wer[k * 32 + (t - 1) * 16 + col]; }
            Wp4[idx] = v;
        }
    }
    {
        const int* pos = (const int*)F.in[1]; float* tabA = (float*)(ws + WS_TABA); float* tabB = (float*)(ws + WS_TABB);
        const float fB = powf(10000.0f, -(float)F.lane * (1.0f / 64.0f)), fA = powf(500000.0f, -(float)(F.lane & 7) * 0.125f);
        for (int tk = gw; tk < M; tk += NGW) {
            const float p = (float)pos[tk]; float s, c;
            sincos_acc(p * fB, s, c); tabB[(size_t)tk * 128 + F.lane] = c; tabB[(size_t)tk * 128 + 64 + F.lane] = s;
            if (F.lane < 8) { sincos_acc(p * fA, s, c); tabA[(size_t)tk * 16 + F.lane] = c; tabA[(size_t)tk * 16 + 8 + F.lane] = s; }
        }
    }
    {
        const float* g = F.in[2]; bf16* H = (bf16*)(ws + WS_H);
        f32x4 gv[4];
#pragma unroll
        for (int j = 0; j < 4; ++j) gv[j] = ((const f32x4*)g)[F.lane + 64 * j];
        for (int m = gw; m < M; m += NGW) {
            const GAS f32x4* xr = (const GAS f32x4*)(F.in[0] + (size_t)m * DM) + F.lane;
            f32x4 v[4]; float s = 0.f;
#pragma unroll
            for (int j = 0; j < 4; ++j) { v[j] = xr[64 * j]; s += (v[j].x * v[j].x + v[j].y * v[j].y) + (v[j].z * v[j].z + v[j].w * v[j].w); }
            const float rstd = rsqrtf(wave_sum(s) * (1.f / DM) + EPS);
            GAS unsigned long long* o8 = (GAS unsigned long long*)(H + (size_t)m * DM) + F.lane;
#pragma unroll
            for (int j = 0; j < 4; ++j) o8[64 * j] = (unsigned long long)pk2(v[j].x * rstd * gv[j].x, v[j].y * rstd * gv[j].y) | ((unsigned long long)pk2(v[j].z * rstd * gv[j].z, v[j].w * rstd * gv[j].w) << 32);
        }
    }
}

__device__ __forceinline__ void p2_post(Frame& F) {
    const int gw = F.vcu * NWAVES + F.wave, NGW = F.G * NWAVES, lane = F.lane;
    unsigned char* ws = F.ws;
    const float* tabA = (const float*)(ws + WS_TABA); const float* tabB = (const float*)(ws + WS_TABB);
    constexpr float C2 = 0.125f * 1.4426950408889634f;
    const int sub = lane & 7;
    float qg[8], kg[8];
#pragma unroll
    for (int t = 0; t < 8; ++t) { qg[t] = F.in[4][sub * 8 + t]; kg[t] = F.in[5][sub * 8 + t]; }
    for (int tk = gw; tk < M; tk += NGW) {
        float ca[8], sa[8];
#pragma unroll
        for (int t = 0; t < 8; ++t) { ca[t] = tabA[(size_t)tk * 16 + t]; sa[t] = tabA[(size_t)tk * 16 + 8 + t]; }
#pragma unroll
        for (int which = 0; which < 2; ++which) {
            GAS v4u* p = (GAS v4u*)((bf16*)(ws + WS_P + (size_t)which * PBUF) + (size_t)tk * 512 + lane * 8);
            float x[8]; unpack8(*p, x);
            float ss = 0.f;
#pragma unroll
            for (int t = 0; t < 8; ++t) ss += x[t] * x[t];
            ss += __shfl_xor(ss, 1); ss += __shfl_xor(ss, 2); ss += __shfl_xor(ss, 4);
            const float rstd = rsqrtf(ss * (1.f / 64.f) + EPS);
            float y[8];
#pragma unroll
            for (int t = 0; t < 8; ++t) y[t] = x[t] * rstd * (which == 0 ? qg[t] : kg[t]);
#pragma unroll
            for (int t = 0; t < 8; ++t) { const float o = __shfl_xor(y[t], 1);
                if (sub == 0) y[t] = y[t] * ca[t] - o * sa[t]; else if (sub == 1) y[t] = y[t] * ca[t] + o * sa[t]; }
            if (which == 0) {
#pragma unroll
                for (int t = 0; t < 8; ++t) y[t] *= C2;
            }
            *p = pack8(y);
        }
        const int i0 = (lane & 7) * 8;
        float cb[8], sb[8];
#pragma unroll
        for (int t = 0; t < 8; ++t) { cb[t] = tabB[(size_t)tk * 128 + i0 + t]; sb[t] = tabB[(size_t)tk * 128 + 64 + i0 + t]; }
#pragma unroll
        for (int which = 0; which < 2; ++which) {
            GAS v4u* p = (GAS v4u*)((bf16*)(ws + WS_P + (size_t)(3 + which) * PBUF) + (size_t)tk * 512 + lane * 8);
            float x[8]; unpack8(*p, x); float y[8];
#pragma unroll
            for (int t = 0; t < 8; ++t) { const float o = __shfl_xor(x[t], 8);
                y[t] = (lane & 8) ? (x[t] * cb[t] + o * sb[t]) : (x[t] * cb[t] - o * sb[t]);
                if (which == 1) y[t] *= 0.08838834764831845f; }
            *p = pack8(y);
        }
    }
}

__device__ __forceinline__ int rt_off(int row, int kb) { return row * 256 + ((((kb >> 4) ^ (row & 15)) << 4) | (kb & 15)); }
__device__ __forceinline__ bf16x8 rt_frag(const LAS unsigned char* tile, int r0, int ks, int lane) {
    return *(const LAS bf16x8*)(tile + rt_off(r0 + (lane & 15), ks * 64 + 16 * (lane >> 4)));
}
__device__ __forceinline__ float log2_gamma(int h) { return log2f(1.0f - exp2f(-5.0f - (float)h)); }

__device__ __forceinline__ void ret_kv_item(Frame& F, int item) {
    const int bh = item >> 5, n = item & 31, b = bh >> 2, h = bh & 3, tid = F.tid, lane = F.lane, w = F.wave;
    const size_t tok0 = (size_t)b * SEQ + (size_t)n * 128;
    const bf16* kr = (const bf16*)(F.ws + WS_P + 4 * PBUF); const bf16* vr = (const bf16*)(F.ws + WS_P + 5 * PBUF);
    float* RS = F.out + (size_t)item * 16384;
    LAS unsigned char* Kt = F.lds; LAS unsigned char* Vt = F.lds + 32768;
    const float lg = log2_gamma(h);
#pragma unroll
    for (int it = 0; it < 4; ++it) {
        const int idx = tid + it * 512, j = idx & 127, ch = idx >> 7;
        const v4u kv = *(const GAS v4u*)(kr + (tok0 + j) * 512 + h * 128 + ch * 8);
        const v4u vv = *(const GAS v4u*)(vr + (tok0 + j) * 512 + h * 128 + ch * 8);
        float kx[8], vx[8]; unpack8(kv, kx); unpack8(vv, vx);
        const float z = exp2f((float)(127 - j) * lg);
#pragma unroll
        for (int t = 0; t < 8; ++t) {
            *(LAS unsigned short*)(Kt + rt_off(ch * 8 + t, j * 2)) = (unsigned short)f2bf(kx[t]);
            *(LAS unsigned short*)(Vt + rt_off(ch * 8 + t, j * 2)) = (unsigned short)f2bf(vx[t] * z);
        }
    }
    __syncthreads();
    f32x4 acc[8];
#pragma unroll
    for (int dt = 0; dt < 8; ++dt) acc[dt] = (f32x4){0.f, 0.f, 0.f, 0.f};
#pragma unroll
    for (int ks = 0; ks < 4; ++ks) {
        const bf16x8 a = rt_frag(Vt, 16 * w, ks, lane);
#pragma unroll
        for (int dt = 0; dt < 8; ++dt) { const bf16x8 bb = rt_frag(Kt, 16 * dt, ks, lane); acc[dt] = __builtin_amdgcn_mfma_f32_16x16x32_bf16(bb, a, acc[dt], 0, 0, 0); }
    }
    const int e = 16 * w + (lane & 15), q = lane >> 4;
#pragma unroll
    for (int dt = 0; dt < 8; ++dt) *(GAS f32x4*)(RS + (size_t)e * 128 + 16 * dt + 4 * q) = acc[dt];
    __syncthreads();
}
__device__ __forceinline__ void p4_scan(Frame& F) {
    const int gid = F.vcu * (NWAVES * 64) + F.tid, NT = F.G * NWAVES * 64;
    for (int idx = gid; idx < 16 * 4096; idx += NT) {
        const int bh = idx >> 12, off = idx & 4095, h = bh & 3;
        const float g = exp2f(128.0f * log2_gamma(h));
        f32x4 r = (f32x4){0.f, 0.f, 0.f, 0.f};
        GAS f32x4* p = (GAS f32x4*)(F.out + (size_t)bh * 32 * 16384) + off;
        for (int n = 0; n < 32; ++n) { const f32x4 t = p[(size_t)n * 4096]; p[(size_t)n * 4096] = r; r = r * g + t; }
    }
}
__device__ __forceinline__ void ret_out_item(Frame& F, int item) {
    const int bh = item >> 5, n = item & 31, b = bh >> 2, h = bh & 3, tid = F.tid, lane = F.lane, w = F.wave;
    const size_t tok0 = (size_t)b * SEQ + (size_t)n * 128;
    const bf16* qr = (const bf16*)(F.ws + WS_P + 3 * PBUF); const bf16* kr = (const bf16*)(F.ws + WS_P + 4 * PBUF); const bf16* vr = (const bf16*)(F.ws + WS_P + 5 * PBUF);
    const bf16* gb = (const bf16*)(F.ws + WS_P + 6 * PBUF); bf16* obg = (bf16*)(F.ws + WS_OB);
    const float* RS = F.out + (size_t)item * 16384;
    LAS unsigned char* Qs = F.lds; LAS unsigned char* Ks = F.lds + 32768; LAS unsigned char* Vt = F.lds + 65536; LAS unsigned char* Rt = F.lds + 98304;
    const float lg = log2_gamma(h);
#pragma unroll
    for (int it = 0; it < 4; ++it) {
        const int idx = tid + it * 512;
        { const int row = idx >> 4, ch = idx & 15;
          *(LAS v4u*)(Qs + rt_off(row, ch * 16)) = *(const GAS v4u*)(qr + (tok0 + row) * 512 + h * 128 + ch * 8);
          *(LAS v4u*)(Ks + rt_off(row, ch * 16)) = *(const GAS v4u*)(kr + (tok0 + row) * 512 + h * 128 + ch * 8);
          const f32x4 r0 = *(const GAS f32x4*)(RS + (size_t)row * 128 + ch * 8), r1 = *(const GAS f32x4*)(RS + (size_t)row * 128 + ch * 8 + 4);
          v4u o; o.x = pk2(r0.x, r0.y); o.y = pk2(r0.z, r0.w); o.z = pk2(r1.x, r1.y); o.w = pk2(r1.z, r1.w);
          *(LAS v4u*)(Rt + rt_off(row, ch * 16)) = o; }
        { const int j = idx & 127, ch = idx >> 7;
          const v4u vv = *(const GAS v4u*)(vr + (tok0 + j) * 512 + h * 128 + ch * 8);
          *(LAS unsigned short*)(Vt + rt_off(ch * 8 + 0, j * 2)) = (unsigned short)(vv.x & 0xffffu); *(LAS unsigned short*)(Vt + rt_off(ch * 8 + 1, j * 2)) = (unsigned short)(vv.x >> 16);
          *(LAS unsigned short*)(Vt + rt_off(ch * 8 + 2, j * 2)) = (unsigned short)(vv.y & 0xffffu); *(LAS unsigned short*)(Vt + rt_off(ch * 8 + 3, j * 2)) = (unsigned short)(vv.y >> 16);
          *(LAS unsigned short*)(Vt + rt_off(ch * 8 + 4, j * 2)) = (unsigned short)(vv.z & 0xffffu); *(LAS unsigned short*)(Vt + rt_off(ch * 8 + 5, j * 2)) = (unsigned short)(vv.z >> 16);
          *(LAS unsigned short*)(Vt + rt_off(ch * 8 + 6, j * 2)) = (unsigned short)(vv.w & 0xffffu); *(LAS unsigned short*)(Vt + rt_off(ch * 8 + 7, j * 2)) = (unsigned short)(vv.w >> 16); }
    }
    __syncthreads();
    const int i = 16 * w + (lane & 15), q = lane >> 4;
    f32x4 sacc[8];
#pragma unroll
    for (int jt = 0; jt < 8; ++jt) sacc[jt] = (f32x4){0.f, 0.f, 0.f, 0.f};
#pragma unroll
    for (int ks = 0; ks < 4; ++ks) {
        const bf16x8 a = rt_frag(Qs, 16 * w, ks, lane);
#pragma unroll
        for (int jt = 0; jt < 8; ++jt) { const bf16x8 bb = rt_frag(Ks, 16 * jt, ks, lane); sacc[jt] = __builtin_amdgcn_mfma_f32_16x16x32_bf16(bb, a, sacc[jt], 0, 0, 0); }
    }
    __syncthreads();
#pragma unroll
    for (int jt = 0; jt < 8; ++jt) {
        float v[4];
#pragma unroll
        for (int t = 0; t < 4; ++t) { const int j = 16 * jt + 4 * q + t; v[t] = (i >= j) ? sacc[jt][t] * exp2f((float)(i - j) * lg) : 0.f; }
        *(LAS unsigned long long*)(Ks + rt_off(i, (16 * jt + 4 * q) * 2)) = (unsigned long long)pk2(v[0], v[1]) | ((unsigned long long)pk2(v[2], v[3]) << 32);
    }
    __syncthreads();
    f32x4 a1[8], a2[8];
#pragma unroll
    for (int et = 0; et < 8; ++et) { a1[et] = (f32x4){0.f, 0.f, 0.f, 0.f}; a2[et] = (f32x4){0.f, 0.f, 0.f, 0.f}; }
#pragma unroll
    for (int ks = 0; ks < 4; ++ks) {
        const bf16x8 aS = rt_frag(Ks, 16 * w, ks, lane), aQ = rt_frag(Qs, 16 * w, ks, lane);
#pragma unroll
        for (int et = 0; et < 8; ++et) {
            const bf16x8 bV = rt_frag(Vt, 16 * et, ks, lane), bR = rt_frag(Rt, 16 * et, ks, lane);
            a1[et] = __builtin_amdgcn_mfma_f32_16x16x32_bf16(bV, aS, a1[et], 0, 0, 0);
            a2[et] = __builtin_amdgcn_mfma_f32_16x16x32_bf16(bR, aQ, a2[et], 0, 0, 0);
        }
    }
    const float xi = exp2f((float)(i + 1) * lg);
    float s = 0.f;
#pragma unroll
    for (int et = 0; et < 8; ++et) { a1[et] = a1[et] + a2[et] * xi; s += (a1[et][0] + a1[et][1]) + (a1[et][2] + a1[et][3]); }
    s += __shfl_xor(s, 16); s += __shfl_xor(s, 32);
    const float mu = s * (1.f / 128.f); float vq = 0.f;
#pragma unroll
    for (int et = 0; et < 8; ++et) { const f32x4 d = a1[et] - mu; vq += (d[0] * d[0] + d[1] * d[1]) + (d[2] * d[2] + d[3] * d[3]); }
    vq += __shfl_xor(vq, 16); vq += __shfl_xor(vq, 32);
    const float rstd = rsqrtf(vq * (1.f / 128.f) + EPS);
    const float* gng = F.in[11] + h * 128; const float* gnb = F.in[12] + h * 128;
#pragma unroll
    for (int et = 0; et < 8; ++et) {
        const int e = 16 * et + 4 * q;
        const f32x4 gg = *(const f32x4*)(gng + e), bb = *(const f32x4*)(gnb + e);
        const unsigned long long gw8 = *(const GAS unsigned long long*)(gb + (tok0 + i) * 512 + h * 128 + e);
        const float g0 = bflo((unsigned)gw8), g1 = bfhi((unsigned)gw8), g2 = bflo((unsigned)(gw8 >> 32)), g3 = bfhi((unsigned)(gw8 >> 32));
        const f32x4 y = (a1[et] - mu) * rstd * gg + bb;
        *(GAS unsigned long long*)(obg + (tok0 + i) * 512 + h * 128 + e) =
            (unsigned long long)pk2(y[0] * siluf_(g0), y[1] * siluf_(g1)) | ((unsigned long long)pk2(y[2] * siluf_(g2), y[3] * siluf_(g3)) << 32);
    }
    __syncthreads();
}
__device__ __forceinline__ void p5_attn_combine(Frame& F) {
    const int gw = F.vcu * NWAVES + F.wave, NGW = F.G * NWAVES, lane = F.lane;
    const float s1 = wave_sum(F.in[6][lane] * F.in[7][lane]), s2 = wave_sum(F.in[8][lane] * F.in[9][lane]);
    const float lam = expf(s1) - expf(s2) + LAM_INIT;
    const bf16* AO = (const bf16*)(F.ws + WS_H); bf16* oa = (bf16*)(F.ws + WS_OA);
    const int h = lane >> 4, e0 = (lane & 15) * 8, vhalf = e0 >> 6, d = e0 & 63;
    float g[8];
#pragma unroll
    for (int t = 0; t < 8; ++t) g[t] = F.in[10][e0 + t] * (1.0f - LAM_INIT);
    for (int tk = gw; tk < M; tk += NGW) {
        float x0[8], x1[8];
        unpack8(*(const GAS v4u*)(AO + (size_t)tk * 1024 + (h * 4 + vhalf) * 64 + d), x0);
        unpack8(*(const GAS v4u*)(AO + (size_t)tk * 1024 + (h * 4 + 2 + vhalf) * 64 + d), x1);
        float y[8], ss = 0.f;
#pragma unroll
        for (int t = 0; t < 8; ++t) { y[t] = x0[t] - lam * x1[t]; ss += y[t] * y[t]; }
        ss += __shfl_xor(ss, 1); ss += __shfl_xor(ss, 2); ss += __shfl_xor(ss, 4); ss += __shfl_xor(ss, 8);
        const float rstd = rsqrtf(ss * (1.f / 128.f) + EPS);
#pragma unroll
        for (int t = 0; t < 8; ++t) y[t] = y[t] * rstd * g[t];
        *(GAS v4u*)(oa + (size_t)tk * 512 + h * 128 + e0) = pack8(y);
    }
}

struct EpiGateA {
    static constexpr bool PERM = false, AFTER_DRAIN = false;
    float* T; const bf16* g0; const bf16* g1;
    __device__ __forceinline__ void operator()(const f32x4 (&acc)[2][2][4][2], const pg8::Unit& u, int wr, int wc, int fr, int fq) const {
        const int row0 = u.pm * 256 + wr * 64 + fr, col0 = u.pn * 256 + wc * 32 + 4 * fq;
#pragma unroll
        for (int ai = 0; ai < 2; ++ai)
#pragma unroll
            for (int m = 0; m < 4; ++m) { const size_t row = (size_t)(row0 + ai * 128 + m * 16);
#pragma unroll
                for (int bj = 0; bj < 2; ++bj)
#pragma unroll
                    for (int n = 0; n < 2; ++n) { const int col = col0 + bj * 128 + n * 16;
                        const unsigned long long gw8 = *(const GAS unsigned long long*)((col < 512 ? g0 : g1) + row * 512 + (col & 511));
                        f32x4 s; s[0] = sigmoidf_(bflo((unsigned)gw8)); s[1] = sigmoidf_(bfhi((unsigned)gw8)); s[2] = sigmoidf_(bflo((unsigned)(gw8 >> 32))); s[3] = sigmoidf_(bfhi((unsigned)(gw8 >> 32)));
                        *(GAS f32x4*)(T + row * 1024 + col) = s * acc[ai][bj][m][n]; } }
    }
};
struct EpiMerge {
    static constexpr bool PERM = false, AFTER_DRAIN = false;
    const float* T; bf16* O; const bf16* g0; const bf16* g1;
    __device__ __forceinline__ void operator()(const f32x4 (&acc)[2][2][4][2], const pg8::Unit& u, int wr, int wc, int fr, int fq) const {
        const int row0 = u.pm * 256 + wr * 64 + fr, col0 = u.pn * 256 + wc * 32 + 4 * fq;
#pragma unroll
        for (int ai = 0; ai < 2; ++ai)
#pragma unroll
            for (int m = 0; m < 4; ++m) { const size_t row = (size_t)(row0 + ai * 128 + m * 16);
#pragma unroll
                for (int bj = 0; bj < 2; ++bj)
#pragma unroll
                    for (int n = 0; n < 2; ++n) { const int col = col0 + bj * 128 + n * 16;
                        const unsigned long long gw8 = *(const GAS unsigned long long*)((col < 512 ? g0 : g1) + row * 512 + (col & 511));
                        f32x4 s; s[0] = sigmoidf_(bflo((unsigned)gw8)); s[1] = sigmoidf_(bfhi((unsigned)gw8)); s[2] = sigmoidf_(bflo((unsigned)(gw8 >> 32))); s[3] = sigmoidf_(bfhi((unsigned)(gw8 >> 32)));
                        const f32x4 v = *(const GAS f32x4*)(T + row * 1024 + col) + s * acc[ai][bj][m][n];
                        *(GAS unsigned long long*)(O + row * 1024 + col) = (unsigned long long)pk2(v[0], v[1]) | ((unsigned long long)pk2(v[2], v[3]) << 32); } }
    }
};
struct EpiResid {
    static constexpr bool PERM = false, AFTER_DRAIN = false;
    const float* X; float* O;
    __device__ __forceinline__ void operator()(const f32x4 (&acc)[2][2][4][2], const pg8::Unit& u, int wr, int wc, int fr, int fq) const {
        const int row0 = u.pm * 256 + wr * 64 + fr, col0 = u.pn * 256 + wc * 32 + 4 * fq;
#pragma unroll
        for (int ai = 0; ai < 2; ++ai)
#pragma unroll
            for (int m = 0; m < 4; ++m) { const size_t row = (size_t)(row0 + ai * 128 + m * 16);
#pragma unroll
                for (int bj = 0; bj < 2; ++bj)
#pragma unroll
                    for (int n = 0; n < 2; ++n) { const int col = col0 + bj * 128 + n * 16;
                        *(GAS f32x4*)(O + row * 1024 + col) = *(const GAS f32x4*)(X + row * 1024 + col) + acc[ai][bj][m][n]; } }
    }
};
struct EpiSwiGLU {
    static constexpr bool PERM = true, AFTER_DRAIN = false;
    bf16* Hm;
    __device__ __forceinline__ void operator()(const f32x4 (&acc)[2][2][4][2], const pg8::Unit& u, int wr, int wc, int fr, int fq) const {
        const int row0 = u.pm * 256 + wr * 64 + fr, j0 = (u.pn & 3) * 128 + wc * 16 + 4 * fq;
#pragma unroll
        for (int ai = 0; ai < 2; ++ai)
#pragma unroll
            for (int m = 0; m < 4; ++m) { const size_t row = (size_t)(row0 + ai * 128 + m * 16);
#pragma unroll
                for (int bj = 0; bj < 2; ++bj) { const f32x4 a = acc[ai][bj][m][0], uu = acc[ai][bj][m][1];
                    *(GAS unsigned long long*)(Hm + row * 512 + j0 + bj * 64) =
                        (unsigned long long)pk2(siluf_(a[0]) * uu[0], siluf_(a[1]) * uu[1]) | ((unsigned long long)pk2(siluf_(a[2]) * uu[2], siluf_(a[3]) * uu[3]) << 32); } }
    }
};
struct EpiY {
    static constexpr bool PERM = true, AFTER_DRAIN = false;
    bf16* Y; const int* ent_tok; const float* ent_w; const volatile LAS unsigned* cntL;
    __device__ __forceinline__ void operator()(const f32x4 (&acc)[2][2][4][2], const pg8::Unit& u, int wr, int wc, int fr, int fq) const {
        const int r0 = u.ti * 256 + wr * 64 + fr, col0 = (u.pn & 3) * 256 + wc * 32 + 8 * fq, cnt = (int)cntL[u.e];
#pragma unroll
        for (int ai = 0; ai < 2; ++ai)
#pragma unroll
            for (int m = 0; m < 4; ++m) { const int ent = r0 + ai * 128 + m * 16;
                if (ent < cnt) { const int tk2 = ent_tok[(size_t)u.e * M + ent]; const float w = ent_w[(size_t)u.e * M + ent];
                    bf16* o = Y + ((size_t)(tk2 & 1) * M + (size_t)(tk2 >> 1)) * 1024 + col0;
#pragma unroll
                    for (int bj = 0; bj < 2; ++bj) { const f32x4 v0 = acc[ai][bj][m][0] * w, v1 = acc[ai][bj][m][1] * w;
                        v4u o4; o4.x = pk2(v0[0], v0[1]); o4.y = pk2(v0[2], v0[3]); o4.z = pk2(v1[0], v1[1]); o4.w = pk2(v1[2], v1[3]);
                        *(GAS v4u*)(o + bj * 128) = o4; } } }
    }
};
template <bool GA> struct GroupedOrderT {
    static constexpr bool GATHER = GA;
    const volatile LAS unsigned* tp; const volatile LAS unsigned* cntL; const int* ent_tok; int G, c;
    __device__ __forceinline__ bool next(int i, pg8::Unit& u) const {
        const int L = i * G + c; const int total = (int)tp[32] * 4; if (L >= total) return false;
        const int T = L >> 2; int e = 0;
#pragma unroll 1
        for (int k = 1; k < 32; ++k) e += (T >= (int)tp[k]) ? 1 : 0;
        u.pm = T; u.pn = e * 4 + (L & 3); u.e = e; u.ti = T - (int)tp[e]; return true;
    }
    __device__ __forceinline__ unsigned arow_off(const pg8::Unit& u, int r) const {
        const int ent = u.ti * 256 + r; const int tk2 = (ent < (int)cntL[u.e]) ? ent_tok[(size_t)u.e * M + ent] : 0;
        return (unsigned)(tk2 >> 1) * (unsigned)(DM * 2);
    }
    __device__ __forceinline__ void a_ready(const pg8::Unit&) const {}
    __device__ __forceinline__ void done(const pg8::Unit&) const {}
};

__device__ __forceinline__ void p9_router(Frame& F) {
    const int gw = F.vcu * NWAVES + F.wave, NGW = F.G * NWAVES, lane = F.lane;
    unsigned char* ws = F.ws;
    LAS float* scr = (LAS float*)(F.lds + RING_OFF + F.wave * 16384);
    LAS float* Lg = (LAS float*)(F.lds + RING_OFF + F.wave * 16384 + 12288);
    const float* X1 = F.out; bf16* H = (bf16*)(ws + WS_H); const float* g2 = F.in[16];
    const f32x4* Wp4 = (const f32x4*)(ws + WS_WRP);
    int* ent_tok = (int*)(ws + WS_ENT_TOK); float* ent_w = (float*)(ws + WS_ENT_W);
    f32x4 gv[4];
#pragma unroll
    for (int j = 0; j < 4; ++j) gv[j] = ((const f32x4*)g2)[lane + 64 * j];
    for (int item = gw; item < M / 16; item += NGW) {
        const int tok0 = item * 16; float myrstd = 0.f;
        for (int r = 0; r < 16; ++r) {
            const GAS f32x4* xr = (const GAS f32x4*)(X1 + (size_t)(tok0 + r) * DM) + lane;
            f32x4 v[4]; float s = 0.f;
#pragma unroll
            for (int j = 0; j < 4; ++j) { v[j] = xr[64 * j]; s += (v[j].x * v[j].x + v[j].y * v[j].y) + (v[j].z * v[j].z + v[j].w * v[j].w); }
            const float rstd = rsqrtf(wave_sum(s) * (1.f / DM) + EPS);
            GAS unsigned long long* o8 = (GAS unsigned long long*)(H + (size_t)(tok0 + r) * DM) + lane;
#pragma unroll
            for (int j = 0; j < 4; ++j) o8[64 * j] = (unsigned long long)pk2(v[j].x * rstd * gv[j].x, v[j].y * rstd * gv[j].y) | ((unsigned long long)pk2(v[j].z * rstd * gv[j].z, v[j].w * rstd * gv[j].w) << 32);
            if ((lane & 15) == r) myrstd = rstd;
        }
        f32x4 acc[3];
#pragma unroll
        for (int t = 0; t < 3; ++t) acc[t] = (f32x4){0.f, 0.f, 0.f, 0.f};
        const float* xa = X1 + (size_t)(tok0 + (lane & 15)) * DM + 4 * (lane >> 4);
        const float* ga = g2 + 4 * (lane >> 4);
#pragma unroll 2
        for (int s = 0; s < 64; ++s) {
            const f32x4 xv = *(const GAS f32x4*)(xa + 16 * s), gq = *(const f32x4*)(ga + 16 * s);
            const f32x4 a = xv * gq * myrstd;
#pragma unroll
            for (int t = 0; t < 3; ++t) { const f32x4 wv = Wp4[(s * 3 + t) * 64 + lane];
#pragma unroll
                for (int j = 0; j < 4; ++j) acc[t] = __builtin_amdgcn_mfma_f32_16x16x4f32(a[j], wv[j], acc[t], 0, 0, 0); }
        }
#pragma unroll
        for (int t = 0; t < 3; ++t)
#pragma unroll
            for (int r = 0; r < 4; ++r) Lg[(4 * (lane >> 4) + r) * 48 + t * 16 + (lane & 15)] = acc[t][r];
        LDS_WAIT(); asm volatile("" ::: "memory");
        if (lane < 16) {
            const int tok = tok0 + lane; const LAS float* Lr = Lg + lane * 48;
            float gl[4];
#pragma unroll
            for (int k = 0; k < 4; ++k) gl[k] = Lr[k] + F.in[18][k];
            int gi = 0; float mx = gl[0];
#pragma unroll
            for (int k = 1; k < 4; ++k) if (gl[k] > mx) { mx = gl[k]; gi = k; }
            float se = 0.f;
#pragma unroll
            for (int k = 0; k < 4; ++k) se += __expf(gl[k] - mx);
            const float pg = 1.0f / se;
            float v0 = -3.0e38f, v1 = -3.0e38f; int i0 = 0, i1 = 0;
#pragma unroll
            for (int k = 0; k < 8; ++k) { const float el = Lr[16 + gi * 8 + k] + F.in[20][gi * 8 + k];
                if (el > v0) { v1 = v0; i1 = i0; v0 = el; i0 = k; } else if (el > v1) { v1 = el; i1 = k; } }
            const float w0 = pg / (1.0f + __expf(v1 - v0)), w1 = pg - w0;
            const int e0 = gi * 8 + i0, e1 = gi * 8 + i1;
            const unsigned p0 = atomicAdd((unsigned*)(F.ctl + CW_CNT) + e0, 1u); ent_tok[(size_t)e0 * M + p0] = tok * 2; ent_w[(size_t)e0 * M + p0] = w0;
            const unsigned p1 = atomicAdd((unsigned*)(F.ctl + CW_CNT) + e1, 1u); ent_tok[(size_t)e1 * M + p1] = tok * 2 + 1; ent_w[(size_t)e1 * M + p1] = w1;
        }
        LDS_WAIT(); asm volatile("" ::: "memory");
    }
    for (int it = gw; it < NEXP * 768; it += NGW) {
        const int e = it / 768, r = it % 768;
        if (r < 256) transpose_item(F.in[21] + (size_t)e * DM * EFF, EFF, (bf16*)(ws + WS_WGU) + (size_t)e * 1024 * 1024, 1024, 0, 1, scr, r / 16, r % 16, lane);
        else if (r < 512) transpose_item(F.in[22] + (size_t)e * DM * EFF, EFF, (bf16*)(ws + WS_WGU) + (size_t)e * 1024 * 1024, 1024, 0, 2, scr, (r - 256) / 16, (r - 256) % 16, lane);
        else transpose_item(F.in[23] + (size_t)e * EFF * DM, DM, (bf16*)(ws + WS_WD) + (size_t)e * 1024 * 512, 512, 0, 0, scr, (r - 512) / 32, (r - 512) % 32, lane);
    }
}
__device__ __forceinline__ void load_expert_tables(Frame& F) {
    if (F.tid < 32) F.MISC[MI_CNT + F.tid] = __hip_atomic_load(F.ctl + CW_CNT + F.tid, RLX_AGENT);
    __syncthreads();
    if (F.tid == 0) { unsigned a = 0; for (int e = 0; e < 32; ++e) { F.MISC[MI_TP + e] = a; a += (F.MISC[MI_CNT + e] + 255u) >> 8; } F.MISC[MI_TP + 32] = a; }
    __syncthreads();
}
struct Args { const void* in[24]; float* out; unsigned char* ws; int ph_lo, ph_hi; };
__global__ void __launch_bounds__(NWAVES * 64, 2) mk_fwd(Args args) {
    extern __shared__ __attribute__((aligned(16))) unsigned char lds[];
    Frame F;
    F.lds = (LAS unsigned char*)lds;
    F.MISC = (volatile LAS unsigned*)(F.lds + MISC_OFF);
    F.tid = threadIdx.x; F.lane = F.tid & 63; F.wave = __builtin_amdgcn_readfirstlane(F.tid >> 6);
    F.G = gridDim.x; { const int bx = blockIdx.x; F.vcu = (F.G % 8 == 0) ? (bx % 8) * (F.G / 8) + bx / 8 : bx; }
    unsigned char* ws = args.ws; F.ws = ws; F.out = args.out;
    F.ctl = (gu32*)(ws + WS_CTL);
#pragma unroll
    for (int i = 0; i < 24; ++i) F.in[i] = (const float*)args.in[i];
    for (int u = F.tid; u < (LDS_BYTES - LDSCTL_OFF) / 4; u += NWAVES * 64) ((LAS unsigned*)(F.lds + LDSCTL_OFF))[u] = 0u;
    __syncthreads();
    XcdBarrier bar; bar.bar = (unsigned*)(F.ctl + CW_BAR); bar.x = 0; bar.st = nullptr;
#if !MK_PER_PHASE
    bar = xcd_barrier_post((unsigned*)(F.ctl + CW_BAR), F.MISC + 8);
#endif
    const int lo = args.ph_lo, hi = args.ph_hi;
#define IN(k) (lo <= (k) && (k) < hi)
#define STAMP(k) do { if (PROBING && blockIdx.x == 0 && F.tid == 0) { const unsigned long long t_ = __builtin_amdgcn_s_memrealtime(); F.MISC[MI_TS + 2 * (k)] = (unsigned)t_; F.MISC[MI_TS + 2 * (k) + 1] = (unsigned)(t_ >> 32); } } while (0)
#define SEAM(k) do { if (IN(k) && IN((k) + 1)) xcd_barrier(bar); STAMP((k) + 1); } while (0)
    STAMP(0);

    if (IN(0)) { p0_prologue(F); } SEAM(0);
    if (IN(1)) {
        pg8::Gemm g{(const pg8::bf16_t*)(ws + WS_H), (const pg8::bf16_t*)(ws + WS_WIN), M, IN_COLS, DM}; pg8::StaticOrder S; S.init(M, IN_COLS, F.G, (int)blockIdx.x);
        pg8::EpiBf16<0> E{(pg8::bf16_t*)(ws + WS_P), 512, nullptr, 512, (size_t)PBUF / 2, 1.0f};
        pg8::gemm_phase<pg8::EpiBf16<0>, pg8::StaticOrder, true, true>(F.lds + RING_OFF, g, S, E);
    } SEAM(1);
    if (IN(2)) { p2_post(F); } SEAM(2);
    if (IN(3)) {
        const attn_body::AttnTensors AT{(const attn_body::bf16*)(ws + WS_P), (const attn_body::bf16*)(ws + WS_P + PBUF), (const attn_body::bf16*)(ws + WS_P + 2 * PBUF), (attn_body::bf16*)(ws + WS_H)};
        const attn_body::StaticOrder S((int)F.G, (int)blockIdx.x);
        attn_body::attn_phase<attn_body::StaticOrder>((char*)lds + RING_OFF, AT, S);
        __syncthreads();
        for (int item = F.vcu; item < 512; item += F.G) ret_kv_item(F, item);
    } SEAM(3);
    if (IN(4)) { p4_scan(F); } SEAM(4);
    if (IN(5)) { for (int item = F.vcu; item < 512; item += F.G) ret_out_item(F, item); p5_attn_combine(F); } SEAM(5);
    if (IN(6)) {
        pg8::Gemm g{(const pg8::bf16_t*)(ws + WS_OA), (const pg8::bf16_t*)(ws + WS_WA), M, DM, 512}; pg8::StaticOrder S; S.init(M, DM, F.G, (int)blockIdx.x);
        EpiGateA E{(float*)(ws + WS_T), (const bf16*)(ws + WS_P + 7 * PBUF), (const bf16*)(ws + WS_P + 8 * PBUF)};
        pg8::gemm_phase<EpiGateA, pg8::StaticOrder, true, true>(F.lds + RING_OFF, g, S, E);
    } SEAM(6);
    if (IN(7)) {
        pg8::Gemm g{(const pg8::bf16_t*)(ws + WS_OB), (const pg8::bf16_t*)(ws + WS_WB), M, DM, 512}; pg8::StaticOrder S; S.init(M, DM, F.G, (int)blockIdx.x);
        EpiMerge E{(const float*)(ws + WS_T), (bf16*)(ws + WS_MERGED), (const bf16*)(ws + WS_P + 9 * PBUF), (const bf16*)(ws + WS_P + 10 * PBUF)};
        pg8::gemm_phase<EpiMerge, pg8::StaticOrder, true, true>(F.lds + RING_OFF, g, S, E);
    } SEAM(7);
    if (IN(8)) {
        pg8::Gemm g{(const pg8::bf16_t*)(ws + WS_MERGED), (const pg8::bf16_t*)(ws + WS_WOUT), M, DM, DM}; pg8::StaticOrder S; S.init(M, DM, F.G, (int)blockIdx.x);
        EpiResid E{F.in[0], F.out};
        pg8::gemm_phase<EpiResid, pg8::StaticOrder, true, true>(F.lds + RING_OFF, g, S, E);
    } SEAM(8);
    if (IN(9)) { p9_router(F); } SEAM(9);
    if (IN(10)) {
        load_expert_tables(F);
        pg8::Gemm g{(const pg8::bf16_t*)(ws + WS_H), (const pg8::bf16_t*)(ws + WS_WGU), MAXROWS, NEXP * 1024, DM};
        GroupedOrderT<true> S{F.MISC + MI_TP, F.MISC + MI_CNT, (const int*)(ws + WS_ENT_TOK), F.G, (int)blockIdx.x};
        EpiSwiGLU E{(bf16*)(ws + WS_HMID)};
        pg8::gemm_phase<EpiSwiGLU, GroupedOrderT<true>, true, true>(F.lds + RING_OFF, g, S, E);
    } SEAM(10);
    if (IN(11)) {
        load_expert_tables(F);
        pg8::Gemm g{(const pg8::bf16_t*)(ws + WS_HMID), (const pg8::bf16_t*)(ws + WS_WD), MAXROWS, NEXP * 1024, EFF};
        GroupedOrderT<false> S{F.MISC + MI_TP, F.MISC + MI_CNT, (const int*)(ws + WS_ENT_TOK), F.G, (int)blockIdx.x};
        EpiY E{(bf16*)(ws + WS_Y), (const int*)(ws + WS_ENT_TOK), (const float*)(ws + WS_ENT_W), F.MISC + MI_CNT};
        pg8::gemm_phase<EpiY, GroupedOrderT<false>, true, true>(F.lds + RING_OFF, g, S, E);
    } SEAM(11);
    if (IN(12)) {
        const int gid = F.vcu * (NWAVES * 64) + F.tid, NT = F.G * NWAVES * 64;
        const bf16* Y0 = (const bf16*)(ws + WS_Y); const bf16* Y1 = Y0 + (size_t)M * 1024;
        for (int idx = gid; idx < M * 1024 / 8; idx += NT) {
            GAS f32x4* o = (GAS f32x4*)F.out + (size_t)idx * 2;
            f32x4 a = o[0], b2 = o[1]; float y0[8], y1[8];
            unpack8(*(const GAS v4u*)(Y0 + (size_t)idx * 8), y0); unpack8(*(const GAS v4u*)(Y1 + (size_t)idx * 8), y1);
            a[0] += y0[0] + y1[0]; a[1] += y0[1] + y1[1]; a[2] += y0[2] + y1[2]; a[3] += y0[3] + y1[3];
            b2[0] += y0[4] + y1[4]; b2[1] += y0[5] + y1[5]; b2[2] += y0[6] + y1[6]; b2[3] += y0[7] + y1[7];
            o[0] = a; o[1] = b2;
        }
    }
    if (PROBING) {
        xcd_barrier(bar); STAMP(N_PHASES);
        if (blockIdx.x == 0) {
            __syncthreads();
            float dA = 0.f, dB = 0.f;
            if (PROBE_A >= 0) { const unsigned long long t0 = ((unsigned long long)F.MISC[MI_TS + 2 * PROBE_A + 1] << 32) | F.MISC[MI_TS + 2 * PROBE_A], t1 = ((unsigned long long)F.MISC[MI_TS + 2 * PROBE_A + 3] << 32) | F.MISC[MI_TS + 2 * PROBE_A + 2]; dA = (float)(t1 - t0); }
            if (PROBE_B == 99) dB = 1.0f;
            else if (PROBE_B >= 0) { const unsigned long long t0 = ((unsigned long long)F.MISC[MI_TS + 2 * PROBE_B + 1] << 32) | F.MISC[MI_TS + 2 * PROBE_B], t1 = ((unsigned long long)F.MISC[MI_TS + 2 * PROBE_B + 3] << 32) | F.MISC[MI_TS + 2 * PROBE_B + 2]; dB = (float)(t1 - t0) * 0.0001f; }
            if (F.tid == 0) F.out[0] += dA;
            for (int i = F.tid; i < (1 << 20); i += NWAVES * 64) F.out[4096 + i] += dB;
        }
    }
#undef IN
#undef SEAM
}

extern "C" void kernel_launch(void* const* d_in, const int* in_sizes, int n_in, void* d_out, int out_size, void* d_ws, size_t ws_size, hipStream_t stream) {
    static int grid = 0;
    if (grid == 0) {
        if (n_in != 24 || in_sizes[0] != M * DM || out_size != M * DM || ws_size < WS_END) { fprintf(stderr, "kernel_launch: unexpected shapes/workspace (n_in %d, ws %zu); nothing launched\n", n_in, ws_size); grid = -1; return; }
        int dev = 0, cus = 0, per_cu = 0;
        if (hipGetDevice(&dev) != hipSuccess || hipDeviceGetAttribute(&cus, hipDeviceAttributeMultiprocessorCount, dev) != hipSuccess) { grid = -1; return; }
        if (hipFuncSetAttribute((const void*)mk_fwd, hipFuncAttributeMaxDynamicSharedMemorySize, LDS_BYTES) != hipSuccess) { fprintf(stderr, "kernel_launch: hipFuncSetAttribute failed\n"); grid = -1; return; }
        if (hipOccupancyMaxActiveBlocksPerMultiprocessor(&per_cu, (const void*)mk_fwd, NWAVES * 64, LDS_BYTES) != hipSuccess || per_cu < 1) fprintf(stderr, "kernel_launch: occupancy query reports %d\n", per_cu);
        (void)hipGetLastError();
        grid = cus;
    }
    if (grid < 0) return;
    if (hipMemsetAsync((char*)d_ws + WS_CTL, 0, CTL_ZERO_BYTES, stream) != hipSuccess) return;
    Args a{};
    for (int i = 0; i < 24; ++i) a.in[i] = d_in[i];
    a.out = (float*)d_out; a.ws = (unsigned char*)d_ws;
#if MK_PER_PHASE
    for (int p = 0; p < N_PHASES; ++p) { a.ph_lo = p; a.ph_hi = p + 1; hipLaunchKernelGGL(mk_fwd, dim3(grid), dim3(NWAVES * 64), LDS_BYTES, stream, a); }
#else
    a.ph_lo = 0; a.ph_hi = N_PHASES;
    hipLaunchKernelGGL(mk_fwd, dim3(grid), dim3(NWAVES * 64), LDS_BYTES, stream, a);
#endif
}
```

```cpp
#include <hip/hip_runtime.h>
#include <cstdio>
#include <cstdint>

namespace pg8 {
#define PG8_LAS __attribute__((address_space(3)))
typedef unsigned short bf16_t;
typedef short bf16x8 __attribute__((ext_vector_type(8)));
typedef float f32x4 __attribute__((ext_vector_type(4)));
typedef unsigned u32x4 __attribute__((ext_vector_type(4)));
constexpr int BM = 256, BK = 64, HALF = 128, HTB = HALF * BK * 2  , STAGE_BYTES = 8 * HTB, NXCD = 8, WGM = 8;

__host__ __device__ __forceinline__ int lds_byte(int r, int c) { const int st = (r >> 4) * 2 + (c >> 5), rr = r & 15, cc = c & 31, ob = rr * 64 + cc * 2; return st * 1024 + (ob ^ (((ob >> 9) & 1) << 5)); }
__host__ __device__ __forceinline__ void stage_rc(int b, int& R, int& C) { const int st = b / 1024, sb = b % 1024, swz = sb ^ (((sb >> 9) & 1) << 5); R = (st >> 1) * 16 + swz / 64; C = (st & 1) * 32 + (swz % 64) / 2; }
__host__ __device__ __forceinline__ int perm32(int rho) { const int n = rho >> 4, i = rho & 15; return 8 * (i >> 2) + 4 * n + (i & 3); }

struct Unit { int pm, pn, e, ti; };
struct Gemm { const bf16_t* A; const bf16_t* Bt; int M, N, K; };

struct StaticOrder {
    static constexpr bool GATHER = false;
    int nM, nN, nwg, G, c;
    __host__ __device__ void init(int M, int N, int G_, int c_) { nM = M / BM; nN = N / BM; nwg = nM * nN; G = G_; c = c_; }
    __host__ __device__ bool next(int i, Unit& u) const {
        const long L = (long)i * G + c; if (L >= nwg) return false;
        int wgid = (int)L; { const int q = nwg / NXCD, r = nwg % NXCD, xcd = wgid % NXCD, off = wgid / NXCD; wgid = (xcd < r ? xcd * (q + 1) : r * (q + 1) + (xcd - r) * q) + off; }
        const int nig = WGM * nN, gid = wgid / nig, fm = gid * WGM, gsz = (nM - fm) < WGM ? (nM - fm) : WGM;
        u.pm = fm + ((wgid % nig) % gsz); u.pn = (wgid % nig) / gsz; return true;
    }
    __device__ __forceinline__ void a_ready(const Unit&) const {}
    __device__ __forceinline__ void done(const Unit&) const {}
};

__device__ __forceinline__ unsigned cvt_pk_bf16(float lo, float hi) { unsigned r; asm volatile("v_cvt_pk_bf16_f32 %0, %1, %2" : "=v"(r) : "v"(lo), "v"(hi)); return r; }
typedef float f32x2 __attribute__((ext_vector_type(2)));
__device__ __forceinline__ f32x2 gelu_pk(f32x2 v) {
    const f32x2 av = __builtin_elementwise_abs(v), d = av * 0.2316418882f + 1.0f;
    f32x2 t; t.x = __builtin_amdgcn_rcpf(d.x); t.y = __builtin_amdgcn_rcpf(d.y);
    f32x2 q = t * 0.5307027145f + (-0.7265760135f); q = q * t + 0.7107068705f; q = q * t + (-0.142248368f); q = q * t + 0.127414796f; q = q * t;
    const f32x2 s = (v * v) * (-0.72134752044f);
    f32x2 e; e.x = __builtin_amdgcn_exp2f(s.x); e.y = __builtin_amdgcn_exp2f(s.y);
    const f32x2 m = v * (q * e), r = v - m;
    f32x2 o; o.x = v.x < 0.f ? m.x : r.x; o.y = v.y < 0.f ? m.y : r.y; return o;
}

template <int ACT  > struct EpiBf16 {
    static constexpr bool PERM = true, AFTER_DRAIN = false; static_assert(ACT == 0 || ACT == 1, "EpiBf16: ACT is 0 (none) or 1 (gelu_pk)");
    bf16_t* O; int ldc; const float* bias; int split_cols; size_t split_stride; float scale0;
    __device__ __forceinline__ void operator()(const f32x4 (&acc)[2][2][4][2], const Unit& u, int wr, int wc, int fr, int fq) const {
        const int row0 = u.pm * BM + wr * 64 + fr; int colt = u.pn * BM; bf16_t* base = O;
        float sc = 1.f; if (split_cols) { const int t = colt / split_cols; base += (size_t)t * split_stride; colt -= t * split_cols; if (t == 0) sc = scale0; }
        const int col0 = colt + wc * 32 + 8 * fq, bcol0 = u.pn * BM + wc * 32 + 8 * fq;
        f32x4 bv[2][2];
#pragma unroll
        for (int bj = 0; bj < 2; ++bj)
#pragma unroll
            for (int n = 0; n < 2; ++n) bv[bj][n] = bias ? *(const f32x4*)(bias + bcol0 + bj * HALF + 4 * n) : (f32x4){0.f, 0.f, 0.f, 0.f};
#pragma unroll
        for (int ai = 0; ai < 2; ++ai)
#pragma unroll
            for (int m = 0; m < 4; ++m) { bf16_t* rowp = base + (size_t)(row0 + ai * HALF + m * 16) * ldc + col0;
#pragma unroll
                for (int bj = 0; bj < 2; ++bj) { f32x4 v0 = acc[ai][bj][m][0] + bv[bj][0], v1 = acc[ai][bj][m][1] + bv[bj][1];
                    if (ACT == 1) { f32x2 a = gelu_pk((f32x2){v0[0], v0[1]}), b = gelu_pk((f32x2){v0[2], v0[3]}), c = gelu_pk((f32x2){v1[0], v1[1]}), d = gelu_pk((f32x2){v1[2], v1[3]});
                        v0 = (f32x4){a.x, a.y, b.x, b.y}; v1 = (f32x4){c.x, c.y, d.x, d.y}; }
                    v0 = v0 * sc; v1 = v1 * sc; u32x4 w; w.x = cvt_pk_bf16(v0[0], v0[1]); w.y = cvt_pk_bf16(v0[2], v0[3]); w.z = cvt_pk_bf16(v1[0], v1[1]); w.w = cvt_pk_bf16(v1[2], v1[3]);
                    *(u32x4*)(rowp + bj * HALF) = w; } }
    }
};

template <class Epi, class Sched, bool ALIGN_EPI = false, bool SP2 = false>
__device__ __forceinline__ void gemm_phase(PG8_LAS unsigned char* lds, const Gemm g, const Sched& S, const Epi& E) {
    const int tid = threadIdx.x, wid = __builtin_amdgcn_readfirstlane(tid >> 6), lane = tid & 63, wr = wid >> 2, wc = wid & 3, fr = lane & 15, fq = lane >> 4;
    const int K = g.K, nt = K / BK;
    unsigned voffB[2], vA0[2], vA1[2], nA0[2], nA1[2]; int Rr[2], Cc[2];
#pragma unroll
    for (int i = 0; i < 2; ++i) { int R, C; stage_rc(tid * 16 + i * 8192, R, C); const int Rb = Epi::PERM ? ((R & ~31) + perm32(R & 31)) : R;
        Rr[i] = R; Cc[i] = C; vA0[i] = vA1[i] = nA0[i] = nA1[i] = (unsigned)(R * K + C) * 2u; voffB[i] = (unsigned)(Rb * K + C) * 2u; }
#define PG8_GOFF(u, d0, d1) do { if constexpr (Sched::GATHER) { _Pragma("unroll") for (int _i = 0; _i < 2; ++_i) { d0[_i] = S.arow_off(u, Rr[_i]) + (unsigned)Cc[_i] * 2u; d1[_i] = S.arow_off(u, HALF + Rr[_i]) + (unsigned)Cc[_i] * 2u; } } } while (0)
    const size_t kstep = (size_t)(BK * 2);
    const size_t hstep = (size_t)HALF * K * 2;
    const size_t hstepA = Sched::GATHER ? (size_t)0 : hstep;
    const size_t tstep = 2 * hstep;
    const unsigned ldsw = (unsigned)wid * 1024u;
    const int aoff = lds_byte(wr * 64 + fr, fq * 8), boff = lds_byte(wc * 32 + fr, fq * 8);
#define PG8_SA(b, h) (((b) * 2 + (h)) * HTB)
#define PG8_SB(b, h) ((4 + (b) * 2 + (h)) * HTB)
#define PG8_STAGE(bufoff, gbase, voff) do { _Pragma("unroll") for (int _i = 0; _i < 2; ++_i) \
        __builtin_amdgcn_global_load_lds((const unsigned*)((const char*)(gbase) + (voff)[_i]), (PG8_LAS unsigned*)(lds + (bufoff) + ldsw + _i * 8192), 16, 0, 0); } while (0)
#define PG8_LDA(dst, b, h) do { _Pragma("unroll") for (int m = 0; m < 4; ++m) _Pragma("unroll") for (int k = 0; k < 2; ++k) dst[m][k] = *(const PG8_LAS bf16x8*)(lds + PG8_SA(b, h) + aoff + m * 2048 + k * 1024); } while (0)
#define PG8_LDB(dst, b, h) do { _Pragma("unroll") for (int n = 0; n < 2; ++n) _Pragma("unroll") for (int k = 0; k < 2; ++k) dst[n][k] = *(const PG8_LAS bf16x8*)(lds + PG8_SB(b, h) + boff + n * 2048 + k * 1024); } while (0)
#define PG8_MMA(ai, bj, At, Bt) do { __builtin_amdgcn_s_setprio(1); _Pragma("unroll") for (int m = 0; m < 4; ++m) _Pragma("unroll") for (int n = 0; n < 2; ++n) _Pragma("unroll") for (int k = 0; k < 2; ++k) \
        acc[ai][bj][m][n] = __builtin_amdgcn_mfma_f32_16x16x32_bf16(Bt[n][k], At[m][k], acc[ai][bj][m][n], 0, 0, 0); __builtin_amdgcn_s_setprio(0); } while (0)
#define PG8_WAIT_V(n) asm volatile("s_waitcnt vmcnt(" #n ")" ::: "memory")
#define PG8_WAIT_L(n) asm volatile("s_waitcnt lgkmcnt(" #n ")" ::: "memory")
#define PG8_BAR __builtin_amdgcn_s_barrier()
#define PG8_SCHED __builtin_amdgcn_sched_barrier(0)
    Unit cur, nxt; int ui = 0;
    if (!S.next(0, cur)) return;
    f32x4 acc[2][2][4][2];
#pragma unroll
    for (int a = 0; a < 2; ++a)
#pragma unroll
        for (int b = 0; b < 2; ++b)
#pragma unroll
            for (int m = 0; m < 4; ++m)
#pragma unroll
                for (int n = 0; n < 2; ++n) acc[a][b][m][n] = (f32x4){0.f, 0.f, 0.f, 0.f};
    bf16x8 At[4][2], B0[2][2], B1[2][2];
    const char* cA = (const char*)g.A + (Sched::GATHER ? (size_t)0 : (size_t)cur.pm * tstep); const char* cB = (const char*)g.Bt + (size_t)cur.pn * tstep;
    PG8_GOFF(cur, vA0, vA1);
    S.a_ready(cur);
    if constexpr (SP2) {
        PG8_STAGE(PG8_SB(0, 0), cB, voffB); PG8_STAGE(PG8_SB(0, 1), cB + hstep, voffB); PG8_STAGE(PG8_SA(0, 0), cA, vA0); PG8_STAGE(PG8_SA(0, 1), cA + hstepA, vA1);
        if (wr == 1) PG8_BAR;
        PG8_WAIT_V(2); PG8_BAR;
        PG8_STAGE(PG8_SB(1, 0), cB + kstep, voffB); PG8_STAGE(PG8_SA(1, 0), cA + kstep, vA0); PG8_STAGE(PG8_SB(1, 1), cB + hstep + kstep, voffB);
        PG8_WAIT_V(6); PG8_BAR;
    } else {
        PG8_STAGE(PG8_SB(0, 0), cB, voffB); PG8_STAGE(PG8_SA(0, 0), cA, vA0); PG8_STAGE(PG8_SB(0, 1), cB + hstep, voffB); PG8_STAGE(PG8_SA(0, 1), cA + hstepA, vA1);
        if (wr == 1) PG8_BAR;
        PG8_WAIT_V(4); PG8_BAR;
        PG8_STAGE(PG8_SB(1, 0), cB + kstep, voffB); PG8_STAGE(PG8_SA(1, 0), cA + kstep, vA0); PG8_STAGE(PG8_SB(1, 1), cB + hstep + kstep, voffB);
        PG8_WAIT_V(6); PG8_BAR;
    }
    for (;;) {
        const bool has_next = S.next(ui + 1, nxt);
        const char* nA = has_next ? (const char*)g.A + (Sched::GATHER ? (size_t)0 : (size_t)nxt.pm * tstep) : cA; const char* nB = has_next ? (const char*)g.Bt + (size_t)nxt.pn * tstep : cB;
        if constexpr (Sched::GATHER) { if (has_next) { PG8_GOFF(nxt, nA0, nA1); } else {
#pragma unroll
            for (int _i = 0; _i < 2; ++_i) { nA0[_i] = vA0[_i]; nA1[_i] = vA1[_i]; } } }
        for (int t = 0; t < nt; t += 2) {
            const bool last = (t == nt - 2);
            const char* a1 = cA + (size_t)(t + 1) * kstep;
            const char* a2 = last ? nA : cA + (size_t)(t + 2) * kstep; const char* b2 = last ? nB : cB + (size_t)(t + 2) * kstep;
            const char* a3 = a2 + kstep; const char* b3 = b2 + kstep;
            if (last && has_next) S.a_ready(nxt);
            unsigned wA0[2], wA1[2];
#pragma unroll
            for (int _i = 0; _i < 2; ++_i) { wA0[_i] = (Sched::GATHER && last) ? nA0[_i] : vA0[_i]; wA1[_i] = (Sched::GATHER && last) ? nA1[_i] : vA1[_i]; }
            if constexpr (SP2) {
            PG8_LDB(B0, 0, 0); PG8_LDB(B1, 0, 1); PG8_SCHED; PG8_LDA(At, 0, 0); PG8_STAGE(PG8_SA(1, 1), a1 + hstepA, vA1);
            PG8_WAIT_V(8); PG8_WAIT_L(0); PG8_BAR; PG8_MMA(0, 0, At, B0); PG8_MMA(0, 1, At, B1); PG8_BAR; PG8_SCHED;
            PG8_LDA(At, 0, 1); PG8_STAGE(PG8_SB(0, 0), b2, voffB); PG8_STAGE(PG8_SB(0, 1), b2 + hstep, voffB); PG8_STAGE(PG8_SA(0, 0), a2, wA0);
            PG8_WAIT_V(8); PG8_WAIT_L(0); PG8_BAR; PG8_MMA(1, 0, At, B0); PG8_MMA(1, 1, At, B1); PG8_BAR; PG8_SCHED;
            PG8_LDB(B0, 1, 0); PG8_LDB(B1, 1, 1); PG8_SCHED; PG8_LDA(At, 1, 0); PG8_STAGE(PG8_SA(0, 1), a2 + hstepA, wA1);
            PG8_WAIT_V(8); PG8_WAIT_L(0); PG8_BAR; PG8_MMA(0, 0, At, B0); PG8_MMA(0, 1, At, B1); PG8_BAR; PG8_SCHED;
            PG8_LDA(At, 1, 1); PG8_STAGE(PG8_SB(1, 0), b3, voffB); PG8_STAGE(PG8_SB(1, 1), b3 + hstep, voffB); PG8_STAGE(PG8_SA(1, 0), a3, wA0);
            PG8_WAIT_V(8); PG8_WAIT_L(0); PG8_BAR; PG8_MMA(1, 0, At, B0); PG8_MMA(1, 1, At, B1); PG8_BAR; PG8_SCHED;
            } else {
            PG8_LDB(B0, 0, 0); PG8_SCHED; PG8_LDA(At, 0, 0); PG8_STAGE(PG8_SA(1, 1), a1 + hstepA, vA1);
            PG8_WAIT_L(8); PG8_BAR; PG8_WAIT_L(0); PG8_MMA(0, 0, At, B0); PG8_BAR; PG8_SCHED;
            PG8_LDB(B1, 0, 1); PG8_STAGE(PG8_SB(0, 0), b2, voffB);
            PG8_BAR; PG8_WAIT_L(0); PG8_MMA(0, 1, At, B1); PG8_BAR;
            PG8_LDA(At, 0, 1); PG8_STAGE(PG8_SA(0, 0), a2, wA0);
            PG8_BAR; PG8_WAIT_L(0); PG8_MMA(1, 0, At, B0); PG8_BAR; PG8_SCHED;
            PG8_STAGE(PG8_SB(0, 1), b2 + hstep, voffB);
            PG8_WAIT_V(6); PG8_BAR; PG8_MMA(1, 1, At, B1); PG8_BAR;
            PG8_LDB(B0, 1, 0); PG8_SCHED; PG8_LDA(At, 1, 0); PG8_STAGE(PG8_SA(0, 1), a2 + hstepA, wA1);
            PG8_WAIT_L(8); PG8_BAR; PG8_WAIT_L(0); PG8_MMA(0, 0, At, B0); PG8_BAR; PG8_SCHED;
            PG8_LDB(B1, 1, 1); PG8_STAGE(PG8_SB(1, 0), b3, voffB);
            PG8_BAR; PG8_WAIT_L(0); PG8_MMA(0, 1, At, B1); PG8_BAR;
            PG8_LDA(At, 1, 1); PG8_STAGE(PG8_SA(1, 0), a3, wA0);
            PG8_BAR; PG8_WAIT_L(0); PG8_MMA(1, 0, At, B0); PG8_BAR; PG8_SCHED;
            PG8_STAGE(PG8_SB(1, 1), b3 + hstep, voffB);
            PG8_WAIT_V(6); PG8_BAR; PG8_MMA(1, 1, At, B1); PG8_BAR;
            }
        }
        if constexpr (ALIGN_EPI) { if (wr == 0) PG8_BAR; }
        if constexpr (!Epi::AFTER_DRAIN) { E(acc, cur, wr, wc, fr, fq); S.done(cur); }
        if (!has_next) break;
#pragma unroll
        for (int a = 0; a < 2; ++a)
#pragma unroll
            for (int b = 0; b < 2; ++b)
#pragma unroll
                for (int m = 0; m < 4; ++m)
#pragma unroll
                    for (int n = 0; n < 2; ++n) acc[a][b][m][n] = (f32x4){0.f, 0.f, 0.f, 0.f};
        cur = nxt; cA = nA; cB = nB; ++ui;
#pragma unroll
        for (int _i = 0; _i < 2; ++_i) { vA0[_i] = nA0[_i]; vA1[_i] = nA1[_i]; }
        if constexpr (ALIGN_EPI) { if (wr == 1) PG8_BAR; }
    }
    PG8_WAIT_V(0);
    if constexpr (!ALIGN_EPI) { if (wr == 0) PG8_BAR; }
    PG8_BAR;
    if constexpr (Epi::AFTER_DRAIN) { E.fused(acc, cur, wr, wc, fr, fq, lds, wid, lane); S.done(cur); }
#undef PG8_GOFF
#undef PG8_SA
#undef PG8_SB
#undef PG8_STAGE
#undef PG8_LDA
#undef PG8_LDB
#undef PG8_MMA
#undef PG8_WAIT_V
#undef PG8_WAIT_L
#undef PG8_BAR
#undef PG8_SCHED
}
}

#ifndef PG8_SP2
#define PG8_SP2 true
#endif

#include <hip/hip_bf16.h>
#include <cmath>
namespace attn_body {
using bf16=__hip_bfloat16;
using bf16x8=__attribute__((ext_vector_type(8)))short;
using s16x4=__attribute__((ext_vector_type(4)))short;
using f32x16=__attribute__((ext_vector_type(16)))float;
using u32x4=__attribute__((ext_vector_type(4)))unsigned;
constexpr int BATCH=4,NHEAD=16,SEQ=4096,D=64,PQ=512,PO=1024;
constexpr int NW=8,QBLK=32,QB=QBLK*NW,KVBLK=64,NQB=SEQ/QB;
constexpr int ATTN_UNIT_ROWS=QB;
__device__ __forceinline__ int crow(int r,int hi){return (r&3)+8*(r>>2)+4*hi;}
#define SBAR() __builtin_amdgcn_sched_barrier(0)
__device__ __forceinline__ void cmask(f32x16&p0,f32x16&p1,int jb,int qrel,int hi){
  const float NEG=-INFINITY; int kb=64*jb+4*hi;
  #pragma unroll
  for(int r=0;r<16;++r){int kv=kb+(r&3)+8*(r>>2); if(kv>qrel)p0[r]=NEG; if(kv+32>qrel)p1[r]=NEG;}
}

constexpr int NSLOT=3, SLOTB=8192;
constexpr int LDS_K=0, LDS_V=NSLOT*SLOTB, LDS_WS=2*NSLOT*SLOTB, LDS_OST=LDS_WS+NW*64*4, LDS_BYTES=LDS_OST+NW*4096;
constexpr float C2=0.125f*1.4426950408889634f;
__device__ __forceinline__ void glds16(const void*gsrc,unsigned lds_dst){unsigned keep;
  asm volatile("s_mov_b32 %0, m0\n\ts_mov_b32 m0, %2\n\ts_nop 0\n\tglobal_load_lds_dwordx4 %1, off\n\ts_mov_b32 m0, %0":"=&s"(keep):"v"(gsrc),"s"(lds_dst):"memory");}
__device__ __forceinline__ float max3f(float a,float b,float c){float r;asm("v_max3_f32 %0, %1, %2, %3":"=v"(r):"v"(a),"v"(b),"v"(c));return r;}
__device__ __forceinline__ float max2f(float a,float b){float r;asm("v_max_f32_e32 %0, %1, %2":"=v"(r):"v"(a),"v"(b));return r;}
__device__ __forceinline__ float fadd_s(float a,float b){float r;asm("v_add_f32_e32 %0, %1, %2":"=v"(r):"v"(a),"v"(b));return r;}
__device__ __forceinline__ float fsub_s(float a,float b){float r;asm("v_sub_f32_e32 %0, %1, %2":"=v"(r):"v"(a),"v"(b));return r;}
typedef float f32x2_t __attribute__((ext_vector_type(2))); typedef __bf16 bf16x2_t __attribute__((ext_vector_type(2)));
__device__ __forceinline__ unsigned cvtpk_s(float lo,float hi){f32x2_t v={lo,hi};bf16x2_t b=__builtin_convertvector(v,bf16x2_t);return __builtin_bit_cast(unsigned,b);}
#define WAIT_BAR(N) asm volatile("s_waitcnt vmcnt(" #N ") lgkmcnt(0)\n\ts_barrier":::"memory")

__device__ __forceinline__ void qkt(f32x16&p0,f32x16&p1,const char*Kslot,const bf16x8*qr,const f32x16&negm,int r32,int hi){
  const char*kb=Kslot+hi*1024+r32*16;
  #pragma unroll
  for(int d0=0;d0<4;++d0){
    const bf16x8 b0=*reinterpret_cast<const bf16x8*>(kb+d0*2048);
    const bf16x8 b1=*reinterpret_cast<const bf16x8*>(kb+d0*2048+512);
    if(d0==0){p0=__builtin_amdgcn_mfma_f32_32x32x16_bf16(b0,qr[0],negm,0,0,0);p1=__builtin_amdgcn_mfma_f32_32x32x16_bf16(b1,qr[0],negm,0,0,0);}
    else{p0=__builtin_amdgcn_mfma_f32_32x32x16_bf16(b0,qr[d0],p0,0,0,0);p1=__builtin_amdgcn_mfma_f32_32x32x16_bf16(b1,qr[d0],p1,0,0,0);}}
}
typedef __attribute__((address_space(3))) const char* lds_cptr;
typedef short v4i16_t __attribute__((ext_vector_type(4)));
__device__ __forceinline__ void kload8(bf16x8*kf,lds_cptr kp){
  kf[0]=*(const __attribute__((address_space(3))) bf16x8*)(kp);      kf[1]=*(const __attribute__((address_space(3))) bf16x8*)(kp+512);
  kf[2]=*(const __attribute__((address_space(3))) bf16x8*)(kp+2048); kf[3]=*(const __attribute__((address_space(3))) bf16x8*)(kp+2560);
  kf[4]=*(const __attribute__((address_space(3))) bf16x8*)(kp+4096); kf[5]=*(const __attribute__((address_space(3))) bf16x8*)(kp+4608);
  kf[6]=*(const __attribute__((address_space(3))) bf16x8*)(kp+6144); kf[7]=*(const __attribute__((address_space(3))) bf16x8*)(kp+6656);
}
__device__ __forceinline__ void kload2(bf16x8*kf,lds_cptr kp,int j){ kf[2*j]=*(const __attribute__((address_space(3))) bf16x8*)(kp+j*2048); kf[2*j+1]=*(const __attribute__((address_space(3))) bf16x8*)(kp+j*2048+512); }
__device__ __forceinline__ s16x4 vtr(lds_cptr p){ return __builtin_bit_cast(s16x4,__builtin_amdgcn_ds_read_tr16_b64_v4i16((__attribute__((address_space(3))) v4i16_t*)p)); }
__device__ __forceinline__ float rowmax(const f32x16&p0,const f32x16&p1){
  float a=max3f(p0[0],p0[1],p1[0]),b=max3f(p0[2],p0[3],p1[1]);a=max3f(a,p1[2],p1[3]);
  #pragma unroll
  for(int r=4;r<16;r+=4){a=max3f(a,p0[r],p0[r+1]);b=max3f(b,p0[r+2],p0[r+3]);a=max3f(a,p1[r],p1[r+1]);b=max3f(b,p1[r+2],p1[r+3]);}
  const float m=max2f(a,b);
  auto rr=__builtin_amdgcn_permlane32_swap(__float_as_uint(m),__float_as_uint(m),false,false);
  return max2f(__uint_as_float(rr[0]),__uint_as_float(rr[1]));
}
__device__ __forceinline__ void pv(f32x16*o,int vb,bf16x8 pa0,bf16x8 pa1,bf16x8 pa2,bf16x8 pa3){
  #pragma unroll
  for(int d0=0;d0<2;++d0){s16x4 lo[4],hi[4];
    #pragma unroll
    for(int ks=0;ks<4;++ks){
      asm volatile("ds_read_b64_tr_b16 %0,%1 offset:%c2":"=&v"(lo[ks]):"v"(vb),"i"(d0*4096+ks*1024):"memory");
      asm volatile("ds_read_b64_tr_b16 %0,%1 offset:%c2":"=&v"(hi[ks]):"v"(vb),"i"(d0*4096+ks*1024+512):"memory");}
    asm volatile("s_waitcnt lgkmcnt(0)":::"memory");SBAR();
    #define PK(k) (bf16x8){lo[k][0],lo[k][1],lo[k][2],lo[k][3],hi[k][0],hi[k][1],hi[k][2],hi[k][3]}
    o[d0]=__builtin_amdgcn_mfma_f32_32x32x16_bf16(pa0,PK(0),o[d0],0,0,0);
    o[d0]=__builtin_amdgcn_mfma_f32_32x32x16_bf16(pa1,PK(1),o[d0],0,0,0);
    o[d0]=__builtin_amdgcn_mfma_f32_32x32x16_bf16(pa2,PK(2),o[d0],0,0,0);
    o[d0]=__builtin_amdgcn_mfma_f32_32x32x16_bf16(pa3,PK(3),o[d0],0,0,0);
    #undef PK
  }
}

#ifndef ATTN_STORE16
#define ATTN_STORE16(p,v) (*(u32x4*)(p)=(v))
#endif
template<int THRL> __device__ __forceinline__ void attn_unit(int b,int h,int qb,const bf16*Q,const bf16*__restrict__ K,const bf16*__restrict__ V,bf16*O,char*shm){
  const int tid=threadIdx.x,lane=tid&63,r32=lane&31,hi=lane>>5; const int wid=__builtin_amdgcn_readfirstlane(tid>>6);
  const long rowbase=(long)b*SEQ; const int q0=qb*QB;
  const int qkc=(h>>1)*D, vcol=(h>>2)*128+(h&1)*D;
  const bf16*Qw=Q+(rowbase+q0+wid*QBLK)*PQ+qkc;
  const bf16*Kh=K+rowbase*PQ+qkc,*Vh=V+rowbase*PQ+vcol;
  const unsigned lds0=(unsigned)(uintptr_t)shm;
  float*wsf=(float*)(shm+LDS_WS)+wid*64;
  const bf16*ksrc=Kh+(long)lane*PQ+wid*8;
  const bf16*vsrc=Vh+(long)(16*(wid&3)+(lane>>2))*PQ+(wid>>2)*32+(lane&3)*8;
  const unsigned kdst=lds0+LDS_K+wid*1024, vdst=lds0+LDS_V+wid*1024;
  #define DMA_K(t,slot) glds16(ksrc+(long)(t)*KVBLK*PQ,(unsigned)__builtin_amdgcn_readfirstlane(kdst+(slot)))
  #define DMA_V(t,slot) glds16(vsrc+(long)(t)*KVBLK*PQ,(unsigned)__builtin_amdgcn_readfirstlane(vdst+(slot)))
  const int vb0=(int)(lds0+LDS_V)+((lane>>4)&1)*32+(lane&3)*8+(4*hi+((lane&15)>>2))*64;
  const char*Kbase=shm+LDS_K; bf16x8 kf[8];
  const lds_cptr shm3=(lds_cptr)shm; const lds_cptr kp0=shm3+LDS_K+hi*1024+r32*16; const lds_cptr vp0=shm3+LDS_V+((lane>>4)&1)*32+(lane&3)*8+(4*hi+((lane&15)>>2))*64;
  const int NT=(q0+QB)/KVBLK;
  DMA_K(0,0);DMA_V(0,0);DMA_K(1,SLOTB);
  bf16x8 qr[4];
  #pragma unroll
  for(int d0=0;d0<4;++d0)qr[d0]=*reinterpret_cast<const bf16x8*>(&Qw[(long)r32*PQ+d0*16+hi*8]);
  float mhat=0.f,l_reg=0.f;f32x16 o[2];o[0]=f32x16{};o[1]=f32x16{};f32x16 negm=f32x16{};asm volatile("":"+v"(negm));
  const int qrel=wid*QBLK+r32;
  #define CMASK(P0,P1,t) do{int jb_=(t)-(NT-4); if(jb_>=0)cmask(P0,P1,jb_,qrel,hi);}while(0)
  bool resc=false;
  #define START(P0,P1) do{ const float rm=rowmax(P0,P1); resc=false; \
    { const float dl=rm; mhat=fadd_s(mhat,dl); \
      _Pragma("unroll") for(int r=0;r<16;++r){P0[r]=fsub_s(P0[r],dl);P1[r]=fsub_s(P1[r],dl);} \
      _Pragma("unroll") for(int r=0;r<16;++r)negm[r]=-mhat; asm volatile("":"+v"(negm)); } \
    _Pragma("unroll") for(int r=0;r<16;++r)P0[r]=__builtin_amdgcn_exp2f(P0[r]); }while(0)
  #define RESC() do{ if(resc){ asm volatile("s_waitcnt lgkmcnt(0)":::"memory"); \
      _Pragma("unroll") for(int d_=0;d_<2;++d_) _Pragma("unroll") for(int r=0;r<16;++r)o[d_][r]*=wsf[crow(r,hi)]; } }while(0)
  f32x16 pA0,pA1,pB0,pB1;
  int sl_prev=0,sl_cur=0,sl_next=SLOTB;
  #define ROT() do{sl_prev=sl_cur;sl_cur=sl_next;sl_next=(sl_next==(NSLOT-1)*SLOTB)?0:sl_next+SLOTB;}while(0)
  DMA_K(2,2*SLOTB);
  WAIT_BAR(3);
  qkt(pA0,pA1,Kbase,qr,negm,r32,hi);asm volatile("s_nop 15\n\ts_nop 7":"+v"(pA0),"+v"(pA1));CMASK(pA0,pA1,0);
  START(pA0,pA1);
  _Pragma("unroll") for(int r=0;r<16;++r)pA1[r]=__builtin_amdgcn_exp2f(pA1[r]);
  WAIT_BAR(0);
  DMA_K(3,0);DMA_V(1,SLOTB);
  ROT();
  kload8(kf,kp0+sl_cur);
  WAIT_BAR(2);
  s16x4 vlo[8],vhi[8]; u32x4 pw0,pw1,pw2,pw3;
  #define PKW(P,B) cvtpk_s(P[B],P[B+1])
  #define PAF(k) __builtin_bit_cast(bf16x8,pw##k)
  #define VFR(i) (bf16x8){vlo[i][0],vlo[i][1],vlo[i][2],vlo[i][3],vhi[i][0],vhi[i][1],vhi[i][2],vhi[i][3]}
  #define PIN(x) asm volatile("":"+v"(x))
  #define MX3(a,b,c) __builtin_fmaxf(__builtin_fmaxf((a),(b)),(c))
  #define GAPA(MF,A0,A1,A2,A3,W0,W1,PW) do{ MF; sacc+=A0; sacc+=A1; sacc+=A2; sacc+=A3; PIN(sacc); W0; W1; PIN(PW); SBAR(); }while(0)
  #define EX(v) __builtin_amdgcn_exp2f(v)
  #define GAPB(MF,X,B) do{ MF; X[B]=EX(X[B]); X[B+1]=EX(X[B+1]); X[B+2]=EX(X[B+2]); X[B+3]=EX(X[B+3]); PIN(X); SBAR(); }while(0)
  #define VRD(i) do{ vlo[i]=vtr(vp_+(((i)>>2)*4096+((i)&3)*1024)); vhi[i]=vtr(vp_+(((i)>>2)*4096+((i)&3)*1024+512)); }while(0)
  #define KRD(G,j) do{ if(G){ kload2(kf,kp0+sl_next,j); SBAR(); } }while(0)
  #define STEP(C0,C1,P0,P1,t,GK,GV,GL) do{ SBAR(); \
    const lds_cptr vp_=vp0+sl_prev; \
    VRD(0); SBAR(); float sacc=(P0[0]+P0[1]); \
    GAPA(C0=__builtin_amdgcn_mfma_f32_32x32x16_bf16(kf[0],qr[0],negm,0,0,0), P0[2],P0[3],P0[4],P0[5],     pw0[0]=PKW(P0,0), pw0[1]=PKW(P0,2), pw0); \
    VRD(4); SBAR(); GAPA(C1=__builtin_amdgcn_mfma_f32_32x32x16_bf16(kf[1],qr[0],negm,0,0,0), P0[6],P0[7],P0[8],P0[9],     pw0[2]=PKW(P0,4), pw0[3]=PKW(P0,6), pw0); \
    VRD(1); SBAR(); GAPA(C0=__builtin_amdgcn_mfma_f32_32x32x16_bf16(kf[2],qr[1],C0,0,0,0),   P0[10],P0[11],P0[12],P0[13], pw1[0]=PKW(P0,8), pw1[1]=PKW(P0,10), pw1); \
    VRD(5); SBAR(); GAPA(C1=__builtin_amdgcn_mfma_f32_32x32x16_bf16(kf[3],qr[1],C1,0,0,0),   P0[14],P0[15],P1[0],P1[1],   pw1[2]=PKW(P0,12),pw1[3]=PKW(P0,14), pw1); \
    VRD(2); SBAR(); GAPA(C0=__builtin_amdgcn_mfma_f32_32x32x16_bf16(kf[4],qr[2],C0,0,0,0),   P1[2],P1[3],P1[4],P1[5],     pw2[0]=PKW(P1,0), pw2[1]=PKW(P1,2), pw2); \
    VRD(6); SBAR(); GAPA(C1=__builtin_amdgcn_mfma_f32_32x32x16_bf16(kf[5],qr[2],C1,0,0,0),   P1[6],P1[7],P1[8],P1[9],     pw2[2]=PKW(P1,4), pw2[3]=PKW(P1,6), pw2); \
    VRD(3); SBAR(); GAPA(C0=__builtin_amdgcn_mfma_f32_32x32x16_bf16(kf[6],qr[3],C0,0,0,0),   P1[10],P1[11],P1[12],P1[13], pw3[0]=PKW(P1,8), pw3[1]=PKW(P1,10), pw3); \
    VRD(7); SBAR(); GAPA(C1=__builtin_amdgcn_mfma_f32_32x32x16_bf16(kf[7],qr[3],C1,0,0,0),   P1[14],P1[15],0.f,0.f,       pw3[2]=PKW(P1,12),pw3[3]=PKW(P1,14), pw3); \
    l_reg+=sacc; \
    if(GK){DMA_K((t)+3,sl_cur);} if(GV){DMA_V((t)+1,sl_next);} \
    CMASK(C0,C1,t); \
    { float a=MX3(C0[0],C0[1],C1[0]),b=MX3(C0[2],C0[3],C1[1]); a=MX3(a,C1[2],C1[3]); \
      _Pragma("unroll") for(int r=4;r<16;r+=4){a=MX3(a,C0[r],C0[r+1]);b=MX3(b,C0[r+2],C0[r+3]);a=MX3(a,C1[r],C1[r+1]);b=MX3(b,C1[r+2],C1[r+3]);} \
      float rm=__builtin_fmaxf(a,b); { auto rr=__builtin_amdgcn_permlane32_swap(__float_as_uint(rm),__float_as_uint(rm),false,false); rm=__builtin_fmaxf(__uint_as_float(rr[0]),__uint_as_float(rr[1])); } \
      resc=false; \
      if(__builtin_expect(__any(rm>(float)THRL),0)){ const float dl=__builtin_fmaxf(rm,0.f); mhat+=dl; \
        _Pragma("unroll") for(int r=0;r<16;++r){C0[r]-=dl;C1[r]-=dl;} \
        _Pragma("unroll") for(int r=0;r<16;++r)negm[r]=-mhat; asm volatile("":"+v"(negm)); \
        const float f=__builtin_amdgcn_exp2f(-dl); l_reg*=f; if(hi==0)wsf[r32]=f; resc=true; } } \
    SBAR(); \
    GAPB(o[0]=__builtin_amdgcn_mfma_f32_32x32x16_bf16(PAF(0),VFR(0),o[0],0,0,0), C0,0); \
    GAPB(o[1]=__builtin_amdgcn_mfma_f32_32x32x16_bf16(PAF(0),VFR(4),o[1],0,0,0), C0,4); \
    KRD(GL,0); GAPB(o[0]=__builtin_amdgcn_mfma_f32_32x32x16_bf16(PAF(1),VFR(1),o[0],0,0,0), C0,8); \
    KRD(GL,1); GAPB(o[1]=__builtin_amdgcn_mfma_f32_32x32x16_bf16(PAF(1),VFR(5),o[1],0,0,0), C0,12); \
    KRD(GL,2); GAPB(o[0]=__builtin_amdgcn_mfma_f32_32x32x16_bf16(PAF(2),VFR(2),o[0],0,0,0), C1,0); \
    KRD(GL,3); GAPB(o[1]=__builtin_amdgcn_mfma_f32_32x32x16_bf16(PAF(2),VFR(6),o[1],0,0,0), C1,4); \
    GAPB(o[0]=__builtin_amdgcn_mfma_f32_32x32x16_bf16(PAF(3),VFR(3),o[0],0,0,0), C1,8); \
    GAPB(o[1]=__builtin_amdgcn_mfma_f32_32x32x16_bf16(PAF(3),VFR(7),o[1],0,0,0), C1,12); \
    }while(0)
  int t=1;
  #undef CMASK
  #define CMASK(P0,P1,t) do{}while(0)
  for(;t+5<NT;t+=2){
    STEP(pB0,pB1,pA0,pA1,t,true,true,true);     WAIT_BAR(2); RESC(); ROT();
    STEP(pA0,pA1,pB0,pB1,t+1,true,true,true);   WAIT_BAR(2); RESC(); ROT();
  }
  #undef CMASK
  #define CMASK(P0,P1,t) do{int jb_=(t)-(NT-4); if(jb_>=0)cmask(P0,P1,jb_,qrel,hi);}while(0)
  #define ENDW(tt) do{ if((tt)+3<NT){WAIT_BAR(2);} else if((tt)+2<NT){WAIT_BAR(1);} else {WAIT_BAR(0);} }while(0)
  for(;t+1<NT;t+=2){
    STEP(pB0,pB1,pA0,pA1,t,(t+3<NT),(t+1<NT),(t+1<NT));       ENDW(t);   RESC(); ROT();
    STEP(pA0,pA1,pB0,pB1,t+1,(t+4<NT),(t+2<NT),(t+2<NT));     ENDW(t+1); RESC(); ROT();
  }
  STEP(pB0,pB1,pA0,pA1,NT-1,false,false,false); RESC();
  { float sacc=pB0[0]+pB0[1]; _Pragma("unroll") for(int r=2;r<16;++r)sacc+=pB0[r]; _Pragma("unroll") for(int r=0;r<16;++r)sacc+=pB1[r]; l_reg+=sacc;
    pw0=(u32x4){PKW(pB0,0),PKW(pB0,2),PKW(pB0,4),PKW(pB0,6)};pw1=(u32x4){PKW(pB0,8),PKW(pB0,10),PKW(pB0,12),PKW(pB0,14)};pw2=(u32x4){PKW(pB1,0),PKW(pB1,2),PKW(pB1,4),PKW(pB1,6)};pw3=(u32x4){PKW(pB1,8),PKW(pB1,10),PKW(pB1,12),PKW(pB1,14)};
    SBAR(); pv(o,vb0+sl_cur,PAF(0),PAF(1),PAF(2),PAF(3)); }
  #undef PKW
  #undef PAF
  #undef VFR
  #undef PIN
  #undef MX3
  #undef GAPA
  #undef GAPB
  #undef EX
  #undef VRD
  #undef KRD
  #undef STEP
  #undef ENDW
  {auto rr=__builtin_amdgcn_permlane32_swap(__float_as_uint(l_reg),__float_as_uint(l_reg),false,false);l_reg=__uint_as_float(rr[0])+__uint_as_float(rr[1]);}
  if(hi==0)wsf[32+r32]=l_reg;asm volatile("s_waitcnt lgkmcnt(0)":::"memory");
  float rli[16];
  #pragma unroll
  for(int r=0;r<16;++r)rli[r]=__builtin_amdgcn_rcpf(wsf[32+crow(r,hi)]);
  bf16*Ow=O+(rowbase+q0+wid*QBLK)*PO+h*D;
  { bf16*stg=(bf16*)(shm+LDS_OST)+wid*2048;
    #pragma unroll
    for(int r=0;r<16;++r){const int orow=crow(r,hi);
      #pragma unroll
      for(int d0=0;d0<2;++d0)stg[orow*64+d0*32+r32]=__float2bfloat16(o[d0][r]*rli[r]);}
    asm volatile("s_waitcnt lgkmcnt(0)":::"memory");
    #pragma unroll
    for(int i=0;i<4;++i){const int row=i*8+(lane>>3),ch=lane&7; const u32x4 v=*(const u32x4*)(stg+row*64+ch*8); ATTN_STORE16(Ow+(long)row*PO+ch*8,v);} }
  asm volatile("s_waitcnt lgkmcnt(0)\n\ts_barrier":::"memory");
  #undef DMA_K
  #undef DMA_V
  #undef CMASK
  #undef START
  #undef RESC
  #undef ROT
}
constexpr int ATTN_LDS_BYTES=LDS_BYTES;
struct AttnTensors { const bf16* Q; const bf16* K; const bf16* V; bf16* O; };
struct AttnUnit { int bh; int qb; };
struct StaticOrder {
  int vcu;
  __device__ __forceinline__ explicit StaticOrder(int grid,int block):vcu((block%8)*(grid/8)+block/8){}
  __device__ __forceinline__ bool next(int i,AttnUnit&u)const{ if(i>=4)return false; const int s=vcu&3; u.bh=vcu>>2; u.qb=(i==0)?s:(i==1)?7-s:(i==2)?8+s:15-s; return true; }
  __device__ __forceinline__ void a_ready(const AttnUnit&)const{}
  __device__ __forceinline__ void done(const AttnUnit&)const{}
};
template<class Sched,int THRL=8> __device__ __forceinline__ void attn_phase(char*lds,const AttnTensors&T,const Sched&S){
  AttnUnit u;
  for(int i=0;S.next(i,u);++i){ S.a_ready(u); attn_unit<THRL>(u.bh/NHEAD,u.bh%NHEAD,u.qb,T.Q,T.K,T.V,T.O,lds); S.done(u); }
}
#undef SBAR
#undef WAIT_BAR
}

#define GAS __attribute__((address_space(1)))
#define LAS __attribute__((address_space(3)))
typedef unsigned short bf16;
typedef unsigned v4u __attribute__((ext_vector_type(4)));
typedef float f32x4 __attribute__((ext_vector_type(4)));
typedef short bf16x8 __attribute__((ext_vector_type(8)));
typedef GAS unsigned gu32;
typedef GAS unsigned long long gu64;
#define RLX_AGENT __ATOMIC_RELAXED, __HIP_MEMORY_SCOPE_AGENT
#define LDS_WAIT() asm volatile("s_waitcnt lgkmcnt(0)" ::: "memory")
#define VM_WAIT() asm volatile("s_waitcnt vmcnt(0)" ::: "memory")
__device__ __forceinline__ unsigned long long rt() { return __builtin_amdgcn_s_memrealtime(); }
__device__ __forceinline__ unsigned f2bf(float f) { unsigned u = __builtin_bit_cast(unsigned, f); return (u + 0x7fffu + ((u >> 16) & 1u)) >> 16; }
__device__ __forceinline__ unsigned pk2(float lo, float hi) { return f2bf(lo) | (f2bf(hi) << 16); }

#define XB_TMO      128
#define XB_XCNT(j)  (256  + 64 * (j))
#define XB_XSUB(j)  (1280 + 64 * (j))
#define XB_XGEN(j)  (2304 + 64 * (j))
#define XB_TOP      3328
#define XB_TOPGEN   3392
#define XCD_BAR_WORDS 3456
#define XB_SPIN_CAP (1u << 18)

__device__ __forceinline__ unsigned xb_ld(unsigned* p)              { return __hip_atomic_load(p, __ATOMIC_RELAXED, __HIP_MEMORY_SCOPE_AGENT); }
__device__ __forceinline__ unsigned xb_add(unsigned* p, unsigned v) { return __hip_atomic_fetch_add(p, v, __ATOMIC_RELAXED, __HIP_MEMORY_SCOPE_AGENT); }
__device__ __forceinline__ unsigned xb_xcc_id() { return (unsigned)__builtin_amdgcn_s_getreg((3 << 11) | 20) & 0xFu; }
#define XB_SPIN(cond, bar) do { unsigned _sp = 0; while (cond) { __builtin_amdgcn_s_sleep(1); \
    if ((++_sp & 255u) == 0u) { if (xb_ld(&(bar)[XB_TMO])) break; if (_sp > XB_SPIN_CAP) { atomicAdd(&(bar)[XB_TMO], 1u); break; } } } } while (0)

struct XcdBarrier {
    unsigned* bar; unsigned x;
    volatile LAS unsigned* st;
};

__device__ __forceinline__ XcdBarrier xcd_barrier_post(unsigned* bar, volatile LAS unsigned* st) {
    XcdBarrier b; b.bar = bar; b.x = xb_xcc_id(); b.st = st;
    if (threadIdx.x == 0) (void)xb_add(&bar[XB_XCNT(b.x)], 1u);
    return b;
}
__device__ __forceinline__ void xcd_barrier_complete(unsigned* bar, unsigned x, unsigned& nloc, unsigned& nx) {
    const unsigned G = gridDim.x * gridDim.y * gridDim.z;
    unsigned sum, cnt, mine, sp = 0u;
    for (;;) {
        sum = 0u; cnt = 0u; mine = 0u;
#pragma unroll
        for (unsigned j = 0; j < 16; ++j) { const unsigned c = xb_ld(&bar[XB_XCNT(j)]); sum += c; cnt += (c > 0u) ? 1u : 0u; mine = (j == x) ? c : mine; }
        if (sum == G) break;
        __builtin_amdgcn_s_sleep(1);
        if ((++sp & 255u) == 0u) { if (xb_ld(&bar[XB_TMO])) break; if (sp > XB_SPIN_CAP) { atomicAdd(&bar[XB_TMO], 1u); break; } }
    }
    nloc = mine > 0u ? mine : 1u; nx = cnt > 0u ? cnt : 1u;
}

__device__ __forceinline__ void xcd_barrier(const XcdBarrier& b) {
    asm volatile("s_waitcnt vmcnt(0)" ::: "memory");
    __syncthreads();
    if (threadIdx.x == 0) {
        unsigned* bar = b.bar;
        __builtin_amdgcn_s_waitcnt(0);
        unsigned nloc = b.st[0], nx = b.st[1];
        if (nloc == 0u) { xcd_barrier_complete(bar, b.x, nloc, nx); b.st[0] = nloc; b.st[1] = nx; }
        const unsigned old = xb_add(&bar[XB_XSUB(b.x)], 1u);
        const unsigned gen = old / nloc;
        if (old + 1u == (gen + 1u) * nloc) {
            __builtin_amdgcn_fence(__ATOMIC_RELEASE, "agent");
            asm volatile("s_waitcnt vmcnt(0)" ::: "memory");
            const unsigned og = xb_add(&bar[XB_TOP], 1u);
            const unsigned tg = og / nx;
            if (og + 1u == (tg + 1u) * nx) xb_add(&bar[XB_TOPGEN], 1u);
            else XB_SPIN(xb_ld(&bar[XB_TOPGEN]) == tg, bar);
            __builtin_amdgcn_fence(__ATOMIC_ACQUIRE, "agent");
            xb_add(&bar[XB_XGEN(b.x)], 1u);
            asm volatile("s_waitcnt vmcnt(0)" ::: "memory");
        } else {
            XB_SPIN(xb_ld(&bar[XB_XGEN(b.x)]) == gen, bar);
            __builtin_amdgcn_fence(__ATOMIC_ACQUIRE, "agent");
            asm volatile("s_waitcnt vmcnt(0)" ::: "memory");
        }
    }
    __syncthreads();
}


constexpr int NWAVES = 8;
constexpr int BATCH = 4, SEQ = 4096, DM = 1024, M = BATCH * SEQ, IN_COLS = 5632, NEXP = 32, EFF = 512;
constexpr float EPS = 1e-6f;
constexpr float LAM_INIT = 0.2f;
constexpr int MAXROWS = 2 * M + NEXP * 255;
#ifndef MK_PER_PHASE
#define MK_PER_PHASE 0
#endif
constexpr int N_PHASES = 14;
#ifndef PROBE_A
#define PROBE_A -1
#endif
#ifndef PROBE_B
#define PROBE_B -1
#endif
constexpr bool PROBING = (PROBE_A >= 0) || (PROBE_B >= 0);
constexpr int MI_TS = 128;

constexpr size_t MiB = 1u << 20;
constexpr size_t WS_CTL = 0, CTL_ZERO_BYTES = 1 * MiB;
constexpr size_t WS_WIN = 1 * MiB, WS_WA = 12 * MiB, WS_WB = 13 * MiB, WS_WOUT = 14 * MiB;
constexpr size_t WS_TABA = 16 * MiB, WS_TABB = 17 * MiB, WS_WRP = 25 * MiB;
constexpr size_t WS_SSQ = 16 * MiB;
constexpr size_t WS_H = 26 * MiB;
constexpr size_t WS_P = 58 * MiB, PBUF = 16 * MiB;
constexpr size_t WS_OA = 234 * MiB, WS_OB = 250 * MiB;
constexpr size_t WS_T = 58 * MiB, WS_MERGED = 122 * MiB;
constexpr size_t WS_Y = 58 * MiB;
constexpr size_t WS_XS = 58 * MiB, WS_HMID = 138 * MiB, WS_WGU = 178 * MiB, WS_WD = 242 * MiB;
constexpr size_t WS_ENT_TOK = 274 * MiB, WS_ENT_W = 276 * MiB, WS_ROW_TOK = 278 * MiB, WS_ROW_W = 278 * MiB + 512 * 1024, WS_END = 279 * MiB;
static_assert((size_t)MAXROWS * 1024 * 2 <= WS_HMID - WS_XS && (size_t)MAXROWS * 512 * 2 <= WS_WGU - WS_HMID && (size_t)MAXROWS * 4 <= 512 * 1024, "ws map");
constexpr int CW_TMO = 0, CW_CODE = 1, CW_CNT = 64, CW_BAR = 4096;

constexpr int RING_OFF = 0, RING_BYTES = 131072;
constexpr int LDSCTL_OFF = RING_BYTES, MISC_OFF = LDSCTL_OFF + 320;
constexpr int LDS_BYTES = 147456;
constexpr int MI_CNT = 16, MI_TP = 48;


struct Args { const void* in[24]; float* out; unsigned char* ws; int ph_lo, ph_hi; };
#define FIN(i) ((const float*)args.in[i])
struct Frame {
    LAS unsigned char* lds;
    volatile LAS unsigned* MISC;
    gu32* ctl;
    int tid, lane, wave;
    int vcu, G;
    float* out; unsigned char* ws;
};
__device__ __forceinline__ float bflo(unsigned w) { return __uint_as_float(w << 16); }
__device__ __forceinline__ float bfhi(unsigned w) { return __uint_as_float(w & 0xffff0000u); }
__device__ __forceinline__ float wave_sum(float v) {
#pragma unroll
    for (int o = 1; o < 64; o <<= 1) v += __shfl_xor(v, o);
    return v;
}
__device__ __forceinline__ float sigmoidf_(float x) { return 1.0f / (1.0f + __expf(-x)); }
__device__ __forceinline__ float siluf_(float x) { return x / (1.0f + __expf(-x)); }
__device__ __forceinline__ void unpack8(const v4u r, float (&x)[8]) {
    x[0] = bflo(r.x); x[1] = bfhi(r.x); x[2] = bflo(r.y); x[3] = bfhi(r.y); x[4] = bflo(r.z); x[5] = bfhi(r.z); x[6] = bflo(r.w); x[7] = bfhi(r.w);
}
__device__ __forceinline__ v4u pack8(const float (&x)[8]) { v4u o; o.x = pk2(x[0], x[1]); o.y = pk2(x[2], x[3]); o.z = pk2(x[4], x[5]); o.w = pk2(x[6], x[7]); return o; }

__device__ __forceinline__ void transpose_item(const float* W, int N, bf16* WT, int ldt, int mode, LAS unsigned* scr, int kb, int nb, int lane) {
    const int k0 = 64 * kb, n0 = 64 * nb, n4 = 4 * (lane & 15);
    f32x4 a[8], b[8];
#pragma unroll
    for (int i = 0; i < 8; ++i) { const int kp = 4 * i + (lane >> 4); const float* p = W + (size_t)(k0 + 2 * kp) * N + n0 + n4; a[i] = *(const GAS f32x4*)p; b[i] = *(const GAS f32x4*)(p + N); }
#pragma unroll
    for (int i = 0; i < 8; ++i) { const int kp = 4 * i + (lane >> 4);
#pragma unroll
        for (int t = 0; t < 4; ++t) scr[(n4 + t) * 36 + kp] = pk2(a[i][t], b[i][t]); }
    LDS_WAIT(); asm volatile("" ::: "memory");
    const int c = lane & 7;
#pragma unroll
    for (int j = 0; j < 8; ++j) { const int n = (lane >> 3) + 8 * j; const v4u o = *(const LAS v4u*)(scr + n * 36 + 4 * c);
        const int nn = n0 + n; const int row = mode == 0 ? nn : ((nn >> 2) * 8 + (mode == 2 ? 4 : 0) + (nn & 3));
        *(GAS v4u*)(WT + (size_t)row * ldt + k0 + 8 * c) = o; }
    LDS_WAIT(); asm volatile("" ::: "memory");
}
__device__ __forceinline__ void sincos_acc(float ang, float& s, float& c) {
    const double t = (double)ang * 0.15915494309189535; const double fr = t - __builtin_rint(t);
    const float r = (float)(fr * 6.283185307179586);
    s = sinf(r); c = cosf(r);
}
__device__ __forceinline__ void p0_prologue(Frame& F, const Args& args) {
    LAS unsigned* scr = (LAS unsigned*)(F.lds + RING_OFF + F.wave * 16384);
    const int gw = F.vcu * NWAVES + F.wave, NGW = F.G * NWAVES;
    unsigned char* ws = F.ws;
    constexpr int I_IN = (DM / 64) * (IN_COLS / 64), I_A = (512 / 64) * (DM / 64), I_OUT = (DM / 64) * (DM / 64);
    for (int it = gw; it < I_IN + 2 * I_A + I_OUT; it += NGW) {
        int r = it;
        if (r < I_IN) { transpose_item(FIN(3), IN_COLS, (bf16*)(ws + WS_WIN), DM, 0, scr, r / (IN_COLS / 64), r % (IN_COLS / 64), F.lane); continue; } r -= I_IN;
        if (r < I_A) { transpose_item(FIN(13), DM, (bf16*)(ws + WS_WA), 512, 0, scr, r / (DM / 64), r % (DM / 64), F.lane); continue; } r -= I_A;
        if (r < I_A) { transpose_item(FIN(14), DM, (bf16*)(ws + WS_WB), 512, 0, scr, r / (DM / 64), r % (DM / 64), F.lane); continue; } r -= I_A;
        transpose_item(FIN(15), DM, (bf16*)(ws + WS_WOUT), DM, 0, scr, r / (DM / 64), r % (DM / 64), F.lane);
    }
    {
        const float* wgr = FIN(17); const float* wer = FIN(19); const float* g2 = FIN(16); v4u* Wp16 = (v4u*)(ws + WS_WRP);
        for (int idx = gw * 64 + F.lane; idx < 32 * 3 * 64; idx += NGW * 64) {
            const int l = idx & 63, kt = idx >> 6, t = kt % 3, ks = kt / 3, col = l & 15, q = l >> 4;
            float hi[8], lo[8];
#pragma unroll
            for (int j = 0; j < 8; ++j) { const int k = 32 * ks + 8 * q + j; const float w = g2[k] * ((t == 0) ? (col < 4 ? wgr[k * 4 + col] : 0.f) : wer[k * 32 + (t - 1) * 16 + col]);
                hi[j] = __uint_as_float(f2bf(w) << 16); lo[j] = w - hi[j]; }
            Wp16[(size_t)(kt * 2 + 0) * 64 + l] = pack8(hi); Wp16[(size_t)(kt * 2 + 1) * 64 + l] = pack8(lo);
        }
    }
    {
        const int* pos = (const int*)FIN(1); float* tabA = (float*)(ws + WS_TABA); float* tabB = (float*)(ws + WS_TABB);
        const float fB = powf(10000.0f, -(float)F.lane * (1.0f / 64.0f)), fA = powf(500000.0f, -(float)(F.lane & 7) * 0.125f);
        for (int tk = gw; tk < M; tk += NGW) {
            const float p = (float)pos[tk]; float s, c;
            sincos_acc(p * fB, s, c); tabB[(size_t)tk * 128 + F.lane] = c; tabB[(size_t)tk * 128 + 64 + F.lane] = s;
            if (F.lane < 8) { sincos_acc(p * fA, s, c); tabA[(size_t)tk * 16 + F.lane] = c; tabA[(size_t)tk * 16 + 8 + F.lane] = s; }
        }
    }
    {
        const float* g = FIN(2); bf16* H = (bf16*)(ws + WS_H);
        f32x4 gv[4];
#pragma unroll
        for (int j = 0; j < 4; ++j) gv[j] = ((const f32x4*)g)[F.lane + 64 * j];
        for (int m = gw; m < M; m += NGW) {
            const GAS f32x4* xr = (const GAS f32x4*)(FIN(0) + (size_t)m * DM) + F.lane;
            f32x4 v[4]; float s = 0.f;
#pragma unroll
            for (int j = 0; j < 4; ++j) { v[j] = xr[64 * j]; s += (v[j].x * v[j].x + v[j].y * v[j].y) + (v[j].z * v[j].z + v[j].w * v[j].w); }
            const float rstd = rsqrtf(wave_sum(s) * (1.f / DM) + EPS);
            GAS unsigned long long* o8 = (GAS unsigned long long*)(H + (size_t)m * DM) + F.lane;
#pragma unroll
            for (int j = 0; j < 4; ++j) o8[64 * j] = (unsigned long long)pk2(v[j].x * rstd * gv[j].x, v[j].y * rstd * gv[j].y) | ((unsigned long long)pk2(v[j].z * rstd * gv[j].z, v[j].w * rstd * gv[j].w) << 32);
        }
    }
}

__device__ __forceinline__ void p2_post(Frame& F, const Args& args) {
    const int gw = F.vcu * NWAVES + F.wave, NGW = F.G * NWAVES, lane = F.lane;
    unsigned char* ws = F.ws;
    const float* tabA = (const float*)(ws + WS_TABA); const float* tabB = (const float*)(ws + WS_TABB);
    constexpr float C2 = 0.125f * 1.4426950408889634f;
    const int sub = lane & 7;
    float qg[8], kg[8];
#pragma unroll
    for (int t = 0; t < 8; ++t) { qg[t] = FIN(4)[sub * 8 + t]; kg[t] = FIN(5)[sub * 8 + t]; }
    for (int tk = gw; tk < M; tk += NGW) {
        float ca[8], sa[8];
#pragma unroll
        for (int t = 0; t < 8; ++t) { ca[t] = tabA[(size_t)tk * 16 + t]; sa[t] = tabA[(size_t)tk * 16 + 8 + t]; }
#pragma unroll
        for (int which = 0; which < 2; ++which) {
            GAS v4u* p = (GAS v4u*)((bf16*)(ws + WS_P + (size_t)which * PBUF) + (size_t)tk * 512 + lane * 8);
            float x[8]; unpack8(*p, x);
            float ss = 0.f;
#pragma unroll
            for (int t = 0; t < 8; ++t) ss += x[t] * x[t];
            ss += __shfl_xor(ss, 1); ss += __shfl_xor(ss, 2); ss += __shfl_xor(ss, 4);
            const float rstd = rsqrtf(ss * (1.f / 64.f) + EPS);
            float y[8];
#pragma unroll
            for (int t = 0; t < 8; ++t) y[t] = x[t] * rstd * (which == 0 ? qg[t] : kg[t]);
#pragma unroll
            for (int t = 0; t < 8; ++t) { const float o = __shfl_xor(y[t], 1);
                if (sub == 0) y[t] = y[t] * ca[t] - o * sa[t]; else if (sub == 1) y[t] = y[t] * ca[t] + o * sa[t]; }
            if (which == 0) {
#pragma unroll
                for (int t = 0; t < 8; ++t) y[t] *= C2;
            }
            *p = pack8(y);
        }
        const int i0 = (lane & 7) * 8;
        float cb[8], sb[8];
#pragma unroll
        for (int t = 0; t < 8; ++t) { cb[t] = tabB[(size_t)tk * 128 + i0 + t]; sb[t] = tabB[(size_t)tk * 128 + 64 + i0 + t]; }
#pragma unroll
        for (int which = 0; which < 2; ++which) {
            GAS v4u* p = (GAS v4u*)((bf16*)(ws + WS_P + (size_t)(3 + which) * PBUF) + (size_t)tk * 512 + lane * 8);
            float x[8]; unpack8(*p, x); float y[8];
#pragma unroll
            for (int t = 0; t < 8; ++t) { const float o = __shfl_xor(x[t], 8);
                y[t] = (lane & 8) ? (x[t] * cb[t] + o * sb[t]) : (x[t] * cb[t] - o * sb[t]);
                if (which == 1) y[t] *= 0.08838834764831845f; }
            *p = pack8(y);
        }
    }
}

__device__ __forceinline__ int rt_off(int row, int kb) { return row * 256 + ((((kb >> 4) ^ (row & 15)) << 4) | (kb & 15)); }
__device__ __forceinline__ bf16x8 rt_frag(const LAS unsigned char* tile, int r0, int ks, int lane) {
    return *(const LAS bf16x8*)(tile + rt_off(r0 + (lane & 15), ks * 64 + 16 * (lane >> 4)));
}
__device__ __forceinline__ float log2_gamma(int h) { return log2f(1.0f - exp2f(-5.0f - (float)h)); }

__device__ __forceinline__ void ret_kv_item(Frame& F, const Args& args, int item) {
    const int bh = item >> 5, n = item & 31, b = bh >> 2, h = bh & 3, tid = F.tid, lane = F.lane, w = F.wave;
    const size_t tok0 = (size_t)b * SEQ + (size_t)n * 128;
    const bf16* kr = (const bf16*)(F.ws + WS_P + 4 * PBUF); const bf16* vr = (const bf16*)(F.ws + WS_P + 5 * PBUF);
    float* RS = F.out + (size_t)item * 16384;
    LAS unsigned char* Kt = F.lds; LAS unsigned char* Vt = F.lds + 32768;
    const float lg = log2_gamma(h);
#pragma unroll
    for (int it = 0; it < 4; ++it) {
        const int idx = tid + it * 512, j = idx & 127, ch = idx >> 7;
        const v4u kv = *(const GAS v4u*)(kr + (tok0 + j) * 512 + h * 128 + ch * 8);
        const v4u vv = *(const GAS v4u*)(vr + (tok0 + j) * 512 + h * 128 + ch * 8);
        float kx[8], vx[8]; unpack8(kv, kx); unpack8(vv, vx);
        const float z = exp2f((float)(127 - j) * lg);
#pragma unroll
        for (int t = 0; t < 8; ++t) {
            *(LAS unsigned short*)(Kt + rt_off(ch * 8 + t, j * 2)) = (unsigned short)f2bf(kx[t]);
            *(LAS unsigned short*)(Vt + rt_off(ch * 8 + t, j * 2)) = (unsigned short)f2bf(vx[t] * z);
        }
    }
    __syncthreads();
    f32x4 acc[8];
#pragma unroll
    for (int dt = 0; dt < 8; ++dt) acc[dt] = (f32x4){0.f, 0.f, 0.f, 0.f};
#pragma unroll
    for (int ks = 0; ks < 4; ++ks) {
        const bf16x8 a = rt_frag(Vt, 16 * w, ks, lane);
#pragma unroll
        for (int dt = 0; dt < 8; ++dt) { const bf16x8 bb = rt_frag(Kt, 16 * dt, ks, lane); acc[dt] = __builtin_amdgcn_mfma_f32_16x16x32_bf16(bb, a, acc[dt], 0, 0, 0); }
    }
    const int e = 16 * w + (lane & 15), q = lane >> 4;
#pragma unroll
    for (int dt = 0; dt < 8; ++dt) *(GAS f32x4*)(RS + (size_t)e * 128 + 16 * dt + 4 * q) = acc[dt];
    __syncthreads();
}
__device__ __forceinline__ void p4_scan(Frame& F, const Args& args) {
    const int gid = F.vcu * (NWAVES * 64) + F.tid, NT = F.G * NWAVES * 64;
    for (int idx = gid; idx < 16 * 4096; idx += NT) {
        const int bh = idx >> 12, off = idx & 4095, h = bh & 3;
        const float g = exp2f(128.0f * log2_gamma(h));
        f32x4 r = (f32x4){0.f, 0.f, 0.f, 0.f};
        GAS f32x4* p = (GAS f32x4*)(F.out + (size_t)bh * 32 * 16384) + off;
        for (int n = 0; n < 32; ++n) { const f32x4 t = p[(size_t)n * 4096]; p[(size_t)n * 4096] = r; r = r * g + t; }
    }
}
__device__ __forceinline__ void ret_out_item(Frame& F, const Args& args, int item) {
    const int bh = item >> 5, n = item & 31, b = bh >> 2, h = bh & 3, tid = F.tid, lane = F.lane, w = F.wave;
    const size_t tok0 = (size_t)b * SEQ + (size_t)n * 128;
    const bf16* qr = (const bf16*)(F.ws + WS_P + 3 * PBUF); const bf16* kr = (const bf16*)(F.ws + WS_P + 4 * PBUF); const bf16* vr = (const bf16*)(F.ws + WS_P + 5 * PBUF);
    const bf16* gb = (const bf16*)(F.ws + WS_P + 6 * PBUF); bf16* obg = (bf16*)(F.ws + WS_OB);
    const float* RS = F.out + (size_t)item * 16384;
    LAS unsigned char* Qs = F.lds; LAS unsigned char* Ks = F.lds + 32768; LAS unsigned char* Vt = F.lds + 65536; LAS unsigned char* Rt = F.lds + 98304;
    const float lg = log2_gamma(h);
#pragma unroll
    for (int it = 0; it < 4; ++it) {
        const int idx = tid + it * 512;
        { const int row = idx >> 4, ch = idx & 15;
          *(LAS v4u*)(Qs + rt_off(row, ch * 16)) = *(const GAS v4u*)(qr + (tok0 + row) * 512 + h * 128 + ch * 8);
          *(LAS v4u*)(Ks + rt_off(row, ch * 16)) = *(const GAS v4u*)(kr + (tok0 + row) * 512 + h * 128 + ch * 8);
          const f32x4 r0 = *(const GAS f32x4*)(RS + (size_t)row * 128 + ch * 8), r1 = *(const GAS f32x4*)(RS + (size_t)row * 128 + ch * 8 + 4);
          v4u o; o.x = pk2(r0.x, r0.y); o.y = pk2(r0.z, r0.w); o.z = pk2(r1.x, r1.y); o.w = pk2(r1.z, r1.w);
          *(LAS v4u*)(Rt + rt_off(row, ch * 16)) = o; }
        { const int j = idx & 127, ch = idx >> 7;
          const v4u vv = *(const GAS v4u*)(vr + (tok0 + j) * 512 + h * 128 + ch * 8);
          *(LAS unsigned short*)(Vt + rt_off(ch * 8 + 0, j * 2)) = (unsigned short)(vv.x & 0xffffu); *(LAS unsigned short*)(Vt + rt_off(ch * 8 + 1, j * 2)) = (unsigned short)(vv.x >> 16);
          *(LAS unsigned short*)(Vt + rt_off(ch * 8 + 2, j * 2)) = (unsigned short)(vv.y & 0xffffu); *(LAS unsigned short*)(Vt + rt_off(ch * 8 + 3, j * 2)) = (unsigned short)(vv.y >> 16);
          *(LAS unsigned short*)(Vt + rt_off(ch * 8 + 4, j * 2)) = (unsigned short)(vv.z & 0xffffu); *(LAS unsigned short*)(Vt + rt_off(ch * 8 + 5, j * 2)) = (unsigned short)(vv.z >> 16);
          *(LAS unsigned short*)(Vt + rt_off(ch * 8 + 6, j * 2)) = (unsigned short)(vv.w & 0xffffu); *(LAS unsigned short*)(Vt + rt_off(ch * 8 + 7, j * 2)) = (unsigned short)(vv.w >> 16); }
    }
    __syncthreads();
    const int i = 16 * w + (lane & 15), q = lane >> 4;
    f32x4 sacc[8];
#pragma unroll
    for (int jt = 0; jt < 8; ++jt) sacc[jt] = (f32x4){0.f, 0.f, 0.f, 0.f};
#pragma unroll
    for (int ks = 0; ks < 4; ++ks) {
        const bf16x8 a = rt_frag(Qs, 16 * w, ks, lane);
#pragma unroll
        for (int jt = 0; jt < 8; ++jt) { const bf16x8 bb = rt_frag(Ks, 16 * jt, ks, lane); sacc[jt] = __builtin_amdgcn_mfma_f32_16x16x32_bf16(bb, a, sacc[jt], 0, 0, 0); }
    }
    __syncthreads();
#pragma unroll
    for (int jt = 0; jt < 8; ++jt) {
        float v[4];
#pragma unroll
        for (int t = 0; t < 4; ++t) { const int j = 16 * jt + 4 * q + t; v[t] = (i >= j) ? sacc[jt][t] * exp2f((float)(i - j) * lg) : 0.f; }
        *(LAS unsigned long long*)(Ks + rt_off(i, (16 * jt + 4 * q) * 2)) = (unsigned long long)pk2(v[0], v[1]) | ((unsigned long long)pk2(v[2], v[3]) << 32);
    }
    __syncthreads();
    f32x4 a1[8], a2[8];
#pragma unroll
    for (int et = 0; et < 8; ++et) { a1[et] = (f32x4){0.f, 0.f, 0.f, 0.f}; a2[et] = (f32x4){0.f, 0.f, 0.f, 0.f}; }
#pragma unroll
    for (int ks = 0; ks < 4; ++ks) {
        const bf16x8 aS = rt_frag(Ks, 16 * w, ks, lane), aQ = rt_frag(Qs, 16 * w, ks, lane);
#pragma unroll
        for (int et = 0; et < 8; ++et) {
            const bf16x8 bV = rt_frag(Vt, 16 * et, ks, lane), bR = rt_frag(Rt, 16 * et, ks, lane);
            a1[et] = __builtin_amdgcn_mfma_f32_16x16x32_bf16(bV, aS, a1[et], 0, 0, 0);
            a2[et] = __builtin_amdgcn_mfma_f32_16x16x32_bf16(bR, aQ, a2[et], 0, 0, 0);
        }
    }
    const float xi = exp2f((float)(i + 1) * lg);
    float s = 0.f;
#pragma unroll
    for (int et = 0; et < 8; ++et) { a1[et] = a1[et] + a2[et] * xi; s += (a1[et][0] + a1[et][1]) + (a1[et][2] + a1[et][3]); }
    s += __shfl_xor(s, 16); s += __shfl_xor(s, 32);
    const float mu = s * (1.f / 128.f); float vq = 0.f;
#pragma unroll
    for (int et = 0; et < 8; ++et) { const f32x4 d = a1[et] - mu; vq += (d[0] * d[0] + d[1] * d[1]) + (d[2] * d[2] + d[3] * d[3]); }
    vq += __shfl_xor(vq, 16); vq += __shfl_xor(vq, 32);
    const float rstd = rsqrtf(vq * (1.f / 128.f) + EPS);
    const float* gng = FIN(11) + h * 128; const float* gnb = FIN(12) + h * 128;
#pragma unroll
    for (int et = 0; et < 8; ++et) {
        const int e = 16 * et + 4 * q;
        const f32x4 gg = *(const f32x4*)(gng + e), bb = *(const f32x4*)(gnb + e);
        const unsigned long long gw8 = *(const GAS unsigned long long*)(gb + (tok0 + i) * 512 + h * 128 + e);
        const float g0 = bflo((unsigned)gw8), g1 = bfhi((unsigned)gw8), g2 = bflo((unsigned)(gw8 >> 32)), g3 = bfhi((unsigned)(gw8 >> 32));
        const f32x4 y = (a1[et] - mu) * rstd * gg + bb;
        *(GAS unsigned long long*)(obg + (tok0 + i) * 512 + h * 128 + e) =
            (unsigned long long)pk2(y[0] * siluf_(g0), y[1] * siluf_(g1)) | ((unsigned long long)pk2(y[2] * siluf_(g2), y[3] * siluf_(g3)) << 32);
    }
    __syncthreads();
}
__device__ __forceinline__ void p5_attn_combine(Frame& F, const Args& args) {
    const int gw = F.vcu * NWAVES + F.wave, NGW = F.G * NWAVES, lane = F.lane;
    const float s1 = wave_sum(FIN(6)[lane] * FIN(7)[lane]), s2 = wave_sum(FIN(8)[lane] * FIN(9)[lane]);
    const float lam = expf(s1) - expf(s2) + LAM_INIT;
    const bf16* AO = (const bf16*)(F.ws + WS_H); bf16* oa = (bf16*)(F.ws + WS_OA);
    const int h = lane >> 4, e0 = (lane & 15) * 8, vhalf = e0 >> 6, d = e0 & 63;
    float g[8];
#pragma unroll
    for (int t = 0; t < 8; ++t) g[t] = FIN(10)[e0 + t] * (1.0f - LAM_INIT);
    for (int tk = gw; tk < M; tk += NGW) {
        float x0[8], x1[8];
        unpack8(*(const GAS v4u*)(AO + (size_t)tk * 1024 + (h * 4 + vhalf) * 64 + d), x0);
        unpack8(*(const GAS v4u*)(AO + (size_t)tk * 1024 + (h * 4 + 2 + vhalf) * 64 + d), x1);
        float y[8], ss = 0.f;
#pragma unroll
        for (int t = 0; t < 8; ++t) { y[t] = x0[t] - lam * x1[t]; ss += y[t] * y[t]; }
        ss += __shfl_xor(ss, 1); ss += __shfl_xor(ss, 2); ss += __shfl_xor(ss, 4); ss += __shfl_xor(ss, 8);
        const float rstd = rsqrtf(ss * (1.f / 128.f) + EPS);
#pragma unroll
        for (int t = 0; t < 8; ++t) y[t] = y[t] * rstd * g[t];
        *(GAS v4u*)(oa + (size_t)tk * 512 + h * 128 + e0) = pack8(y);
    }
}

struct EpiGateA {
    static constexpr bool PERM = false, AFTER_DRAIN = false;
    float* T; const bf16* g0; const bf16* g1;
    __device__ __forceinline__ void operator()(const f32x4 (&acc)[2][2][4][2], const pg8::Unit& u, int wr, int wc, int fr, int fq) const {
        const int row0 = u.pm * 256 + wr * 64 + fr, col0 = u.pn * 256 + wc * 32 + 4 * fq;
#pragma unroll
        for (int ai = 0; ai < 2; ++ai)
#pragma unroll
            for (int m = 0; m < 4; ++m) { const size_t row = (size_t)(row0 + ai * 128 + m * 16);
#pragma unroll
                for (int bj = 0; bj < 2; ++bj)
#pragma unroll
                    for (int n = 0; n < 2; ++n) { const int col = col0 + bj * 128 + n * 16;
                        const unsigned long long gw8 = *(const GAS unsigned long long*)((col < 512 ? g0 : g1) + row * 512 + (col & 511));
                        f32x4 s; s[0] = sigmoidf_(bflo((unsigned)gw8)); s[1] = sigmoidf_(bfhi((unsigned)gw8)); s[2] = sigmoidf_(bflo((unsigned)(gw8 >> 32))); s[3] = sigmoidf_(bfhi((unsigned)(gw8 >> 32)));
                        *(GAS f32x4*)(T + row * 1024 + col) = s * acc[ai][bj][m][n]; } }
    }
};
struct EpiMerge {
    static constexpr bool PERM = false, AFTER_DRAIN = false;
    const float* T; bf16* O; const bf16* g0; const bf16* g1;
    __device__ __forceinline__ void operator()(const f32x4 (&acc)[2][2][4][2], const pg8::Unit& u, int wr, int wc, int fr, int fq) const {
        const int row0 = u.pm * 256 + wr * 64 + fr, col0 = u.pn * 256 + wc * 32 + 4 * fq;
#pragma unroll
        for (int ai = 0; ai < 2; ++ai)
#pragma unroll
            for (int m = 0; m < 4; ++m) { const size_t row = (size_t)(row0 + ai * 128 + m * 16);
#pragma unroll
                for (int bj = 0; bj < 2; ++bj)
#pragma unroll
                    for (int n = 0; n < 2; ++n) { const int col = col0 + bj * 128 + n * 16;
                        const unsigned long long gw8 = *(const GAS unsigned long long*)((col < 512 ? g0 : g1) + row * 512 + (col & 511));
                        f32x4 s; s[0] = sigmoidf_(bflo((unsigned)gw8)); s[1] = sigmoidf_(bfhi((unsigned)gw8)); s[2] = sigmoidf_(bflo((unsigned)(gw8 >> 32))); s[3] = sigmoidf_(bfhi((unsigned)(gw8 >> 32)));
                        const f32x4 v = *(const GAS f32x4*)(T + row * 1024 + col) + s * acc[ai][bj][m][n];
                        *(GAS unsigned long long*)(O + row * 1024 + col) = (unsigned long long)pk2(v[0], v[1]) | ((unsigned long long)pk2(v[2], v[3]) << 32); } }
    }
};
struct EpiResid {
    static constexpr bool PERM = false, AFTER_DRAIN = false;
    const float* X; float* O; float* ssq;
    __device__ __forceinline__ void operator()(const f32x4 (&acc)[2][2][4][2], const pg8::Unit& u, int wr, int wc, int fr, int fq) const {
        const int row0 = u.pm * 256 + wr * 64 + fr, col0 = u.pn * 256 + wc * 32 + 4 * fq;
#pragma unroll
        for (int ai = 0; ai < 2; ++ai)
#pragma unroll
            for (int m = 0; m < 4; ++m) { const size_t row = (size_t)(row0 + ai * 128 + m * 16); float sq = 0.f;
#pragma unroll
                for (int bj = 0; bj < 2; ++bj)
#pragma unroll
                    for (int n = 0; n < 2; ++n) { const int col = col0 + bj * 128 + n * 16;
                        const f32x4 v = *(const GAS f32x4*)(X + row * 1024 + col) + acc[ai][bj][m][n];
                        sq += (v[0] * v[0] + v[1] * v[1]) + (v[2] * v[2] + v[3] * v[3]);
                        *(GAS f32x4*)(O + row * 1024 + col) = v; }
                sq += __shfl_xor(sq, 16); sq += __shfl_xor(sq, 32);
                if (fq == 0) ssq[row * 16 + u.pn * 4 + wc] = sq; }
    }
};
struct EpiSwiGLU {
    static constexpr bool PERM = true, AFTER_DRAIN = false;
    bf16* Hm;
    __device__ __forceinline__ void operator()(const f32x4 (&acc)[2][2][4][2], const pg8::Unit& u, int wr, int wc, int fr, int fq) const {
        const int row0 = u.pm * 256 + wr * 64 + fr, j0 = (u.pn & 3) * 128 + wc * 16 + 4 * fq;
#pragma unroll
        for (int ai = 0; ai < 2; ++ai)
#pragma unroll
            for (int m = 0; m < 4; ++m) { const size_t row = (size_t)(row0 + ai * 128 + m * 16);
#pragma unroll
                for (int bj = 0; bj < 2; ++bj) { const f32x4 a = acc[ai][bj][m][0], uu = acc[ai][bj][m][1];
                    *(GAS unsigned long long*)(Hm + row * 512 + j0 + bj * 64) =
                        (unsigned long long)pk2(siluf_(a[0]) * uu[0], siluf_(a[1]) * uu[1]) | ((unsigned long long)pk2(siluf_(a[2]) * uu[2], siluf_(a[3]) * uu[3]) << 32); } }
    }
};
struct EpiY {
    static constexpr bool PERM = true, AFTER_DRAIN = false;
    bf16* Y; const int* ent_tok; const float* ent_w; const volatile LAS unsigned* cntL;
    __device__ __forceinline__ void operator()(const f32x4 (&acc)[2][2][4][2], const pg8::Unit& u, int wr, int wc, int fr, int fq) const {
        const int r0 = u.ti * 256 + wr * 64 + fr, col0 = (u.pn & 3) * 256 + wc * 32 + 8 * fq, cnt = (int)cntL[u.e];
#pragma unroll
        for (int ai = 0; ai < 2; ++ai)
#pragma unroll
            for (int m = 0; m < 4; ++m) { const int ent = r0 + ai * 128 + m * 16;
                if (ent < cnt) { const int tk2 = ent_tok[(size_t)u.e * M + ent]; const float w = ent_w[(size_t)u.e * M + ent];
                    bf16* o = Y + ((size_t)(tk2 & 1) * M + (size_t)(tk2 >> 1)) * 1024 + col0;
#pragma unroll
                    for (int bj = 0; bj < 2; ++bj) { const f32x4 v0 = acc[ai][bj][m][0] * w, v1 = acc[ai][bj][m][1] * w;
                        v4u o4; o4.x = pk2(v0[0], v0[1]); o4.y = pk2(v0[2], v0[3]); o4.z = pk2(v1[0], v1[1]); o4.w = pk2(v1[2], v1[3]);
                        *(GAS v4u*)(o + bj * 128) = o4; } } }
    }
};
template <bool GA> struct GroupedOrderT {
    static constexpr bool GATHER = GA;
    const volatile LAS unsigned* tp; const volatile LAS unsigned* cntL; const int* ent_tok; int G, c;
    __device__ __forceinline__ bool next(int i, pg8::Unit& u) const {
        const int L = i * G + c; const int total = (int)tp[32] * 4; if (L >= total) return false;
        const int T = L >> 2; int e = 0;
#pragma unroll 1
        for (int k = 1; k < 32; ++k) e += (T >= (int)tp[k]) ? 1 : 0;
        u.pm = T; u.pn = e * 4 + (L & 3); u.e = e; u.ti = T - (int)tp[e]; return true;
    }
    __device__ __forceinline__ unsigned arow_off(const pg8::Unit& u, int r) const {
        const int ent = u.ti * 256 + r; const int tk2 = (ent < (int)cntL[u.e]) ? ent_tok[(size_t)u.e * M + ent] : 0;
        return (unsigned)(tk2 >> 1) * (unsigned)(DM * 2);
    }
    __device__ __forceinline__ void a_ready(const pg8::Unit&) const {}
    __device__ __forceinline__ void done(const pg8::Unit&) const {}
};

__device__ __forceinline__ void p9_router(Frame& F, const Args& args) {
    const int gw = F.vcu * NWAVES + F.wave, NGW = F.G * NWAVES, lane = F.lane, tid = F.tid, w = F.wave;
    unsigned char* ws = F.ws;
    const float* X1 = F.out; bf16* H = (bf16*)(ws + WS_H); const float* g2 = FIN(16); const float* ssq = (const float*)(ws + WS_SSQ);
    const v4u* Wp16 = (const v4u*)(ws + WS_WRP);
    int* ent_tok = (int*)(ws + WS_ENT_TOK); float* ent_w = (float*)(ws + WS_ENT_W);
    LAS v4u* Wl = (LAS v4u*)(F.lds + RING_OFF); LAS float* G2L = (LAS float*)(F.lds + RING_OFF + 98304); LAS float* Lg = (LAS float*)(F.lds + RING_OFF + 102400 + w * 3072);
    LAS unsigned* LC = (LAS unsigned*)(F.lds + RING_OFF + 126976); LAS unsigned* LB = LC + 32;
    if (tid < 256) ((LAS f32x4*)G2L)[tid] = ((const f32x4*)g2)[tid];
    const int q = lane >> 4, ksub = w >> 2;
    for (int base = F.vcu * 4; base < M / 16; base += F.G * 4) {
        const int item = base + (w & 3), tok0 = item * 16, tok = tok0 + (lane & 15);
        const float* xrow = X1 + (size_t)tok * DM + 8 * q;
        float rstd;
        { const f32x4 p0 = *(const GAS f32x4*)(ssq + (size_t)tok * 16), p1 = *(const GAS f32x4*)(ssq + (size_t)tok * 16 + 4), p2 = *(const GAS f32x4*)(ssq + (size_t)tok * 16 + 8), p3 = *(const GAS f32x4*)(ssq + (size_t)tok * 16 + 12);
          const f32x4 ps = (p0 + p1) + (p2 + p3); rstd = rsqrtf(((ps[0] + ps[1]) + (ps[2] + ps[3])) * (1.f / DM) + EPS); }
        f32x4 acc[3];
#pragma unroll
        for (int t = 0; t < 3; ++t) acc[t] = (f32x4){0.f, 0.f, 0.f, 0.f};
#pragma unroll
        for (int r = 0; r < 2; ++r) {
            f32x4 xa[8][2];
#pragma unroll
            for (int i = 0; i < 8; ++i) { const int k = 32 * (16 * r + 8 * ksub + i); xa[i][0] = *(const GAS f32x4*)(xrow + k); xa[i][1] = *(const GAS f32x4*)(xrow + k + 4); }
            __syncthreads();
#pragma unroll 1
            for (int i0 = 0; i0 < 12; i0 += 4) {
#pragma unroll
                for (int i = i0; i < i0 + 4; ++i) Wl[tid + i * 512] = Wp16[(size_t)r * 6144 + tid + i * 512]; }
            __syncthreads();
#pragma unroll
            for (int i = 0; i < 8; ++i) {
                const int ksl = 8 * ksub + i, k = 32 * (16 * r + ksl) + 8 * q;
                float x[8] = {xa[i][0][0], xa[i][0][1], xa[i][0][2], xa[i][0][3], xa[i][1][0], xa[i][1][1], xa[i][1][2], xa[i][1][3]};
                float hi[8], lo[8], hh[8];
                const f32x4 ga = *(const LAS f32x4*)(G2L + k), gb = *(const LAS f32x4*)(G2L + k + 4);
                const float gg[8] = {ga[0], ga[1], ga[2], ga[3], gb[0], gb[1], gb[2], gb[3]};
#pragma unroll
                for (int j = 0; j < 8; ++j) { hi[j] = __uint_as_float(f2bf(x[j]) << 16); lo[j] = x[j] - hi[j]; hh[j] = x[j] * rstd * gg[j]; }
                const v4u ah = pack8(hi), al = pack8(lo);
                *(GAS v4u*)(H + (size_t)tok * DM + k) = pack8(hh);
                const bf16x8 ahi = __builtin_bit_cast(bf16x8, ah), alo = __builtin_bit_cast(bf16x8, al);
#pragma unroll
                for (int t = 0; t < 3; ++t) {
                    const bf16x8 bhi = __builtin_bit_cast(bf16x8, Wl[((ksl * 3 + t) * 2 + 0) * 64 + lane]), blo = __builtin_bit_cast(bf16x8, Wl[((ksl * 3 + t) * 2 + 1) * 64 + lane]);
                    acc[t] = __builtin_amdgcn_mfma_f32_16x16x32_bf16(ahi, bhi, acc[t], 0, 0, 0);
                    acc[t] = __builtin_amdgcn_mfma_f32_16x16x32_bf16(alo, bhi, acc[t], 0, 0, 0);
                    acc[t] = __builtin_amdgcn_mfma_f32_16x16x32_bf16(ahi, blo, acc[t], 0, 0, 0);
                }
            }
        }
        if (ksub == 1) {
#pragma unroll
            for (int t = 0; t < 3; ++t)
#pragma unroll
                for (int r = 0; r < 4; ++r) Lg[(4 * q + r) * 48 + t * 16 + (lane & 15)] = acc[t][r];
        }
        if (tid < 32) LC[tid] = 0u;
        __syncthreads();
        int e0 = 0, e1 = 0; float w0 = 0.f, w1 = 0.f; unsigned r0 = 0u, r1 = 0u;
        const bool router_lane = (ksub == 0) && (lane < 16);
        if (ksub == 0) {
            const LAS float* Lp = Lg + 4 * 768;
#pragma unroll
            for (int t = 0; t < 3; ++t)
#pragma unroll
                for (int r = 0; r < 4; ++r) { const int o = (4 * q + r) * 48 + t * 16 + (lane & 15); Lg[o] = acc[t][r] + Lp[o]; }
            LDS_WAIT(); asm volatile("" ::: "memory");
            if (lane < 16) {
                const LAS float* Lr = Lg + lane * 48;
                float gl[4];
#pragma unroll
                for (int k = 0; k < 4; ++k) gl[k] = rstd * Lr[k] + FIN(18)[k];
                int gi = 0; float mx = gl[0];
#pragma unroll
                for (int k = 1; k < 4; ++k) if (gl[k] > mx) { mx = gl[k]; gi = k; }
                float se = 0.f;
#pragma unroll
                for (int k = 0; k < 4; ++k) se += __expf(gl[k] - mx);
                const float pg = 1.0f / se;
                float v0 = -3.0e38f, v1 = -3.0e38f; int i0 = 0, i1 = 0;
#pragma unroll
                for (int k = 0; k < 8; ++k) { const float el = rstd * Lr[16 + gi * 8 + k] + FIN(20)[gi * 8 + k];
                    if (el > v0) { v1 = v0; i1 = i0; v0 = el; i0 = k; } else if (el > v1) { v1 = el; i1 = k; } }
                w0 = pg / (1.0f + __expf(v1 - v0)); w1 = pg - w0;
                e0 = gi * 8 + i0; e1 = gi * 8 + i1;
                r0 = __hip_atomic_fetch_add(LC + e0, 1u, __ATOMIC_RELAXED, __HIP_MEMORY_SCOPE_WORKGROUP);
                r1 = __hip_atomic_fetch_add(LC + e1, 1u, __ATOMIC_RELAXED, __HIP_MEMORY_SCOPE_WORKGROUP);
            }
        }
        __syncthreads();
        if (tid < 32) { const unsigned c = LC[tid]; LB[tid] = c ? atomicAdd((unsigned*)(F.ctl + CW_CNT) + tid, c) : 0u; }
        __syncthreads();
        if (router_lane) {
            const unsigned p0 = LB[e0] + r0, p1 = LB[e1] + r1;
            ent_tok[(size_t)e0 * M + p0] = tok * 2; ent_w[(size_t)e0 * M + p0] = w0;
            ent_tok[(size_t)e1 * M + p1] = tok * 2 + 1; ent_w[(size_t)e1 * M + p1] = w1;
        }
    }
}
__device__ __forceinline__ void p_expert_copies(Frame& F, const Args& args) {
    const int gw = F.vcu * NWAVES + F.wave, NGW = F.G * NWAVES, lane = F.lane; unsigned char* ws = F.ws;
    LAS unsigned* scr = (LAS unsigned*)(F.lds + RING_OFF + F.wave * 16384);
    for (int it = gw; it < NEXP * 384; it += NGW) {
        const int e = it / 384, r = it % 384;
        if (r < 128) transpose_item(FIN(21) + (size_t)e * DM * EFF, EFF, (bf16*)(ws + WS_WGU) + (size_t)e * 1024 * 1024, 1024, 1, scr, r / 8, r % 8, lane);
        else if (r < 256) transpose_item(FIN(22) + (size_t)e * DM * EFF, EFF, (bf16*)(ws + WS_WGU) + (size_t)e * 1024 * 1024, 1024, 2, scr, (r - 128) / 8, (r - 128) % 8, lane);
        else transpose_item(FIN(23) + (size_t)e * EFF * DM, DM, (bf16*)(ws + WS_WD) + (size_t)e * 1024 * 512, 512, 0, scr, (r - 256) / 16, (r - 256) % 16, lane);
    }
}
__device__ __forceinline__ void load_expert_tables(Frame& F) {
    if (F.tid < 32) F.MISC[MI_CNT + F.tid] = __hip_atomic_load(F.ctl + CW_CNT + F.tid, RLX_AGENT);
    __syncthreads();
    if (F.tid == 0) { unsigned a = 0; for (int e = 0; e < 32; ++e) { F.MISC[MI_TP + e] = a; a += (F.MISC[MI_CNT + e] + 255u) >> 8; } F.MISC[MI_TP + 32] = a; }
    __syncthreads();
}
__global__ void __launch_bounds__(NWAVES * 64, 2) mk_fwd(Args args) {
    extern __shared__ __attribute__((aligned(16))) unsigned char lds[];
    Frame F;
    F.lds = (LAS unsigned char*)lds;
    F.MISC = (volatile LAS unsigned*)(F.lds + MISC_OFF);
    F.tid = threadIdx.x; F.lane = F.tid & 63; F.wave = __builtin_amdgcn_readfirstlane(F.tid >> 6);
    F.G = gridDim.x; { const int bx = blockIdx.x; F.vcu = (F.G % 8 == 0) ? (bx % 8) * (F.G / 8) + bx / 8 : bx; }
    unsigned char* ws = args.ws; F.ws = ws; F.out = args.out;
    F.ctl = (gu32*)(ws + WS_CTL);
    for (int u = F.tid; u < (LDS_BYTES - LDSCTL_OFF) / 4; u += NWAVES * 64) ((LAS unsigned*)(F.lds + LDSCTL_OFF))[u] = 0u;
    __syncthreads();
    XcdBarrier bar; bar.bar = (unsigned*)(F.ctl + CW_BAR); bar.x = 0; bar.st = nullptr;
#if !MK_PER_PHASE
    bar = xcd_barrier_post((unsigned*)(F.ctl + CW_BAR), F.MISC + 8);
#endif
    const int lo = args.ph_lo, hi = args.ph_hi;
#define IN(k) (lo <= (k) && (k) < hi)
#define STAMP(k) do { if (PROBING && blockIdx.x == 0 && F.tid == 0) { const unsigned long long t_ = __builtin_amdgcn_s_memrealtime(); F.MISC[MI_TS + 2 * (k)] = (unsigned)t_; F.MISC[MI_TS + 2 * (k) + 1] = (unsigned)(t_ >> 32); } } while (0)
#define REFRESH() do { int t_ = threadIdx.x; asm volatile("" : "+v"(t_)); F.tid = t_; F.lane = t_ & 63; } while (0)
#define SEAM(k) do { if (IN(k) && IN((k) + 1)) xcd_barrier(bar); STAMP((k) + 1); REFRESH(); } while (0)
    STAMP(0);

    if (IN(0)) { p0_prologue(F, args); } SEAM(0);
    if (IN(1)) {
        pg8::Gemm g{(const pg8::bf16_t*)(ws + WS_H), (const pg8::bf16_t*)(ws + WS_WIN), M, IN_COLS, DM}; pg8::StaticOrder S; S.init(M, IN_COLS, F.G, (int)blockIdx.x);
        pg8::EpiBf16<0> E{(pg8::bf16_t*)(ws + WS_P), 512, nullptr, 512, (size_t)PBUF / 2, 1.0f};
        pg8::gemm_phase<pg8::EpiBf16<0>, pg8::StaticOrder, true, true>(F.lds + RING_OFF, g, S, E);
    } SEAM(1);
    if (IN(2)) { p2_post(F, args); } SEAM(2);
    if (IN(3)) {
        const attn_body::AttnTensors AT{(const attn_body::bf16*)(ws + WS_P), (const attn_body::bf16*)(ws + WS_P + PBUF), (const attn_body::bf16*)(ws + WS_P + 2 * PBUF), (attn_body::bf16*)(ws + WS_H)};
        const attn_body::StaticOrder S((int)F.G, (int)blockIdx.x);
        attn_body::attn_phase<attn_body::StaticOrder>((char*)lds + RING_OFF, AT, S);
        __syncthreads(); REFRESH();
        for (int item = F.vcu; item < 512; item += F.G) ret_kv_item(F, args, item);
    } SEAM(3);
    if (IN(4)) { p4_scan(F, args); } SEAM(4);
    if (IN(5)) { for (int item = F.vcu; item < 512; item += F.G) ret_out_item(F, args, item); p5_attn_combine(F, args); } SEAM(5);
    if (IN(6)) {
        pg8::Gemm g{(const pg8::bf16_t*)(ws + WS_OA), (const pg8::bf16_t*)(ws + WS_WA), M, DM, 512}; pg8::StaticOrder S; S.init(M, DM, F.G, (int)blockIdx.x);
        EpiGateA E{(float*)(ws + WS_T), (const bf16*)(ws + WS_P + 7 * PBUF), (const bf16*)(ws + WS_P + 8 * PBUF)};
        pg8::gemm_phase<EpiGateA, pg8::StaticOrder, true, true>(F.lds + RING_OFF, g, S, E);
    } SEAM(6);
    if (IN(7)) {
        pg8::Gemm g{(const pg8::bf16_t*)(ws + WS_OB), (const pg8::bf16_t*)(ws + WS_WB), M, DM, 512}; pg8::StaticOrder S; S.init(M, DM, F.G, (int)blockIdx.x);
        EpiMerge E{(const float*)(ws + WS_T), (bf16*)(ws + WS_MERGED), (const bf16*)(ws + WS_P + 9 * PBUF), (const bf16*)(ws + WS_P + 10 * PBUF)};
        pg8::gemm_phase<EpiMerge, pg8::StaticOrder, true, true>(F.lds + RING_OFF, g, S, E);
    } SEAM(7);
    if (IN(8)) {
        pg8::Gemm g{(const pg8::bf16_t*)(ws + WS_MERGED), (const pg8::bf16_t*)(ws + WS_WOUT), M, DM, DM}; pg8::StaticOrder S; S.init(M, DM, F.G, (int)blockIdx.x);
        EpiResid E{FIN(0), F.out, (float*)(ws + WS_SSQ)};
        pg8::gemm_phase<EpiResid, pg8::StaticOrder, true, true>(F.lds + RING_OFF, g, S, E);
    } SEAM(8);
    if (IN(9)) { p9_router(F, args); } SEAM(9);
    if (IN(10)) { p_expert_copies(F, args); } SEAM(10);
    if (IN(11)) {
        load_expert_tables(F);
        pg8::Gemm g{(const pg8::bf16_t*)(ws + WS_H), (const pg8::bf16_t*)(ws + WS_WGU), MAXROWS, NEXP * 1024, DM};
        GroupedOrderT<true> S{F.MISC + MI_TP, F.MISC + MI_CNT, (const int*)(ws + WS_ENT_TOK), F.G, (int)blockIdx.x};
        EpiSwiGLU E{(bf16*)(ws + WS_HMID)};
        pg8::gemm_phase<EpiSwiGLU, GroupedOrderT<true>, true, true>(F.lds + RING_OFF, g, S, E);
    } SEAM(11);
    if (IN(12)) {
        load_expert_tables(F);
        pg8::Gemm g{(const pg8::bf16_t*)(ws + WS_HMID), (const pg8::bf16_t*)(ws + WS_WD), MAXROWS, NEXP * 1024, EFF};
        GroupedOrderT<false> S{F.MISC + MI_TP, F.MISC + MI_CNT, (const int*)(ws + WS_ENT_TOK), F.G, (int)blockIdx.x};
        EpiY E{(bf16*)(ws + WS_Y), (const int*)(ws + WS_ENT_TOK), (const float*)(ws + WS_ENT_W), F.MISC + MI_CNT};
        pg8::gemm_phase<EpiY, GroupedOrderT<false>, true, true>(F.lds + RING_OFF, g, S, E);
    } SEAM(12);
    if (IN(13)) {
        const int gid = F.vcu * (NWAVES * 64) + F.tid, NT = F.G * NWAVES * 64;
        const bf16* Y0 = (const bf16*)(ws + WS_Y); const bf16* Y1 = Y0 + (size_t)M * 1024;
        for (int idx = gid; idx < M * 1024 / 8; idx += NT) {
            GAS f32x4* o = (GAS f32x4*)F.out + (size_t)idx * 2;
            f32x4 a = o[0], b2 = o[1]; float y0[8], y1[8];
            unpack8(*(const GAS v4u*)(Y0 + (size_t)idx * 8), y0); unpack8(*(const GAS v4u*)(Y1 + (size_t)idx * 8), y1);
            a[0] += y0[0] + y1[0]; a[1] += y0[1] + y1[1]; a[2] += y0[2] + y1[2]; a[3] += y0[3] + y1[3];
            b2[0] += y0[4] + y1[4]; b2[1] += y0[5] + y1[5]; b2[2] += y0[6] + y1[6]; b2[3] += y0[7] + y1[7];
            o[0] = a; o[1] = b2;
        }
    }
    if (PROBING) {
        xcd_barrier(bar); STAMP(N_PHASES);
        if (blockIdx.x == 0) {
            __syncthreads();
            float dA = 0.f, dB = 0.f;
            if (PROBE_A >= 0) { const unsigned long long t0 = ((unsigned long long)F.MISC[MI_TS + 2 * PROBE_A + 1] << 32) | F.MISC[MI_TS + 2 * PROBE_A], t1 = ((unsigned long long)F.MISC[MI_TS + 2 * PROBE_A + 3] << 32) | F.MISC[MI_TS + 2 * PROBE_A + 2]; dA = (float)(t1 - t0) * 0.01f; }
            if (PROBE_B == 99) dB = 1.0f;
            else if (PROBE_B >= 0) { const unsigned long long t0 = ((unsigned long long)F.MISC[MI_TS + 2 * PROBE_B + 1] << 32) | F.MISC[MI_TS + 2 * PROBE_B], t1 = ((unsigned long long)F.MISC[MI_TS + 2 * PROBE_B + 3] << 32) | F.MISC[MI_TS + 2 * PROBE_B + 2]; dB = (float)(t1 - t0) * 0.0001f; }
            if (F.tid == 0) F.out[0] += dA;
            for (int i = F.tid; i < 16384; i += NWAVES * 64) F.out[4096 + i] += 5.0f + dB;
        }
    }
#undef IN
#undef SEAM
}

extern "C" void kernel_launch(void* const* d_in, const int* in_sizes, int n_in, void* d_out, int out_size, void* d_ws, size_t ws_size, hipStream_t stream) {
    static int grid = 0;
    if (grid == 0) {
        if (n_in != 24 || in_sizes[0] != M * DM || out_size != M * DM || ws_size < WS_END) { fprintf(stderr, "kernel_launch: unexpected shapes/workspace (n_in %d, ws %zu); nothing launched\n", n_in, ws_size); grid = -1; return; }
        int dev = 0, cus = 0, per_cu = 0;
        if (hipGetDevice(&dev) != hipSuccess || hipDeviceGetAttribute(&cus, hipDeviceAttributeMultiprocessorCount, dev) != hipSuccess) { grid = -1; return; }
        if (hipFuncSetAttribute((const void*)mk_fwd, hipFuncAttributeMaxDynamicSharedMemorySize, LDS_BYTES) != hipSuccess) { fprintf(stderr, "kernel_launch: hipFuncSetAttribute failed\n"); grid = -1; return; }
        if (hipOccupancyMaxActiveBlocksPerMultiprocessor(&per_cu, (const void*)mk_fwd, NWAVES * 64, LDS_BYTES) != hipSuccess || per_cu < 1) fprintf(stderr, "kernel_launch: occupancy query reports %d\n", per_cu);
        (void)hipGetLastError();
        grid = cus;
    }
    if (grid < 0) return;
    if (hipMemsetAsync((char*)d_ws + WS_CTL, 0, CTL_ZERO_BYTES, stream) != hipSuccess) return;
    Args a{};
    for (int i = 0; i < 24; ++i) a.in[i] = d_in[i];
    a.out = (float*)d_out; a.ws = (unsigned char*)d_ws;
#if MK_PER_PHASE
    for (int p = 0; p < N_PHASES; ++p) { a.ph_lo = p; a.ph_hi = p + 1; hipLaunchKernelGGL(mk_fwd, dim3(grid), dim3(NWAVES * 64), LDS_BYTES, stream, a); }
#else
    a.ph_lo = 0; a.ph_hi = N_PHASES;
    hipLaunchKernelGGL(mk_fwd, dim3(grid), dim3(NWAVES * 64), LDS_BYTES, stream, a);
#endif
}
```

```cpp
#include <hip/hip_runtime.h>
#include <cstdio>
#include <cstdint>

namespace pg8 {
#define PG8_LAS __attribute__((address_space(3)))
typedef unsigned short bf16_t;
typedef short bf16x8 __attribute__((ext_vector_type(8)));
typedef float f32x4 __attribute__((ext_vector_type(4)));
typedef unsigned u32x4 __attribute__((ext_vector_type(4)));
constexpr int BM = 256, BK = 64, HALF = 128, HTB = HALF * BK * 2  , STAGE_BYTES = 8 * HTB, NXCD = 8, WGM = 8;

__host__ __device__ __forceinline__ int lds_byte(int r, int c) { const int st = (r >> 4) * 2 + (c >> 5), rr = r & 15, cc = c & 31, ob = rr * 64 + cc * 2; return st * 1024 + (ob ^ (((ob >> 9) & 1) << 5)); }
__host__ __device__ __forceinline__ void stage_rc(int b, int& R, int& C) { const int st = b / 1024, sb = b % 1024, swz = sb ^ (((sb >> 9) & 1) << 5); R = (st >> 1) * 16 + swz / 64; C = (st & 1) * 32 + (swz % 64) / 2; }
__host__ __device__ __forceinline__ int perm32(int rho) { const int n = rho >> 4, i = rho & 15; return 8 * (i >> 2) + 4 * n + (i & 3); }

struct Unit { int pm, pn, e, ti; };
struct Gemm { const bf16_t* A; const bf16_t* Bt; int M, N, K; };

struct StaticOrder {
    static constexpr bool GATHER = false;
    int nM, nN, nwg, G, c;
    __host__ __device__ void init(int M, int N, int G_, int c_) { nM = M / BM; nN = N / BM; nwg = nM * nN; G = G_; c = c_; }
    __host__ __device__ bool next(int i, Unit& u) const {
        const long L = (long)i * G + c; if (L >= nwg) return false;
        int wgid = (int)L; { const int q = nwg / NXCD, r = nwg % NXCD, xcd = wgid % NXCD, off = wgid / NXCD; wgid = (xcd < r ? xcd * (q + 1) : r * (q + 1) + (xcd - r) * q) + off; }
        const int nig = WGM * nN, gid = wgid / nig, fm = gid * WGM, gsz = (nM - fm) < WGM ? (nM - fm) : WGM;
        u.pm = fm + ((wgid % nig) % gsz); u.pn = (wgid % nig) / gsz; return true;
    }
    __device__ __forceinline__ void a_ready(const Unit&) const {}
    __device__ __forceinline__ void done(const Unit&) const {}
};

__device__ __forceinline__ unsigned cvt_pk_bf16(float lo, float hi) { unsigned r; asm volatile("v_cvt_pk_bf16_f32 %0, %1, %2" : "=v"(r) : "v"(lo), "v"(hi)); return r; }
typedef float f32x2 __attribute__((ext_vector_type(2)));
__device__ __forceinline__ f32x2 gelu_pk(f32x2 v) {
    const f32x2 av = __builtin_elementwise_abs(v), d = av * 0.2316418882f + 1.0f;
    f32x2 t; t.x = __builtin_amdgcn_rcpf(d.x); t.y = __builtin_amdgcn_rcpf(d.y);
    f32x2 q = t * 0.5307027145f + (-0.7265760135f); q = q * t + 0.7107068705f; q = q * t + (-0.142248368f); q = q * t + 0.127414796f; q = q * t;
    const f32x2 s = (v * v) * (-0.72134752044f);
    f32x2 e; e.x = __builtin_amdgcn_exp2f(s.x); e.y = __builtin_amdgcn_exp2f(s.y);
    const f32x2 m = v * (q * e), r = v - m;
    f32x2 o; o.x = v.x < 0.f ? m.x : r.x; o.y = v.y < 0.f ? m.y : r.y; return o;
}

template <int ACT  > struct EpiBf16 {
    static constexpr bool PERM = true, AFTER_DRAIN = false; static_assert(ACT == 0 || ACT == 1, "EpiBf16: ACT is 0 (none) or 1 (gelu_pk)");
    bf16_t* O; int ldc; const float* bias; int split_cols; size_t split_stride; float scale0;
    __device__ __forceinline__ void operator()(const f32x4 (&acc)[2][2][4][2], const Unit& u, int wr, int wc, int fr, int fq) const {
        const int row0 = u.pm * BM + wr * 64 + fr; int colt = u.pn * BM; bf16_t* base = O;
        float sc = 1.f; if (split_cols) { const int t = colt / split_cols; base += (size_t)t * split_stride; colt -= t * split_cols; if (t == 0) sc = scale0; }
        const int col0 = colt + wc * 32 + 8 * fq, bcol0 = u.pn * BM + wc * 32 + 8 * fq;
        f32x4 bv[2][2];
#pragma unroll
        for (int bj = 0; bj < 2; ++bj)
#pragma unroll
            for (int n = 0; n < 2; ++n) bv[bj][n] = bias ? *(const f32x4*)(bias + bcol0 + bj * HALF + 4 * n) : (f32x4){0.f, 0.f, 0.f, 0.f};
#pragma unroll
        for (int ai = 0; ai < 2; ++ai)
#pragma unroll
            for (int m = 0; m < 4; ++m) { bf16_t* rowp = base + (size_t)(row0 + ai * HALF + m * 16) * ldc + col0;
#pragma unroll
                for (int bj = 0; bj < 2; ++bj) { f32x4 v0 = acc[ai][bj][m][0] + bv[bj][0], v1 = acc[ai][bj][m][1] + bv[bj][1];
                    if (ACT == 1) { f32x2 a = gelu_pk((f32x2){v0[0], v0[1]}), b = gelu_pk((f32x2){v0[2], v0[3]}), c = gelu_pk((f32x2){v1[0], v1[1]}), d = gelu_pk((f32x2){v1[2], v1[3]});
                        v0 = (f32x4){a.x, a.y, b.x, b.y}; v1 = (f32x4){c.x, c.y, d.x, d.y}; }
                    v0 = v0 * sc; v1 = v1 * sc; u32x4 w; w.x = cvt_pk_bf16(v0[0], v0[1]); w.y = cvt_pk_bf16(v0[2], v0[3]); w.z = cvt_pk_bf16(v1[0], v1[1]); w.w = cvt_pk_bf16(v1[2], v1[3]);
                    *(u32x4*)(rowp + bj * HALF) = w; } }
    }
};

template <class Epi, class Sched, bool ALIGN_EPI = false, bool SP2 = false>
__device__ __forceinline__ void gemm_phase(PG8_LAS unsigned char* lds, const Gemm g, const Sched& S, const Epi& E) {
    const int tid = threadIdx.x, wid = __builtin_amdgcn_readfirstlane(tid >> 6), lane = tid & 63, wr = wid >> 2, wc = wid & 3, fr = lane & 15, fq = lane >> 4;
    const int K = g.K, nt = K / BK;
    unsigned voffB[2], vA0[2], vA1[2], nA0[2], nA1[2]; int Rr[2], Cc[2];
#pragma unroll
    for (int i = 0; i < 2; ++i) { int R, C; stage_rc(tid * 16 + i * 8192, R, C); const int Rb = Epi::PERM ? ((R & ~31) + perm32(R & 31)) : R;
        Rr[i] = R; Cc[i] = C; vA0[i] = vA1[i] = nA0[i] = nA1[i] = (unsigned)(R * K + C) * 2u; voffB[i] = (unsigned)(Rb * K + C) * 2u; }
#define PG8_GOFF(u, d0, d1) do { if constexpr (Sched::GATHER) { _Pragma("unroll") for (int _i = 0; _i < 2; ++_i) { d0[_i] = S.arow_off(u, Rr[_i]) + (unsigned)Cc[_i] * 2u; d1[_i] = S.arow_off(u, HALF + Rr[_i]) + (unsigned)Cc[_i] * 2u; } } } while (0)
    const size_t kstep = (size_t)(BK * 2);
    const size_t hstep = (size_t)HALF * K * 2;
    const size_t hstepA = Sched::GATHER ? (size_t)0 : hstep;
    const size_t tstep = 2 * hstep;
    const unsigned ldsw = (unsigned)wid * 1024u;
    const int aoff = lds_byte(wr * 64 + fr, fq * 8), boff = lds_byte(wc * 32 + fr, fq * 8);
#define PG8_SA(b, h) (((b) * 2 + (h)) * HTB)
#define PG8_SB(b, h) ((4 + (b) * 2 + (h)) * HTB)
#define PG8_STAGE(bufoff, gbase, voff) do { _Pragma("unroll") for (int _i = 0; _i < 2; ++_i) \
        __builtin_amdgcn_global_load_lds((const unsigned*)((const char*)(gbase) + (voff)[_i]), (PG8_LAS unsigned*)(lds + (bufoff) + ldsw + _i * 8192), 16, 0, 0); } while (0)
#define PG8_LDA(dst, b, h) do { _Pragma("unroll") for (int m = 0; m < 4; ++m) _Pragma("unroll") for (int k = 0; k < 2; ++k) dst[m][k] = *(const PG8_LAS bf16x8*)(lds + PG8_SA(b, h) + aoff + m * 2048 + k * 1024); } while (0)
#define PG8_LDB(dst, b, h) do { _Pragma("unroll") for (int n = 0; n < 2; ++n) _Pragma("unroll") for (int k = 0; k < 2; ++k) dst[n][k] = *(const PG8_LAS bf16x8*)(lds + PG8_SB(b, h) + boff + n * 2048 + k * 1024); } while (0)
#define PG8_MMA(ai, bj, At, Bt) do { __builtin_amdgcn_s_setprio(1); _Pragma("unroll") for (int m = 0; m < 4; ++m) _Pragma("unroll") for (int n = 0; n < 2; ++n) _Pragma("unroll") for (int k = 0; k < 2; ++k) \
        acc[ai][bj][m][n] = __builtin_amdgcn_mfma_f32_16x16x32_bf16(Bt[n][k], At[m][k], acc[ai][bj][m][n], 0, 0, 0); __builtin_amdgcn_s_setprio(0); } while (0)
#define PG8_WAIT_V(n) asm volatile("s_waitcnt vmcnt(" #n ")" ::: "memory")
#define PG8_WAIT_L(n) asm volatile("s_waitcnt lgkmcnt(" #n ")" ::: "memory")
#define PG8_BAR __builtin_amdgcn_s_barrier()
#define PG8_SCHED __builtin_amdgcn_sched_barrier(0)
    Unit cur, nxt; int ui = 0;
    if (!S.next(0, cur)) return;
    f32x4 acc[2][2][4][2];
#pragma unroll
    for (int a = 0; a < 2; ++a)
#pragma unroll
        for (int b = 0; b < 2; ++b)
#pragma unroll
            for (int m = 0; m < 4; ++m)
#pragma unroll
                for (int n = 0; n < 2; ++n) acc[a][b][m][n] = (f32x4){0.f, 0.f, 0.f, 0.f};
    bf16x8 At[4][2], B0[2][2], B1[2][2];
    const char* cA = (const char*)g.A + (Sched::GATHER ? (size_t)0 : (size_t)cur.pm * tstep); const char* cB = (const char*)g.Bt + (size_t)cur.pn * tstep;
    PG8_GOFF(cur, vA0, vA1);
    S.a_ready(cur);
    if constexpr (SP2) {
        PG8_STAGE(PG8_SB(0, 0), cB, voffB); PG8_STAGE(PG8_SB(0, 1), cB + hstep, voffB); PG8_STAGE(PG8_SA(0, 0), cA, vA0); PG8_STAGE(PG8_SA(0, 1), cA + hstepA, vA1);
        if (wr == 1) PG8_BAR;
        PG8_WAIT_V(2); PG8_BAR;
        PG8_STAGE(PG8_SB(1, 0), cB + kstep, voffB); PG8_STAGE(PG8_SA(1, 0), cA + kstep, vA0); PG8_STAGE(PG8_SB(1, 1), cB + hstep + kstep, voffB);
        PG8_WAIT_V(6); PG8_BAR;
    } else {
        PG8_STAGE(PG8_SB(0, 0), cB, voffB); PG8_STAGE(PG8_SA(0, 0), cA, vA0); PG8_STAGE(PG8_SB(0, 1), cB + hstep, voffB); PG8_STAGE(PG8_SA(0, 1), cA + hstepA, vA1);
        if (wr == 1) PG8_BAR;
        PG8_WAIT_V(4); PG8_BAR;
        PG8_STAGE(PG8_SB(1, 0), cB + kstep, voffB); PG8_STAGE(PG8_SA(1, 0), cA + kstep, vA0); PG8_STAGE(PG8_SB(1, 1), cB + hstep + kstep, voffB);
        PG8_WAIT_V(6); PG8_BAR;
    }
    for (;;) {
        const bool has_next = S.next(ui + 1, nxt);
        const char* nA = has_next ? (const char*)g.A + (Sched::GATHER ? (size_t)0 : (size_t)nxt.pm * tstep) : cA; const char* nB = has_next ? (const char*)g.Bt + (size_t)nxt.pn * tstep : cB;
        if constexpr (Sched::GATHER) { if (has_next) { PG8_GOFF(nxt, nA0, nA1); } else {
#pragma unroll
            for (int _i = 0; _i < 2; ++_i) { nA0[_i] = vA0[_i]; nA1[_i] = vA1[_i]; } } }
        for (int t = 0; t < nt; t += 2) {
            const bool last = (t == nt - 2);
            const char* a1 = cA + (size_t)(t + 1) * kstep;
            const char* a2 = last ? nA : cA + (size_t)(t + 2) * kstep; const char* b2 = last ? nB : cB + (size_t)(t + 2) * kstep;
            const char* a3 = a2 + kstep; const char* b3 = b2 + kstep;
            if (last && has_next) S.a_ready(nxt);
            unsigned wA0[2], wA1[2];
#pragma unroll
            for (int _i = 0; _i < 2; ++_i) { wA0[_i] = (Sched::GATHER && last) ? nA0[_i] : vA0[_i]; wA1[_i] = (Sched::GATHER && last) ? nA1[_i] : vA1[_i]; }
            if constexpr (SP2) {
            PG8_LDB(B0, 0, 0); PG8_LDB(B1, 0, 1); PG8_SCHED; PG8_LDA(At, 0, 0); PG8_STAGE(PG8_SA(1, 1), a1 + hstepA, vA1);
            PG8_WAIT_V(8); PG8_WAIT_L(0); PG8_BAR; PG8_MMA(0, 0, At, B0); PG8_MMA(0, 1, At, B1); PG8_BAR; PG8_SCHED;
            PG8_LDA(At, 0, 1); PG8_STAGE(PG8_SB(0, 0), b2, voffB); PG8_STAGE(PG8_SB(0, 1), b2 + hstep, voffB); PG8_STAGE(PG8_SA(0, 0), a2, wA0);
            PG8_WAIT_V(8); PG8_WAIT_L(0); PG8_BAR; PG8_MMA(1, 0, At, B0); PG8_MMA(1, 1, At, B1); PG8_BAR; PG8_SCHED;
            PG8_LDB(B0, 1, 0); PG8_LDB(B1, 1, 1); PG8_SCHED; PG8_LDA(At, 1, 0); PG8_STAGE(PG8_SA(0, 1), a2 + hstepA, wA1);
            PG8_WAIT_V(8); PG8_WAIT_L(0); PG8_BAR; PG8_MMA(0, 0, At, B0); PG8_MMA(0, 1, At, B1); PG8_BAR; PG8_SCHED;
            PG8_LDA(At, 1, 1); PG8_STAGE(PG8_SB(1, 0), b3, voffB); PG8_STAGE(PG8_SB(1, 1), b3 + hstep, voffB); PG8_STAGE(PG8_SA(1, 0), a3, wA0);
            PG8_WAIT_V(8); PG8_WAIT_L(0); PG8_BAR; PG8_MMA(1, 0, At, B0); PG8_MMA(1, 1, At, B1); PG8_BAR; PG8_SCHED;
            } else {
            PG8_LDB(B0, 0, 0); PG8_SCHED; PG8_LDA(At, 0, 0); PG8_STAGE(PG8_SA(1, 1), a1 + hstepA, vA1);
            PG8_WAIT_L(8); PG8_BAR; PG8_WAIT_L(0); PG8_MMA(0, 0, At, B0); PG8_BAR; PG8_SCHED;
            PG8_LDB(B1, 0, 1); PG8_STAGE(PG8_SB(0, 0), b2, voffB);
            PG8_BAR; PG8_WAIT_L(0); PG8_MMA(0, 1, At, B1); PG8_BAR;
            PG8_LDA(At, 0, 1); PG8_STAGE(PG8_SA(0, 0), a2, wA0);
            PG8_BAR; PG8_WAIT_L(0); PG8_MMA(1, 0, At, B0); PG8_BAR; PG8_SCHED;
            PG8_STAGE(PG8_SB(0, 1), b2 + hstep, voffB);
            PG8_WAIT_V(6); PG8_BAR; PG8_MMA(1, 1, At, B1); PG8_BAR;
            PG8_LDB(B0, 1, 0); PG8_SCHED; PG8_LDA(At, 1, 0); PG8_STAGE(PG8_SA(0, 1), a2 + hstepA, wA1);
            PG8_WAIT_L(8); PG8_BAR; PG8_WAIT_L(0); PG8_MMA(0, 0, At, B0); PG8_BAR; PG8_SCHED;
            PG8_LDB(B1, 1, 1); PG8_STAGE(PG8_SB(1, 0), b3, voffB);
            PG8_BAR; PG8_WAIT_L(0); PG8_MMA(0, 1, At, B1); PG8_BAR;
            PG8_LDA(At, 1, 1); PG8_STAGE(PG8_SA(1, 0), a3, wA0);
            PG8_BAR; PG8_WAIT_L(0); PG8_MMA(1, 0, At, B0); PG8_BAR; PG8_SCHED;
            PG8_STAGE(PG8_SB(1, 1), b3 + hstep, voffB);
            PG8_WAIT_V(6); PG8_BAR; PG8_MMA(1, 1, At, B1); PG8_BAR;
            }
        }
        if constexpr (ALIGN_EPI) { if (wr == 0) PG8_BAR; }
        if constexpr (!Epi::AFTER_DRAIN) { E(acc, cur, wr, wc, fr, fq); S.done(cur); }
        if (!has_next) break;
#pragma unroll
        for (int a = 0; a < 2; ++a)
#pragma unroll
            for (int b = 0; b < 2; ++b)
#pragma unroll
                for (int m = 0; m < 4; ++m)
#pragma unroll
                    for (int n = 0; n < 2; ++n) acc[a][b][m][n] = (f32x4){0.f, 0.f, 0.f, 0.f};
        cur = nxt; cA = nA; cB = nB; ++ui;
#pragma unroll
        for (int _i = 0; _i < 2; ++_i) { vA0[_i] = nA0[_i]; vA1[_i] = nA1[_i]; }
        if constexpr (ALIGN_EPI) { if (wr == 1) PG8_BAR; }
    }
    PG8_WAIT_V(0);
    if constexpr (!ALIGN_EPI) { if (wr == 0) PG8_BAR; }
    PG8_BAR;
    if constexpr (Epi::AFTER_DRAIN) { E.fused(acc, cur, wr, wc, fr, fq, lds, wid, lane); S.done(cur); }
#undef PG8_GOFF
#undef PG8_SA
#undef PG8_SB
#undef PG8_STAGE
#undef PG8_LDA
#undef PG8_LDB
#undef PG8_MMA
#undef PG8_WAIT_V
#undef PG8_WAIT_L
#undef PG8_BAR
#undef PG8_SCHED
}
}

#ifndef PG8_SP2
#define PG8_SP2 true
#endif

#include <hip/hip_bf16.h>
#include <cmath>
namespace attn_body {
using bf16=__hip_bfloat16;
using bf16x8=__attribute__((ext_vector_type(8)))short;
using s16x4=__attribute__((ext_vector_type(4)))short;
using f32x16=__attribute__((ext_vector_type(16)))float;
using u32x4=__attribute__((ext_vector_type(4)))unsigned;
constexpr int BATCH=4,NHEAD=16,SEQ=4096,D=64,PQ=512,PO=1024;
constexpr int NW=8,QBLK=32,QB=QBLK*NW,KVBLK=64,NQB=SEQ/QB;
constexpr int ATTN_UNIT_ROWS=QB;
__device__ __forceinline__ int crow(int r,int hi){return (r&3)+8*(r>>2)+4*hi;}
#define SBAR() __builtin_amdgcn_sched_barrier(0)
__device__ __forceinline__ void cmask(f32x16&p0,f32x16&p1,int jb,int qrel,int hi){
  const float NEG=-INFINITY; int kb=64*jb+4*hi;
  #pragma unroll
  for(int r=0;r<16;++r){int kv=kb+(r&3)+8*(r>>2); if(kv>qrel)p0[r]=NEG; if(kv+32>qrel)p1[r]=NEG;}
}

constexpr int NSLOT=3, SLOTB=8192;
constexpr int LDS_K=0, LDS_V=NSLOT*SLOTB, LDS_WS=2*NSLOT*SLOTB, LDS_OST=LDS_WS+NW*64*4, LDS_BYTES=LDS_OST+NW*4096;
constexpr float C2=0.125f*1.4426950408889634f;
__device__ __forceinline__ void glds16(const void*gsrc,unsigned lds_dst){unsigned keep;
  asm volatile("s_mov_b32 %0, m0\n\ts_mov_b32 m0, %2\n\ts_nop 0\n\tglobal_load_lds_dwordx4 %1, off\n\ts_mov_b32 m0, %0":"=&s"(keep):"v"(gsrc),"s"(lds_dst):"memory");}
__device__ __forceinline__ float max3f(float a,float b,float c){float r;asm("v_max3_f32 %0, %1, %2, %3":"=v"(r):"v"(a),"v"(b),"v"(c));return r;}
__device__ __forceinline__ float max2f(float a,float b){float r;asm("v_max_f32_e32 %0, %1, %2":"=v"(r):"v"(a),"v"(b));return r;}
__device__ __forceinline__ float fadd_s(float a,float b){float r;asm("v_add_f32_e32 %0, %1, %2":"=v"(r):"v"(a),"v"(b));return r;}
__device__ __forceinline__ float fsub_s(float a,float b){float r;asm("v_sub_f32_e32 %0, %1, %2":"=v"(r):"v"(a),"v"(b));return r;}
typedef float f32x2_t __attribute__((ext_vector_type(2))); typedef __bf16 bf16x2_t __attribute__((ext_vector_type(2)));
__device__ __forceinline__ unsigned cvtpk_s(float lo,float hi){f32x2_t v={lo,hi};bf16x2_t b=__builtin_convertvector(v,bf16x2_t);return __builtin_bit_cast(unsigned,b);}
#define WAIT_BAR(N) asm volatile("s_waitcnt vmcnt(" #N ") lgkmcnt(0)\n\ts_barrier":::"memory")

__device__ __forceinline__ void qkt(f32x16&p0,f32x16&p1,const char*Kslot,const bf16x8*qr,const f32x16&negm,int r32,int hi){
  const char*kb=Kslot+hi*1024+r32*16;
  #pragma unroll
  for(int d0=0;d0<4;++d0){
    const bf16x8 b0=*reinterpret_cast<const bf16x8*>(kb+d0*2048);
    const bf16x8 b1=*reinterpret_cast<const bf16x8*>(kb+d0*2048+512);
    if(d0==0){p0=__builtin_amdgcn_mfma_f32_32x32x16_bf16(b0,qr[0],negm,0,0,0);p1=__builtin_amdgcn_mfma_f32_32x32x16_bf16(b1,qr[0],negm,0,0,0);}
    else{p0=__builtin_amdgcn_mfma_f32_32x32x16_bf16(b0,qr[d0],p0,0,0,0);p1=__builtin_amdgcn_mfma_f32_32x32x16_bf16(b1,qr[d0],p1,0,0,0);}}
}
typedef __attribute__((address_space(3))) const char* lds_cptr;
typedef short v4i16_t __attribute__((ext_vector_type(4)));
__device__ __forceinline__ void kload8(bf16x8*kf,lds_cptr kp){
  kf[0]=*(const __attribute__((address_space(3))) bf16x8*)(kp);      kf[1]=*(const __attribute__((address_space(3))) bf16x8*)(kp+512);
  kf[2]=*(const __attribute__((address_space(3))) bf16x8*)(kp+2048); kf[3]=*(const __attribute__((address_space(3))) bf16x8*)(kp+2560);
  kf[4]=*(const __attribute__((address_space(3))) bf16x8*)(kp+4096); kf[5]=*(const __attribute__((address_space(3))) bf16x8*)(kp+4608);
  kf[6]=*(const __attribute__((address_space(3))) bf16x8*)(kp+6144); kf[7]=*(const __attribute__((address_space(3))) bf16x8*)(kp+6656);
}
__device__ __forceinline__ void kload2(bf16x8*kf,lds_cptr kp,int j){ kf[2*j]=*(const __attribute__((address_space(3))) bf16x8*)(kp+j*2048); kf[2*j+1]=*(const __attribute__((address_space(3))) bf16x8*)(kp+j*2048+512); }
__device__ __forceinline__ s16x4 vtr(lds_cptr p){ return __builtin_bit_cast(s16x4,__builtin_amdgcn_ds_read_tr16_b64_v4i16((__attribute__((address_space(3))) v4i16_t*)p)); }
__device__ __forceinline__ float rowmax(const f32x16&p0,const f32x16&p1){
  float a=max3f(p0[0],p0[1],p1[0]),b=max3f(p0[2],p0[3],p1[1]);a=max3f(a,p1[2],p1[3]);
  #pragma unroll
  for(int r=4;r<16;r+=4){a=max3f(a,p0[r],p0[r+1]);b=max3f(b,p0[r+2],p0[r+3]);a=max3f(a,p1[r],p1[r+1]);b=max3f(b,p1[r+2],p1[r+3]);}
  const float m=max2f(a,b);
  auto rr=__builtin_amdgcn_permlane32_swap(__float_as_uint(m),__float_as_uint(m),false,false);
  return max2f(__uint_as_float(rr[0]),__uint_as_float(rr[1]));
}
__device__ __forceinline__ void pv(f32x16*o,int vb,bf16x8 pa0,bf16x8 pa1,bf16x8 pa2,bf16x8 pa3){
  #pragma unroll
  for(int d0=0;d0<2;++d0){s16x4 lo[4],hi[4];
    #pragma unroll
    for(int ks=0;ks<4;++ks){
      asm volatile("ds_read_b64_tr_b16 %0,%1 offset:%c2":"=&v"(lo[ks]):"v"(vb),"i"(d0*4096+ks*1024):"memory");
      asm volatile("ds_read_b64_tr_b16 %0,%1 offset:%c2":"=&v"(hi[ks]):"v"(vb),"i"(d0*4096+ks*1024+512):"memory");}
    asm volatile("s_waitcnt lgkmcnt(0)":::"memory");SBAR();
    #define PK(k) (bf16x8){lo[k][0],lo[k][1],lo[k][2],lo[k][3],hi[k][0],hi[k][1],hi[k][2],hi[k][3]}
    o[d0]=__builtin_amdgcn_mfma_f32_32x32x16_bf16(pa0,PK(0),o[d0],0,0,0);
    o[d0]=__builtin_amdgcn_mfma_f32_32x32x16_bf16(pa1,PK(1),o[d0],0,0,0);
    o[d0]=__builtin_amdgcn_mfma_f32_32x32x16_bf16(pa2,PK(2),o[d0],0,0,0);
    o[d0]=__builtin_amdgcn_mfma_f32_32x32x16_bf16(pa3,PK(3),o[d0],0,0,0);
    #undef PK
  }
}

#ifndef ATTN_STORE16
#define ATTN_STORE16(p,v) (*(u32x4*)(p)=(v))
#endif
template<int THRL> __device__ __forceinline__ void attn_unit(int b,int h,int qb,const bf16*Q,const bf16*__restrict__ K,const bf16*__restrict__ V,bf16*O,char*shm){
  const int tid=threadIdx.x,lane=tid&63,r32=lane&31,hi=lane>>5; const int wid=__builtin_amdgcn_readfirstlane(tid>>6);
  const long rowbase=(long)b*SEQ; const int q0=qb*QB;
  const int qkc=(h>>1)*D, vcol=(h>>2)*128+(h&1)*D;
  const bf16*Qw=Q+(rowbase+q0+wid*QBLK)*PQ+qkc;
  const bf16*Kh=K+rowbase*PQ+qkc,*Vh=V+rowbase*PQ+vcol;
  const unsigned lds0=(unsigned)(uintptr_t)shm;
  float*wsf=(float*)(shm+LDS_WS)+wid*64;
  const bf16*ksrc=Kh+(long)lane*PQ+wid*8;
  const bf16*vsrc=Vh+(long)(16*(wid&3)+(lane>>2))*PQ+(wid>>2)*32+(lane&3)*8;
  const unsigned kdst=lds0+LDS_K+wid*1024, vdst=lds0+LDS_V+wid*1024;
  #define DMA_K(t,slot) glds16(ksrc+(long)(t)*KVBLK*PQ,(unsigned)__builtin_amdgcn_readfirstlane(kdst+(slot)))
  #define DMA_V(t,slot) glds16(vsrc+(long)(t)*KVBLK*PQ,(unsigned)__builtin_amdgcn_readfirstlane(vdst+(slot)))
  const int vb0=(int)(lds0+LDS_V)+((lane>>4)&1)*32+(lane&3)*8+(4*hi+((lane&15)>>2))*64;
  const char*Kbase=shm+LDS_K; bf16x8 kf[8];
  const lds_cptr shm3=(lds_cptr)shm; const lds_cptr kp0=shm3+LDS_K+hi*1024+r32*16; const lds_cptr vp0=shm3+LDS_V+((lane>>4)&1)*32+(lane&3)*8+(4*hi+((lane&15)>>2))*64;
  const int NT=(q0+QB)/KVBLK;
  DMA_K(0,0);DMA_V(0,0);DMA_K(1,SLOTB);
  bf16x8 qr[4];
  #pragma unroll
  for(int d0=0;d0<4;++d0)qr[d0]=*reinterpret_cast<const bf16x8*>(&Qw[(long)r32*PQ+d0*16+hi*8]);
  float mhat=0.f,l_reg=0.f;f32x16 o[2];o[0]=f32x16{};o[1]=f32x16{};f32x16 negm=f32x16{};asm volatile("":"+v"(negm));
  const int qrel=wid*QBLK+r32;
  #define CMASK(P0,P1,t) do{int jb_=(t)-(NT-4); if(jb_>=0)cmask(P0,P1,jb_,qrel,hi);}while(0)
  bool resc=false;
  #define START(P0,P1) do{ const float rm=rowmax(P0,P1); resc=false; \
    { const float dl=rm; mhat=fadd_s(mhat,dl); \
      _Pragma("unroll") for(int r=0;r<16;++r){P0[r]=fsub_s(P0[r],dl);P1[r]=fsub_s(P1[r],dl);} \
      _Pragma("unroll") for(int r=0;r<16;++r)negm[r]=-mhat; asm volatile("":"+v"(negm)); } \
    _Pragma("unroll") for(int r=0;r<16;++r)P0[r]=__builtin_amdgcn_exp2f(P0[r]); }while(0)
  #define RESC() do{ if(resc){ asm volatile("s_waitcnt lgkmcnt(0)":::"memory"); \
      _Pragma("unroll") for(int d_=0;d_<2;++d_) _Pragma("unroll") for(int r=0;r<16;++r)o[d_][r]*=wsf[crow(r,hi)]; } }while(0)
  f32x16 pA0,pA1,pB0,pB1;
  int sl_prev=0,sl_cur=0,sl_next=SLOTB;
  #define ROT() do{sl_prev=sl_cur;sl_cur=sl_next;sl_next=(sl_next==(NSLOT-1)*SLOTB)?0:sl_next+SLOTB;}while(0)
  DMA_K(2,2*SLOTB);
  WAIT_BAR(3);
  qkt(pA0,pA1,Kbase,qr,negm,r32,hi);asm volatile("s_nop 15\n\ts_nop 7":"+v"(pA0),"+v"(pA1));CMASK(pA0,pA1,0);
  START(pA0,pA1);
  _Pragma("unroll") for(int r=0;r<16;++r)pA1[r]=__builtin_amdgcn_exp2f(pA1[r]);
  WAIT_BAR(0);
  DMA_K(3,0);DMA_V(1,SLOTB);
  ROT();
  kload8(kf,kp0+sl_cur);
  WAIT_BAR(2);
  s16x4 vlo[8],vhi[8]; u32x4 pw0,pw1,pw2,pw3;
  #define PKW(P,B) cvtpk_s(P[B],P[B+1])
  #define PAF(k) __builtin_bit_cast(bf16x8,pw##k)
  #define VFR(i) (bf16x8){vlo[i][0],vlo[i][1],vlo[i][2],vlo[i][3],vhi[i][0],vhi[i][1],vhi[i][2],vhi[i][3]}
  #define PIN(x) asm volatile("":"+v"(x))
  #define MX3(a,b,c) __builtin_fmaxf(__builtin_fmaxf((a),(b)),(c))
  #define GAPA(MF,A0,A1,A2,A3,W0,W1,PW) do{ MF; sacc+=A0; sacc+=A1; sacc+=A2; sacc+=A3; PIN(sacc); W0; W1; PIN(PW); SBAR(); }while(0)
  #define EX(v) __builtin_amdgcn_exp2f(v)
  #define GAPB(MF,X,B) do{ MF; X[B]=EX(X[B]); X[B+1]=EX(X[B+1]); X[B+2]=EX(X[B+2]); X[B+3]=EX(X[B+3]); PIN(X); SBAR(); }while(0)
  #define VRD(i) do{ vlo[i]=vtr(vp_+(((i)>>2)*4096+((i)&3)*1024)); vhi[i]=vtr(vp_+(((i)>>2)*4096+((i)&3)*1024+512)); }while(0)
  #define KRD(G,j) do{ if(G){ kload2(kf,kp0+sl_next,j); SBAR(); } }while(0)
  #define STEP(C0,C1,P0,P1,t,GK,GV,GL) do{ SBAR(); \
    const lds_cptr vp_=vp0+sl_prev; \
    VRD(0); SBAR(); float sacc=(P0[0]+P0[1]); \
    GAPA(C0=__builtin_amdgcn_mfma_f32_32x32x16_bf16(kf[0],qr[0],negm,0,0,0), P0[2],P0[3],P0[4],P0[5],     pw0[0]=PKW(P0,0), pw0[1]=PKW(P0,2), pw0); \
    VRD(4); SBAR(); GAPA(C1=__builtin_amdgcn_mfma_f32_32x32x16_bf16(kf[1],qr[0],negm,0,0,0), P0[6],P0[7],P0[8],P0[9],     pw0[2]=PKW(P0,4), pw0[3]=PKW(P0,6), pw0); \
    VRD(1); SBAR(); GAPA(C0=__builtin_amdgcn_mfma_f32_32x32x16_bf16(kf[2],qr[1],C0,0,0,0),   P0[10],P0[11],P0[12],P0[13], pw1[0]=PKW(P0,8), pw1[1]=PKW(P0,10), pw1); \
    VRD(5); SBAR(); GAPA(C1=__builtin_amdgcn_mfma_f32_32x32x16_bf16(kf[3],qr[1],C1,0,0,0),   P0[14],P0[15],P1[0],P1[1],   pw1[2]=PKW(P0,12),pw1[3]=PKW(P0,14), pw1); \
    VRD(2); SBAR(); GAPA(C0=__builtin_amdgcn_mfma_f32_32x32x16_bf16(kf[4],qr[2],C0,0,0,0),   P1[2],P1[3],P1[4],P1[5],     pw2[0]=PKW(P1,0), pw2[1]=PKW(P1,2), pw2); \
    VRD(6); SBAR(); GAPA(C1=__builtin_amdgcn_mfma_f32_32x32x16_bf16(kf[5],qr[2],C1,0,0,0),   P1[6],P1[7],P1[8],P1[9],     pw2[2]=PKW(P1,4), pw2[3]=PKW(P1,6), pw2); \
    VRD(3); SBAR(); GAPA(C0=__builtin_amdgcn_mfma_f32_32x32x16_bf16(kf[6],qr[3],C0,0,0,0),   P1[10],P1[11],P1[12],P1[13], pw3[0]=PKW(P1,8), pw3[1]=PKW(P1,10), pw3); \
    VRD(7); SBAR(); GAPA(C1=__builtin_amdgcn_mfma_f32_32x32x16_bf16(kf[7],qr[3],C1,0,0,0),   P1[14],P1[15],0.f,0.f,       pw3[2]=PKW(P1,12),pw3[3]=PKW(P1,14), pw3); \
    l_reg+=sacc; \
    if(GK){DMA_K((t)+3,sl_cur);} if(GV){DMA_V((t)+1,sl_next);} \
    CMASK(C0,C1,t); \
    { float a=MX3(C0[0],C0[1],C1[0]),b=MX3(C0[2],C0[3],C1[1]); a=MX3(a,C1[2],C1[3]); \
      _Pragma("unroll") for(int r=4;r<16;r+=4){a=MX3(a,C0[r],C0[r+1]);b=MX3(b,C0[r+2],C0[r+3]);a=MX3(a,C1[r],C1[r+1]);b=MX3(b,C1[r+2],C1[r+3]);} \
      float rm=__builtin_fmaxf(a,b); { auto rr=__builtin_amdgcn_permlane32_swap(__float_as_uint(rm),__float_as_uint(rm),false,false); rm=__builtin_fmaxf(__uint_as_float(rr[0]),__uint_as_float(rr[1])); } \
      resc=false; \
      if(__builtin_expect(__any(rm>(float)THRL),0)){ const float dl=__builtin_fmaxf(rm,0.f); mhat+=dl; \
        _Pragma("unroll") for(int r=0;r<16;++r){C0[r]-=dl;C1[r]-=dl;} \
        _Pragma("unroll") for(int r=0;r<16;++r)negm[r]=-mhat; asm volatile("":"+v"(negm)); \
        const float f=__builtin_amdgcn_exp2f(-dl); l_reg*=f; if(hi==0)wsf[r32]=f; resc=true; } } \
    SBAR(); \
    GAPB(o[0]=__builtin_amdgcn_mfma_f32_32x32x16_bf16(PAF(0),VFR(0),o[0],0,0,0), C0,0); \
    GAPB(o[1]=__builtin_amdgcn_mfma_f32_32x32x16_bf16(PAF(0),VFR(4),o[1],0,0,0), C0,4); \
    KRD(GL,0); GAPB(o[0]=__builtin_amdgcn_mfma_f32_32x32x16_bf16(PAF(1),VFR(1),o[0],0,0,0), C0,8); \
    KRD(GL,1); GAPB(o[1]=__builtin_amdgcn_mfma_f32_32x32x16_bf16(PAF(1),VFR(5),o[1],0,0,0), C0,12); \
    KRD(GL,2); GAPB(o[0]=__builtin_amdgcn_mfma_f32_32x32x16_bf16(PAF(2),VFR(2),o[0],0,0,0), C1,0); \
    KRD(GL,3); GAPB(o[1]=__builtin_amdgcn_mfma_f32_32x32x16_bf16(PAF(2),VFR(6),o[1],0,0,0), C1,4); \
    GAPB(o[0]=__builtin_amdgcn_mfma_f32_32x32x16_bf16(PAF(3),VFR(3),o[0],0,0,0), C1,8); \
    GAPB(o[1]=__builtin_amdgcn_mfma_f32_32x32x16_bf16(PAF(3),VFR(7),o[1],0,0,0), C1,12); \
    }while(0)
  int t=1;
  #undef CMASK
  #define CMASK(P0,P1,t) do{}while(0)
  for(;t+5<NT;t+=2){
    STEP(pB0,pB1,pA0,pA1,t,true,true,true);     WAIT_BAR(2); RESC(); ROT();
    STEP(pA0,pA1,pB0,pB1,t+1,true,true,true);   WAIT_BAR(2); RESC(); ROT();
  }
  #undef CMASK
  #define CMASK(P0,P1,t) do{int jb_=(t)-(NT-4); if(jb_>=0)cmask(P0,P1,jb_,qrel,hi);}while(0)
  #define ENDW(tt) do{ if((tt)+3<NT){WAIT_BAR(2);} else if((tt)+2<NT){WAIT_BAR(1);} else {WAIT_BAR(0);} }while(0)
  for(;t+1<NT;t+=2){
    STEP(pB0,pB1,pA0,pA1,t,(t+3<NT),(t+1<NT),(t+1<NT));       ENDW(t);   RESC(); ROT();
    STEP(pA0,pA1,pB0,pB1,t+1,(t+4<NT),(t+2<NT),(t+2<NT));     ENDW(t+1); RESC(); ROT();
  }
  STEP(pB0,pB1,pA0,pA1,NT-1,false,false,false); RESC();
  { float sacc=pB0[0]+pB0[1]; _Pragma("unroll") for(int r=2;r<16;++r)sacc+=pB0[r]; _Pragma("unroll") for(int r=0;r<16;++r)sacc+=pB1[r]; l_reg+=sacc;
    pw0=(u32x4){PKW(pB0,0),PKW(pB0,2),PKW(pB0,4),PKW(pB0,6)};pw1=(u32x4){PKW(pB0,8),PKW(pB0,10),PKW(pB0,12),PKW(pB0,14)};pw2=(u32x4){PKW(pB1,0),PKW(pB1,2),PKW(pB1,4),PKW(pB1,6)};pw3=(u32x4){PKW(pB1,8),PKW(pB1,10),PKW(pB1,12),PKW(pB1,14)};
    SBAR(); pv(o,vb0+sl_cur,PAF(0),PAF(1),PAF(2),PAF(3)); }
  #undef PKW
  #undef PAF
  #undef VFR
  #undef PIN
  #undef MX3
  #undef GAPA
  #undef GAPB
  #undef EX
  #undef VRD
  #undef KRD
  #undef STEP
  #undef ENDW
  {auto rr=__builtin_amdgcn_permlane32_swap(__float_as_uint(l_reg),__float_as_uint(l_reg),false,false);l_reg=__uint_as_float(rr[0])+__uint_as_float(rr[1]);}
  if(hi==0)wsf[32+r32]=l_reg;asm volatile("s_waitcnt lgkmcnt(0)":::"memory");
  float rli[16];
  #pragma unroll
  for(int r=0;r<16;++r)rli[r]=__builtin_amdgcn_rcpf(wsf[32+crow(r,hi)]);
  bf16*Ow=O+(rowbase+q0+wid*QBLK)*PO+h*D;
  { bf16*stg=(bf16*)(shm+LDS_OST)+wid*2048;
    #pragma unroll
    for(int r=0;r<16;++r){const int orow=crow(r,hi);
      #pragma unroll
      for(int d0=0;d0<2;++d0)stg[orow*64+d0*32+r32]=__float2bfloat16(o[d0][r]*rli[r]);}
    asm volatile("s_waitcnt lgkmcnt(0)":::"memory");
    #pragma unroll
    for(int i=0;i<4;++i){const int row=i*8+(lane>>3),ch=lane&7; const u32x4 v=*(const u32x4*)(stg+row*64+ch*8); ATTN_STORE16(Ow+(long)row*PO+ch*8,v);} }
  asm volatile("s_waitcnt lgkmcnt(0)\n\ts_barrier":::"memory");
  #undef DMA_K
  #undef DMA_V
  #undef CMASK
  #undef START
  #undef RESC
  #undef ROT
}
constexpr int ATTN_LDS_BYTES=LDS_BYTES;
struct AttnTensors { const bf16* Q; const bf16* K; const bf16* V; bf16* O; };
struct AttnUnit { int bh; int qb; };
struct StaticOrder {
  int vcu;
  __device__ __forceinline__ explicit StaticOrder(int grid,int block):vcu((block%8)*(grid/8)+block/8){}
  __device__ __forceinline__ bool next(int i,AttnUnit&u)const{ if(i>=4)return false; const int s=vcu&3; u.bh=vcu>>2; u.qb=(i==0)?s:(i==1)?7-s:(i==2)?8+s:15-s; return true; }
  __device__ __forceinline__ void a_ready(const AttnUnit&)const{}
  __device__ __forceinline__ void done(const AttnUnit&)const{}
};
template<class Sched,int THRL=8> __device__ __forceinline__ void attn_phase(char*lds,const AttnTensors&T,const Sched&S){
  AttnUnit u;
  for(int i=0;S.next(i,u);++i){ S.a_ready(u); attn_unit<THRL>(u.bh/NHEAD,u.bh%NHEAD,u.qb,T.Q,T.K,T.V,T.O,lds); S.done(u); }
}
#undef SBAR
#undef WAIT_BAR
}

#define GAS __attribute__((address_space(1)))
#define LAS __attribute__((address_space(3)))
typedef unsigned short bf16;
typedef unsigned v4u __attribute__((ext_vector_type(4)));
typedef float f32x4 __attribute__((ext_vector_type(4)));
typedef short bf16x8 __attribute__((ext_vector_type(8)));
typedef GAS unsigned gu32;
typedef GAS unsigned long long gu64;
#define RLX_AGENT __ATOMIC_RELAXED, __HIP_MEMORY_SCOPE_AGENT
#define LDS_WAIT() asm volatile("s_waitcnt lgkmcnt(0)" ::: "memory")
#define VM_WAIT() asm volatile("s_waitcnt vmcnt(0)" ::: "memory")
__device__ __forceinline__ unsigned long long rt() { return __builtin_amdgcn_s_memrealtime(); }
__device__ __forceinline__ unsigned f2bf(float f) { unsigned u = __builtin_bit_cast(unsigned, f); return (u + 0x7fffu + ((u >> 16) & 1u)) >> 16; }
__device__ __forceinline__ unsigned pk2(float lo, float hi) { return f2bf(lo) | (f2bf(hi) << 16); }

#define XB_TMO      128
#define XB_XCNT(j)  (256  + 64 * (j))
#define XB_XSUB(j)  (1280 + 64 * (j))
#define XB_XGEN(j)  (2304 + 64 * (j))
#define XB_TOP      3328
#define XB_TOPGEN   3392
#define XCD_BAR_WORDS 3456
#define XB_SPIN_CAP (1u << 18)

__device__ __forceinline__ unsigned xb_ld(unsigned* p)              { return __hip_atomic_load(p, __ATOMIC_RELAXED, __HIP_MEMORY_SCOPE_AGENT); }
__device__ __forceinline__ unsigned xb_add(unsigned* p, unsigned v) { return __hip_atomic_fetch_add(p, v, __ATOMIC_RELAXED, __HIP_MEMORY_SCOPE_AGENT); }
__device__ __forceinline__ unsigned xb_xcc_id() { return (unsigned)__builtin_amdgcn_s_getreg((3 << 11) | 20) & 0xFu; }
#define XB_SPIN(cond, bar) do { unsigned _sp = 0; while (cond) { __builtin_amdgcn_s_sleep(1); \
    if ((++_sp & 255u) == 0u) { if (xb_ld(&(bar)[XB_TMO])) break; if (_sp > XB_SPIN_CAP) { atomicAdd(&(bar)[XB_TMO], 1u); break; } } } } while (0)

struct XcdBarrier {
    unsigned* bar; unsigned x;
    volatile LAS unsigned* st;
};

__device__ __forceinline__ XcdBarrier xcd_barrier_post(unsigned* bar, volatile LAS unsigned* st) {
    XcdBarrier b; b.bar = bar; b.x = xb_xcc_id(); b.st = st;
    if (threadIdx.x == 0) (void)xb_add(&bar[XB_XCNT(b.x)], 1u);
    return b;
}
__device__ __forceinline__ void xcd_barrier_complete(unsigned* bar, unsigned x, unsigned& nloc, unsigned& nx) {
    const unsigned G = gridDim.x * gridDim.y * gridDim.z;
    unsigned sum, cnt, mine, sp = 0u;
    for (;;) {
        sum = 0u; cnt = 0u; mine = 0u;
#pragma unroll
        for (unsigned j = 0; j < 16; ++j) { const unsigned c = xb_ld(&bar[XB_XCNT(j)]); sum += c; cnt += (c > 0u) ? 1u : 0u; mine = (j == x) ? c : mine; }
        if (sum == G) break;
        __builtin_amdgcn_s_sleep(1);
        if ((++sp & 255u) == 0u) { if (xb_ld(&bar[XB_TMO])) break; if (sp > XB_SPIN_CAP) { atomicAdd(&bar[XB_TMO], 1u); break; } }
    }
    nloc = mine > 0u ? mine : 1u; nx = cnt > 0u ? cnt : 1u;
}

__device__ __forceinline__ void xcd_barrier(const XcdBarrier& b) {
    asm volatile("s_waitcnt vmcnt(0)" ::: "memory");
    __syncthreads();
    if (threadIdx.x == 0) {
        unsigned* bar = b.bar;
        __builtin_amdgcn_s_waitcnt(0);
        unsigned nloc = b.st[0], nx = b.st[1];
        if (nloc == 0u) { xcd_barrier_complete(bar, b.x, nloc, nx); b.st[0] = nloc; b.st[1] = nx; }
        const unsigned old = xb_add(&bar[XB_XSUB(b.x)], 1u);
        const unsigned gen = old / nloc;
        if (old + 1u == (gen + 1u) * nloc) {
            __builtin_amdgcn_fence(__ATOMIC_RELEASE, "agent");
            asm volatile("s_waitcnt vmcnt(0)" ::: "memory");
            const unsigned og = xb_add(&bar[XB_TOP], 1u);
            const unsigned tg = og / nx;
            if (og + 1u == (tg + 1u) * nx) xb_add(&bar[XB_TOPGEN], 1u);
            else XB_SPIN(xb_ld(&bar[XB_TOPGEN]) == tg, bar);
            __builtin_amdgcn_fence(__ATOMIC_ACQUIRE, "agent");
            xb_add(&bar[XB_XGEN(b.x)], 1u);
            asm volatile("s_waitcnt vmcnt(0)" ::: "memory");
        } else {
            XB_SPIN(xb_ld(&bar[XB_XGEN(b.x)]) == gen, bar);
            __builtin_amdgcn_fence(__ATOMIC_ACQUIRE, "agent");
            asm volatile("s_waitcnt vmcnt(0)" ::: "memory");
        }
    }
    __syncthreads();
}


constexpr int NWAVES = 8;
constexpr int BATCH = 4, SEQ = 4096, DM = 1024, M = BATCH * SEQ, IN_COLS = 5632, NEXP = 32, EFF = 512;
constexpr float EPS = 1e-6f;
constexpr float LAM_INIT = 0.2f;
constexpr int MAXROWS = 2 * M + NEXP * 255;
#ifndef MK_PER_PHASE
#define MK_PER_PHASE 0
#endif
constexpr int N_PHASES = 13;
#ifndef PROBE_A
#define PROBE_A -1
#endif
#ifndef PROBE_B
#define PROBE_B -1
#endif
constexpr bool PROBING = (PROBE_A >= 0) || (PROBE_B >= 0);
constexpr int MI_TS = 128;

constexpr size_t MiB = 1u << 20;
constexpr size_t WS_CTL = 0, CTL_ZERO_BYTES = 1 * MiB;
constexpr size_t WS_WIN = 1 * MiB, WS_WA = 12 * MiB, WS_WB = 13 * MiB, WS_WOUT = 14 * MiB;
constexpr size_t WS_TABA = 16 * MiB, WS_TABB = 17 * MiB, WS_WRP = 25 * MiB;
constexpr size_t WS_SSQ = 16 * MiB;
constexpr size_t WS_H = 26 * MiB;
constexpr size_t WS_P = 58 * MiB, PBUF = 16 * MiB;
constexpr size_t WS_OA = 234 * MiB, WS_OB = 250 * MiB;
constexpr size_t WS_T = 58 * MiB, WS_MERGED = 122 * MiB;
constexpr size_t WS_Y = 58 * MiB;
constexpr size_t WS_XS = 58 * MiB, WS_HMID = 138 * MiB, WS_WGU = 178 * MiB, WS_WD = 242 * MiB;
constexpr size_t WS_ENT_TOK = 274 * MiB, WS_ENT_W = 276 * MiB, WS_ROW_TOK = 278 * MiB, WS_ROW_W = 278 * MiB + 512 * 1024, WS_END = 279 * MiB;
static_assert((size_t)MAXROWS * 1024 * 2 <= WS_HMID - WS_XS && (size_t)MAXROWS * 512 * 2 <= WS_WGU - WS_HMID && (size_t)MAXROWS * 4 <= 512 * 1024, "ws map");
constexpr int CW_TMO = 0, CW_CODE = 1, CW_CNT = 64, CW_BAR = 4096;

constexpr int RING_OFF = 0, RING_BYTES = 131072;
constexpr int LDSCTL_OFF = RING_BYTES, MISC_OFF = LDSCTL_OFF + 320;
constexpr int LDS_BYTES = 147456;
constexpr int MI_CNT = 16, MI_TP = 48;


struct Args { const void* in[24]; float* out; unsigned char* ws; int ph_lo, ph_hi; };
#define FIN(i) ((const float*)args.in[i])
struct Frame {
    LAS unsigned char* lds;
    volatile LAS unsigned* MISC;
    gu32* ctl;
    int tid, lane, wave;
    int vcu, G;
    float* out; unsigned char* ws;
};
__device__ __forceinline__ float bflo(unsigned w) { return __uint_as_float(w << 16); }
__device__ __forceinline__ float bfhi(unsigned w) { return __uint_as_float(w & 0xffff0000u); }
__device__ __forceinline__ float wave_sum(float v) {
#pragma unroll
    for (int o = 1; o < 64; o <<= 1) v += __shfl_xor(v, o);
    return v;
}
__device__ __forceinline__ float sigmoidf_(float x) { return 1.0f / (1.0f + __expf(-x)); }
__device__ __forceinline__ float siluf_(float x) { return x / (1.0f + __expf(-x)); }
__device__ __forceinline__ void unpack8(const v4u r, float (&x)[8]) {
    x[0] = bflo(r.x); x[1] = bfhi(r.x); x[2] = bflo(r.y); x[3] = bfhi(r.y); x[4] = bflo(r.z); x[5] = bfhi(r.z); x[6] = bflo(r.w); x[7] = bfhi(r.w);
}
__device__ __forceinline__ v4u pack8(const float (&x)[8]) { v4u o; o.x = pk2(x[0], x[1]); o.y = pk2(x[2], x[3]); o.z = pk2(x[4], x[5]); o.w = pk2(x[6], x[7]); return o; }

__device__ __forceinline__ int win_row(int n) {
    const int t = n >> 9, pr = n & 511; int pos = pr;
    if (t <= 1) { const int d = pr & 63; pos = (pr & ~63) | (d < 16 ? (2 * (d & 7) + (d >> 3)) : d); }
    else if (t == 3 || t == 4) { const int d = pr & 127; pos = (pr & ~127) | (2 * (d & 63) + (d >> 6)); }
    const int sc = t * 512 + pos, lc = sc & 255;
    const int pc = 128 * ((lc >> 5) & 1) + 32 * (lc >> 6) + (lc & 31);
    return (sc & ~255) | pc;
}
__device__ __forceinline__ void transpose_item(const float* W, int N, bf16* WT, int ldt, int mode, LAS unsigned* scr, int kb, int nb, int lane) {
    const int k0 = 64 * kb, n0 = 64 * nb, n4 = 4 * (lane & 15);
    f32x4 a[8], b[8];
#pragma unroll
    for (int i = 0; i < 8; ++i) { const int kp = 4 * i + (lane >> 4); const float* p = W + (size_t)(k0 + 2 * kp) * N + n0 + n4; a[i] = *(const GAS f32x4*)p; b[i] = *(const GAS f32x4*)(p + N); }
#pragma unroll
    for (int i = 0; i < 8; ++i) { const int kp = 4 * i + (lane >> 4);
#pragma unroll
        for (int t = 0; t < 4; ++t) scr[(n4 + t) * 36 + kp] = pk2(a[i][t], b[i][t]); }
    LDS_WAIT(); asm volatile("" ::: "memory");
    const int c = lane & 7;
#pragma unroll
    for (int j = 0; j < 8; ++j) { const int n = (lane >> 3) + 8 * j; const v4u o = *(const LAS v4u*)(scr + n * 36 + 4 * c);
        const int nn = n0 + n; const int row = mode == 0 ? nn : mode == 3 ? win_row(nn) : ((nn >> 2) * 8 + (mode == 2 ? 4 : 0) + (nn & 3));
        *(GAS v4u*)(WT + (size_t)row * ldt + k0 + 8 * c) = o; }
    LDS_WAIT(); asm volatile("" ::: "memory");
}
__device__ __forceinline__ void sincos_acc(float ang, float& s, float& c) {
    const double t = (double)ang * 0.15915494309189535; const double fr = t - __builtin_rint(t);
    const float r = (float)(fr * 6.283185307179586);
    s = sinf(r); c = cosf(r);
}
__device__ __forceinline__ void p0_prologue(Frame& F, const Args& args) {
    LAS unsigned* scr = (LAS unsigned*)(F.lds + RING_OFF + F.wave * 16384);
    const int gw = F.vcu * NWAVES + F.wave, NGW = F.G * NWAVES;
    unsigned char* ws = F.ws;
    constexpr int I_IN = (DM / 64) * (IN_COLS / 64), I_A = (512 / 64) * (DM / 64), I_OUT = (DM / 64) * (DM / 64);
    for (int it = gw; it < I_IN + 2 * I_A + I_OUT; it += NGW) {
        int r = it;
        if (r < I_IN) { transpose_item(FIN(3), IN_COLS, (bf16*)(ws + WS_WIN), DM, 3, scr, r / (IN_COLS / 64), r % (IN_COLS / 64), F.lane); continue; } r -= I_IN;
        if (r < I_A) { transpose_item(FIN(13), DM, (bf16*)(ws + WS_WA), 512, 0, scr, r / (DM / 64), r % (DM / 64), F.lane); continue; } r -= I_A;
        if (r < I_A) { transpose_item(FIN(14), DM, (bf16*)(ws + WS_WB), 512, 0, scr, r / (DM / 64), r % (DM / 64), F.lane); continue; } r -= I_A;
        transpose_item(FIN(15), DM, (bf16*)(ws + WS_WOUT), DM, 0, scr, r / (DM / 64), r % (DM / 64), F.lane);
    }
    {
        const float* wgr = FIN(17); const float* wer = FIN(19); const float* g2 = FIN(16); v4u* Wp16 = (v4u*)(ws + WS_WRP);
        for (int idx = gw * 64 + F.lane; idx < 32 * 3 * 64; idx += NGW * 64) {
            const int l = idx & 63, kt = idx >> 6, t = kt % 3, ks = kt / 3, col = l & 15, q = l >> 4;
            float hi[8], lo[8];
#pragma unroll
            for (int j = 0; j < 8; ++j) { const int k = 32 * ks + 8 * q + j; const float w = g2[k] * ((t == 0) ? (col < 4 ? wgr[k * 4 + col] : 0.f) : wer[k * 32 + (t - 1) * 16 + col]);
                hi[j] = __uint_as_float(f2bf(w) << 16); lo[j] = w - hi[j]; }
            Wp16[(size_t)(kt * 2 + 0) * 64 + l] = pack8(hi); Wp16[(size_t)(kt * 2 + 1) * 64 + l] = pack8(lo);
        }
    }
    {
        const int* pos = (const int*)FIN(1); float* tabA = (float*)(ws + WS_TABA); float* tabB = (float*)(ws + WS_TABB);
        const float fB = powf(10000.0f, -(float)F.lane * (1.0f / 64.0f)), fA = powf(500000.0f, -(float)(F.lane & 7) * 0.125f);
        for (int tk = gw; tk < M; tk += NGW) {
            const float p = (float)pos[tk]; float s, c;
            sincos_acc(p * fB, s, c); tabB[(size_t)tk * 128 + F.lane] = c; tabB[(size_t)tk * 128 + 64 + F.lane] = s;
            if (F.lane < 8) { sincos_acc(p * fA, s, c); tabA[(size_t)tk * 16 + F.lane] = c; tabA[(size_t)tk * 16 + 8 + F.lane] = s; }
        }
    }
    {
        const float* g = FIN(2); bf16* H = (bf16*)(ws + WS_H);
        f32x4 gv[4];
#pragma unroll
        for (int j = 0; j < 4; ++j) gv[j] = ((const f32x4*)g)[F.lane + 64 * j];
        for (int m = gw; m < M; m += NGW) {
            const GAS f32x4* xr = (const GAS f32x4*)(FIN(0) + (size_t)m * DM) + F.lane;
            f32x4 v[4]; float s = 0.f;
#pragma unroll
            for (int j = 0; j < 4; ++j) { v[j] = xr[64 * j]; s += (v[j].x * v[j].x + v[j].y * v[j].y) + (v[j].z * v[j].z + v[j].w * v[j].w); }
            const float rstd = rsqrtf(wave_sum(s) * (1.f / DM) + EPS);
            GAS unsigned long long* o8 = (GAS unsigned long long*)(H + (size_t)m * DM) + F.lane;
#pragma unroll
            for (int j = 0; j < 4; ++j) o8[64 * j] = (unsigned long long)pk2(v[j].x * rstd * gv[j].x, v[j].y * rstd * gv[j].y) | ((unsigned long long)pk2(v[j].z * rstd * gv[j].z, v[j].w * rstd * gv[j].w) << 32);
        }
    }
}

__device__ __forceinline__ int rt_off(int row, int kb) { return row * 256 + ((((kb >> 4) ^ (row & 15)) << 4) | (kb & 15)); }
__device__ __forceinline__ bf16x8 rt_frag(const LAS unsigned char* tile, int r0, int ks, int lane) {
    return *(const LAS bf16x8*)(tile + rt_off(r0 + (lane & 15), ks * 64 + 16 * (lane >> 4)));
}
__device__ __forceinline__ float log2_gamma(int h) { return log2f(1.0f - exp2f(-5.0f - (float)h)); }

__device__ __forceinline__ void ret_kv_item(Frame& F, const Args& args, int item) {
    const int bh = item >> 5, n = item & 31, b = bh >> 2, h = bh & 3, tid = F.tid, lane = F.lane, w = F.wave;
    const size_t tok0 = (size_t)b * SEQ + (size_t)n * 128;
    const bf16* kr = (const bf16*)(F.ws + WS_P + 4 * PBUF); const bf16* vr = (const bf16*)(F.ws + WS_P + 5 * PBUF);
    float* RS = F.out + (size_t)item * 16384;
    LAS unsigned char* Kt = F.lds; LAS unsigned char* Vt = F.lds + 32768;
    const float lg = log2_gamma(h);
#pragma unroll
    for (int it = 0; it < 4; ++it) {
        const int idx = tid + it * 512, j = idx & 127, ch = idx >> 7;
        const v4u kv = *(const GAS v4u*)(kr + (tok0 + j) * 512 + h * 128 + ch * 8);
        const v4u vv = *(const GAS v4u*)(vr + (tok0 + j) * 512 + h * 128 + ch * 8);
        float kx[8], vx[8]; unpack8(kv, kx); unpack8(vv, vx);
        const float z = exp2f((float)(127 - j) * lg);
#pragma unroll
        for (int t = 0; t < 8; ++t) {
            *(LAS unsigned short*)(Kt + rt_off(ch * 8 + t, j * 2)) = (unsigned short)f2bf(kx[t]);
            *(LAS unsigned short*)(Vt + rt_off(ch * 8 + t, j * 2)) = (unsigned short)f2bf(vx[t] * z);
        }
    }
    __syncthreads();
    f32x4 acc[8];
#pragma unroll
    for (int dt = 0; dt < 8; ++dt) acc[dt] = (f32x4){0.f, 0.f, 0.f, 0.f};
#pragma unroll
    for (int ks = 0; ks < 4; ++ks) {
        const bf16x8 a = rt_frag(Vt, 16 * w, ks, lane);
#pragma unroll
        for (int dt = 0; dt < 8; ++dt) { const bf16x8 bb = rt_frag(Kt, 16 * dt, ks, lane); acc[dt] = __builtin_amdgcn_mfma_f32_16x16x32_bf16(bb, a, acc[dt], 0, 0, 0); }
    }
    const int e = 16 * w + (lane & 15), q = lane >> 4;
#pragma unroll
    for (int dt = 0; dt < 8; ++dt) *(GAS f32x4*)(RS + (size_t)e * 128 + 16 * dt + 4 * q) = acc[dt];
    __syncthreads();
}
__device__ __forceinline__ void p4_scan(Frame& F, const Args& args) {
    const int gid = F.vcu * (NWAVES * 64) + F.tid, NT = F.G * NWAVES * 64;
    for (int idx = gid; idx < 16 * 4096; idx += NT) {
        const int bh = idx >> 12, off = idx & 4095, h = bh & 3;
        const float g = exp2f(128.0f * log2_gamma(h));
        f32x4 r = (f32x4){0.f, 0.f, 0.f, 0.f};
        GAS f32x4* p = (GAS f32x4*)(F.out + (size_t)bh * 32 * 16384) + off;
        for (int n = 0; n < 32; ++n) { const f32x4 t = p[(size_t)n * 4096]; p[(size_t)n * 4096] = r; r = r * g + t; }
    }
}
__device__ __forceinline__ void ret_out_item(Frame& F, const Args& args, int item) {
    const int bh = item >> 5, n = item & 31, b = bh >> 2, h = bh & 3, tid = F.tid, lane = F.lane, w = F.wave;
    const size_t tok0 = (size_t)b * SEQ + (size_t)n * 128;
    const bf16* qr = (const bf16*)(F.ws + WS_P + 3 * PBUF); const bf16* kr = (const bf16*)(F.ws + WS_P + 4 * PBUF); const bf16* vr = (const bf16*)(F.ws + WS_P + 5 * PBUF);
    const bf16* gb = (const bf16*)(F.ws + WS_P + 6 * PBUF); bf16* obg = (bf16*)(F.ws + WS_OB);
    const float* RS = F.out + (size_t)item * 16384;
    LAS unsigned char* Qs = F.lds; LAS unsigned char* Ks = F.lds + 32768; LAS unsigned char* Vt = F.lds + 65536; LAS unsigned char* Rt = F.lds + 98304;
    const float lg = log2_gamma(h);
#pragma unroll
    for (int it = 0; it < 4; ++it) {
        const int idx = tid + it * 512;
        { const int row = idx >> 4, ch = idx & 15;
          *(LAS v4u*)(Qs + rt_off(row, ch * 16)) = *(const GAS v4u*)(qr + (tok0 + row) * 512 + h * 128 + ch * 8);
          *(LAS v4u*)(Ks + rt_off(row, ch * 16)) = *(const GAS v4u*)(kr + (tok0 + row) * 512 + h * 128 + ch * 8);
          const f32x4 r0 = *(const GAS f32x4*)(RS + (size_t)row * 128 + ch * 8), r1 = *(const GAS f32x4*)(RS + (size_t)row * 128 + ch * 8 + 4);
          v4u o; o.x = pk2(r0.x, r0.y); o.y = pk2(r0.z, r0.w); o.z = pk2(r1.x, r1.y); o.w = pk2(r1.z, r1.w);
          *(LAS v4u*)(Rt + rt_off(row, ch * 16)) = o; }
        { const int j = idx & 127, ch = idx >> 7;
          const v4u vv = *(const GAS v4u*)(vr + (tok0 + j) * 512 + h * 128 + ch * 8);
          *(LAS unsigned short*)(Vt + rt_off(ch * 8 + 0, j * 2)) = (unsigned short)(vv.x & 0xffffu); *(LAS unsigned short*)(Vt + rt_off(ch * 8 + 1, j * 2)) = (unsigned short)(vv.x >> 16);
          *(LAS unsigned short*)(Vt + rt_off(ch * 8 + 2, j * 2)) = (unsigned short)(vv.y & 0xffffu); *(LAS unsigned short*)(Vt + rt_off(ch * 8 + 3, j * 2)) = (unsigned short)(vv.y >> 16);
          *(LAS unsigned short*)(Vt + rt_off(ch * 8 + 4, j * 2)) = (unsigned short)(vv.z & 0xffffu); *(LAS unsigned short*)(Vt + rt_off(ch * 8 + 5, j * 2)) = (unsigned short)(vv.z >> 16);
          *(LAS unsigned short*)(Vt + rt_off(ch * 8 + 6, j * 2)) = (unsigned short)(vv.w & 0xffffu); *(LAS unsigned short*)(Vt + rt_off(ch * 8 + 7, j * 2)) = (unsigned short)(vv.w >> 16); }
    }
    __syncthreads();
    const int i = 16 * w + (lane & 15), q = lane >> 4;
    f32x4 sacc[8];
#pragma unroll
    for (int jt = 0; jt < 8; ++jt) sacc[jt] = (f32x4){0.f, 0.f, 0.f, 0.f};
#pragma unroll
    for (int ks = 0; ks < 4; ++ks) {
        const bf16x8 a = rt_frag(Qs, 16 * w, ks, lane);
#pragma unroll
        for (int jt = 0; jt < 8; ++jt) { const bf16x8 bb = rt_frag(Ks, 16 * jt, ks, lane); sacc[jt] = __builtin_amdgcn_mfma_f32_16x16x32_bf16(bb, a, sacc[jt], 0, 0, 0); }
    }
    __syncthreads();
#pragma unroll
    for (int jt = 0; jt < 8; ++jt) {
        float v[4];
#pragma unroll
        for (int t = 0; t < 4; ++t) { const int j = 16 * jt + 4 * q + t; v[t] = (i >= j) ? sacc[jt][t] * exp2f((float)(i - j) * lg) : 0.f; }
        *(LAS unsigned long long*)(Ks + rt_off(i, (16 * jt + 4 * q) * 2)) = (unsigned long long)pk2(v[0], v[1]) | ((unsigned long long)pk2(v[2], v[3]) << 32);
    }
    __syncthreads();
    f32x4 a1[8], a2[8];
#pragma unroll
    for (int et = 0; et < 8; ++et) { a1[et] = (f32x4){0.f, 0.f, 0.f, 0.f}; a2[et] = (f32x4){0.f, 0.f, 0.f, 0.f}; }
#pragma unroll
    for (int ks = 0; ks < 4; ++ks) {
        const bf16x8 aS = rt_frag(Ks, 16 * w, ks, lane), aQ = rt_frag(Qs, 16 * w, ks, lane);
#pragma unroll
        for (int et = 0; et < 8; ++et) {
            const bf16x8 bV = rt_frag(Vt, 16 * et, ks, lane), bR = rt_frag(Rt, 16 * et, ks, lane);
            a1[et] = __builtin_amdgcn_mfma_f32_16x16x32_bf16(bV, aS, a1[et], 0, 0, 0);
            a2[et] = __builtin_amdgcn_mfma_f32_16x16x32_bf16(bR, aQ, a2[et], 0, 0, 0);
        }
    }
    const float xi = exp2f((float)(i + 1) * lg);
    float s = 0.f;
#pragma unroll
    for (int et = 0; et < 8; ++et) { a1[et] = a1[et] + a2[et] * xi; s += (a1[et][0] + a1[et][1]) + (a1[et][2] + a1[et][3]); }
    s += __shfl_xor(s, 16); s += __shfl_xor(s, 32);
    const float mu = s * (1.f / 128.f); float vq = 0.f;
#pragma unroll
    for (int et = 0; et < 8; ++et) { const f32x4 d = a1[et] - mu; vq += (d[0] * d[0] + d[1] * d[1]) + (d[2] * d[2] + d[3] * d[3]); }
    vq += __shfl_xor(vq, 16); vq += __shfl_xor(vq, 32);
    const float rstd = rsqrtf(vq * (1.f / 128.f) + EPS);
    const float* gng = FIN(11) + h * 128; const float* gnb = FIN(12) + h * 128;
#pragma unroll
    for (int et = 0; et < 8; ++et) {
        const int e = 16 * et + 4 * q;
        const f32x4 gg = *(const f32x4*)(gng + e), bb = *(const f32x4*)(gnb + e);
        const unsigned long long gw8 = *(const GAS unsigned long long*)(gb + (tok0 + i) * 512 + h * 128 + e);
        const float g0 = bflo((unsigned)gw8), g1 = bfhi((unsigned)gw8), g2 = bflo((unsigned)(gw8 >> 32)), g3 = bfhi((unsigned)(gw8 >> 32));
        const f32x4 y = (a1[et] - mu) * rstd * gg + bb;
        *(GAS unsigned long long*)(obg + (tok0 + i) * 512 + h * 128 + e) =
            (unsigned long long)pk2(y[0] * siluf_(g0), y[1] * siluf_(g1)) | ((unsigned long long)pk2(y[2] * siluf_(g2), y[3] * siluf_(g3)) << 32);
    }
    __syncthreads();
}
__device__ __forceinline__ void p5_attn_combine(Frame& F, const Args& args) {
    const int gw = F.vcu * NWAVES + F.wave, NGW = F.G * NWAVES, lane = F.lane;
    const float s1 = wave_sum(FIN(6)[lane] * FIN(7)[lane]), s2 = wave_sum(FIN(8)[lane] * FIN(9)[lane]);
    const float lam = expf(s1) - expf(s2) + LAM_INIT;
    const bf16* AO = (const bf16*)(F.ws + WS_H); bf16* oa = (bf16*)(F.ws + WS_OA);
    const int h = lane >> 4, e0 = (lane & 15) * 8, vhalf = e0 >> 6, d = e0 & 63;
    float g[8];
#pragma unroll
    for (int t = 0; t < 8; ++t) g[t] = FIN(10)[e0 + t] * (1.0f - LAM_INIT);
    for (int tk = gw; tk < M; tk += NGW) {
        float x0[8], x1[8];
        unpack8(*(const GAS v4u*)(AO + (size_t)tk * 1024 + (h * 4 + vhalf) * 64 + d), x0);
        unpack8(*(const GAS v4u*)(AO + (size_t)tk * 1024 + (h * 4 + 2 + vhalf) * 64 + d), x1);
        float y[8], ss = 0.f;
#pragma unroll
        for (int t = 0; t < 8; ++t) { y[t] = x0[t] - lam * x1[t]; ss += y[t] * y[t]; }
        ss += __shfl_xor(ss, 1); ss += __shfl_xor(ss, 2); ss += __shfl_xor(ss, 4); ss += __shfl_xor(ss, 8);
        const float rstd = rsqrtf(ss * (1.f / 128.f) + EPS);
#pragma unroll
        for (int t = 0; t < 8; ++t) y[t] = y[t] * rstd * g[t];
        *(GAS v4u*)(oa + (size_t)tk * 512 + h * 128 + e0) = pack8(y);
    }
}

struct EpiIn {
    static constexpr bool PERM = true, AFTER_DRAIN = false;
    bf16* P; const float* tabA; const float* tabB; const float* qg; const float* kg;
    __device__ __forceinline__ void operator()(const f32x4 (&acc)[2][2][4][2], const pg8::Unit& u, int wr, int wc, int fr, int fq) const {
        const int t = u.pn >> 1, row0 = u.pm * 256 + wr * 64 + fr, pos0 = (u.pn & 1) * 256 + 64 * wc + 8 * fq;
        bf16* base = P + (size_t)t * (PBUF / 2);
        constexpr float C2 = 0.125f * 1.4426950408889634f;
        if (t <= 1) {
            float g8[2][8];
            const float* gsrc = (t == 0) ? qg : kg;
#pragma unroll
            for (int bj = 0; bj < 2; ++bj)
#pragma unroll
                for (int i = 0; i < 8; ++i) { const int j = 32 * bj + 8 * fq + i; const int d = (j < 16) ? ((j >> 1) + 8 * (j & 1)) : j; g8[bj][i] = gsrc[d] * (t == 0 ? C2 : 1.0f); }
#pragma unroll
            for (int ai = 0; ai < 2; ++ai)
#pragma unroll
                for (int m = 0; m < 4; ++m) { const size_t row = (size_t)(row0 + ai * 128 + m * 16);
                    float ss = 0.f;
#pragma unroll
                    for (int bj = 0; bj < 2; ++bj)
#pragma unroll
                        for (int n = 0; n < 2; ++n) { const f32x4 v = acc[ai][bj][m][n]; ss += (v[0] * v[0] + v[1] * v[1]) + (v[2] * v[2] + v[3] * v[3]); }
                    ss += __shfl_xor(ss, 16); ss += __shfl_xor(ss, 32);
                    const float rstd = rsqrtf(ss * (1.f / 64.f) + EPS);
#pragma unroll
                    for (int bj = 0; bj < 2; ++bj) {
                        float y[8];
#pragma unroll
                        for (int i = 0; i < 8; ++i) y[i] = acc[ai][bj][m][i >> 2][i & 3] * rstd * g8[bj][i];
                        if (bj == 0 && fq < 2) {
                            const f32x4 cs = *(const GAS f32x4*)(tabA + row * 16 + 4 * fq), sn = *(const GAS f32x4*)(tabA + row * 16 + 8 + 4 * fq);
#pragma unroll
                            for (int p = 0; p < 4; ++p) { const float x1 = y[2 * p], x2 = y[2 * p + 1]; y[2 * p] = x1 * cs[p] - x2 * sn[p]; y[2 * p + 1] = x2 * cs[p] + x1 * sn[p]; }
                        }
                        *(GAS v4u*)(base + row * 512 + pos0 + 32 * bj) = pack8(y);
                    } }
        } else if (t == 3 || t == 4) {
            const float sc = (t == 4) ? 0.08838834764831845f : 1.0f;
#pragma unroll
            for (int ai = 0; ai < 2; ++ai)
#pragma unroll
                for (int m = 0; m < 4; ++m) { const size_t row = (size_t)(row0 + ai * 128 + m * 16);
#pragma unroll
                    for (int bj = 0; bj < 2; ++bj) {
                        const int rho0 = ((pos0 + 32 * bj) & 127) >> 1;
                        const f32x4 cs = *(const GAS f32x4*)(tabB + row * 128 + rho0), sn = *(const GAS f32x4*)(tabB + row * 128 + 64 + rho0);
                        float y[8];
#pragma unroll
                        for (int p = 0; p < 4; ++p) { const float x1 = acc[ai][bj][m][p >> 1][2 * (p & 1)], x2 = acc[ai][bj][m][p >> 1][2 * (p & 1) + 1];
                            y[2 * p] = (x1 * cs[p] - x2 * sn[p]) * sc; y[2 * p + 1] = (x2 * cs[p] + x1 * sn[p]) * sc; }
                        *(GAS v4u*)(base + row * 512 + pos0 + 32 * bj) = pack8(y);
                    } }
        } else {
#pragma unroll
            for (int ai = 0; ai < 2; ++ai)
#pragma unroll
                for (int m = 0; m < 4; ++m) { const size_t row = (size_t)(row0 + ai * 128 + m * 16);
#pragma unroll
                    for (int bj = 0; bj < 2; ++bj) { const f32x4 v0 = acc[ai][bj][m][0], v1 = acc[ai][bj][m][1];
                        v4u o; o.x = pk2(v0[0], v0[1]); o.y = pk2(v0[2], v0[3]); o.z = pk2(v1[0], v1[1]); o.w = pk2(v1[2], v1[3]);
                        *(GAS v4u*)(base + row * 512 + pos0 + 32 * bj) = o; } }
        }
    }
};
struct EpiGateA {
    static constexpr bool PERM = false, AFTER_DRAIN = false;
    float* T; const bf16* g0; const bf16* g1;
    __device__ __forceinline__ void operator()(const f32x4 (&acc)[2][2][4][2], const pg8::Unit& u, int wr, int wc, int fr, int fq) const {
        const int row0 = u.pm * 256 + wr * 64 + fr, col0 = u.pn * 256 + wc * 32 + 4 * fq;
#pragma unroll
        for (int ai = 0; ai < 2; ++ai)
#pragma unroll
            for (int m = 0; m < 4; ++m) { const size_t row = (size_t)(row0 + ai * 128 + m * 16);
#pragma unroll
                for (int bj = 0; bj < 2; ++bj)
#pragma unroll
                    for (int n = 0; n < 2; ++n) { const int col = col0 + bj * 128 + n * 16;
                        const unsigned long long gw8 = *(const GAS unsigned long long*)((col < 512 ? g0 : g1) + row * 512 + (col & 511));
                        f32x4 s; s[0] = sigmoidf_(bflo((unsigned)gw8)); s[1] = sigmoidf_(bfhi((unsigned)gw8)); s[2] = sigmoidf_(bflo((unsigned)(gw8 >> 32))); s[3] = sigmoidf_(bfhi((unsigned)(gw8 >> 32)));
                        *(GAS f32x4*)(T + row * 1024 + col) = s * acc[ai][bj][m][n]; } }
    }
};
struct EpiMerge {
    static constexpr bool PERM = false, AFTER_DRAIN = false;
    const float* T; bf16* O; const bf16* g0; const bf16* g1;
    __device__ __forceinline__ void operator()(const f32x4 (&acc)[2][2][4][2], const pg8::Unit& u, int wr, int wc, int fr, int fq) const {
        const int row0 = u.pm * 256 + wr * 64 + fr, col0 = u.pn * 256 + wc * 32 + 4 * fq;
#pragma unroll
        for (int ai = 0; ai < 2; ++ai)
#pragma unroll
            for (int m = 0; m < 4; ++m) { const size_t row = (size_t)(row0 + ai * 128 + m * 16);
#pragma unroll
                for (int bj = 0; bj < 2; ++bj)
#pragma unroll
                    for (int n = 0; n < 2; ++n) { const int col = col0 + bj * 128 + n * 16;
                        const unsigned long long gw8 = *(const GAS unsigned long long*)((col < 512 ? g0 : g1) + row * 512 + (col & 511));
                        f32x4 s; s[0] = sigmoidf_(bflo((unsigned)gw8)); s[1] = sigmoidf_(bfhi((unsigned)gw8)); s[2] = sigmoidf_(bflo((unsigned)(gw8 >> 32))); s[3] = sigmoidf_(bfhi((unsigned)(gw8 >> 32)));
                        const f32x4 v = *(const GAS f32x4*)(T + row * 1024 + col) + s * acc[ai][bj][m][n];
                        *(GAS unsigned long long*)(O + row * 1024 + col) = (unsigned long long)pk2(v[0], v[1]) | ((unsigned long long)pk2(v[2], v[3]) << 32); } }
    }
};
struct EpiResid {
    static constexpr bool PERM = false, AFTER_DRAIN = false;
    const float* X; float* O; float* ssq;
    __device__ __forceinline__ void operator()(const f32x4 (&acc)[2][2][4][2], const pg8::Unit& u, int wr, int wc, int fr, int fq) const {
        const int row0 = u.pm * 256 + wr * 64 + fr, col0 = u.pn * 256 + wc * 32 + 4 * fq;
#pragma unroll
        for (int ai = 0; ai < 2; ++ai)
#pragma unroll
            for (int m = 0; m < 4; ++m) { const size_t row = (size_t)(row0 + ai * 128 + m * 16); float sq = 0.f;
#pragma unroll
                for (int bj = 0; bj < 2; ++bj)
#pragma unroll
                    for (int n = 0; n < 2; ++n) { const int col = col0 + bj * 128 + n * 16;
                        const f32x4 v = *(const GAS f32x4*)(X + row * 1024 + col) + acc[ai][bj][m][n];
                        sq += (v[0] * v[0] + v[1] * v[1]) + (v[2] * v[2] + v[3] * v[3]);
                        *(GAS f32x4*)(O + row * 1024 + col) = v; }
                sq += __shfl_xor(sq, 16); sq += __shfl_xor(sq, 32);
                if (fq == 0) ssq[row * 16 + u.pn * 4 + wc] = sq; }
    }
};
struct EpiSwiGLU {
    static constexpr bool PERM = true, AFTER_DRAIN = false;
    bf16* Hm;
    __device__ __forceinline__ void operator()(const f32x4 (&acc)[2][2][4][2], const pg8::Unit& u, int wr, int wc, int fr, int fq) const {
        const int row0 = u.pm * 256 + wr * 64 + fr, j0 = (u.pn & 3) * 128 + wc * 16 + 4 * fq;
#pragma unroll
        for (int ai = 0; ai < 2; ++ai)
#pragma unroll
            for (int m = 0; m < 4; ++m) { const size_t row = (size_t)(row0 + ai * 128 + m * 16);
#pragma unroll
                for (int bj = 0; bj < 2; ++bj) { const f32x4 a = acc[ai][bj][m][0], uu = acc[ai][bj][m][1];
                    *(GAS unsigned long long*)(Hm + row * 512 + j0 + bj * 64) =
                        (unsigned long long)pk2(siluf_(a[0]) * uu[0], siluf_(a[1]) * uu[1]) | ((unsigned long long)pk2(siluf_(a[2]) * uu[2], siluf_(a[3]) * uu[3]) << 32); } }
    }
};
struct EpiY {
    static constexpr bool PERM = true, AFTER_DRAIN = false;
    bf16* Y; const int* ent_tok; const float* ent_w; const volatile LAS unsigned* cntL;
    __device__ __forceinline__ void operator()(const f32x4 (&acc)[2][2][4][2], const pg8::Unit& u, int wr, int wc, int fr, int fq) const {
        const int r0 = u.ti * 256 + wr * 64 + fr, col0 = (u.pn & 3) * 256 + wc * 32 + 8 * fq, cnt = (int)cntL[u.e];
#pragma unroll
        for (int ai = 0; ai < 2; ++ai)
#pragma unroll
            for (int m = 0; m < 4; ++m) { const int ent = r0 + ai * 128 + m * 16;
                if (ent < cnt) { const int tk2 = ent_tok[(size_t)u.e * M + ent]; const float w = ent_w[(size_t)u.e * M + ent];
                    bf16* o = Y + ((size_t)(tk2 & 1) * M + (size_t)(tk2 >> 1)) * 1024 + col0;
#pragma unroll
                    for (int bj = 0; bj < 2; ++bj) { const f32x4 v0 = acc[ai][bj][m][0] * w, v1 = acc[ai][bj][m][1] * w;
                        v4u o4; o4.x = pk2(v0[0], v0[1]); o4.y = pk2(v0[2], v0[3]); o4.z = pk2(v1[0], v1[1]); o4.w = pk2(v1[2], v1[3]);
                        *(GAS v4u*)(o + bj * 128) = o4; } } }
    }
};
template <bool GA> struct GroupedOrderT {
    static constexpr bool GATHER = GA;
    const volatile LAS unsigned* tp; const volatile LAS unsigned* cntL; const int* ent_tok; int G, c;
    __device__ __forceinline__ bool next(int i, pg8::Unit& u) const {
        const int L = i * G + c; const int total = (int)tp[32] * 4; if (L >= total) return false;
        const int T = L >> 2; int e = 0;
#pragma unroll 1
        for (int k = 1; k < 32; ++k) e += (T >= (int)tp[k]) ? 1 : 0;
        u.pm = T; u.pn = e * 4 + (L & 3); u.e = e; u.ti = T - (int)tp[e]; return true;
    }
    __device__ __forceinline__ unsigned arow_off(const pg8::Unit& u, int r) const {
        const int ent = u.ti * 256 + r; const int tk2 = (ent < (int)cntL[u.e]) ? ent_tok[(size_t)u.e * M + ent] : 0;
        return (unsigned)(tk2 >> 1) * (unsigned)(DM * 2);
    }
    __device__ __forceinline__ void a_ready(const pg8::Unit&) const {}
    __device__ __forceinline__ void done(const pg8::Unit&) const {}
};

__device__ __forceinline__ void p9_router(Frame& F, const Args& args) {
    const int gw = F.vcu * NWAVES + F.wave, NGW = F.G * NWAVES, lane = F.lane, tid = F.tid, w = F.wave;
    unsigned char* ws = F.ws;
    const float* X1 = F.out; bf16* H = (bf16*)(ws + WS_H); const float* g2 = FIN(16); const float* ssq = (const float*)(ws + WS_SSQ);
    const v4u* Wp16 = (const v4u*)(ws + WS_WRP);
    int* ent_tok = (int*)(ws + WS_ENT_TOK); float* ent_w = (float*)(ws + WS_ENT_W);
    LAS v4u* Wl = (LAS v4u*)(F.lds + RING_OFF); LAS float* G2L = (LAS float*)(F.lds + RING_OFF + 98304); LAS float* Lg = (LAS float*)(F.lds + RING_OFF + 102400 + w * 3072);
    LAS unsigned* LC = (LAS unsigned*)(F.lds + RING_OFF + 126976); LAS unsigned* LB = LC + 32;
    if (tid < 256) ((LAS f32x4*)G2L)[tid] = ((const f32x4*)g2)[tid];
    const int q = lane >> 4, ksub = w >> 2;
    for (int base = F.vcu * 4; base < M / 16; base += F.G * 4) {
        const int item = base + (w & 3), tok0 = item * 16, tok = tok0 + (lane & 15);
        const float* xrow = X1 + (size_t)tok * DM + 8 * q;
        float rstd;
        { const f32x4 p0 = *(const GAS f32x4*)(ssq + (size_t)tok * 16), p1 = *(const GAS f32x4*)(ssq + (size_t)tok * 16 + 4), p2 = *(const GAS f32x4*)(ssq + (size_t)tok * 16 + 8), p3 = *(const GAS f32x4*)(ssq + (size_t)tok * 16 + 12);
          const f32x4 ps = (p0 + p1) + (p2 + p3); rstd = rsqrtf(((ps[0] + ps[1]) + (ps[2] + ps[3])) * (1.f / DM) + EPS); }
        f32x4 acc[3];
#pragma unroll
        for (int t = 0; t < 3; ++t) acc[t] = (f32x4){0.f, 0.f, 0.f, 0.f};
#pragma unroll
        for (int r = 0; r < 2; ++r) {
            f32x4 xa[8][2];
#pragma unroll
            for (int i = 0; i < 8; ++i) { const int k = 32 * (16 * r + 8 * ksub + i); xa[i][0] = *(const GAS f32x4*)(xrow + k); xa[i][1] = *(const GAS f32x4*)(xrow + k + 4); }
            __syncthreads();
#pragma unroll 1
            for (int i0 = 0; i0 < 12; i0 += 4) {
#pragma unroll
                for (int i = i0; i < i0 + 4; ++i) Wl[tid + i * 512] = Wp16[(size_t)r * 6144 + tid + i * 512]; }
            __syncthreads();
#pragma unroll
            for (int i = 0; i < 8; ++i) {
                const int ksl = 8 * ksub + i, k = 32 * (16 * r + ksl) + 8 * q;
                float x[8] = {xa[i][0][0], xa[i][0][1], xa[i][0][2], xa[i][0][3], xa[i][1][0], xa[i][1][1], xa[i][1][2], xa[i][1][3]};
                float hi[8], lo[8], hh[8];
                const f32x4 ga = *(const LAS f32x4*)(G2L + k), gb = *(const LAS f32x4*)(G2L + k + 4);
                const float gg[8] = {ga[0], ga[1], ga[2], ga[3], gb[0], gb[1], gb[2], gb[3]};
#pragma unroll
                for (int j = 0; j < 8; ++j) { hi[j] = __uint_as_float(f2bf(x[j]) << 16); lo[j] = x[j] - hi[j]; hh[j] = x[j] * rstd * gg[j]; }
                const v4u ah = pack8(hi), al = pack8(lo);
                *(GAS v4u*)(H + (size_t)tok * DM + k) = pack8(hh);
                const bf16x8 ahi = __builtin_bit_cast(bf16x8, ah), alo = __builtin_bit_cast(bf16x8, al);
#pragma unroll
                for (int t = 0; t < 3; ++t) {
                    const bf16x8 bhi = __builtin_bit_cast(bf16x8, Wl[((ksl * 3 + t) * 2 + 0) * 64 + lane]), blo = __builtin_bit_cast(bf16x8, Wl[((ksl * 3 + t) * 2 + 1) * 64 + lane]);
                    acc[t] = __builtin_amdgcn_mfma_f32_16x16x32_bf16(ahi, bhi, acc[t], 0, 0, 0);
                    acc[t] = __builtin_amdgcn_mfma_f32_16x16x32_bf16(alo, bhi, acc[t], 0, 0, 0);
                    acc[t] = __builtin_amdgcn_mfma_f32_16x16x32_bf16(ahi, blo, acc[t], 0, 0, 0);
                }
            }
        }
        if (ksub == 1) {
#pragma unroll
            for (int t = 0; t < 3; ++t)
#pragma unroll
                for (int r = 0; r < 4; ++r) Lg[(4 * q + r) * 48 + t * 16 + (lane & 15)] = acc[t][r];
        }
        if (tid < 32) LC[tid] = 0u;
        __syncthreads();
        int e0 = 0, e1 = 0; float w0 = 0.f, w1 = 0.f; unsigned r0 = 0u, r1 = 0u;
        const bool router_lane = (ksub == 0) && (lane < 16);
        if (ksub == 0) {
            const LAS float* Lp = Lg + 4 * 768;
#pragma unroll
            for (int t = 0; t < 3; ++t)
#pragma unroll
                for (int r = 0; r < 4; ++r) { const int o = (4 * q + r) * 48 + t * 16 + (lane & 15); Lg[o] = acc[t][r] + Lp[o]; }
            LDS_WAIT(); asm volatile("" ::: "memory");
            if (lane < 16) {
                const LAS float* Lr = Lg + lane * 48;
                float gl[4];
#pragma unroll
                for (int k = 0; k < 4; ++k) gl[k] = rstd * Lr[k] + FIN(18)[k];
                int gi = 0; float mx = gl[0];
#pragma unroll
                for (int k = 1; k < 4; ++k) if (gl[k] > mx) { mx = gl[k]; gi = k; }
                float se = 0.f;
#pragma unroll
                for (int k = 0; k < 4; ++k) se += __expf(gl[k] - mx);
                const float pg = 1.0f / se;
                float v0 = -3.0e38f, v1 = -3.0e38f; int i0 = 0, i1 = 0;
#pragma unroll
                for (int k = 0; k < 8; ++k) { const float el = rstd * Lr[16 + gi * 8 + k] + FIN(20)[gi * 8 + k];
                    if (el > v0) { v1 = v0; i1 = i0; v0 = el; i0 = k; } else if (el > v1) { v1 = el; i1 = k; } }
                w0 = pg / (1.0f + __expf(v1 - v0)); w1 = pg - w0;
                e0 = gi * 8 + i0; e1 = gi * 8 + i1;
                r0 = __hip_atomic_fetch_add(LC + e0, 1u, __ATOMIC_RELAXED, __HIP_MEMORY_SCOPE_WORKGROUP);
                r1 = __hip_atomic_fetch_add(LC + e1, 1u, __ATOMIC_RELAXED, __HIP_MEMORY_SCOPE_WORKGROUP);
            }
        }
        __syncthreads();
        if (tid < 32) { const unsigned c = LC[tid]; LB[tid] = c ? atomicAdd((unsigned*)(F.ctl + CW_CNT) + tid, c) : 0u; }
        __syncthreads();
        if (router_lane) {
            const unsigned p0 = LB[e0] + r0, p1 = LB[e1] + r1;
            ent_tok[(size_t)e0 * M + p0] = tok * 2; ent_w[(size_t)e0 * M + p0] = w0;
            ent_tok[(size_t)e1 * M + p1] = tok * 2 + 1; ent_w[(size_t)e1 * M + p1] = w1;
        }
    }
}
__device__ __forceinline__ void p_expert_copies(Frame& F, const Args& args) {
    const int gw = F.vcu * NWAVES + F.wave, NGW = F.G * NWAVES, lane = F.lane; unsigned char* ws = F.ws;
    LAS unsigned* scr = (LAS unsigned*)(F.lds + RING_OFF + F.wave * 16384);
    for (int it = gw; it < NEXP * 384; it += NGW) {
        const int e = it / 384, r = it % 384;
        if (r < 128) transpose_item(FIN(21) + (size_t)e * DM * EFF, EFF, (bf16*)(ws + WS_WGU) + (size_t)e * 1024 * 1024, 1024, 1, scr, r / 8, r % 8, lane);
        else if (r < 256) transpose_item(FIN(22) + (size_t)e * DM * EFF, EFF, (bf16*)(ws + WS_WGU) + (size_t)e * 1024 * 1024, 1024, 2, scr, (r - 128) / 8, (r - 128) % 8, lane);
        else transpose_item(FIN(23) + (size_t)e * EFF * DM, DM, (bf16*)(ws + WS_WD) + (size_t)e * 1024 * 512, 512, 0, scr, (r - 256) / 16, (r - 256) % 16, lane);
    }
}
__device__ __forceinline__ void load_expert_tables(Frame& F) {
    if (F.tid < 32) F.MISC[MI_CNT + F.tid] = __hip_atomic_load(F.ctl + CW_CNT + F.tid, RLX_AGENT);
    __syncthreads();
    if (F.tid == 0) { unsigned a = 0; for (int e = 0; e < 32; ++e) { F.MISC[MI_TP + e] = a; a += (F.MISC[MI_CNT + e] + 255u) >> 8; } F.MISC[MI_TP + 32] = a; }
    __syncthreads();
}
__global__ void __launch_bounds__(NWAVES * 64, 2) mk_fwd(Args args) {
    extern __shared__ __attribute__((aligned(16))) unsigned char lds[];
    Frame F;
    F.lds = (LAS unsigned char*)lds;
    F.MISC = (volatile LAS unsigned*)(F.lds + MISC_OFF);
    F.tid = threadIdx.x; F.lane = F.tid & 63; F.wave = __builtin_amdgcn_readfirstlane(F.tid >> 6);
    F.G = gridDim.x; { const int bx = blockIdx.x; F.vcu = (F.G % 8 == 0) ? (bx % 8) * (F.G / 8) + bx / 8 : bx; }
    unsigned char* ws = args.ws; F.ws = ws; F.out = args.out;
    F.ctl = (gu32*)(ws + WS_CTL);
    for (int u = F.tid; u < (LDS_BYTES - LDSCTL_OFF) / 4; u += NWAVES * 64) ((LAS unsigned*)(F.lds + LDSCTL_OFF))[u] = 0u;
    __syncthreads();
    XcdBarrier bar; bar.bar = (unsigned*)(F.ctl + CW_BAR); bar.x = 0; bar.st = nullptr;
#if !MK_PER_PHASE
    bar = xcd_barrier_post((unsigned*)(F.ctl + CW_BAR), F.MISC + 8);
#endif
    const int lo = args.ph_lo, hi = args.ph_hi;
#define IN(k) (lo <= (k) && (k) < hi)
#define STAMP(k) do { if (PROBING && blockIdx.x == 0 && F.tid == 0) { const unsigned long long t_ = __builtin_amdgcn_s_memrealtime(); F.MISC[MI_TS + 2 * (k)] = (unsigned)t_; F.MISC[MI_TS + 2 * (k) + 1] = (unsigned)(t_ >> 32); } } while (0)
#define REFRESH() do { int t_ = threadIdx.x; asm volatile("" : "+v"(t_)); F.tid = t_; F.lane = t_ & 63; } while (0)
#define SEAM(k) do { if (IN(k) && IN((k) + 1)) xcd_barrier(bar); STAMP((k) + 1); REFRESH(); } while (0)
    STAMP(0);

    if (IN(0)) { p0_prologue(F, args); } SEAM(0);
    if (IN(1)) {
        pg8::Gemm g{(const pg8::bf16_t*)(ws + WS_H), (const pg8::bf16_t*)(ws + WS_WIN), M, IN_COLS, DM}; pg8::StaticOrder S; S.init(M, IN_COLS, F.G, (int)blockIdx.x);
        EpiIn E{(bf16*)(ws + WS_P), (const float*)(ws + WS_TABA), (const float*)(ws + WS_TABB), FIN(4), FIN(5)};
        pg8::gemm_phase<EpiIn, pg8::StaticOrder, true, true>(F.lds + RING_OFF, g, S, E);
    } SEAM(1);
    if (IN(2)) {
        const attn_body::AttnTensors AT{(const attn_body::bf16*)(ws + WS_P), (const attn_body::bf16*)(ws + WS_P + PBUF), (const attn_body::bf16*)(ws + WS_P + 2 * PBUF), (attn_body::bf16*)(ws + WS_H)};
        const attn_body::StaticOrder S((int)F.G, (int)blockIdx.x);
        attn_body::attn_phase<attn_body::StaticOrder>((char*)lds + RING_OFF, AT, S);
        __syncthreads(); REFRESH();
        for (int item = F.vcu; item < 512; item += F.G) ret_kv_item(F, args, item);
    } SEAM(2);
    if (IN(3)) { p4_scan(F, args); } SEAM(3);
    if (IN(4)) { for (int item = F.vcu; item < 512; item += F.G) ret_out_item(F, args, item); p5_attn_combine(F, args); } SEAM(4);
    if (IN(5)) {
        pg8::Gemm g{(const pg8::bf16_t*)(ws + WS_OA), (const pg8::bf16_t*)(ws + WS_WA), M, DM, 512}; pg8::StaticOrder S; S.init(M, DM, F.G, (int)blockIdx.x);
        EpiGateA E{(float*)(ws + WS_T), (const bf16*)(ws + WS_P + 7 * PBUF), (const bf16*)(ws + WS_P + 8 * PBUF)};
        pg8::gemm_phase<EpiGateA, pg8::StaticOrder, true, true>(F.lds + RING_OFF, g, S, E);
    } SEAM(5);
    if (IN(6)) {
        pg8::Gemm g{(const pg8::bf16_t*)(ws + WS_OB), (const pg8::bf16_t*)(ws + WS_WB), M, DM, 512}; pg8::StaticOrder S; S.init(M, DM, F.G, (int)blockIdx.x);
        EpiMerge E{(const float*)(ws + WS_T), (bf16*)(ws + WS_MERGED), (const bf16*)(ws + WS_P + 9 * PBUF), (const bf16*)(ws + WS_P + 10 * PBUF)};
        pg8::gemm_phase<EpiMerge, pg8::StaticOrder, true, true>(F.lds + RING_OFF, g, S, E);
    } SEAM(6);
    if (IN(7)) {
        pg8::Gemm g{(const pg8::bf16_t*)(ws + WS_MERGED), (const pg8::bf16_t*)(ws + WS_WOUT), M, DM, DM}; pg8::StaticOrder S; S.init(M, DM, F.G, (int)blockIdx.x);
        EpiResid E{FIN(0), F.out, (float*)(ws + WS_SSQ)};
        pg8::gemm_phase<EpiResid, pg8::StaticOrder, true, true>(F.lds + RING_OFF, g, S, E);
    } SEAM(7);
    if (IN(8)) { p9_router(F, args); } SEAM(8);
    if (IN(9)) { p_expert_copies(F, args); } SEAM(9);
    if (IN(10)) {
        load_expert_tables(F);
        pg8::Gemm g{(const pg8::bf16_t*)(ws + WS_H), (const pg8::bf16_t*)(ws + WS_WGU), MAXROWS, NEXP * 1024, DM};
        GroupedOrderT<true> S{F.MISC + MI_TP, F.MISC + MI_CNT, (const int*)(ws + WS_ENT_TOK), F.G, (int)blockIdx.x};
        EpiSwiGLU E{(bf16*)(ws + WS_HMID)};
        pg8::gemm_phase<EpiSwiGLU, GroupedOrderT<true>, true, true>(F.lds + RING_OFF, g, S, E);
    } SEAM(10);
    if (IN(11)) {
        load_expert_tables(F);
        pg8::Gemm g{(const pg8::bf16_t*)(ws + WS_HMID), (const pg8::bf16_t*)(ws + WS_WD), MAXROWS, NEXP * 1024, EFF};
        GroupedOrderT<false> S{F.MISC + MI_TP, F.MISC + MI_CNT, (const int*)(ws + WS_ENT_TOK), F.G, (int)blockIdx.x};
        EpiY E{(bf16*)(ws + WS_Y), (const int*)(ws + WS_ENT_TOK), (const float*)(ws + WS_ENT_W), F.MISC + MI_CNT};
        pg8::gemm_phase<EpiY, GroupedOrderT<false>, true, true>(F.lds + RING_OFF, g, S, E);
    } SEAM(11);
    if (IN(12)) {
        const int gid = F.vcu * (NWAVES * 64) + F.tid, NT = F.G * NWAVES * 64;
        const bf16* Y0 = (const bf16*)(ws + WS_Y); const bf16* Y1 = Y0 + (size_t)M * 1024;
        for (int idx = gid; idx < M * 1024 / 8; idx += NT) {
            GAS f32x4* o = (GAS f32x4*)F.out + (size_t)idx * 2;
            f32x4 a = o[0], b2 = o[1]; float y0[8], y1[8];
            unpack8(*(const GAS v4u*)(Y0 + (size_t)idx * 8), y0); unpack8(*(const GAS v4u*)(Y1 + (size_t)idx * 8), y1);
            a[0] += y0[0] + y1[0]; a[1] += y0[1] + y1[1]; a[2] += y0[2] + y1[2]; a[3] += y0[3] + y1[3];
            b2[0] += y0[4] + y1[4]; b2[1] += y0[5] + y1[5]; b2[2] += y0[6] + y1[6]; b2[3] += y0[7] + y1[7];
            o[0] = a; o[1] = b2;
        }
    }
    if (PROBING) {
        xcd_barrier(bar); STAMP(N_PHASES);
        if (blockIdx.x == 0) {
            __syncthreads();
            float dA = 0.f, dB = 0.f;
            if (PROBE_A >= 0) { const unsigned long long t0 = ((unsigned long long)F.MISC[MI_TS + 2 * PROBE_A + 1] << 32) | F.MISC[MI_TS + 2 * PROBE_A], t1 = ((unsigned long long)F.MISC[MI_TS + 2 * PROBE_A + 3] << 32) | F.MISC[MI_TS + 2 * PROBE_A + 2]; dA = (float)(t1 - t0) * 0.01f; }
            if (PROBE_B == 99) dB = 1.0f;
            else if (PROBE_B >= 0) { const unsigned long long t0 = ((unsigned long long)F.MISC[MI_TS + 2 * PROBE_B + 1] << 32) | F.MISC[MI_TS + 2 * PROBE_B], t1 = ((unsigned long long)F.MISC[MI_TS + 2 * PROBE_B + 3] << 32) | F.MISC[MI_TS + 2 * PROBE_B + 2]; dB = (float)(t1 - t0) * 0.0001f; }
            if (F.tid == 0) F.out[0] += dA;
            for (int i = F.tid; i < 16384; i += NWAVES * 64) F.out[4096 + i] += 5.0f + dB;
        }
    }
#undef IN
#undef SEAM
}

extern "C" void kernel_launch(void* const* d_in, const int* in_sizes, int n_in, void* d_out, int out_size, void* d_ws, size_t ws_size, hipStream_t stream) {
    static int grid = 0;
    if (grid == 0) {
        if (n_in != 24 || in_sizes[0] != M * DM || out_size != M * DM || ws_size < WS_END) { fprintf(stderr, "kernel_launch: unexpected shapes/workspace (n_in %d, ws %zu); nothing launched\n", n_in, ws_size); grid = -1; return; }
        int dev = 0, cus = 0, per_cu = 0;
        if (hipGetDevice(&dev) != hipSuccess || hipDeviceGetAttribute(&cus, hipDeviceAttributeMultiprocessorCount, dev) != hipSuccess) { grid = -1; return; }
        if (hipFuncSetAttribute((const void*)mk_fwd, hipFuncAttributeMaxDynamicSharedMemorySize, LDS_BYTES) != hipSuccess) { fprintf(stderr, "kernel_launch: hipFuncSetAttribute failed\n"); grid = -1; return; }
        if (hipOccupancyMaxActiveBlocksPerMultiprocessor(&per_cu, (const void*)mk_fwd, NWAVES * 64, LDS_BYTES) != hipSuccess || per_cu < 1) fprintf(stderr, "kernel_launch: occupancy query reports %d\n", per_cu);
        (void)hipGetLastError();
        grid = cus;
    }
    if (grid < 0) return;
    if (hipMemsetAsync((char*)d_ws + WS_CTL, 0, CTL_ZERO_BYTES, stream) != hipSuccess) return;
    Args a{};
    for (int i = 0; i < 24; ++i) a.in[i] = d_in[i];
    a.out = (float*)d_out; a.ws = (unsigned char*)d_ws;
#if MK_PER_PHASE
    for (int p = 0; p < N_PHASES; ++p) { a.ph_lo = p; a.ph_hi = p + 1; hipLaunchKernelGGL(mk_fwd, dim3(grid), dim3(NWAVES * 64), LDS_BYTES, stream, a); }
#else
    a.ph_lo = 0; a.ph_hi = N_PHASES;
    hipLaunchKernelGGL(mk_fwd, dim3(grid), dim3(NWAVES * 64), LDS_BYTES, stream, a);
#endif
}
```

```cpp
#include <hip/hip_runtime.h>
#include <cstdio>
#include <cstdint>

namespace pg8 {
#define PG8_LAS __attribute__((address_space(3)))
typedef unsigned short bf16_t;
typedef short bf16x8 __attribute__((ext_vector_type(8)));
typedef float f32x4 __attribute__((ext_vector_type(4)));
typedef unsigned u32x4 __attribute__((ext_vector_type(4)));
constexpr int BM = 256, BK = 64, HALF = 128, HTB = HALF * BK * 2  , STAGE_BYTES = 8 * HTB, NXCD = 8, WGM = 8;

__host__ __device__ __forceinline__ int lds_byte(int r, int c) { const int st = (r >> 4) * 2 + (c >> 5), rr = r & 15, cc = c & 31, ob = rr * 64 + cc * 2; return st * 1024 + (ob ^ (((ob >> 9) & 1) << 5)); }
__host__ __device__ __forceinline__ void stage_rc(int b, int& R, int& C) { const int st = b / 1024, sb = b % 1024, swz = sb ^ (((sb >> 9) & 1) << 5); R = (st >> 1) * 16 + swz / 64; C = (st & 1) * 32 + (swz % 64) / 2; }
__host__ __device__ __forceinline__ int perm32(int rho) { const int n = rho >> 4, i = rho & 15; return 8 * (i >> 2) + 4 * n + (i & 3); }

struct Unit { int pm, pn, e, ti, kofs, kh; };
struct Gemm { const bf16_t* A; const bf16_t* Bt; int M, N, K, ldk; };

struct StaticOrder {
    static constexpr bool GATHER = false;
    int nM, nN, nwg, G, c;
    __host__ __device__ void init(int M, int N, int G_, int c_) { nM = M / BM; nN = N / BM; nwg = nM * nN; G = G_; c = c_; }
    __host__ __device__ bool next(int i, Unit& u) const {
        const long L = (long)i * G + c; if (L >= nwg) return false;
        int wgid = (int)L; { const int q = nwg / NXCD, r = nwg % NXCD, xcd = wgid % NXCD, off = wgid / NXCD; wgid = (xcd < r ? xcd * (q + 1) : r * (q + 1) + (xcd - r) * q) + off; }
        const int nig = WGM * nN, gid = wgid / nig, fm = gid * WGM, gsz = (nM - fm) < WGM ? (nM - fm) : WGM;
        u.pm = fm + ((wgid % nig) % gsz); u.pn = (wgid % nig) / gsz; u.kofs = 0; u.kh = 0; return true;
    }
    __device__ __forceinline__ void a_ready(const Unit&) const {}
    __device__ __forceinline__ void done(const Unit&) const {}
};

__device__ __forceinline__ unsigned cvt_pk_bf16(float lo, float hi) { unsigned r; asm volatile("v_cvt_pk_bf16_f32 %0, %1, %2" : "=v"(r) : "v"(lo), "v"(hi)); return r; }
typedef float f32x2 __attribute__((ext_vector_type(2)));
__device__ __forceinline__ f32x2 gelu_pk(f32x2 v) {
    const f32x2 av = __builtin_elementwise_abs(v), d = av * 0.2316418882f + 1.0f;
    f32x2 t; t.x = __builtin_amdgcn_rcpf(d.x); t.y = __builtin_amdgcn_rcpf(d.y);
    f32x2 q = t * 0.5307027145f + (-0.7265760135f); q = q * t + 0.7107068705f; q = q * t + (-0.142248368f); q = q * t + 0.127414796f; q = q * t;
    const f32x2 s = (v * v) * (-0.72134752044f);
    f32x2 e; e.x = __builtin_amdgcn_exp2f(s.x); e.y = __builtin_amdgcn_exp2f(s.y);
    const f32x2 m = v * (q * e), r = v - m;
    f32x2 o; o.x = v.x < 0.f ? m.x : r.x; o.y = v.y < 0.f ? m.y : r.y; return o;
}

template <int ACT  > struct EpiBf16 {
    static constexpr bool PERM = true, AFTER_DRAIN = false, MUTATES = false; static_assert(ACT == 0 || ACT == 1, "EpiBf16: ACT is 0 (none) or 1 (gelu_pk)");
    bf16_t* O; int ldc; const float* bias; int split_cols; size_t split_stride; float scale0;
    __device__ __forceinline__ void operator()(const f32x4 (&acc)[2][2][4][2], const Unit& u, int wr, int wc, int fr, int fq) const {
        const int row0 = u.pm * BM + wr * 64 + fr; int colt = u.pn * BM; bf16_t* base = O;
        float sc = 1.f; if (split_cols) { const int t = colt / split_cols; base += (size_t)t * split_stride; colt -= t * split_cols; if (t == 0) sc = scale0; }
        const int col0 = colt + wc * 32 + 8 * fq, bcol0 = u.pn * BM + wc * 32 + 8 * fq;
        f32x4 bv[2][2];
#pragma unroll
        for (int bj = 0; bj < 2; ++bj)
#pragma unroll
            for (int n = 0; n < 2; ++n) bv[bj][n] = bias ? *(const f32x4*)(bias + bcol0 + bj * HALF + 4 * n) : (f32x4){0.f, 0.f, 0.f, 0.f};
#pragma unroll
        for (int ai = 0; ai < 2; ++ai)
#pragma unroll
            for (int m = 0; m < 4; ++m) { bf16_t* rowp = base + (size_t)(row0 + ai * HALF + m * 16) * ldc + col0;
#pragma unroll
                for (int bj = 0; bj < 2; ++bj) { f32x4 v0 = acc[ai][bj][m][0] + bv[bj][0], v1 = acc[ai][bj][m][1] + bv[bj][1];
                    if (ACT == 1) { f32x2 a = gelu_pk((f32x2){v0[0], v0[1]}), b = gelu_pk((f32x2){v0[2], v0[3]}), c = gelu_pk((f32x2){v1[0], v1[1]}), d = gelu_pk((f32x2){v1[2], v1[3]});
                        v0 = (f32x4){a.x, a.y, b.x, b.y}; v1 = (f32x4){c.x, c.y, d.x, d.y}; }
                    v0 = v0 * sc; v1 = v1 * sc; u32x4 w; w.x = cvt_pk_bf16(v0[0], v0[1]); w.y = cvt_pk_bf16(v0[2], v0[3]); w.z = cvt_pk_bf16(v1[0], v1[1]); w.w = cvt_pk_bf16(v1[2], v1[3]);
                    *(u32x4*)(rowp + bj * HALF) = w; } }
    }
};

template <class Epi, class Sched, bool ALIGN_EPI = false, bool SP2 = false>
__device__ __forceinline__ void gemm_phase(PG8_LAS unsigned char* lds, const Gemm g, const Sched& S, const Epi& E) {
    const int tid = threadIdx.x, wid = __builtin_amdgcn_readfirstlane(tid >> 6), lane = tid & 63, wr = wid >> 2, wc = wid & 3, fr = lane & 15, fq = lane >> 4;
    const int K = g.ldk, nt = g.K / BK;
    unsigned voffB[2], vA0[2], vA1[2], nA0[2], nA1[2]; int Rr[2], Cc[2];
#pragma unroll
    for (int i = 0; i < 2; ++i) { int R, C; stage_rc(tid * 16 + i * 8192, R, C); const int Rb = Epi::PERM ? ((R & ~31) + perm32(R & 31)) : R;
        Rr[i] = R; Cc[i] = C; vA0[i] = vA1[i] = nA0[i] = nA1[i] = (unsigned)(R * K + C) * 2u; voffB[i] = (unsigned)(Rb * K + C) * 2u; }
#define PG8_GOFF(u, d0, d1) do { if constexpr (Sched::GATHER) { _Pragma("unroll") for (int _i = 0; _i < 2; ++_i) { d0[_i] = S.arow_off(u, Rr[_i]) + (unsigned)Cc[_i] * 2u; d1[_i] = S.arow_off(u, HALF + Rr[_i]) + (unsigned)Cc[_i] * 2u; } } } while (0)
    const size_t kstep = (size_t)(BK * 2);
    const size_t hstep = (size_t)HALF * K * 2;
    const size_t hstepA = Sched::GATHER ? (size_t)0 : hstep;
    const size_t tstep = 2 * hstep;
    const unsigned ldsw = (unsigned)wid * 1024u;
    const int aoff = lds_byte(wr * 64 + fr, fq * 8), boff = lds_byte(wc * 32 + fr, fq * 8);
#define PG8_SA(b, h) (((b) * 2 + (h)) * HTB)
#define PG8_SB(b, h) ((4 + (b) * 2 + (h)) * HTB)
#define PG8_STAGE(bufoff, gbase, voff) do { _Pragma("unroll") for (int _i = 0; _i < 2; ++_i) \
        __builtin_amdgcn_global_load_lds((const unsigned*)((const char*)(gbase) + (voff)[_i]), (PG8_LAS unsigned*)(lds + (bufoff) + ldsw + _i * 8192), 16, 0, 0); } while (0)
#define PG8_LDA(dst, b, h) do { _Pragma("unroll") for (int m = 0; m < 4; ++m) _Pragma("unroll") for (int k = 0; k < 2; ++k) dst[m][k] = *(const PG8_LAS bf16x8*)(lds + PG8_SA(b, h) + aoff + m * 2048 + k * 1024); } while (0)
#define PG8_LDB(dst, b, h) do { _Pragma("unroll") for (int n = 0; n < 2; ++n) _Pragma("unroll") for (int k = 0; k < 2; ++k) dst[n][k] = *(const PG8_LAS bf16x8*)(lds + PG8_SB(b, h) + boff + n * 2048 + k * 1024); } while (0)
#define PG8_MMA(ai, bj, At, Bt) do { __builtin_amdgcn_s_setprio(1); _Pragma("unroll") for (int m = 0; m < 4; ++m) _Pragma("unroll") for (int n = 0; n < 2; ++n) _Pragma("unroll") for (int k = 0; k < 2; ++k) \
        acc[ai][bj][m][n] = __builtin_amdgcn_mfma_f32_16x16x32_bf16(Bt[n][k], At[m][k], acc[ai][bj][m][n], 0, 0, 0); __builtin_amdgcn_s_setprio(0); } while (0)
#define PG8_WAIT_V(n) asm volatile("s_waitcnt vmcnt(" #n ")" ::: "memory")
#define PG8_WAIT_L(n) asm volatile("s_waitcnt lgkmcnt(" #n ")" ::: "memory")
#define PG8_BAR __builtin_amdgcn_s_barrier()
#define PG8_SCHED __builtin_amdgcn_sched_barrier(0)
    Unit cur, nxt; int ui = 0;
    if (!S.next(0, cur)) return;
    f32x4 acc[2][2][4][2];
#pragma unroll
    for (int a = 0; a < 2; ++a)
#pragma unroll
        for (int b = 0; b < 2; ++b)
#pragma unroll
            for (int m = 0; m < 4; ++m)
#pragma unroll
                for (int n = 0; n < 2; ++n) acc[a][b][m][n] = (f32x4){0.f, 0.f, 0.f, 0.f};
    bf16x8 At[4][2], B0[2][2], B1[2][2];
    const char* cA = (const char*)g.A + (Sched::GATHER ? (size_t)0 : (size_t)cur.pm * tstep) + (size_t)cur.kofs * 2; const char* cB = (const char*)g.Bt + (size_t)cur.pn * tstep + (size_t)cur.kofs * 2;
    PG8_GOFF(cur, vA0, vA1);
    S.a_ready(cur);
    if constexpr (SP2) {
        PG8_STAGE(PG8_SB(0, 0), cB, voffB); PG8_STAGE(PG8_SB(0, 1), cB + hstep, voffB); PG8_STAGE(PG8_SA(0, 0), cA, vA0); PG8_STAGE(PG8_SA(0, 1), cA + hstepA, vA1);
        if (wr == 1) PG8_BAR;
        PG8_WAIT_V(2); PG8_BAR;
        PG8_STAGE(PG8_SB(1, 0), cB + kstep, voffB); PG8_STAGE(PG8_SA(1, 0), cA + kstep, vA0); PG8_STAGE(PG8_SB(1, 1), cB + hstep + kstep, voffB);
        PG8_WAIT_V(6); PG8_BAR;
    } else {
        PG8_STAGE(PG8_SB(0, 0), cB, voffB); PG8_STAGE(PG8_SA(0, 0), cA, vA0); PG8_STAGE(PG8_SB(0, 1), cB + hstep, voffB); PG8_STAGE(PG8_SA(0, 1), cA + hstepA, vA1);
        if (wr == 1) PG8_BAR;
        PG8_WAIT_V(4); PG8_BAR;
        PG8_STAGE(PG8_SB(1, 0), cB + kstep, voffB); PG8_STAGE(PG8_SA(1, 0), cA + kstep, vA0); PG8_STAGE(PG8_SB(1, 1), cB + hstep + kstep, voffB);
        PG8_WAIT_V(6); PG8_BAR;
    }
    for (;;) {
        const bool has_next = S.next(ui + 1, nxt);
        const char* nA = has_next ? (const char*)g.A + (Sched::GATHER ? (size_t)0 : (size_t)nxt.pm * tstep) + (size_t)nxt.kofs * 2 : cA; const char* nB = has_next ? (const char*)g.Bt + (size_t)nxt.pn * tstep + (size_t)nxt.kofs * 2 : cB;
        if constexpr (Sched::GATHER) { if (has_next) { PG8_GOFF(nxt, nA0, nA1); } else {
#pragma unroll
            for (int _i = 0; _i < 2; ++_i) { nA0[_i] = vA0[_i]; nA1[_i] = vA1[_i]; } } }
        for (int t = 0; t < nt; t += 2) {
            const bool last = (t == nt - 2);
            const char* a1 = cA + (size_t)(t + 1) * kstep;
            const char* a2 = last ? nA : cA + (size_t)(t + 2) * kstep; const char* b2 = last ? nB : cB + (size_t)(t + 2) * kstep;
            const char* a3 = a2 + kstep; const char* b3 = b2 + kstep;
            if (last && has_next) S.a_ready(nxt);
            unsigned wA0[2], wA1[2];
#pragma unroll
            for (int _i = 0; _i < 2; ++_i) { wA0[_i] = (Sched::GATHER && last) ? nA0[_i] : vA0[_i]; wA1[_i] = (Sched::GATHER && last) ? nA1[_i] : vA1[_i]; }
            if constexpr (SP2) {
            PG8_LDB(B0, 0, 0); PG8_LDB(B1, 0, 1); PG8_SCHED; PG8_LDA(At, 0, 0); PG8_STAGE(PG8_SA(1, 1), a1 + hstepA, vA1);
            PG8_WAIT_V(8); PG8_WAIT_L(0); PG8_BAR; PG8_MMA(0, 0, At, B0); PG8_MMA(0, 1, At, B1); PG8_BAR; PG8_SCHED;
            PG8_LDA(At, 0, 1); PG8_STAGE(PG8_SB(0, 0), b2, voffB); PG8_STAGE(PG8_SB(0, 1), b2 + hstep, voffB); PG8_STAGE(PG8_SA(0, 0), a2, wA0);
            PG8_WAIT_V(8); PG8_WAIT_L(0); PG8_BAR; PG8_MMA(1, 0, At, B0); PG8_MMA(1, 1, At, B1); PG8_BAR; PG8_SCHED;
            PG8_LDB(B0, 1, 0); PG8_LDB(B1, 1, 1); PG8_SCHED; PG8_LDA(At, 1, 0); PG8_STAGE(PG8_SA(0, 1), a2 + hstepA, wA1);
            PG8_WAIT_V(8); PG8_WAIT_L(0); PG8_BAR; PG8_MMA(0, 0, At, B0); PG8_MMA(0, 1, At, B1); PG8_BAR; PG8_SCHED;
            PG8_LDA(At, 1, 1); PG8_STAGE(PG8_SB(1, 0), b3, voffB); PG8_STAGE(PG8_SB(1, 1), b3 + hstep, voffB); PG8_STAGE(PG8_SA(1, 0), a3, wA0);
            PG8_WAIT_V(8); PG8_WAIT_L(0); PG8_BAR; PG8_MMA(1, 0, At, B0); PG8_MMA(1, 1, At, B1); PG8_BAR; PG8_SCHED;
            } else {
            PG8_LDB(B0, 0, 0); PG8_SCHED; PG8_LDA(At, 0, 0); PG8_STAGE(PG8_SA(1, 1), a1 + hstepA, vA1);
            PG8_WAIT_L(8); PG8_BAR; PG8_WAIT_L(0); PG8_MMA(0, 0, At, B0); PG8_BAR; PG8_SCHED;
            PG8_LDB(B1, 0, 1); PG8_STAGE(PG8_SB(0, 0), b2, voffB);
            PG8_BAR; PG8_WAIT_L(0); PG8_MMA(0, 1, At, B1); PG8_BAR;
            PG8_LDA(At, 0, 1); PG8_STAGE(PG8_SA(0, 0), a2, wA0);
            PG8_BAR; PG8_WAIT_L(0); PG8_MMA(1, 0, At, B0); PG8_BAR; PG8_SCHED;
            PG8_STAGE(PG8_SB(0, 1), b2 + hstep, voffB);
            PG8_WAIT_V(6); PG8_BAR; PG8_MMA(1, 1, At, B1); PG8_BAR;
            PG8_LDB(B0, 1, 0); PG8_SCHED; PG8_LDA(At, 1, 0); PG8_STAGE(PG8_SA(0, 1), a2 + hstepA, wA1);
            PG8_WAIT_L(8); PG8_BAR; PG8_WAIT_L(0); PG8_MMA(0, 0, At, B0); PG8_BAR; PG8_SCHED;
            PG8_LDB(B1, 1, 1); PG8_STAGE(PG8_SB(1, 0), b3, voffB);
            PG8_BAR; PG8_WAIT_L(0); PG8_MMA(0, 1, At, B1); PG8_BAR;
            PG8_LDA(At, 1, 1); PG8_STAGE(PG8_SA(1, 0), a3, wA0);
            PG8_BAR; PG8_WAIT_L(0); PG8_MMA(1, 0, At, B0); PG8_BAR; PG8_SCHED;
            PG8_STAGE(PG8_SB(1, 1), b3 + hstep, voffB);
            PG8_WAIT_V(6); PG8_BAR; PG8_MMA(1, 1, At, B1); PG8_BAR;
            }
        }
        if constexpr (ALIGN_EPI) { if (wr == 0) PG8_BAR; }
        bool keep = false;
        if constexpr (!Epi::AFTER_DRAIN) { if constexpr (Epi::MUTATES) keep = E.mut(acc, cur, wr, wc, fr, fq); else E(acc, cur, wr, wc, fr, fq); S.done(cur); }
        if (!has_next) break;
        if (!keep)
#pragma unroll
        for (int a = 0; a < 2; ++a)
#pragma unroll
            for (int b = 0; b < 2; ++b)
#pragma unroll
                for (int m = 0; m < 4; ++m)
#pragma unroll
                    for (int n = 0; n < 2; ++n) acc[a][b][m][n] = (f32x4){0.f, 0.f, 0.f, 0.f};
        cur = nxt; cA = nA; cB = nB; ++ui;
#pragma unroll
        for (int _i = 0; _i < 2; ++_i) { vA0[_i] = nA0[_i]; vA1[_i] = nA1[_i]; }
        if constexpr (ALIGN_EPI) { if (wr == 1) PG8_BAR; }
    }
    PG8_WAIT_V(0);
    if constexpr (!ALIGN_EPI) { if (wr == 0) PG8_BAR; }
    PG8_BAR;
    if constexpr (Epi::AFTER_DRAIN) { E.fused(acc, cur, wr, wc, fr, fq, lds, wid, lane); S.done(cur); }
#undef PG8_GOFF
#undef PG8_SA
#undef PG8_SB
#undef PG8_STAGE
#undef PG8_LDA
#undef PG8_LDB
#undef PG8_MMA
#undef PG8_WAIT_V
#undef PG8_WAIT_L
#undef PG8_BAR
#undef PG8_SCHED
}
}

#ifndef PG8_SP2
#define PG8_SP2 true
#endif

#include <hip/hip_bf16.h>
#include <cmath>
namespace attn_body {
using bf16=__hip_bfloat16;
using bf16x8=__attribute__((ext_vector_type(8)))short;
using s16x4=__attribute__((ext_vector_type(4)))short;
using f32x16=__attribute__((ext_vector_type(16)))float;
using u32x4=__attribute__((ext_vector_type(4)))unsigned;
constexpr int BATCH=4,NHEAD=16,SEQ=4096,D=64,PQ=512,PO=1024;
constexpr int NW=8,QBLK=32,QB=QBLK*NW,KVBLK=64,NQB=SEQ/QB;
constexpr int ATTN_UNIT_ROWS=QB;
__device__ __forceinline__ int crow(int r,int hi){return (r&3)+8*(r>>2)+4*hi;}
#define SBAR() __builtin_amdgcn_sched_barrier(0)
__device__ __forceinline__ void cmask(f32x16&p0,f32x16&p1,int jb,int qrel,int hi){
  const float NEG=-INFINITY; int kb=64*jb+4*hi;
  #pragma unroll
  for(int r=0;r<16;++r){int kv=kb+(r&3)+8*(r>>2); if(kv>qrel)p0[r]=NEG; if(kv+32>qrel)p1[r]=NEG;}
}

constexpr int NSLOT=3, SLOTB=8192;
constexpr int LDS_K=0, LDS_V=NSLOT*SLOTB, LDS_WS=2*NSLOT*SLOTB, LDS_OST=LDS_WS+NW*64*4, LDS_BYTES=LDS_OST+NW*4096;
constexpr float C2=0.125f*1.4426950408889634f;
__device__ __forceinline__ void glds16(const void*gsrc,unsigned lds_dst){unsigned keep;
  asm volatile("s_mov_b32 %0, m0\n\ts_mov_b32 m0, %2\n\ts_nop 0\n\tglobal_load_lds_dwordx4 %1, off\n\ts_mov_b32 m0, %0":"=&s"(keep):"v"(gsrc),"s"(lds_dst):"memory");}
__device__ __forceinline__ float max3f(float a,float b,float c){float r;asm("v_max3_f32 %0, %1, %2, %3":"=v"(r):"v"(a),"v"(b),"v"(c));return r;}
__device__ __forceinline__ float max2f(float a,float b){float r;asm("v_max_f32_e32 %0, %1, %2":"=v"(r):"v"(a),"v"(b));return r;}
__device__ __forceinline__ float fadd_s(float a,float b){float r;asm("v_add_f32_e32 %0, %1, %2":"=v"(r):"v"(a),"v"(b));return r;}
__device__ __forceinline__ float fsub_s(float a,float b){float r;asm("v_sub_f32_e32 %0, %1, %2":"=v"(r):"v"(a),"v"(b));return r;}
typedef float f32x2_t __attribute__((ext_vector_type(2))); typedef __bf16 bf16x2_t __attribute__((ext_vector_type(2)));
__device__ __forceinline__ unsigned cvtpk_s(float lo,float hi){f32x2_t v={lo,hi};bf16x2_t b=__builtin_convertvector(v,bf16x2_t);return __builtin_bit_cast(unsigned,b);}
#define WAIT_BAR(N) asm volatile("s_waitcnt vmcnt(" #N ") lgkmcnt(0)\n\ts_barrier":::"memory")

__device__ __forceinline__ void qkt(f32x16&p0,f32x16&p1,const char*Kslot,const bf16x8*qr,const f32x16&negm,int r32,int hi){
  const char*kb=Kslot+hi*1024+r32*16;
  #pragma unroll
  for(int d0=0;d0<4;++d0){
    const bf16x8 b0=*reinterpret_cast<const bf16x8*>(kb+d0*2048);
    const bf16x8 b1=*reinterpret_cast<const bf16x8*>(kb+d0*2048+512);
    if(d0==0){p0=__builtin_amdgcn_mfma_f32_32x32x16_bf16(b0,qr[0],negm,0,0,0);p1=__builtin_amdgcn_mfma_f32_32x32x16_bf16(b1,qr[0],negm,0,0,0);}
    else{p0=__builtin_amdgcn_mfma_f32_32x32x16_bf16(b0,qr[d0],p0,0,0,0);p1=__builtin_amdgcn_mfma_f32_32x32x16_bf16(b1,qr[d0],p1,0,0,0);}}
}
typedef __attribute__((address_space(3))) const char* lds_cptr;
typedef short v4i16_t __attribute__((ext_vector_type(4)));
__device__ __forceinline__ void kload8(bf16x8*kf,lds_cptr kp){
  kf[0]=*(const __attribute__((address_space(3))) bf16x8*)(kp);      kf[1]=*(const __attribute__((address_space(3))) bf16x8*)(kp+512);
  kf[2]=*(const __attribute__((address_space(3))) bf16x8*)(kp+2048); kf[3]=*(const __attribute__((address_space(3))) bf16x8*)(kp+2560);
  kf[4]=*(const __attribute__((address_space(3))) bf16x8*)(kp+4096); kf[5]=*(const __attribute__((address_space(3))) bf16x8*)(kp+4608);
  kf[6]=*(const __attribute__((address_space(3))) bf16x8*)(kp+6144); kf[7]=*(const __attribute__((address_space(3))) bf16x8*)(kp+6656);
}
__device__ __forceinline__ void kload2(bf16x8*kf,lds_cptr kp,int j){ kf[2*j]=*(const __attribute__((address_space(3))) bf16x8*)(kp+j*2048); kf[2*j+1]=*(const __attribute__((address_space(3))) bf16x8*)(kp+j*2048+512); }
__device__ __forceinline__ s16x4 vtr(lds_cptr p){ return __builtin_bit_cast(s16x4,__builtin_amdgcn_ds_read_tr16_b64_v4i16((__attribute__((address_space(3))) v4i16_t*)p)); }
__device__ __forceinline__ float rowmax(const f32x16&p0,const f32x16&p1){
  float a=max3f(p0[0],p0[1],p1[0]),b=max3f(p0[2],p0[3],p1[1]);a=max3f(a,p1[2],p1[3]);
  #pragma unroll
  for(int r=4;r<16;r+=4){a=max3f(a,p0[r],p0[r+1]);b=max3f(b,p0[r+2],p0[r+3]);a=max3f(a,p1[r],p1[r+1]);b=max3f(b,p1[r+2],p1[r+3]);}
  const float m=max2f(a,b);
  auto rr=__builtin_amdgcn_permlane32_swap(__float_as_uint(m),__float_as_uint(m),false,false);
  return max2f(__uint_as_float(rr[0]),__uint_as_float(rr[1]));
}
__device__ __forceinline__ void pv(f32x16*o,int vb,bf16x8 pa0,bf16x8 pa1,bf16x8 pa2,bf16x8 pa3){
  #pragma unroll
  for(int d0=0;d0<2;++d0){s16x4 lo[4],hi[4];
    #pragma unroll
    for(int ks=0;ks<4;++ks){
      asm volatile("ds_read_b64_tr_b16 %0,%1 offset:%c2":"=&v"(lo[ks]):"v"(vb),"i"(d0*4096+ks*1024):"memory");
      asm volatile("ds_read_b64_tr_b16 %0,%1 offset:%c2":"=&v"(hi[ks]):"v"(vb),"i"(d0*4096+ks*1024+512):"memory");}
    asm volatile("s_waitcnt lgkmcnt(0)":::"memory");SBAR();
    #define PK(k) (bf16x8){lo[k][0],lo[k][1],lo[k][2],lo[k][3],hi[k][0],hi[k][1],hi[k][2],hi[k][3]}
    o[d0]=__builtin_amdgcn_mfma_f32_32x32x16_bf16(pa0,PK(0),o[d0],0,0,0);
    o[d0]=__builtin_amdgcn_mfma_f32_32x32x16_bf16(pa1,PK(1),o[d0],0,0,0);
    o[d0]=__builtin_amdgcn_mfma_f32_32x32x16_bf16(pa2,PK(2),o[d0],0,0,0);
    o[d0]=__builtin_amdgcn_mfma_f32_32x32x16_bf16(pa3,PK(3),o[d0],0,0,0);
    #undef PK
  }
}

#ifndef ATTN_STORE16
#define ATTN_STORE16(p,v) (*(u32x4*)(p)=(v))
#endif
template<int THRL> __device__ __forceinline__ void attn_unit(int b,int h,int qb,const bf16*Q,const bf16*__restrict__ K,const bf16*__restrict__ V,bf16*O,char*shm){
  const int tid=threadIdx.x,lane=tid&63,r32=lane&31,hi=lane>>5; const int wid=__builtin_amdgcn_readfirstlane(tid>>6);
  const long rowbase=(long)b*SEQ; const int q0=qb*QB;
  const int qkc=(h>>1)*D, vcol=(h>>2)*128+(h&1)*D;
  const bf16*Qw=Q+(rowbase+q0+wid*QBLK)*PQ+qkc;
  const bf16*Kh=K+rowbase*PQ+qkc,*Vh=V+rowbase*PQ+vcol;
  const unsigned lds0=(unsigned)(uintptr_t)shm;
  float*wsf=(float*)(shm+LDS_WS)+wid*64;
  const bf16*ksrc=Kh+(long)lane*PQ+wid*8;
  const bf16*vsrc=Vh+(long)(16*(wid&3)+(lane>>2))*PQ+(wid>>2)*32+(lane&3)*8;
  const unsigned kdst=lds0+LDS_K+wid*1024, vdst=lds0+LDS_V+wid*1024;
  #define DMA_K(t,slot) glds16(ksrc+(long)(t)*KVBLK*PQ,(unsigned)__builtin_amdgcn_readfirstlane(kdst+(slot)))
  #define DMA_V(t,slot) glds16(vsrc+(long)(t)*KVBLK*PQ,(unsigned)__builtin_amdgcn_readfirstlane(vdst+(slot)))
  const int vb0=(int)(lds0+LDS_V)+((lane>>4)&1)*32+(lane&3)*8+(4*hi+((lane&15)>>2))*64;
  const char*Kbase=shm+LDS_K; bf16x8 kf[8];
  const lds_cptr shm3=(lds_cptr)shm; const lds_cptr kp0=shm3+LDS_K+hi*1024+r32*16; const lds_cptr vp0=shm3+LDS_V+((lane>>4)&1)*32+(lane&3)*8+(4*hi+((lane&15)>>2))*64;
  const int NT=(q0+QB)/KVBLK;
  DMA_K(0,0);DMA_V(0,0);DMA_K(1,SLOTB);
  bf16x8 qr[4];
  #pragma unroll
  for(int d0=0;d0<4;++d0)qr[d0]=*reinterpret_cast<const bf16x8*>(&Qw[(long)r32*PQ+d0*16+hi*8]);
  float mhat=0.f,l_reg=0.f;f32x16 o[2];o[0]=f32x16{};o[1]=f32x16{};f32x16 negm=f32x16{};asm volatile("":"+v"(negm));
  const int qrel=wid*QBLK+r32;
  #define CMASK(P0,P1,t) do{int jb_=(t)-(NT-4); if(jb_>=0)cmask(P0,P1,jb_,qrel,hi);}while(0)
  bool resc=false;
  #define START(P0,P1) do{ const float rm=rowmax(P0,P1); resc=false; \
    { const float dl=rm; mhat=fadd_s(mhat,dl); \
      _Pragma("unroll") for(int r=0;r<16;++r){P0[r]=fsub_s(P0[r],dl);P1[r]=fsub_s(P1[r],dl);} \
      _Pragma("unroll") for(int r=0;r<16;++r)negm[r]=-mhat; asm volatile("":"+v"(negm)); } \
    _Pragma("unroll") for(int r=0;r<16;++r)P0[r]=__builtin_amdgcn_exp2f(P0[r]); }while(0)
  #define RESC() do{ if(resc){ asm volatile("s_waitcnt lgkmcnt(0)":::"memory"); \
      _Pragma("unroll") for(int d_=0;d_<2;++d_) _Pragma("unroll") for(int r=0;r<16;++r)o[d_][r]*=wsf[crow(r,hi)]; } }while(0)
  f32x16 pA0,pA1,pB0,pB1;
  int sl_prev=0,sl_cur=0,sl_next=SLOTB;
  #define ROT() do{sl_prev=sl_cur;sl_cur=sl_next;sl_next=(sl_next==(NSLOT-1)*SLOTB)?0:sl_next+SLOTB;}while(0)
  DMA_K(2,2*SLOTB);
  WAIT_BAR(3);
  qkt(pA0,pA1,Kbase,qr,negm,r32,hi);asm volatile("s_nop 15\n\ts_nop 7":"+v"(pA0),"+v"(pA1));CMASK(pA0,pA1,0);
  START(pA0,pA1);
  _Pragma("unroll") for(int r=0;r<16;++r)pA1[r]=__builtin_amdgcn_exp2f(pA1[r]);
  WAIT_BAR(0);
  DMA_K(3,0);DMA_V(1,SLOTB);
  ROT();
  kload8(kf,kp0+sl_cur);
  WAIT_BAR(2);
  s16x4 vlo[8],vhi[8]; u32x4 pw0,pw1,pw2,pw3;
  #define PKW(P,B) cvtpk_s(P[B],P[B+1])
  #define PAF(k) __builtin_bit_cast(bf16x8,pw##k)
  #define VFR(i) (bf16x8){vlo[i][0],vlo[i][1],vlo[i][2],vlo[i][3],vhi[i][0],vhi[i][1],vhi[i][2],vhi[i][3]}
  #define PIN(x) asm volatile("":"+v"(x))
  #define MX3(a,b,c) __builtin_fmaxf(__builtin_fmaxf((a),(b)),(c))
  #define GAPA(MF,A0,A1,A2,A3,W0,W1,PW) do{ MF; sacc+=A0; sacc+=A1; sacc+=A2; sacc+=A3; PIN(sacc); W0; W1; PIN(PW); SBAR(); }while(0)
  #define EX(v) __builtin_amdgcn_exp2f(v)
  #define GAPB(MF,X,B) do{ MF; X[B]=EX(X[B]); X[B+1]=EX(X[B+1]); X[B+2]=EX(X[B+2]); X[B+3]=EX(X[B+3]); PIN(X); SBAR(); }while(0)
  #define VRD(i) do{ vlo[i]=vtr(vp_+(((i)>>2)*4096+((i)&3)*1024)); vhi[i]=vtr(vp_+(((i)>>2)*4096+((i)&3)*1024+512)); }while(0)
  #define KRD(G,j) do{ if(G){ kload2(kf,kp0+sl_next,j); SBAR(); } }while(0)
  #define STEP(C0,C1,P0,P1,t,GK,GV,GL) do{ SBAR(); \
    const lds_cptr vp_=vp0+sl_prev; \
    VRD(0); SBAR(); float sacc=(P0[0]+P0[1]); \
    GAPA(C0=__builtin_amdgcn_mfma_f32_32x32x16_bf16(kf[0],qr[0],negm,0,0,0), P0[2],P0[3],P0[4],P0[5],     pw0[0]=PKW(P0,0), pw0[1]=PKW(P0,2), pw0); \
    VRD(4); SBAR(); GAPA(C1=__builtin_amdgcn_mfma_f32_32x32x16_bf16(kf[1],qr[0],negm,0,0,0), P0[6],P0[7],P0[8],P0[9],     pw0[2]=PKW(P0,4), pw0[3]=PKW(P0,6), pw0); \
    VRD(1); SBAR(); GAPA(C0=__builtin_amdgcn_mfma_f32_32x32x16_bf16(kf[2],qr[1],C0,0,0,0),   P0[10],P0[11],P0[12],P0[13], pw1[0]=PKW(P0,8), pw1[1]=PKW(P0,10), pw1); \
    VRD(5); SBAR(); GAPA(C1=__builtin_amdgcn_mfma_f32_32x32x16_bf16(kf[3],qr[1],C1,0,0,0),   P0[14],P0[15],P1[0],P1[1],   pw1[2]=PKW(P0,12),pw1[3]=PKW(P0,14), pw1); \
    VRD(2); SBAR(); GAPA(C0=__builtin_amdgcn_mfma_f32_32x32x16_bf16(kf[4],qr[2],C0,0,0,0),   P1[2],P1[3],P1[4],P1[5],     pw2[0]=PKW(P1,0), pw2[1]=PKW(P1,2), pw2); \
    VRD(6); SBAR(); GAPA(C1=__builtin_amdgcn_mfma_f32_32x32x16_bf16(kf[5],qr[2],C1,0,0,0),   P1[6],P1[7],P1[8],P1[9],     pw2[2]=PKW(P1,4), pw2[3]=PKW(P1,6), pw2); \
    VRD(3); SBAR(); GAPA(C0=__builtin_amdgcn_mfma_f32_32x32x16_bf16(kf[6],qr[3],C0,0,0,0),   P1[10],P1[11],P1[12],P1[13], pw3[0]=PKW(P1,8), pw3[1]=PKW(P1,10), pw3); \
    VRD(7); SBAR(); GAPA(C1=__builtin_amdgcn_mfma_f32_32x32x16_bf16(kf[7],qr[3],C1,0,0,0),   P1[14],P1[15],0.f,0.f,       pw3[2]=PKW(P1,12),pw3[3]=PKW(P1,14), pw3); \
    l_reg+=sacc; \
    if(GK){DMA_K((t)+3,sl_cur);} if(GV){DMA_V((t)+1,sl_next);} \
    CMASK(C0,C1,t); \
    { float a=MX3(C0[0],C0[1],C1[0]),b=MX3(C0[2],C0[3],C1[1]); a=MX3(a,C1[2],C1[3]); \
      _Pragma("unroll") for(int r=4;r<16;r+=4){a=MX3(a,C0[r],C0[r+1]);b=MX3(b,C0[r+2],C0[r+3]);a=MX3(a,C1[r],C1[r+1]);b=MX3(b,C1[r+2],C1[r+3]);} \
      float rm=__builtin_fmaxf(a,b); { auto rr=__builtin_amdgcn_permlane32_swap(__float_as_uint(rm),__float_as_uint(rm),false,false); rm=__builtin_fmaxf(__uint_as_float(rr[0]),__uint_as_float(rr[1])); } \
      resc=false; \
      if(__builtin_expect(__any(rm>(float)THRL),0)){ const float dl=__builtin_fmaxf(rm,0.f); mhat+=dl; \
        _Pragma("unroll") for(int r=0;r<16;++r){C0[r]-=dl;C1[r]-=dl;} \
        _Pragma("unroll") for(int r=0;r<16;++r)negm[r]=-mhat; asm volatile("":"+v"(negm)); \
        const float f=__builtin_amdgcn_exp2f(-dl); l_reg*=f; if(hi==0)wsf[r32]=f; resc=true; } } \
    SBAR(); \
    GAPB(o[0]=__builtin_amdgcn_mfma_f32_32x32x16_bf16(PAF(0),VFR(0),o[0],0,0,0), C0,0); \
    GAPB(o[1]=__builtin_amdgcn_mfma_f32_32x32x16_bf16(PAF(0),VFR(4),o[1],0,0,0), C0,4); \
    KRD(GL,0); GAPB(o[0]=__builtin_amdgcn_mfma_f32_32x32x16_bf16(PAF(1),VFR(1),o[0],0,0,0), C0,8); \
    KRD(GL,1); GAPB(o[1]=__builtin_amdgcn_mfma_f32_32x32x16_bf16(PAF(1),VFR(5),o[1],0,0,0), C0,12); \
    KRD(GL,2); GAPB(o[0]=__builtin_amdgcn_mfma_f32_32x32x16_bf16(PAF(2),VFR(2),o[0],0,0,0), C1,0); \
    KRD(GL,3); GAPB(o[1]=__builtin_amdgcn_mfma_f32_32x32x16_bf16(PAF(2),VFR(6),o[1],0,0,0), C1,4); \
    GAPB(o[0]=__builtin_amdgcn_mfma_f32_32x32x16_bf16(PAF(3),VFR(3),o[0],0,0,0), C1,8); \
    GAPB(o[1]=__builtin_amdgcn_mfma_f32_32x32x16_bf16(PAF(3),VFR(7),o[1],0,0,0), C1,12); \
    }while(0)
  int t=1;
  #undef CMASK
  #define CMASK(P0,P1,t) do{}while(0)
  for(;t+5<NT;t+=2){
    STEP(pB0,pB1,pA0,pA1,t,true,true,true);     WAIT_BAR(2); RESC(); ROT();
    STEP(pA0,pA1,pB0,pB1,t+1,true,true,true);   WAIT_BAR(2); RESC(); ROT();
  }
  #undef CMASK
  #define CMASK(P0,P1,t) do{int jb_=(t)-(NT-4); if(jb_>=0)cmask(P0,P1,jb_,qrel,hi);}while(0)
  #define ENDW(tt) do{ if((tt)+3<NT){WAIT_BAR(2);} else if((tt)+2<NT){WAIT_BAR(1);} else {WAIT_BAR(0);} }while(0)
  for(;t+1<NT;t+=2){
    STEP(pB0,pB1,pA0,pA1,t,(t+3<NT),(t+1<NT),(t+1<NT));       ENDW(t);   RESC(); ROT();
    STEP(pA0,pA1,pB0,pB1,t+1,(t+4<NT),(t+2<NT),(t+2<NT));     ENDW(t+1); RESC(); ROT();
  }
  STEP(pB0,pB1,pA0,pA1,NT-1,false,false,false); RESC();
  { float sacc=pB0[0]+pB0[1]; _Pragma("unroll") for(int r=2;r<16;++r)sacc+=pB0[r]; _Pragma("unroll") for(int r=0;r<16;++r)sacc+=pB1[r]; l_reg+=sacc;
    pw0=(u32x4){PKW(pB0,0),PKW(pB0,2),PKW(pB0,4),PKW(pB0,6)};pw1=(u32x4){PKW(pB0,8),PKW(pB0,10),PKW(pB0,12),PKW(pB0,14)};pw2=(u32x4){PKW(pB1,0),PKW(pB1,2),PKW(pB1,4),PKW(pB1,6)};pw3=(u32x4){PKW(pB1,8),PKW(pB1,10),PKW(pB1,12),PKW(pB1,14)};
    SBAR(); pv(o,vb0+sl_cur,PAF(0),PAF(1),PAF(2),PAF(3)); }
  #undef PKW
  #undef PAF
  #undef VFR
  #undef PIN
  #undef MX3
  #undef GAPA
  #undef GAPB
  #undef EX
  #undef VRD
  #undef KRD
  #undef STEP
  #undef ENDW
  {auto rr=__builtin_amdgcn_permlane32_swap(__float_as_uint(l_reg),__float_as_uint(l_reg),false,false);l_reg=__uint_as_float(rr[0])+__uint_as_float(rr[1]);}
  if(hi==0)wsf[32+r32]=l_reg;asm volatile("s_waitcnt lgkmcnt(0)":::"memory");
  float rli[16];
  #pragma unroll
  for(int r=0;r<16;++r)rli[r]=__builtin_amdgcn_rcpf(wsf[32+crow(r,hi)]);
  bf16*Ow=O+(rowbase+q0+wid*QBLK)*PO+h*D;
  { bf16*stg=(bf16*)(shm+LDS_OST)+wid*2048;
    #pragma unroll
    for(int r=0;r<16;++r){const int orow=crow(r,hi);
      #pragma unroll
      for(int d0=0;d0<2;++d0)stg[orow*64+d0*32+r32]=__float2bfloat16(o[d0][r]*rli[r]);}
    asm volatile("s_waitcnt lgkmcnt(0)":::"memory");
    #pragma unroll
    for(int i=0;i<4;++i){const int row=i*8+(lane>>3),ch=lane&7; const u32x4 v=*(const u32x4*)(stg+row*64+ch*8); ATTN_STORE16(Ow+(long)row*PO+ch*8,v);} }
  asm volatile("s_waitcnt lgkmcnt(0)\n\ts_barrier":::"memory");
  #undef DMA_K
  #undef DMA_V
  #undef CMASK
  #undef START
  #undef RESC
  #undef ROT
}
constexpr int ATTN_LDS_BYTES=LDS_BYTES;
struct AttnTensors { const bf16* Q; const bf16* K; const bf16* V; bf16* O; };
struct AttnUnit { int bh; int qb; };
struct StaticOrder {
  int vcu;
  __device__ __forceinline__ explicit StaticOrder(int grid,int block):vcu((block%8)*(grid/8)+block/8){}
  __device__ __forceinline__ bool next(int i,AttnUnit&u)const{ if(i>=4)return false; const int s=vcu&3; u.bh=vcu>>2; u.qb=(i==0)?s:(i==1)?7-s:(i==2)?8+s:15-s; return true; }
  __device__ __forceinline__ void a_ready(const AttnUnit&)const{}
  __device__ __forceinline__ void done(const AttnUnit&)const{}
};
template<class Sched,int THRL=8> __device__ __forceinline__ void attn_phase(char*lds,const AttnTensors&T,const Sched&S){
  AttnUnit u;
  for(int i=0;S.next(i,u);++i){ S.a_ready(u); attn_unit<THRL>(u.bh/NHEAD,u.bh%NHEAD,u.qb,T.Q,T.K,T.V,T.O,lds); S.done(u); }
}
#undef SBAR
#undef WAIT_BAR
}

#define GAS __attribute__((address_space(1)))
#define LAS __attribute__((address_space(3)))
typedef unsigned short bf16;
typedef unsigned v4u __attribute__((ext_vector_type(4)));
typedef float f32x4 __attribute__((ext_vector_type(4)));
typedef short bf16x8 __attribute__((ext_vector_type(8)));
typedef GAS unsigned gu32;
typedef GAS unsigned long long gu64;
#define RLX_AGENT __ATOMIC_RELAXED, __HIP_MEMORY_SCOPE_AGENT
#define LDS_WAIT() asm volatile("s_waitcnt lgkmcnt(0)" ::: "memory")
#define VM_WAIT() asm volatile("s_waitcnt vmcnt(0)" ::: "memory")
__device__ __forceinline__ unsigned long long rt() { return __builtin_amdgcn_s_memrealtime(); }
__device__ __forceinline__ unsigned f2bf(float f) { unsigned u = __builtin_bit_cast(unsigned, f); return (u + 0x7fffu + ((u >> 16) & 1u)) >> 16; }
__device__ __forceinline__ unsigned pk2(float lo, float hi) { return f2bf(lo) | (f2bf(hi) << 16); }

#define XB_TMO      128
#define XB_XCNT(j)  (256  + 64 * (j))
#define XB_XSUB(j)  (1280 + 64 * (j))
#define XB_XGEN(j)  (2304 + 64 * (j))
#define XB_TOP      3328
#define XB_TOPGEN   3392
#define XCD_BAR_WORDS 3456
#define XB_SPIN_CAP (1u << 18)

__device__ __forceinline__ unsigned xb_ld(unsigned* p)              { return __hip_atomic_load(p, __ATOMIC_RELAXED, __HIP_MEMORY_SCOPE_AGENT); }
__device__ __forceinline__ unsigned xb_add(unsigned* p, unsigned v) { return __hip_atomic_fetch_add(p, v, __ATOMIC_RELAXED, __HIP_MEMORY_SCOPE_AGENT); }
__device__ __forceinline__ unsigned xb_xcc_id() { return (unsigned)__builtin_amdgcn_s_getreg((3 << 11) | 20) & 0xFu; }
#define XB_SPIN(cond, bar) do { unsigned _sp = 0; while (cond) { __builtin_amdgcn_s_sleep(1); \
    if ((++_sp & 255u) == 0u) { if (xb_ld(&(bar)[XB_TMO])) break; if (_sp > XB_SPIN_CAP) { atomicAdd(&(bar)[XB_TMO], 1u); break; } } } } while (0)

struct XcdBarrier {
    unsigned* bar; unsigned x;
    volatile LAS unsigned* st;
};

__device__ __forceinline__ XcdBarrier xcd_barrier_post(unsigned* bar, volatile LAS unsigned* st) {
    XcdBarrier b; b.bar = bar; b.x = xb_xcc_id(); b.st = st;
    if (threadIdx.x == 0) (void)xb_add(&bar[XB_XCNT(b.x)], 1u);
    return b;
}
__device__ __forceinline__ void xcd_barrier_complete(unsigned* bar, unsigned x, unsigned& nloc, unsigned& nx) {
    const unsigned G = gridDim.x * gridDim.y * gridDim.z;
    unsigned sum, cnt, mine, sp = 0u;
    for (;;) {
        sum = 0u; cnt = 0u; mine = 0u;
#pragma unroll
        for (unsigned j = 0; j < 16; ++j) { const unsigned c = xb_ld(&bar[XB_XCNT(j)]); sum += c; cnt += (c > 0u) ? 1u : 0u; mine = (j == x) ? c : mine; }
        if (sum == G) break;
        __builtin_amdgcn_s_sleep(1);
        if ((++sp & 255u) == 0u) { if (xb_ld(&bar[XB_TMO])) break; if (sp > XB_SPIN_CAP) { atomicAdd(&bar[XB_TMO], 1u); break; } }
    }
    nloc = mine > 0u ? mine : 1u; nx = cnt > 0u ? cnt : 1u;
}

__device__ __forceinline__ void xcd_barrier(const XcdBarrier& b) {
    asm volatile("s_waitcnt vmcnt(0)" ::: "memory");
    __syncthreads();
    if (threadIdx.x == 0) {
        unsigned* bar = b.bar;
        __builtin_amdgcn_s_waitcnt(0);
        unsigned nloc = b.st[0], nx = b.st[1];
        if (nloc == 0u) { xcd_barrier_complete(bar, b.x, nloc, nx); b.st[0] = nloc; b.st[1] = nx; }
        const unsigned old = xb_add(&bar[XB_XSUB(b.x)], 1u);
        const unsigned gen = old / nloc;
        if (old + 1u == (gen + 1u) * nloc) {
            __builtin_amdgcn_fence(__ATOMIC_RELEASE, "agent");
            asm volatile("s_waitcnt vmcnt(0)" ::: "memory");
            const unsigned og = xb_add(&bar[XB_TOP], 1u);
            const unsigned tg = og / nx;
            if (og + 1u == (tg + 1u) * nx) xb_add(&bar[XB_TOPGEN], 1u);
            else XB_SPIN(xb_ld(&bar[XB_TOPGEN]) == tg, bar);
            __builtin_amdgcn_fence(__ATOMIC_ACQUIRE, "agent");
            xb_add(&bar[XB_XGEN(b.x)], 1u);
            asm volatile("s_waitcnt vmcnt(0)" ::: "memory");
        } else {
            XB_SPIN(xb_ld(&bar[XB_XGEN(b.x)]) == gen, bar);
            __builtin_amdgcn_fence(__ATOMIC_ACQUIRE, "agent");
            asm volatile("s_waitcnt vmcnt(0)" ::: "memory");
        }
    }
    __syncthreads();
}


constexpr int NWAVES = 8;
constexpr int BATCH = 4, SEQ = 4096, DM = 1024, M = BATCH * SEQ, IN_COLS = 5632, NEXP = 32, EFF = 512;
constexpr float EPS = 1e-6f;
constexpr float LAM_INIT = 0.2f;
constexpr int MAXROWS = 2 * M + NEXP * 255;
#ifndef MK_PER_PHASE
#define MK_PER_PHASE 0
#endif
constexpr int N_PHASES = 12;
#ifndef PROBE_A
#define PROBE_A -1
#endif
#ifndef PROBE_B
#define PROBE_B -1
#endif
constexpr bool PROBING = (PROBE_A >= 0) || (PROBE_B >= 0);
constexpr int MI_TS = 128;

constexpr size_t MiB = 1u << 20;
constexpr size_t WS_CTL = 0, CTL_ZERO_BYTES = 1 * MiB;
constexpr size_t WS_WIN = 1 * MiB, WS_WA = 12 * MiB, WS_WB = 13 * MiB, WS_WOUT = 14 * MiB;
constexpr size_t WS_TABA = 16 * MiB, WS_TABB = 17 * MiB, WS_WRP = 25 * MiB;
constexpr size_t WS_SSQ = 16 * MiB;
constexpr size_t WS_H = 26 * MiB;
constexpr size_t WS_P = 58 * MiB, PBUF = 16 * MiB;
constexpr size_t WS_OA = 234 * MiB, WS_OB = 250 * MiB;
constexpr size_t WS_T = 58 * MiB, WS_MERGED = 122 * MiB;
constexpr size_t WS_Y = 58 * MiB;
constexpr size_t WS_XS = 58 * MiB, WS_HMID = 138 * MiB, WS_WGU = 178 * MiB, WS_WD = 242 * MiB;
constexpr size_t WS_ENT_TOK = 274 * MiB, WS_ENT_W = 276 * MiB, WS_ROW_TOK = 278 * MiB, WS_ROW_W = 278 * MiB + 512 * 1024, WS_END = 279 * MiB;
static_assert((size_t)MAXROWS * 1024 * 2 <= WS_HMID - WS_XS && (size_t)MAXROWS * 512 * 2 <= WS_WGU - WS_HMID && (size_t)MAXROWS * 4 <= 512 * 1024, "ws map");
constexpr int CW_TMO = 0, CW_CODE = 1, CW_CNT = 64, CW_BAR = 4096;

constexpr int RING_OFF = 0, RING_BYTES = 131072;
constexpr int LDSCTL_OFF = RING_BYTES, MISC_OFF = LDSCTL_OFF + 320;
constexpr int LDS_BYTES = 147456;
constexpr int MI_CNT = 16, MI_TP = 48;


struct Args { const void* in[24]; float* out; unsigned char* ws; int ph_lo, ph_hi; };
#define FIN(i) ((const float*)args.in[i])
struct Frame {
    LAS unsigned char* lds;
    volatile LAS unsigned* MISC;
    gu32* ctl;
    int tid, lane, wave;
    int vcu, G;
    float* out; unsigned char* ws;
};
__device__ __forceinline__ float bflo(unsigned w) { return __uint_as_float(w << 16); }
__device__ __forceinline__ float bfhi(unsigned w) { return __uint_as_float(w & 0xffff0000u); }
__device__ __forceinline__ float wave_sum(float v) {
#pragma unroll
    for (int o = 1; o < 64; o <<= 1) v += __shfl_xor(v, o);
    return v;
}
__device__ __forceinline__ float sigmoidf_(float x) { return 1.0f / (1.0f + __expf(-x)); }
__device__ __forceinline__ float siluf_(float x) { return x / (1.0f + __expf(-x)); }
__device__ __forceinline__ void unpack8(const v4u r, float (&x)[8]) {
    x[0] = bflo(r.x); x[1] = bfhi(r.x); x[2] = bflo(r.y); x[3] = bfhi(r.y); x[4] = bflo(r.z); x[5] = bfhi(r.z); x[6] = bflo(r.w); x[7] = bfhi(r.w);
}
__device__ __forceinline__ v4u pack8(const float (&x)[8]) { v4u o; o.x = pk2(x[0], x[1]); o.y = pk2(x[2], x[3]); o.z = pk2(x[4], x[5]); o.w = pk2(x[6], x[7]); return o; }

__device__ __forceinline__ int win_row(int n) {
    const int t = n >> 9, pr = n & 511; int pos = pr;
    if (t <= 1) { const int d = pr & 63; pos = (pr & ~63) | (d < 16 ? (2 * (d & 7) + (d >> 3)) : d); }
    else if (t == 3 || t == 4) { const int d = pr & 127; pos = (pr & ~127) | (2 * (d & 63) + (d >> 6)); }
    const int sc = t * 512 + pos, lc = sc & 255;
    const int pc = 128 * ((lc >> 5) & 1) + 32 * (lc >> 6) + (lc & 31);
    return (sc & ~255) | pc;
}
__device__ __forceinline__ void transpose_item(const float* W, int N, bf16* WT, int ldt, int mode, LAS unsigned* scr, int kb, int nb, int lane) {
    const int k0 = 64 * kb, n0 = 64 * nb, n4 = 4 * (lane & 15);
    f32x4 a[8], b[8];
#pragma unroll
    for (int i = 0; i < 8; ++i) { const int kp = 4 * i + (lane >> 4); const float* p = W + (size_t)(k0 + 2 * kp) * N + n0 + n4; a[i] = *(const GAS f32x4*)p; b[i] = *(const GAS f32x4*)(p + N); }
#pragma unroll
    for (int i = 0; i < 8; ++i) { const int kp = 4 * i + (lane >> 4);
#pragma unroll
        for (int t = 0; t < 4; ++t) scr[(n4 + t) * 36 + kp] = pk2(a[i][t], b[i][t]); }
    LDS_WAIT(); asm volatile("" ::: "memory");
    const int c = lane & 7;
#pragma unroll
    for (int j = 0; j < 8; ++j) { const int n = (lane >> 3) + 8 * j; const v4u o = *(const LAS v4u*)(scr + n * 36 + 4 * c);
        const int nn = n0 + n; const int row = mode == 0 ? nn : mode == 3 ? win_row(nn) : ((nn >> 2) * 8 + (mode == 2 ? 4 : 0) + (nn & 3));
        *(GAS v4u*)(WT + (size_t)row * ldt + k0 + 8 * c) = o; }
    LDS_WAIT(); asm volatile("" ::: "memory");
}
__device__ __forceinline__ void sincos_acc(float ang, float& s, float& c) {
    const double t = (double)ang * 0.15915494309189535; const double fr = t - __builtin_rint(t);
    const float r = (float)(fr * 6.283185307179586);
    s = sinf(r); c = cosf(r);
}
__device__ __forceinline__ void p0_prologue(Frame& F, const Args& args) {
    LAS unsigned* scr = (LAS unsigned*)(F.lds + RING_OFF + F.wave * 16384);
    const int gw = F.vcu * NWAVES + F.wave, NGW = F.G * NWAVES;
    unsigned char* ws = F.ws;
    constexpr int I_IN = (DM / 64) * (IN_COLS / 64), I_A = (512 / 64) * (DM / 64), I_OUT = (DM / 64) * (DM / 64);
    for (int it = gw; it < I_IN + 2 * I_A + I_OUT; it += NGW) {
        int r = it;
        if (r < I_IN) { transpose_item(FIN(3), IN_COLS, (bf16*)(ws + WS_WIN), DM, 3, scr, r / (IN_COLS / 64), r % (IN_COLS / 64), F.lane); continue; } r -= I_IN;
        if (r < I_A) { transpose_item(FIN(13), DM, (bf16*)(ws + WS_WA), 1024, 0, scr, r / (DM / 64), r % (DM / 64), F.lane); continue; } r -= I_A;
        if (r < I_A) { transpose_item(FIN(14), DM, (bf16*)(ws + WS_WA) + 512, 1024, 0, scr, r / (DM / 64), r % (DM / 64), F.lane); continue; } r -= I_A;
        transpose_item(FIN(15), DM, (bf16*)(ws + WS_WOUT), DM, 0, scr, r / (DM / 64), r % (DM / 64), F.lane);
    }
    {
        const float* wgr = FIN(17); const float* wer = FIN(19); const float* g2 = FIN(16); v4u* Wp16 = (v4u*)(ws + WS_WRP);
        for (int idx = gw * 64 + F.lane; idx < 32 * 3 * 64; idx += NGW * 64) {
            const int l = idx & 63, kt = idx >> 6, t = kt % 3, ks = kt / 3, col = l & 15, q = l >> 4;
            float hi[8], lo[8];
#pragma unroll
            for (int j = 0; j < 8; ++j) { const int k = 32 * ks + 8 * q + j; const float w = g2[k] * ((t == 0) ? (col < 4 ? wgr[k * 4 + col] : 0.f) : wer[k * 32 + (t - 1) * 16 + col]);
                hi[j] = __uint_as_float(f2bf(w) << 16); lo[j] = w - hi[j]; }
            Wp16[(size_t)(kt * 2 + 0) * 64 + l] = pack8(hi); Wp16[(size_t)(kt * 2 + 1) * 64 + l] = pack8(lo);
        }
    }
    {
        const int* pos = (const int*)FIN(1); float* tabA = (float*)(ws + WS_TABA); float* tabB = (float*)(ws + WS_TABB);
        const float fB = powf(10000.0f, -(float)F.lane * (1.0f / 64.0f)), fA = powf(500000.0f, -(float)(F.lane & 7) * 0.125f);
        for (int tk = gw; tk < M; tk += NGW) {
            const float p = (float)pos[tk]; float s, c;
            sincos_acc(p * fB, s, c); tabB[(size_t)tk * 128 + F.lane] = c; tabB[(size_t)tk * 128 + 64 + F.lane] = s;
            if (F.lane < 8) { sincos_acc(p * fA, s, c); tabA[(size_t)tk * 16 + F.lane] = c; tabA[(size_t)tk * 16 + 8 + F.lane] = s; }
        }
    }
    {
        const float* g = FIN(2); bf16* H = (bf16*)(ws + WS_H);
        f32x4 gv[4];
#pragma unroll
        for (int j = 0; j < 4; ++j) gv[j] = ((const f32x4*)g)[F.lane + 64 * j];
        for (int m = gw; m < M; m += NGW) {
            const GAS f32x4* xr = (const GAS f32x4*)(FIN(0) + (size_t)m * DM) + F.lane;
            f32x4 v[4]; float s = 0.f;
#pragma unroll
            for (int j = 0; j < 4; ++j) { v[j] = xr[64 * j]; s += (v[j].x * v[j].x + v[j].y * v[j].y) + (v[j].z * v[j].z + v[j].w * v[j].w); }
            const float rstd = rsqrtf(wave_sum(s) * (1.f / DM) + EPS);
            GAS unsigned long long* o8 = (GAS unsigned long long*)(H + (size_t)m * DM) + F.lane;
#pragma unroll
            for (int j = 0; j < 4; ++j) o8[64 * j] = (unsigned long long)pk2(v[j].x * rstd * gv[j].x, v[j].y * rstd * gv[j].y) | ((unsigned long long)pk2(v[j].z * rstd * gv[j].z, v[j].w * rstd * gv[j].w) << 32);
        }
    }
}

__device__ __forceinline__ int rt_off(int row, int kb) { return row * 256 + ((((kb >> 4) ^ (row & 15)) << 4) | (kb & 15)); }
__device__ __forceinline__ bf16x8 rt_frag(const LAS unsigned char* tile, int r0, int ks, int lane) {
    return *(const LAS bf16x8*)(tile + rt_off(r0 + (lane & 15), ks * 64 + 16 * (lane >> 4)));
}
__device__ __forceinline__ float log2_gamma(int h) { return log2f(1.0f - exp2f(-5.0f - (float)h)); }

__device__ __forceinline__ void ret_kv_item(Frame& F, const Args& args, int item) {
    const int bh = item >> 5, n = item & 31, b = bh >> 2, h = bh & 3, tid = F.tid, lane = F.lane, w = F.wave;
    const size_t tok0 = (size_t)b * SEQ + (size_t)n * 128;
    const bf16* kr = (const bf16*)(F.ws + WS_P + 4 * PBUF); const bf16* vr = (const bf16*)(F.ws + WS_P + 5 * PBUF);
    float* RS = F.out + (size_t)item * 16384;
    LAS unsigned char* Kt = F.lds; LAS unsigned char* Vt = F.lds + 32768;
    const float lg = log2_gamma(h);
#pragma unroll
    for (int it = 0; it < 4; ++it) {
        const int idx = tid + it * 512, j = idx & 127, ch = idx >> 7;
        const v4u kv = *(const GAS v4u*)(kr + (tok0 + j) * 512 + h * 128 + ch * 8);
        const v4u vv = *(const GAS v4u*)(vr + (tok0 + j) * 512 + h * 128 + ch * 8);
        float kx[8], vx[8]; unpack8(kv, kx); unpack8(vv, vx);
        const float z = exp2f((float)(127 - j) * lg);
#pragma unroll
        for (int t = 0; t < 8; ++t) {
            *(LAS unsigned short*)(Kt + rt_off(ch * 8 + t, j * 2)) = (unsigned short)f2bf(kx[t]);
            *(LAS unsigned short*)(Vt + rt_off(ch * 8 + t, j * 2)) = (unsigned short)f2bf(vx[t] * z);
        }
    }
    __syncthreads();
    f32x4 acc[8];
#pragma unroll
    for (int dt = 0; dt < 8; ++dt) acc[dt] = (f32x4){0.f, 0.f, 0.f, 0.f};
#pragma unroll
    for (int ks = 0; ks < 4; ++ks) {
        const bf16x8 a = rt_frag(Vt, 16 * w, ks, lane);
#pragma unroll
        for (int dt = 0; dt < 8; ++dt) { const bf16x8 bb = rt_frag(Kt, 16 * dt, ks, lane); acc[dt] = __builtin_amdgcn_mfma_f32_16x16x32_bf16(bb, a, acc[dt], 0, 0, 0); }
    }
    const int e = 16 * w + (lane & 15), q = lane >> 4;
#pragma unroll
    for (int dt = 0; dt < 8; ++dt) *(GAS f32x4*)(RS + (size_t)e * 128 + 16 * dt + 4 * q) = acc[dt];
    __syncthreads();
}
__device__ __forceinline__ void p4_scan(Frame& F, const Args& args) {
    const int gid = F.vcu * (NWAVES * 64) + F.tid, NT = F.G * NWAVES * 64;
    for (int idx = gid; idx < 16 * 4096; idx += NT) {
        const int bh = idx >> 12, off = idx & 4095, h = bh & 3;
        const float g = exp2f(128.0f * log2_gamma(h));
        f32x4 r = (f32x4){0.f, 0.f, 0.f, 0.f};
        GAS f32x4* p = (GAS f32x4*)(F.out + (size_t)bh * 32 * 16384) + off;
        for (int n = 0; n < 32; ++n) { const f32x4 t = p[(size_t)n * 4096]; p[(size_t)n * 4096] = r; r = r * g + t; }
    }
}
__device__ __forceinline__ void ret_out_item(Frame& F, const Args& args, int item) {
    const int bh = item >> 5, n = item & 31, b = bh >> 2, h = bh & 3, tid = F.tid, lane = F.lane, w = F.wave;
    const size_t tok0 = (size_t)b * SEQ + (size_t)n * 128;
    const bf16* qr = (const bf16*)(F.ws + WS_P + 3 * PBUF); const bf16* kr = (const bf16*)(F.ws + WS_P + 4 * PBUF); const bf16* vr = (const bf16*)(F.ws + WS_P + 5 * PBUF);
    const bf16* gb = (const bf16*)(F.ws + WS_P + 6 * PBUF); bf16* obg = (bf16*)(F.ws + WS_OA) + 512;
    const float* RS = F.out + (size_t)item * 16384;
    LAS unsigned char* Qs = F.lds; LAS unsigned char* Ks = F.lds + 32768; LAS unsigned char* Vt = F.lds + 65536; LAS unsigned char* Rt = F.lds + 98304;
    const float lg = log2_gamma(h);
#pragma unroll
    for (int it = 0; it < 4; ++it) {
        const int idx = tid + it * 512;
        { const int row = idx >> 4, ch = idx & 15;
          *(LAS v4u*)(Qs + rt_off(row, ch * 16)) = *(const GAS v4u*)(qr + (tok0 + row) * 512 + h * 128 + ch * 8);
          *(LAS v4u*)(Ks + rt_off(row, ch * 16)) = *(const GAS v4u*)(kr + (tok0 + row) * 512 + h * 128 + ch * 8);
          const f32x4 r0 = *(const GAS f32x4*)(RS + (size_t)row * 128 + ch * 8), r1 = *(const GAS f32x4*)(RS + (size_t)row * 128 + ch * 8 + 4);
          v4u o; o.x = pk2(r0.x, r0.y); o.y = pk2(r0.z, r0.w); o.z = pk2(r1.x, r1.y); o.w = pk2(r1.z, r1.w);
          *(LAS v4u*)(Rt + rt_off(row, ch * 16)) = o; }
        { const int j = idx & 127, ch = idx >> 7;
          const v4u vv = *(const GAS v4u*)(vr + (tok0 + j) * 512 + h * 128 + ch * 8);
          *(LAS unsigned short*)(Vt + rt_off(ch * 8 + 0, j * 2)) = (unsigned short)(vv.x & 0xffffu); *(LAS unsigned short*)(Vt + rt_off(ch * 8 + 1, j * 2)) = (unsigned short)(vv.x >> 16);
          *(LAS unsigned short*)(Vt + rt_off(ch * 8 + 2, j * 2)) = (unsigned short)(vv.y & 0xffffu); *(LAS unsigned short*)(Vt + rt_off(ch * 8 + 3, j * 2)) = (unsigned short)(vv.y >> 16);
          *(LAS unsigned short*)(Vt + rt_off(ch * 8 + 4, j * 2)) = (unsigned short)(vv.z & 0xffffu); *(LAS unsigned short*)(Vt + rt_off(ch * 8 + 5, j * 2)) = (unsigned short)(vv.z >> 16);
          *(LAS unsigned short*)(Vt + rt_off(ch * 8 + 6, j * 2)) = (unsigned short)(vv.w & 0xffffu); *(LAS unsigned short*)(Vt + rt_off(ch * 8 + 7, j * 2)) = (unsigned short)(vv.w >> 16); }
    }
    __syncthreads();
    const int i = 16 * w + (lane & 15), q = lane >> 4;
    f32x4 sacc[8];
#pragma unroll
    for (int jt = 0; jt < 8; ++jt) sacc[jt] = (f32x4){0.f, 0.f, 0.f, 0.f};
#pragma unroll
    for (int ks = 0; ks < 4; ++ks) {
        const bf16x8 a = rt_frag(Qs, 16 * w, ks, lane);
#pragma unroll
        for (int jt = 0; jt < 8; ++jt) { const bf16x8 bb = rt_frag(Ks, 16 * jt, ks, lane); sacc[jt] = __builtin_amdgcn_mfma_f32_16x16x32_bf16(bb, a, sacc[jt], 0, 0, 0); }
    }
    __syncthreads();
#pragma unroll
    for (int jt = 0; jt < 8; ++jt) {
        float v[4];
#pragma unroll
        for (int t = 0; t < 4; ++t) { const int j = 16 * jt + 4 * q + t; v[t] = (i >= j) ? sacc[jt][t] * exp2f((float)(i - j) * lg) : 0.f; }
        *(LAS unsigned long long*)(Ks + rt_off(i, (16 * jt + 4 * q) * 2)) = (unsigned long long)pk2(v[0], v[1]) | ((unsigned long long)pk2(v[2], v[3]) << 32);
    }
    __syncthreads();
    f32x4 a1[8], a2[8];
#pragma unroll
    for (int et = 0; et < 8; ++et) { a1[et] = (f32x4){0.f, 0.f, 0.f, 0.f}; a2[et] = (f32x4){0.f, 0.f, 0.f, 0.f}; }
#pragma unroll
    for (int ks = 0; ks < 4; ++ks) {
        const bf16x8 aS = rt_frag(Ks, 16 * w, ks, lane), aQ = rt_frag(Qs, 16 * w, ks, lane);
#pragma unroll
        for (int et = 0; et < 8; ++et) {
            const bf16x8 bV = rt_frag(Vt, 16 * et, ks, lane), bR = rt_frag(Rt, 16 * et, ks, lane);
            a1[et] = __builtin_amdgcn_mfma_f32_16x16x32_bf16(bV, aS, a1[et], 0, 0, 0);
            a2[et] = __builtin_amdgcn_mfma_f32_16x16x32_bf16(bR, aQ, a2[et], 0, 0, 0);
        }
    }
    const float xi = exp2f((float)(i + 1) * lg);
    float s = 0.f;
#pragma unroll
    for (int et = 0; et < 8; ++et) { a1[et] = a1[et] + a2[et] * xi; s += (a1[et][0] + a1[et][1]) + (a1[et][2] + a1[et][3]); }
    s += __shfl_xor(s, 16); s += __shfl_xor(s, 32);
    const float mu = s * (1.f / 128.f); float vq = 0.f;
#pragma unroll
    for (int et = 0; et < 8; ++et) { const f32x4 d = a1[et] - mu; vq += (d[0] * d[0] + d[1] * d[1]) + (d[2] * d[2] + d[3] * d[3]); }
    vq += __shfl_xor(vq, 16); vq += __shfl_xor(vq, 32);
    const float rstd = rsqrtf(vq * (1.f / 128.f) + EPS);
    const float* gng = FIN(11) + h * 128; const float* gnb = FIN(12) + h * 128;
#pragma unroll
    for (int et = 0; et < 8; ++et) {
        const int e = 16 * et + 4 * q;
        const f32x4 gg = *(const f32x4*)(gng + e), bb = *(const f32x4*)(gnb + e);
        const unsigned long long gw8 = *(const GAS unsigned long long*)(gb + (tok0 + i) * 512 + h * 128 + e);
        const float g0 = bflo((unsigned)gw8), g1 = bfhi((unsigned)gw8), g2 = bflo((unsigned)(gw8 >> 32)), g3 = bfhi((unsigned)(gw8 >> 32));
        const f32x4 y = (a1[et] - mu) * rstd * gg + bb;
        *(GAS unsigned long long*)(obg + (tok0 + i) * 1024 + h * 128 + e) =
            (unsigned long long)pk2(y[0] * siluf_(g0), y[1] * siluf_(g1)) | ((unsigned long long)pk2(y[2] * siluf_(g2), y[3] * siluf_(g3)) << 32);
    }
    __syncthreads();
}
__device__ __forceinline__ void p5_attn_combine(Frame& F, const Args& args) {
    const int gw = F.vcu * NWAVES + F.wave, NGW = F.G * NWAVES, lane = F.lane;
    const float s1 = wave_sum(FIN(6)[lane] * FIN(7)[lane]), s2 = wave_sum(FIN(8)[lane] * FIN(9)[lane]);
    const float lam = expf(s1) - expf(s2) + LAM_INIT;
    const bf16* AO = (const bf16*)(F.ws + WS_H); bf16* oa = (bf16*)(F.ws + WS_OA);
    const int h = lane >> 4, e0 = (lane & 15) * 8, vhalf = e0 >> 6, d = e0 & 63;
    float g[8];
#pragma unroll
    for (int t = 0; t < 8; ++t) g[t] = FIN(10)[e0 + t] * (1.0f - LAM_INIT);
    for (int tk = gw; tk < M; tk += NGW) {
        float x0[8], x1[8];
        unpack8(*(const GAS v4u*)(AO + (size_t)tk * 1024 + (h * 4 + vhalf) * 64 + d), x0);
        unpack8(*(const GAS v4u*)(AO + (size_t)tk * 1024 + (h * 4 + 2 + vhalf) * 64 + d), x1);
        float y[8], ss = 0.f;
#pragma unroll
        for (int t = 0; t < 8; ++t) { y[t] = x0[t] - lam * x1[t]; ss += y[t] * y[t]; }
        ss += __shfl_xor(ss, 1); ss += __shfl_xor(ss, 2); ss += __shfl_xor(ss, 4); ss += __shfl_xor(ss, 8);
        const float rstd = rsqrtf(ss * (1.f / 128.f) + EPS);
#pragma unroll
        for (int t = 0; t < 8; ++t) y[t] = y[t] * rstd * g[t];
        *(GAS v4u*)(oa + (size_t)tk * 1024 + h * 128 + e0) = pack8(y);
    }
}

struct EpiIn {
    static constexpr bool PERM = true, AFTER_DRAIN = false, MUTATES = false;
    bf16* P; const float* tabA; const float* tabB; const float* qg; const float* kg;
    __device__ __forceinline__ void operator()(const f32x4 (&acc)[2][2][4][2], const pg8::Unit& u, int wr, int wc, int fr, int fq) const {
        const int t = u.pn >> 1, row0 = u.pm * 256 + wr * 64 + fr, pos0 = (u.pn & 1) * 256 + 64 * wc + 8 * fq;
        bf16* base = P + (size_t)t * (PBUF / 2);
        constexpr float C2 = 0.125f * 1.4426950408889634f;
        if (t <= 1) {
            float g8[2][8];
            const float* gsrc = (t == 0) ? qg : kg;
#pragma unroll
            for (int bj = 0; bj < 2; ++bj)
#pragma unroll
                for (int i = 0; i < 8; ++i) { const int j = 32 * bj + 8 * fq + i; const int d = (j < 16) ? ((j >> 1) + 8 * (j & 1)) : j; g8[bj][i] = gsrc[d] * (t == 0 ? C2 : 1.0f); }
#pragma unroll
            for (int ai = 0; ai < 2; ++ai)
#pragma unroll
                for (int m = 0; m < 4; ++m) { const size_t row = (size_t)(row0 + ai * 128 + m * 16);
                    float ss = 0.f;
#pragma unroll
                    for (int bj = 0; bj < 2; ++bj)
#pragma unroll
                        for (int n = 0; n < 2; ++n) { const f32x4 v = acc[ai][bj][m][n]; ss += (v[0] * v[0] + v[1] * v[1]) + (v[2] * v[2] + v[3] * v[3]); }
                    ss += __shfl_xor(ss, 16); ss += __shfl_xor(ss, 32);
                    const float rstd = rsqrtf(ss * (1.f / 64.f) + EPS);
#pragma unroll
                    for (int bj = 0; bj < 2; ++bj) {
                        float y[8];
#pragma unroll
                        for (int i = 0; i < 8; ++i) y[i] = acc[ai][bj][m][i >> 2][i & 3] * rstd * g8[bj][i];
                        if (bj == 0 && fq < 2) {
                            const f32x4 cs = *(const GAS f32x4*)(tabA + row * 16 + 4 * fq), sn = *(const GAS f32x4*)(tabA + row * 16 + 8 + 4 * fq);
#pragma unroll
                            for (int p = 0; p < 4; ++p) { const float x1 = y[2 * p], x2 = y[2 * p + 1]; y[2 * p] = x1 * cs[p] - x2 * sn[p]; y[2 * p + 1] = x2 * cs[p] + x1 * sn[p]; }
                        }
                        *(GAS v4u*)(base + row * 512 + pos0 + 32 * bj) = pack8(y);
                    } }
        } else if (t == 3 || t == 4) {
            const float sc = (t == 4) ? 0.08838834764831845f : 1.0f;
#pragma unroll
            for (int ai = 0; ai < 2; ++ai)
#pragma unroll
                for (int m = 0; m < 4; ++m) { const size_t row = (size_t)(row0 + ai * 128 + m * 16);
#pragma unroll
                    for (int bj = 0; bj < 2; ++bj) {
                        const int rho0 = ((pos0 + 32 * bj) & 127) >> 1;
                        const f32x4 cs = *(const GAS f32x4*)(tabB + row * 128 + rho0), sn = *(const GAS f32x4*)(tabB + row * 128 + 64 + rho0);
                        float y[8];
#pragma unroll
                        for (int p = 0; p < 4; ++p) { const float x1 = acc[ai][bj][m][p >> 1][2 * (p & 1)], x2 = acc[ai][bj][m][p >> 1][2 * (p & 1) + 1];
                            y[2 * p] = (x1 * cs[p] - x2 * sn[p]) * sc; y[2 * p + 1] = (x2 * cs[p] + x1 * sn[p]) * sc; }
                        *(GAS v4u*)(base + row * 512 + pos0 + 32 * bj) = pack8(y);
                    } }
        } else {
#pragma unroll
            for (int ai = 0; ai < 2; ++ai)
#pragma unroll
                for (int m = 0; m < 4; ++m) { const size_t row = (size_t)(row0 + ai * 128 + m * 16);
#pragma unroll
                    for (int bj = 0; bj < 2; ++bj) { const f32x4 v0 = acc[ai][bj][m][0], v1 = acc[ai][bj][m][1];
                        v4u o; o.x = pk2(v0[0], v0[1]); o.y = pk2(v0[2], v0[3]); o.z = pk2(v1[0], v1[1]); o.w = pk2(v1[2], v1[3]);
                        *(GAS v4u*)(base + row * 512 + pos0 + 32 * bj) = o; } }
        }
    }
};
struct EpiMerge2 {
    static constexpr bool PERM = false, AFTER_DRAIN = false, MUTATES = true;
    bf16* O; const bf16* ga0; const bf16* ga1; const bf16* gb0; const bf16* gb1;
    __device__ __forceinline__ bool mut(f32x4 (&acc)[2][2][4][2], const pg8::Unit& u, int wr, int wc, int fr, int fq) const {
        const int row0 = u.pm * 256 + wr * 64 + fr, col0 = u.pn * 256 + wc * 32 + 4 * fq;
#pragma unroll
        for (int ai = 0; ai < 2; ++ai)
#pragma unroll
            for (int m = 0; m < 4; ++m) { const size_t row = (size_t)(row0 + ai * 128 + m * 16);
#pragma unroll
                for (int bj = 0; bj < 2; ++bj)
#pragma unroll
                    for (int n = 0; n < 2; ++n) { const int col = col0 + bj * 128 + n * 16;
                        const unsigned long long b8 = *(const GAS unsigned long long*)((col < 512 ? gb0 : gb1) + row * 512 + (col & 511));
                        const float eb[4] = {__expf(-bflo((unsigned)b8)), __expf(-bfhi((unsigned)b8)), __expf(-bflo((unsigned)(b8 >> 32))), __expf(-bfhi((unsigned)(b8 >> 32)))};
                        if (u.kh == 0) {
                            const unsigned long long a8 = *(const GAS unsigned long long*)((col < 512 ? ga0 : ga1) + row * 512 + (col & 511));
                            const float ea[4] = {__expf(-bflo((unsigned)a8)), __expf(-bfhi((unsigned)a8)), __expf(-bflo((unsigned)(a8 >> 32))), __expf(-bfhi((unsigned)(a8 >> 32)))};
#pragma unroll
                            for (int t = 0; t < 4; ++t) acc[ai][bj][m][n][t] *= (1.0f + eb[t]) / (1.0f + ea[t]);
                        } else {
                            float v[4];
#pragma unroll
                            for (int t = 0; t < 4; ++t) v[t] = acc[ai][bj][m][n][t] / (1.0f + eb[t]);
                            *(GAS unsigned long long*)(O + row * 1024 + col) = (unsigned long long)pk2(v[0], v[1]) | ((unsigned long long)pk2(v[2], v[3]) << 32);
                        } } }
        return u.kh == 0;
    }
};
struct EpiResid {
    static constexpr bool PERM = false, AFTER_DRAIN = false, MUTATES = false;
    const float* X; float* O; float* ssq;
    __device__ __forceinline__ void operator()(const f32x4 (&acc)[2][2][4][2], const pg8::Unit& u, int wr, int wc, int fr, int fq) const {
        const int row0 = u.pm * 256 + wr * 64 + fr, col0 = u.pn * 256 + wc * 32 + 4 * fq;
#pragma unroll
        for (int ai = 0; ai < 2; ++ai)
#pragma unroll
            for (int m = 0; m < 4; ++m) { const size_t row = (size_t)(row0 + ai * 128 + m * 16); float sq = 0.f;
#pragma unroll
                for (int bj = 0; bj < 2; ++bj)
#pragma unroll
                    for (int n = 0; n < 2; ++n) { const int col = col0 + bj * 128 + n * 16;
                        const f32x4 v = *(const GAS f32x4*)(X + row * 1024 + col) + acc[ai][bj][m][n];
                        sq += (v[0] * v[0] + v[1] * v[1]) + (v[2] * v[2] + v[3] * v[3]);
                        *(GAS f32x4*)(O + row * 1024 + col) = v; }
                sq += __shfl_xor(sq, 16); sq += __shfl_xor(sq, 32);
                if (fq == 0) ssq[row * 16 + u.pn * 4 + wc] = sq; }
    }
};
struct EpiSwiGLU {
    static constexpr bool PERM = true, AFTER_DRAIN = false, MUTATES = false;
    bf16* Hm;
    __device__ __forceinline__ void operator()(const f32x4 (&acc)[2][2][4][2], const pg8::Unit& u, int wr, int wc, int fr, int fq) const {
        const int row0 = u.pm * 256 + wr * 64 + fr, j0 = (u.pn & 3) * 128 + wc * 16 + 4 * fq;
#pragma unroll
        for (int ai = 0; ai < 2; ++ai)
#pragma unroll
            for (int m = 0; m < 4; ++m) { const size_t row = (size_t)(row0 + ai * 128 + m * 16);
#pragma unroll
                for (int bj = 0; bj < 2; ++bj) { const f32x4 a = acc[ai][bj][m][0], uu = acc[ai][bj][m][1];
                    *(GAS unsigned long long*)(Hm + row * 512 + j0 + bj * 64) =
                        (unsigned long long)pk2(siluf_(a[0]) * uu[0], siluf_(a[1]) * uu[1]) | ((unsigned long long)pk2(siluf_(a[2]) * uu[2], siluf_(a[3]) * uu[3]) << 32); } }
    }
};
struct EpiY {
    static constexpr bool PERM = true, AFTER_DRAIN = false, MUTATES = false;
    bf16* Y; const int* ent_tok; const float* ent_w; const volatile LAS unsigned* cntL;
    __device__ __forceinline__ void operator()(const f32x4 (&acc)[2][2][4][2], const pg8::Unit& u, int wr, int wc, int fr, int fq) const {
        const int r0 = u.ti * 256 + wr * 64 + fr, col0 = (u.pn & 3) * 256 + wc * 32 + 8 * fq, cnt = (int)cntL[u.e];
#pragma unroll
        for (int ai = 0; ai < 2; ++ai)
#pragma unroll
            for (int m = 0; m < 4; ++m) { const int ent = r0 + ai * 128 + m * 16;
                if (ent < cnt) { const int tk2 = ent_tok[(size_t)u.e * M + ent]; const float w = ent_w[(size_t)u.e * M + ent];
                    bf16* o = Y + ((size_t)(tk2 & 1) * M + (size_t)(tk2 >> 1)) * 1024 + col0;
#pragma unroll
                    for (int bj = 0; bj < 2; ++bj) { const f32x4 v0 = acc[ai][bj][m][0] * w, v1 = acc[ai][bj][m][1] * w;
                        v4u o4; o4.x = pk2(v0[0], v0[1]); o4.y = pk2(v0[2], v0[3]); o4.z = pk2(v1[0], v1[1]); o4.w = pk2(v1[2], v1[3]);
                        *(GAS v4u*)(o + bj * 128) = o4; } } }
    }
};
struct SplitKOrder : pg8::StaticOrder {
    __device__ __forceinline__ bool next(int i, pg8::Unit& u) const { if (!pg8::StaticOrder::next(i >> 1, u)) return false; u.kh = i & 1; u.kofs = (i & 1) * 512; return true; }
};
template <bool GA> struct GroupedOrderT {
    static constexpr bool GATHER = GA;
    const volatile LAS unsigned* tp; const volatile LAS unsigned* cntL; const int* ent_tok; int G, c;
    __device__ __forceinline__ bool next(int i, pg8::Unit& u) const {
        const int L = i * G + c; const int total = (int)tp[32] * 4; if (L >= total) return false;
        const int T = L >> 2; int e = 0;
#pragma unroll 1
        for (int k = 1; k < 32; ++k) e += (T >= (int)tp[k]) ? 1 : 0;
        u.pm = T; u.pn = e * 4 + (L & 3); u.e = e; u.ti = T - (int)tp[e]; u.kofs = 0; u.kh = 0; return true;
    }
    __device__ __forceinline__ unsigned arow_off(const pg8::Unit& u, int r) const {
        const int ent = u.ti * 256 + r; const int tk2 = (ent < (int)cntL[u.e]) ? ent_tok[(size_t)u.e * M + ent] : 0;
        return (unsigned)(tk2 >> 1) * (unsigned)(DM * 2);
    }
    __device__ __forceinline__ void a_ready(const pg8::Unit&) const {}
    __device__ __forceinline__ void done(const pg8::Unit&) const {}
};

__device__ __forceinline__ void p9_router(Frame& F, const Args& args) {
    const int gw = F.vcu * NWAVES + F.wave, NGW = F.G * NWAVES, lane = F.lane, tid = F.tid, w = F.wave;
    unsigned char* ws = F.ws;
    const float* X1 = F.out; bf16* H = (bf16*)(ws + WS_H); const float* g2 = FIN(16); const float* ssq = (const float*)(ws + WS_SSQ);
    const v4u* Wp16 = (const v4u*)(ws + WS_WRP);
    int* ent_tok = (int*)(ws + WS_ENT_TOK); float* ent_w = (float*)(ws + WS_ENT_W);
    LAS v4u* Wl = (LAS v4u*)(F.lds + RING_OFF); LAS float* G2L = (LAS float*)(F.lds + RING_OFF + 98304); LAS float* Lg = (LAS float*)(F.lds + RING_OFF + 102400 + w * 3072);
    LAS unsigned* LC = (LAS unsigned*)(F.lds + RING_OFF + 126976); LAS unsigned* LB = LC + 32;
    if (tid < 256) ((LAS f32x4*)G2L)[tid] = ((const f32x4*)g2)[tid];
    const int q = lane >> 4, ksub = w >> 2;
    for (int base = F.vcu * 4; base < M / 16; base += F.G * 4) {
        const int item = base + (w & 3), tok0 = item * 16, tok = tok0 + (lane & 15);
        const float* xrow = X1 + (size_t)tok * DM + 8 * q;
        float rstd;
        { const f32x4 p0 = *(const GAS f32x4*)(ssq + (size_t)tok * 16), p1 = *(const GAS f32x4*)(ssq + (size_t)tok * 16 + 4), p2 = *(const GAS f32x4*)(ssq + (size_t)tok * 16 + 8), p3 = *(const GAS f32x4*)(ssq + (size_t)tok * 16 + 12);
          const f32x4 ps = (p0 + p1) + (p2 + p3); rstd = rsqrtf(((ps[0] + ps[1]) + (ps[2] + ps[3])) * (1.f / DM) + EPS); }
        f32x4 acc[3];
#pragma unroll
        for (int t = 0; t < 3; ++t) acc[t] = (f32x4){0.f, 0.f, 0.f, 0.f};
#pragma unroll
        for (int r = 0; r < 2; ++r) {
            f32x4 xa[8][2];
#pragma unroll
            for (int i = 0; i < 8; ++i) { const int k = 32 * (16 * r + 8 * ksub + i); xa[i][0] = *(const GAS f32x4*)(xrow + k); xa[i][1] = *(const GAS f32x4*)(xrow + k + 4); }
            __syncthreads();
#pragma unroll 1
            for (int i0 = 0; i0 < 12; i0 += 4) {
#pragma unroll
                for (int i = i0; i < i0 + 4; ++i) Wl[tid + i * 512] = Wp16[(size_t)r * 6144 + tid + i * 512]; }
            __syncthreads();
#pragma unroll
            for (int i = 0; i < 8; ++i) {
                const int ksl = 8 * ksub + i, k = 32 * (16 * r + ksl) + 8 * q;
                float x[8] = {xa[i][0][0], xa[i][0][1], xa[i][0][2], xa[i][0][3], xa[i][1][0], xa[i][1][1], xa[i][1][2], xa[i][1][3]};
                float hi[8], lo[8], hh[8];
                const f32x4 ga = *(const LAS f32x4*)(G2L + k), gb = *(const LAS f32x4*)(G2L + k + 4);
                const float gg[8] = {ga[0], ga[1], ga[2], ga[3], gb[0], gb[1], gb[2], gb[3]};
#pragma unroll
                for (int j = 0; j < 8; ++j) { hi[j] = __uint_as_float(f2bf(x[j]) << 16); lo[j] = x[j] - hi[j]; hh[j] = x[j] * rstd * gg[j]; }
                const v4u ah = pack8(hi), al = pack8(lo);
                *(GAS v4u*)(H + (size_t)tok * DM + k) = pack8(hh);
                const bf16x8 ahi = __builtin_bit_cast(bf16x8, ah), alo = __builtin_bit_cast(bf16x8, al);
#pragma unroll
                for (int t = 0; t < 3; ++t) {
                    const bf16x8 bhi = __builtin_bit_cast(bf16x8, Wl[((ksl * 3 + t) * 2 + 0) * 64 + lane]), blo = __builtin_bit_cast(bf16x8, Wl[((ksl * 3 + t) * 2 + 1) * 64 + lane]);
                    acc[t] = __builtin_amdgcn_mfma_f32_16x16x32_bf16(ahi, bhi, acc[t], 0, 0, 0);
                    acc[t] = __builtin_amdgcn_mfma_f32_16x16x32_bf16(alo, bhi, acc[t], 0, 0, 0);
                    acc[t] = __builtin_amdgcn_mfma_f32_16x16x32_bf16(ahi, blo, acc[t], 0, 0, 0);
                }
            }
        }
        if (ksub == 1) {
#pragma unroll
            for (int t = 0; t < 3; ++t)
#pragma unroll
                for (int r = 0; r < 4; ++r) Lg[(4 * q + r) * 48 + t * 16 + (lane & 15)] = acc[t][r];
        }
        if (tid < 32) LC[tid] = 0u;
        __syncthreads();
        int e0 = 0, e1 = 0; float w0 = 0.f, w1 = 0.f; unsigned r0 = 0u, r1 = 0u;
        const bool router_lane = (ksub == 0) && (lane < 16);
        if (ksub == 0) {
            const LAS float* Lp = Lg + 4 * 768;
#pragma unroll
            for (int t = 0; t < 3; ++t)
#pragma unroll
                for (int r = 0; r < 4; ++r) { const int o = (4 * q + r) * 48 + t * 16 + (lane & 15); Lg[o] = acc[t][r] + Lp[o]; }
            LDS_WAIT(); asm volatile("" ::: "memory");
            if (lane < 16) {
                const LAS float* Lr = Lg + lane * 48;
                float gl[4];
#pragma unroll
                for (int k = 0; k < 4; ++k) gl[k] = rstd * Lr[k] + FIN(18)[k];
                int gi = 0; float mx = gl[0];
#pragma unroll
                for (int k = 1; k < 4; ++k) if (gl[k] > mx) { mx = gl[k]; gi = k; }
                float se = 0.f;
#pragma unroll
                for (int k = 0; k < 4; ++k) se += __expf(gl[k] - mx);
                const float pg = 1.0f / se;
                float v0 = -3.0e38f, v1 = -3.0e38f; int i0 = 0, i1 = 0;
#pragma unroll
                for (int k = 0; k < 8; ++k) { const float el = rstd * Lr[16 + gi * 8 + k] + FIN(20)[gi * 8 + k];
                    if (el > v0) { v1 = v0; i1 = i0; v0 = el; i0 = k; } else if (el > v1) { v1 = el; i1 = k; } }
                w0 = pg / (1.0f + __expf(v1 - v0)); w1 = pg - w0;
                e0 = gi * 8 + i0; e1 = gi * 8 + i1;
                r0 = __hip_atomic_fetch_add(LC + e0, 1u, __ATOMIC_RELAXED, __HIP_MEMORY_SCOPE_WORKGROUP);
                r1 = __hip_atomic_fetch_add(LC + e1, 1u, __ATOMIC_RELAXED, __HIP_MEMORY_SCOPE_WORKGROUP);
            }
        }
        __syncthreads();
        if (tid < 32) { const unsigned c = LC[tid]; LB[tid] = c ? atomicAdd((unsigned*)(F.ctl + CW_CNT) + tid, c) : 0u; }
        __syncthreads();
        if (router_lane) {
            const unsigned p0 = LB[e0] + r0, p1 = LB[e1] + r1;
            ent_tok[(size_t)e0 * M + p0] = tok * 2; ent_w[(size_t)e0 * M + p0] = w0;
            ent_tok[(size_t)e1 * M + p1] = tok * 2 + 1; ent_w[(size_t)e1 * M + p1] = w1;
        }
    }
}
__device__ __forceinline__ void p_expert_copies(Frame& F, const Args& args) {
    const int gw = F.vcu * NWAVES + F.wave, NGW = F.G * NWAVES, lane = F.lane; unsigned char* ws = F.ws;
    LAS unsigned* scr = (LAS unsigned*)(F.lds + RING_OFF + F.wave * 16384);
    for (int it = gw; it < NEXP * 384; it += NGW) {
        const int e = it / 384, r = it % 384;
        if (r < 128) transpose_item(FIN(21) + (size_t)e * DM * EFF, EFF, (bf16*)(ws + WS_WGU) + (size_t)e * 1024 * 1024, 1024, 1, scr, r / 8, r % 8, lane);
        else if (r < 256) transpose_item(FIN(22) + (size_t)e * DM * EFF, EFF, (bf16*)(ws + WS_WGU) + (size_t)e * 1024 * 1024, 1024, 2, scr, (r - 128) / 8, (r - 128) % 8, lane);
        else transpose_item(FIN(23) + (size_t)e * EFF * DM, DM, (bf16*)(ws + WS_WD) + (size_t)e * 1024 * 512, 512, 0, scr, (r - 256) / 16, (r - 256) % 16, lane);
    }
}
__device__ __forceinline__ void load_expert_tables(Frame& F) {
    if (F.tid < 32) F.MISC[MI_CNT + F.tid] = __hip_atomic_load(F.ctl + CW_CNT + F.tid, RLX_AGENT);
    __syncthreads();
    if (F.tid == 0) { unsigned a = 0; for (int e = 0; e < 32; ++e) { F.MISC[MI_TP + e] = a; a += (F.MISC[MI_CNT + e] + 255u) >> 8; } F.MISC[MI_TP + 32] = a; }
    __syncthreads();
}
__global__ void __launch_bounds__(NWAVES * 64, 2) mk_fwd(Args args) {
    extern __shared__ __attribute__((aligned(16))) unsigned char lds[];
    Frame F;
    F.lds = (LAS unsigned char*)lds;
    F.MISC = (volatile LAS unsigned*)(F.lds + MISC_OFF);
    F.tid = threadIdx.x; F.lane = F.tid & 63; F.wave = __builtin_amdgcn_readfirstlane(F.tid >> 6);
    F.G = gridDim.x; { const int bx = blockIdx.x; F.vcu = (F.G % 8 == 0) ? (bx % 8) * (F.G / 8) + bx / 8 : bx; }
    unsigned char* ws = args.ws; F.ws = ws; F.out = args.out;
    F.ctl = (gu32*)(ws + WS_CTL);
    for (int u = F.tid; u < (LDS_BYTES - LDSCTL_OFF) / 4; u += NWAVES * 64) ((LAS unsigned*)(F.lds + LDSCTL_OFF))[u] = 0u;
    __syncthreads();
    XcdBarrier bar; bar.bar = (unsigned*)(F.ctl + CW_BAR); bar.x = 0; bar.st = nullptr;
#if !MK_PER_PHASE
    bar = xcd_barrier_post((unsigned*)(F.ctl + CW_BAR), F.MISC + 8);
#endif
    const int lo = args.ph_lo, hi = args.ph_hi;
#define IN(k) (lo <= (k) && (k) < hi)
#define STAMP(k) do { if (PROBING && blockIdx.x == 0 && F.tid == 0) { const unsigned long long t_ = __builtin_amdgcn_s_memrealtime(); F.MISC[MI_TS + 2 * (k)] = (unsigned)t_; F.MISC[MI_TS + 2 * (k) + 1] = (unsigned)(t_ >> 32); } } while (0)
#define REFRESH() do { int t_ = threadIdx.x; asm volatile("" : "+v"(t_)); F.tid = t_; F.lane = t_ & 63; } while (0)
#define SEAM(k) do { if (IN(k) && IN((k) + 1)) xcd_barrier(bar); STAMP((k) + 1); REFRESH(); } while (0)
    STAMP(0);

    if (IN(0)) { p0_prologue(F, args); } SEAM(0);
    if (IN(1)) {
        pg8::Gemm g{(const pg8::bf16_t*)(ws + WS_H), (const pg8::bf16_t*)(ws + WS_WIN), M, IN_COLS, DM, DM}; pg8::StaticOrder S; S.init(M, IN_COLS, F.G, (int)blockIdx.x);
        EpiIn E{(bf16*)(ws + WS_P), (const float*)(ws + WS_TABA), (const float*)(ws + WS_TABB), FIN(4), FIN(5)};
        pg8::gemm_phase<EpiIn, pg8::StaticOrder, true, true>(F.lds + RING_OFF, g, S, E);
    } SEAM(1);
    if (IN(2)) {
        const attn_body::AttnTensors AT{(const attn_body::bf16*)(ws + WS_P), (const attn_body::bf16*)(ws + WS_P + PBUF), (const attn_body::bf16*)(ws + WS_P + 2 * PBUF), (attn_body::bf16*)(ws + WS_H)};
        const attn_body::StaticOrder S((int)F.G, (int)blockIdx.x);
        attn_body::attn_phase<attn_body::StaticOrder>((char*)lds + RING_OFF, AT, S);
        __syncthreads(); REFRESH();
        for (int item = F.vcu; item < 512; item += F.G) ret_kv_item(F, args, item);
    } SEAM(2);
    if (IN(3)) { p4_scan(F, args); } SEAM(3);
    if (IN(4)) { for (int item = F.vcu; item < 512; item += F.G) ret_out_item(F, args, item); p5_attn_combine(F, args); } SEAM(4);
    if (IN(5)) {
        pg8::Gemm g{(const pg8::bf16_t*)(ws + WS_OA), (const pg8::bf16_t*)(ws + WS_WA), M, DM, 512, 1024}; SplitKOrder S; S.init(M, DM, F.G, (int)blockIdx.x);
        EpiMerge2 E{(bf16*)(ws + WS_MERGED), (const bf16*)(ws + WS_P + 7 * PBUF), (const bf16*)(ws + WS_P + 8 * PBUF), (const bf16*)(ws + WS_P + 9 * PBUF), (const bf16*)(ws + WS_P + 10 * PBUF)};
        pg8::gemm_phase<EpiMerge2, SplitKOrder, true, true>(F.lds + RING_OFF, g, S, E);
    } SEAM(5);
    if (IN(6)) {
        pg8::Gemm g{(const pg8::bf16_t*)(ws + WS_MERGED), (const pg8::bf16_t*)(ws + WS_WOUT), M, DM, DM, DM}; pg8::StaticOrder S; S.init(M, DM, F.G, (int)blockIdx.x);
        EpiResid E{FIN(0), F.out, (float*)(ws + WS_SSQ)};
        pg8::gemm_phase<EpiResid, pg8::StaticOrder, true, true>(F.lds + RING_OFF, g, S, E);
    } SEAM(6);
    if (IN(7)) { p9_router(F, args); } SEAM(7);
    if (IN(8)) { p_expert_copies(F, args); } SEAM(8);
    if (IN(9)) {
        load_expert_tables(F);
        pg8::Gemm g{(const pg8::bf16_t*)(ws + WS_H), (const pg8::bf16_t*)(ws + WS_WGU), MAXROWS, NEXP * 1024, DM, DM};
        GroupedOrderT<true> S{F.MISC + MI_TP, F.MISC + MI_CNT, (const int*)(ws + WS_ENT_TOK), F.G, (int)blockIdx.x};
        EpiSwiGLU E{(bf16*)(ws + WS_HMID)};
        pg8::gemm_phase<EpiSwiGLU, GroupedOrderT<true>, true, true>(F.lds + RING_OFF, g, S, E);
    } SEAM(9);
    if (IN(10)) {
        load_expert_tables(F);
        pg8::Gemm g{(const pg8::bf16_t*)(ws + WS_HMID), (const pg8::bf16_t*)(ws + WS_WD), MAXROWS, NEXP * 1024, EFF, EFF};
        GroupedOrderT<false> S{F.MISC + MI_TP, F.MISC + MI_CNT, (const int*)(ws + WS_ENT_TOK), F.G, (int)blockIdx.x};
        EpiY E{(bf16*)(ws + WS_Y), (const int*)(ws + WS_ENT_TOK), (const float*)(ws + WS_ENT_W), F.MISC + MI_CNT};
        pg8::gemm_phase<EpiY, GroupedOrderT<false>, true, true>(F.lds + RING_OFF, g, S, E);
    } SEAM(10);
    if (IN(11)) {
        const int gid = F.vcu * (NWAVES * 64) + F.tid, NT = F.G * NWAVES * 64;
        const bf16* Y0 = (const bf16*)(ws + WS_Y); const bf16* Y1 = Y0 + (size_t)M * 1024;
        for (int idx = gid; idx < M * 1024 / 8; idx += NT) {
            GAS f32x4* o = (GAS f32x4*)F.out + (size_t)idx * 2;
            f32x4 a = o[0], b2 = o[1]; float y0[8], y1[8];
            unpack8(*(const GAS v4u*)(Y0 + (size_t)idx * 8), y0); unpack8(*(const GAS v4u*)(Y1 + (size_t)idx * 8), y1);
            a[0] += y0[0] + y1[0]; a[1] += y0[1] + y1[1]; a[2] += y0[2] + y1[2]; a[3] += y0[3] + y1[3];
            b2[0] += y0[4] + y1[4]; b2[1] += y0[5] + y1[5]; b2[2] += y0[6] + y1[6]; b2[3] += y0[7] + y1[7];
            o[0] = a; o[1] = b2;
        }
    }
    if (PROBING) {
        xcd_barrier(bar); STAMP(N_PHASES);
        if (blockIdx.x == 0) {
            __syncthreads();
            float dA = 0.f, dB = 0.f;
            if (PROBE_A >= 0) { const unsigned long long t0 = ((unsigned long long)F.MISC[MI_TS + 2 * PROBE_A + 1] << 32) | F.MISC[MI_TS + 2 * PROBE_A], t1 = ((unsigned long long)F.MISC[MI_TS + 2 * PROBE_A + 3] << 32) | F.MISC[MI_TS + 2 * PROBE_A + 2]; dA = (float)(t1 - t0) * 0.01f; }
            if (PROBE_B == 99) dB = 1.0f;
            else if (PROBE_B >= 0) { const unsigned long long t0 = ((unsigned long long)F.MISC[MI_TS + 2 * PROBE_B + 1] << 32) | F.MISC[MI_TS + 2 * PROBE_B], t1 = ((unsigned long long)F.MISC[MI_TS + 2 * PROBE_B + 3] << 32) | F.MISC[MI_TS + 2 * PROBE_B + 2]; dB = (float)(t1 - t0) * 0.0001f; }
            if (F.tid == 0) F.out[0] += dA;
            for (int i = F.tid; i < 16384; i += NWAVES * 64) F.out[4096 + i] += 5.0f + dB;
        }
    }
#undef IN
#undef SEAM
}

extern "C" void kernel_launch(void* const* d_in, const int* in_sizes, int n_in, void* d_out, int out_size, void* d_ws, size_t ws_size, hipStream_t stream) {
    static int grid = 0;
    if (grid == 0) {
        if (n_in != 24 || in_sizes[0] != M * DM || out_size != M * DM || ws_size < WS_END) { fprintf(stderr, "kernel_launch: unexpected shapes/workspace (n_in %d, ws %zu); nothing launched\n", n_in, ws_size); grid = -1; return; }
        int dev = 0, cus = 0, per_cu = 0;
        if (hipGetDevice(&dev) != hipSuccess || hipDeviceGetAttribute(&cus, hipDeviceAttributeMultiprocessorCount, dev) != hipSuccess) { grid = -1; return; }
        if (hipFuncSetAttribute((const void*)mk_fwd, hipFuncAttributeMaxDynamicSharedMemorySize, LDS_BYTES) != hipSuccess) { fprintf(stderr, "kernel_launch: hipFuncSetAttribute failed\n"); grid = -1; return; }
        if (hipOccupancyMaxActiveBlocksPerMultiprocessor(&per_cu, (const void*)mk_fwd, NWAVES * 64, LDS_BYTES) != hipSuccess || per_cu < 1) fprintf(stderr, "kernel_launch: occupancy query reports %d\n", per_cu);
        (void)hipGetLastError();
        grid = cus;
    }
    if (grid < 0) return;
    if (hipMemsetAsync((char*)d_ws + WS_CTL, 0, CTL_ZERO_BYTES, stream) != hipSuccess) return;
    Args a{};
    for (int i = 0; i < 24; ++i) a.in[i] = d_in[i];
    a.out = (float*)d_out; a.ws = (unsigned char*)d_ws;
#if MK_PER_PHASE
    for (int p = 0; p < N_PHASES; ++p) { a.ph_lo = p; a.ph_hi = p + 1; hipLaunchKernelGGL(mk_fwd, dim3(grid), dim3(NWAVES * 64), LDS_BYTES, stream, a); }
#else
    a.ph_lo = 0; a.ph_hi = N_PHASES;
    hipLaunchKernelGGL(mk_fwd, dim3(grid), dim3(NWAVES * 64), LDS_BYTES, stream, a);
#endif
}
```

```cpp
#include <hip/hip_runtime.h>
#include <cstdio>
#include <cstdint>

namespace pg8 {
#define PG8_LAS __attribute__((address_space(3)))
typedef unsigned short bf16_t;
typedef short bf16x8 __attribute__((ext_vector_type(8)));
typedef float f32x4 __attribute__((ext_vector_type(4)));
typedef unsigned u32x4 __attribute__((ext_vector_type(4)));
constexpr int BM = 256, BK = 64, HALF = 128, HTB = HALF * BK * 2  , STAGE_BYTES = 8 * HTB, NXCD = 8, WGM = 8;

__host__ __device__ __forceinline__ int lds_byte(int r, int c) { const int st = (r >> 4) * 2 + (c >> 5), rr = r & 15, cc = c & 31, ob = rr * 64 + cc * 2; return st * 1024 + (ob ^ (((ob >> 9) & 1) << 5)); }
__host__ __device__ __forceinline__ void stage_rc(int b, int& R, int& C) { const int st = b / 1024, sb = b % 1024, swz = sb ^ (((sb >> 9) & 1) << 5); R = (st >> 1) * 16 + swz / 64; C = (st & 1) * 32 + (swz % 64) / 2; }
__host__ __device__ __forceinline__ int perm32(int rho) { const int n = rho >> 4, i = rho & 15; return 8 * (i >> 2) + 4 * n + (i & 3); }

struct Unit { int pm, pn, e, ti, kofs, kh; };
struct Gemm { const bf16_t* A; const bf16_t* Bt; int M, N, K, ldk; };

struct StaticOrder {
    static constexpr bool GATHER = false;
    int nM, nN, nwg, G, c;
    __host__ __device__ void init(int M, int N, int G_, int c_) { nM = M / BM; nN = N / BM; nwg = nM * nN; G = G_; c = c_; }
    __host__ __device__ bool next(int i, Unit& u) const {
        const long L = (long)i * G + c; if (L >= nwg) return false;
        int wgid = (int)L; { const int q = nwg / NXCD, r = nwg % NXCD, xcd = wgid % NXCD, off = wgid / NXCD; wgid = (xcd < r ? xcd * (q + 1) : r * (q + 1) + (xcd - r) * q) + off; }
        const int nig = WGM * nN, gid = wgid / nig, fm = gid * WGM, gsz = (nM - fm) < WGM ? (nM - fm) : WGM;
        u.pm = fm + ((wgid % nig) % gsz); u.pn = (wgid % nig) / gsz; u.kofs = 0; u.kh = 0; return true;
    }
    __device__ __forceinline__ void a_ready(const Unit&) const {}
    __device__ __forceinline__ void done(const Unit&) const {}
};

__device__ __forceinline__ unsigned cvt_pk_bf16(float lo, float hi) { unsigned r; asm volatile("v_cvt_pk_bf16_f32 %0, %1, %2" : "=v"(r) : "v"(lo), "v"(hi)); return r; }
typedef float f32x2 __attribute__((ext_vector_type(2)));
__device__ __forceinline__ f32x2 gelu_pk(f32x2 v) {
    const f32x2 av = __builtin_elementwise_abs(v), d = av * 0.2316418882f + 1.0f;
    f32x2 t; t.x = __builtin_amdgcn_rcpf(d.x); t.y = __builtin_amdgcn_rcpf(d.y);
    f32x2 q = t * 0.5307027145f + (-0.7265760135f); q = q * t + 0.7107068705f; q = q * t + (-0.142248368f); q = q * t + 0.127414796f; q = q * t;
    const f32x2 s = (v * v) * (-0.72134752044f);
    f32x2 e; e.x = __builtin_amdgcn_exp2f(s.x); e.y = __builtin_amdgcn_exp2f(s.y);
    const f32x2 m = v * (q * e), r = v - m;
    f32x2 o; o.x = v.x < 0.f ? m.x : r.x; o.y = v.y < 0.f ? m.y : r.y; return o;
}

template <int ACT  > struct EpiBf16 {
    static constexpr bool PERM = true, AFTER_DRAIN = false, MUTATES = false; static_assert(ACT == 0 || ACT == 1, "EpiBf16: ACT is 0 (none) or 1 (gelu_pk)");
    bf16_t* O; int ldc; const float* bias; int split_cols; size_t split_stride; float scale0;
    __device__ __forceinline__ void operator()(const f32x4 (&acc)[2][2][4][2], const Unit& u, int wr, int wc, int fr, int fq) const {
        const int row0 = u.pm * BM + wr * 64 + fr; int colt = u.pn * BM; bf16_t* base = O;
        float sc = 1.f; if (split_cols) { const int t = colt / split_cols; base += (size_t)t * split_stride; colt -= t * split_cols; if (t == 0) sc = scale0; }
        const int col0 = colt + wc * 32 + 8 * fq, bcol0 = u.pn * BM + wc * 32 + 8 * fq;
        f32x4 bv[2][2];
#pragma unroll
        for (int bj = 0; bj < 2; ++bj)
#pragma unroll
            for (int n = 0; n < 2; ++n) bv[bj][n] = bias ? *(const f32x4*)(bias + bcol0 + bj * HALF + 4 * n) : (f32x4){0.f, 0.f, 0.f, 0.f};
#pragma unroll
        for (int ai = 0; ai < 2; ++ai)
#pragma unroll
            for (int m = 0; m < 4; ++m) { bf16_t* rowp = base + (size_t)(row0 + ai * HALF + m * 16) * ldc + col0;
#pragma unroll
                for (int bj = 0; bj < 2; ++bj) { f32x4 v0 = acc[ai][bj][m][0] + bv[bj][0], v1 = acc[ai][bj][m][1] + bv[bj][1];
                    if (ACT == 1) { f32x2 a = gelu_pk((f32x2){v0[0], v0[1]}), b = gelu_pk((f32x2){v0[2], v0[3]}), c = gelu_pk((f32x2){v1[0], v1[1]}), d = gelu_pk((f32x2){v1[2], v1[3]});
                        v0 = (f32x4){a.x, a.y, b.x, b.y}; v1 = (f32x4){c.x, c.y, d.x, d.y}; }
                    v0 = v0 * sc; v1 = v1 * sc; u32x4 w; w.x = cvt_pk_bf16(v0[0], v0[1]); w.y = cvt_pk_bf16(v0[2], v0[3]); w.z = cvt_pk_bf16(v1[0], v1[1]); w.w = cvt_pk_bf16(v1[2], v1[3]);
                    *(u32x4*)(rowp + bj * HALF) = w; } }
    }
};

template <class Epi, class Sched, bool ALIGN_EPI = false, bool SP2 = false>
__device__ __forceinline__ void gemm_phase(PG8_LAS unsigned char* lds, const Gemm g, const Sched& S, const Epi& E) {
    const int tid = threadIdx.x, wid = __builtin_amdgcn_readfirstlane(tid >> 6), lane = tid & 63, wr = wid >> 2, wc = wid & 3, fr = lane & 15, fq = lane >> 4;
    const int K = g.ldk, nt = g.K / BK;
    unsigned voffB[2], vA0[2], vA1[2], nA0[2], nA1[2]; int Rr[2], Cc[2];
#pragma unroll
    for (int i = 0; i < 2; ++i) { int R, C; stage_rc(tid * 16 + i * 8192, R, C); const int Rb = Epi::PERM ? ((R & ~31) + perm32(R & 31)) : R;
        Rr[i] = R; Cc[i] = C; vA0[i] = vA1[i] = nA0[i] = nA1[i] = (unsigned)(R * K + C) * 2u; voffB[i] = (unsigned)(Rb * K + C) * 2u; }
#define PG8_GOFF(u, d0, d1) do { if constexpr (Sched::GATHER) { _Pragma("unroll") for (int _i = 0; _i < 2; ++_i) { d0[_i] = S.arow_off(u, Rr[_i]) + (unsigned)Cc[_i] * 2u; d1[_i] = S.arow_off(u, HALF + Rr[_i]) + (unsigned)Cc[_i] * 2u; } } } while (0)
    const size_t kstep = (size_t)(BK * 2);
    const size_t hstep = (size_t)HALF * K * 2;
    const size_t hstepA = Sched::GATHER ? (size_t)0 : hstep;
    const size_t tstep = 2 * hstep;
    const unsigned ldsw = (unsigned)wid * 1024u;
    const int aoff = lds_byte(wr * 64 + fr, fq * 8), boff = lds_byte(wc * 32 + fr, fq * 8);
#define PG8_SA(b, h) (((b) * 2 + (h)) * HTB)
#define PG8_SB(b, h) ((4 + (b) * 2 + (h)) * HTB)
#define PG8_STAGE(bufoff, gbase, voff) do { _Pragma("unroll") for (int _i = 0; _i < 2; ++_i) \
        __builtin_amdgcn_global_load_lds((const unsigned*)((const char*)(gbase) + (voff)[_i]), (PG8_LAS unsigned*)(lds + (bufoff) + ldsw + _i * 8192), 16, 0, 0); } while (0)
#define PG8_LDA(dst, b, h) do { _Pragma("unroll") for (int m = 0; m < 4; ++m) _Pragma("unroll") for (int k = 0; k < 2; ++k) dst[m][k] = *(const PG8_LAS bf16x8*)(lds + PG8_SA(b, h) + aoff + m * 2048 + k * 1024); } while (0)
#define PG8_LDB(dst, b, h) do { _Pragma("unroll") for (int n = 0; n < 2; ++n) _Pragma("unroll") for (int k = 0; k < 2; ++k) dst[n][k] = *(const PG8_LAS bf16x8*)(lds + PG8_SB(b, h) + boff + n * 2048 + k * 1024); } while (0)
#define PG8_MMA(ai, bj, At, Bt) do { __builtin_amdgcn_s_setprio(1); _Pragma("unroll") for (int m = 0; m < 4; ++m) _Pragma("unroll") for (int n = 0; n < 2; ++n) _Pragma("unroll") for (int k = 0; k < 2; ++k) \
        acc[ai][bj][m][n] = __builtin_amdgcn_mfma_f32_16x16x32_bf16(Bt[n][k], At[m][k], acc[ai][bj][m][n], 0, 0, 0); __builtin_amdgcn_s_setprio(0); } while (0)
#define PG8_WAIT_V(n) asm volatile("s_waitcnt vmcnt(" #n ")" ::: "memory")
#define PG8_WAIT_L(n) asm volatile("s_waitcnt lgkmcnt(" #n ")" ::: "memory")
#define PG8_BAR __builtin_amdgcn_s_barrier()
#define PG8_SCHED __builtin_amdgcn_sched_barrier(0)
    Unit cur, nxt; int ui = 0;
    if (!S.next(0, cur)) return;
    f32x4 acc[2][2][4][2];
#pragma unroll
    for (int a = 0; a < 2; ++a)
#pragma unroll
        for (int b = 0; b < 2; ++b)
#pragma unroll
            for (int m = 0; m < 4; ++m)
#pragma unroll
                for (int n = 0; n < 2; ++n) acc[a][b][m][n] = (f32x4){0.f, 0.f, 0.f, 0.f};
    bf16x8 At[4][2], B0[2][2], B1[2][2];
    const char* cA = (const char*)g.A + (Sched::GATHER ? (size_t)0 : (size_t)cur.pm * tstep) + (size_t)cur.kofs * 2; const char* cB = (const char*)g.Bt + (size_t)cur.pn * tstep + (size_t)cur.kofs * 2;
    PG8_GOFF(cur, vA0, vA1);
    S.a_ready(cur);
    if constexpr (SP2) {
        PG8_STAGE(PG8_SB(0, 0), cB, voffB); PG8_STAGE(PG8_SB(0, 1), cB + hstep, voffB); PG8_STAGE(PG8_SA(0, 0), cA, vA0); PG8_STAGE(PG8_SA(0, 1), cA + hstepA, vA1);
        if (wr == 1) PG8_BAR;
        PG8_WAIT_V(2); PG8_BAR;
        PG8_STAGE(PG8_SB(1, 0), cB + kstep, voffB); PG8_STAGE(PG8_SA(1, 0), cA + kstep, vA0); PG8_STAGE(PG8_SB(1, 1), cB + hstep + kstep, voffB);
        PG8_WAIT_V(6); PG8_BAR;
    } else {
        PG8_STAGE(PG8_SB(0, 0), cB, voffB); PG8_STAGE(PG8_SA(0, 0), cA, vA0); PG8_STAGE(PG8_SB(0, 1), cB + hstep, voffB); PG8_STAGE(PG8_SA(0, 1), cA + hstepA, vA1);
        if (wr == 1) PG8_BAR;
        PG8_WAIT_V(4); PG8_BAR;
        PG8_STAGE(PG8_SB(1, 0), cB + kstep, voffB); PG8_STAGE(PG8_SA(1, 0), cA + kstep, vA0); PG8_STAGE(PG8_SB(1, 1), cB + hstep + kstep, voffB);
        PG8_WAIT_V(6); PG8_BAR;
    }
    for (;;) {
        const bool has_next = S.next(ui + 1, nxt);
        const char* nA = has_next ? (const char*)g.A + (Sched::GATHER ? (size_t)0 : (size_t)nxt.pm * tstep) + (size_t)nxt.kofs * 2 : cA; const char* nB = has_next ? (const char*)g.Bt + (size_t)nxt.pn * tstep + (size_t)nxt.kofs * 2 : cB;
        if constexpr (Sched::GATHER) { if (has_next) { PG8_GOFF(nxt, nA0, nA1); } else {
#pragma unroll
            for (int _i = 0; _i < 2; ++_i) { nA0[_i] = vA0[_i]; nA1[_i] = vA1[_i]; } } }
        for (int t = 0; t < nt; t += 2) {
            const bool last = (t == nt - 2);
            const char* a1 = cA + (size_t)(t + 1) * kstep;
            const char* a2 = last ? nA : cA + (size_t)(t + 2) * kstep; const char* b2 = last ? nB : cB + (size_t)(t + 2) * kstep;
            const char* a3 = a2 + kstep; const char* b3 = b2 + kstep;
            if (last && has_next) S.a_ready(nxt);
            unsigned wA0[2], wA1[2];
#pragma unroll
            for (int _i = 0; _i < 2; ++_i) { wA0[_i] = (Sched::GATHER && last) ? nA0[_i] : vA0[_i]; wA1[_i] = (Sched::GATHER && last) ? nA1[_i] : vA1[_i]; }
            if constexpr (SP2) {
            PG8_LDB(B0, 0, 0); PG8_LDB(B1, 0, 1); PG8_SCHED; PG8_LDA(At, 0, 0); PG8_STAGE(PG8_SA(1, 1), a1 + hstepA, vA1);
            PG8_WAIT_V(8); PG8_WAIT_L(0); PG8_BAR; PG8_MMA(0, 0, At, B0); PG8_MMA(0, 1, At, B1); PG8_BAR; PG8_SCHED;
            PG8_LDA(At, 0, 1); PG8_STAGE(PG8_SB(0, 0), b2, voffB); PG8_STAGE(PG8_SB(0, 1), b2 + hstep, voffB); PG8_STAGE(PG8_SA(0, 0), a2, wA0);
            PG8_WAIT_V(8); PG8_WAIT_L(0); PG8_BAR; PG8_MMA(1, 0, At, B0); PG8_MMA(1, 1, At, B1); PG8_BAR; PG8_SCHED;
            PG8_LDB(B0, 1, 0); PG8_LDB(B1, 1, 1); PG8_SCHED; PG8_LDA(At, 1, 0); PG8_STAGE(PG8_SA(0, 1), a2 + hstepA, wA1);
            PG8_WAIT_V(8); PG8_WAIT_L(0); PG8_BAR; PG8_MMA(0, 0, At, B0); PG8_MMA(0, 1, At, B1); PG8_BAR; PG8_SCHED;
            PG8_LDA(At, 1, 1); PG8_STAGE(PG8_SB(1, 0), b3, voffB); PG8_STAGE(PG8_SB(1, 1), b3 + hstep, voffB); PG8_STAGE(PG8_SA(1, 0), a3, wA0);
            PG8_WAIT_V(8); PG8_WAIT_L(0); PG8_BAR; PG8_MMA(1, 0, At, B0); PG8_MMA(1, 1, At, B1); PG8_BAR; PG8_SCHED;
            } else {
            PG8_LDB(B0, 0, 0); PG8_SCHED; PG8_LDA(At, 0, 0); PG8_STAGE(PG8_SA(1, 1), a1 + hstepA, vA1);
            PG8_WAIT_L(8); PG8_BAR; PG8_WAIT_L(0); PG8_MMA(0, 0, At, B0); PG8_BAR; PG8_SCHED;
            PG8_LDB(B1, 0, 1); PG8_STAGE(PG8_SB(0, 0), b2, voffB);
            PG8_BAR; PG8_WAIT_L(0); PG8_MMA(0, 1, At, B1); PG8_BAR;
            PG8_LDA(At, 0, 1); PG8_STAGE(PG8_SA(0, 0), a2, wA0);
            PG8_BAR; PG8_WAIT_L(0); PG8_MMA(1, 0, At, B0); PG8_BAR; PG8_SCHED;
            PG8_STAGE(PG8_SB(0, 1), b2 + hstep, voffB);
            PG8_WAIT_V(6); PG8_BAR; PG8_MMA(1, 1, At, B1); PG8_BAR;
            PG8_LDB(B0, 1, 0); PG8_SCHED; PG8_LDA(At, 1, 0); PG8_STAGE(PG8_SA(0, 1), a2 + hstepA, wA1);
            PG8_WAIT_L(8); PG8_BAR; PG8_WAIT_L(0); PG8_MMA(0, 0, At, B0); PG8_BAR; PG8_SCHED;
            PG8_LDB(B1, 1, 1); PG8_STAGE(PG8_SB(1, 0), b3, voffB);
            PG8_BAR; PG8_WAIT_L(0); PG8_MMA(0, 1, At, B1); PG8_BAR;
            PG8_LDA(At, 1, 1); PG8_STAGE(PG8_SA(1, 0), a3, wA0);
            PG8_BAR; PG8_WAIT_L(0); PG8_MMA(1, 0, At, B0); PG8_BAR; PG8_SCHED;
            PG8_STAGE(PG8_SB(1, 1), b3 + hstep, voffB);
            PG8_WAIT_V(6); PG8_BAR; PG8_MMA(1, 1, At, B1); PG8_BAR;
            }
        }
        if constexpr (ALIGN_EPI) { if (wr == 0) PG8_BAR; }
        bool keep = false;
        if constexpr (!Epi::AFTER_DRAIN) { if constexpr (Epi::MUTATES) keep = E.mut(acc, cur, wr, wc, fr, fq); else E(acc, cur, wr, wc, fr, fq); S.done(cur); }
        if (!has_next) break;
        if (!keep)
#pragma unroll
        for (int a = 0; a < 2; ++a)
#pragma unroll
            for (int b = 0; b < 2; ++b)
#pragma unroll
                for (int m = 0; m < 4; ++m)
#pragma unroll
                    for (int n = 0; n < 2; ++n) acc[a][b][m][n] = (f32x4){0.f, 0.f, 0.f, 0.f};
        cur = nxt; cA = nA; cB = nB; ++ui;
#pragma unroll
        for (int _i = 0; _i < 2; ++_i) { vA0[_i] = nA0[_i]; vA1[_i] = nA1[_i]; }
        if constexpr (ALIGN_EPI) { if (wr == 1) PG8_BAR; }
    }
    PG8_WAIT_V(0);
    if constexpr (!ALIGN_EPI) { if (wr == 0) PG8_BAR; }
    PG8_BAR;
    if constexpr (Epi::AFTER_DRAIN) { E.fused(acc, cur, wr, wc, fr, fq, lds, wid, lane); S.done(cur); }
#undef PG8_GOFF
#undef PG8_SA
#undef PG8_SB
#undef PG8_STAGE
#undef PG8_LDA
#undef PG8_LDB
#undef PG8_MMA
#undef PG8_WAIT_V
#undef PG8_WAIT_L
#undef PG8_BAR
#undef PG8_SCHED
}
}

#ifndef PG8_SP2
#define PG8_SP2 true
#endif

#include <hip/hip_bf16.h>
#include <cmath>
namespace attn_body {
using bf16=__hip_bfloat16;
using bf16x8=__attribute__((ext_vector_type(8)))short;
using s16x4=__attribute__((ext_vector_type(4)))short;
using f32x16=__attribute__((ext_vector_type(16)))float;
using u32x4=__attribute__((ext_vector_type(4)))unsigned;
constexpr int BATCH=4,NHEAD=16,SEQ=4096,D=64,PQ=512,PO=1024;
constexpr int NW=8,QBLK=32,QB=QBLK*NW,KVBLK=64,NQB=SEQ/QB;
constexpr int ATTN_UNIT_ROWS=QB;
__device__ __forceinline__ int crow(int r,int hi){return (r&3)+8*(r>>2)+4*hi;}
#define SBAR() __builtin_amdgcn_sched_barrier(0)
__device__ __forceinline__ void cmask(f32x16&p0,f32x16&p1,int jb,int qrel,int hi){
  const float NEG=-INFINITY; int kb=64*jb+4*hi;
  #pragma unroll
  for(int r=0;r<16;++r){int kv=kb+(r&3)+8*(r>>2); if(kv>qrel)p0[r]=NEG; if(kv+32>qrel)p1[r]=NEG;}
}

constexpr int NSLOT=3, SLOTB=8192;
constexpr int LDS_K=0, LDS_V=NSLOT*SLOTB, LDS_WS=2*NSLOT*SLOTB, LDS_OST=LDS_WS+NW*64*4, LDS_BYTES=LDS_OST+NW*4096;
constexpr float C2=0.125f*1.4426950408889634f;
__device__ __forceinline__ void glds16(const void*gsrc,unsigned lds_dst){unsigned keep;
  asm volatile("s_mov_b32 %0, m0\n\ts_mov_b32 m0, %2\n\ts_nop 0\n\tglobal_load_lds_dwordx4 %1, off\n\ts_mov_b32 m0, %0":"=&s"(keep):"v"(gsrc),"s"(lds_dst):"memory");}
__device__ __forceinline__ float max3f(float a,float b,float c){float r;asm("v_max3_f32 %0, %1, %2, %3":"=v"(r):"v"(a),"v"(b),"v"(c));return r;}
__device__ __forceinline__ float max2f(float a,float b){float r;asm("v_max_f32_e32 %0, %1, %2":"=v"(r):"v"(a),"v"(b));return r;}
__device__ __forceinline__ float fadd_s(float a,float b){float r;asm("v_add_f32_e32 %0, %1, %2":"=v"(r):"v"(a),"v"(b));return r;}
__device__ __forceinline__ float fsub_s(float a,float b){float r;asm("v_sub_f32_e32 %0, %1, %2":"=v"(r):"v"(a),"v"(b));return r;}
typedef float f32x2_t __attribute__((ext_vector_type(2))); typedef __bf16 bf16x2_t __attribute__((ext_vector_type(2)));
__device__ __forceinline__ unsigned cvtpk_s(float lo,float hi){f32x2_t v={lo,hi};bf16x2_t b=__builtin_convertvector(v,bf16x2_t);return __builtin_bit_cast(unsigned,b);}
#define WAIT_BAR(N) asm volatile("s_waitcnt vmcnt(" #N ") lgkmcnt(0)\n\ts_barrier":::"memory")

__device__ __forceinline__ void qkt(f32x16&p0,f32x16&p1,const char*Kslot,const bf16x8*qr,const f32x16&negm,int r32,int hi){
  const char*kb=Kslot+hi*1024+r32*16;
  #pragma unroll
  for(int d0=0;d0<4;++d0){
    const bf16x8 b0=*reinterpret_cast<const bf16x8*>(kb+d0*2048);
    const bf16x8 b1=*reinterpret_cast<const bf16x8*>(kb+d0*2048+512);
    if(d0==0){p0=__builtin_amdgcn_mfma_f32_32x32x16_bf16(b0,qr[0],negm,0,0,0);p1=__builtin_amdgcn_mfma_f32_32x32x16_bf16(b1,qr[0],negm,0,0,0);}
    else{p0=__builtin_amdgcn_mfma_f32_32x32x16_bf16(b0,qr[d0],p0,0,0,0);p1=__builtin_amdgcn_mfma_f32_32x32x16_bf16(b1,qr[d0],p1,0,0,0);}}
}
typedef __attribute__((address_space(3))) const char* lds_cptr;
typedef short v4i16_t __attribute__((ext_vector_type(4)));
__device__ __forceinline__ void kload8(bf16x8*kf,lds_cptr kp){
  kf[0]=*(const __attribute__((address_space(3))) bf16x8*)(kp);      kf[1]=*(const __attribute__((address_space(3))) bf16x8*)(kp+512);
  kf[2]=*(const __attribute__((address_space(3))) bf16x8*)(kp+2048); kf[3]=*(const __attribute__((address_space(3))) bf16x8*)(kp+2560);
  kf[4]=*(const __attribute__((address_space(3))) bf16x8*)(kp+4096); kf[5]=*(const __attribute__((address_space(3))) bf16x8*)(kp+4608);
  kf[6]=*(const __attribute__((address_space(3))) bf16x8*)(kp+6144); kf[7]=*(const __attribute__((address_space(3))) bf16x8*)(kp+6656);
}
__device__ __forceinline__ void kload2(bf16x8*kf,lds_cptr kp,int j){ kf[2*j]=*(const __attribute__((address_space(3))) bf16x8*)(kp+j*2048); kf[2*j+1]=*(const __attribute__((address_space(3))) bf16x8*)(kp+j*2048+512); }
__device__ __forceinline__ s16x4 vtr(lds_cptr p){ return __builtin_bit_cast(s16x4,__builtin_amdgcn_ds_read_tr16_b64_v4i16((__attribute__((address_space(3))) v4i16_t*)p)); }
__device__ __forceinline__ float rowmax(const f32x16&p0,const f32x16&p1){
  float a=max3f(p0[0],p0[1],p1[0]),b=max3f(p0[2],p0[3],p1[1]);a=max3f(a,p1[2],p1[3]);
  #pragma unroll
  for(int r=4;r<16;r+=4){a=max3f(a,p0[r],p0[r+1]);b=max3f(b,p0[r+2],p0[r+3]);a=max3f(a,p1[r],p1[r+1]);b=max3f(b,p1[r+2],p1[r+3]);}
  const float m=max2f(a,b);
  auto rr=__builtin_amdgcn_permlane32_swap(__float_as_uint(m),__float_as_uint(m),false,false);
  return max2f(__uint_as_float(rr[0]),__uint_as_float(rr[1]));
}
__device__ __forceinline__ void pv(f32x16*o,int vb,bf16x8 pa0,bf16x8 pa1,bf16x8 pa2,bf16x8 pa3){
  #pragma unroll
  for(int d0=0;d0<2;++d0){s16x4 lo[4],hi[4];
    #pragma unroll
    for(int ks=0;ks<4;++ks){
      asm volatile("ds_read_b64_tr_b16 %0,%1 offset:%c2":"=&v"(lo[ks]):"v"(vb),"i"(d0*4096+ks*1024):"memory");
      asm volatile("ds_read_b64_tr_b16 %0,%1 offset:%c2":"=&v"(hi[ks]):"v"(vb),"i"(d0*4096+ks*1024+512):"memory");}
    asm volatile("s_waitcnt lgkmcnt(0)":::"memory");SBAR();
    #define PK(k) (bf16x8){lo[k][0],lo[k][1],lo[k][2],lo[k][3],hi[k][0],hi[k][1],hi[k][2],hi[k][3]}
    o[d0]=__builtin_amdgcn_mfma_f32_32x32x16_bf16(pa0,PK(0),o[d0],0,0,0);
    o[d0]=__builtin_amdgcn_mfma_f32_32x32x16_bf16(pa1,PK(1),o[d0],0,0,0);
    o[d0]=__builtin_amdgcn_mfma_f32_32x32x16_bf16(pa2,PK(2),o[d0],0,0,0);
    o[d0]=__builtin_amdgcn_mfma_f32_32x32x16_bf16(pa3,PK(3),o[d0],0,0,0);
    #undef PK
  }
}

#ifndef ATTN_STORE16
#define ATTN_STORE16(p,v) (*(u32x4*)(p)=(v))
#endif
template<int THRL> __device__ __forceinline__ void attn_unit(int b,int h,int qb,const bf16*Q,const bf16*__restrict__ K,const bf16*__restrict__ V,bf16*O,char*shm){
  const int tid=threadIdx.x,lane=tid&63,r32=lane&31,hi=lane>>5; const int wid=__builtin_amdgcn_readfirstlane(tid>>6);
  const long rowbase=(long)b*SEQ; const int q0=qb*QB;
  const int qkc=(h>>1)*D, vcol=(h>>2)*128+(h&1)*D;
  const bf16*Qw=Q+(rowbase+q0+wid*QBLK)*PQ+qkc;
  const bf16*Kh=K+rowbase*PQ+qkc,*Vh=V+rowbase*PQ+vcol;
  const unsigned lds0=(unsigned)(uintptr_t)shm;
  float*wsf=(float*)(shm+LDS_WS)+wid*64;
  const bf16*ksrc=Kh+(long)lane*PQ+wid*8;
  const bf16*vsrc=Vh+(long)(16*(wid&3)+(lane>>2))*PQ+(wid>>2)*32+(lane&3)*8;
  const unsigned kdst=lds0+LDS_K+wid*1024, vdst=lds0+LDS_V+wid*1024;
  #define DMA_K(t,slot) glds16(ksrc+(long)(t)*KVBLK*PQ,(unsigned)__builtin_amdgcn_readfirstlane(kdst+(slot)))
  #define DMA_V(t,slot) glds16(vsrc+(long)(t)*KVBLK*PQ,(unsigned)__builtin_amdgcn_readfirstlane(vdst+(slot)))
  const int vb0=(int)(lds0+LDS_V)+((lane>>4)&1)*32+(lane&3)*8+(4*hi+((lane&15)>>2))*64;
  const char*Kbase=shm+LDS_K; bf16x8 kf[8];
  const lds_cptr shm3=(lds_cptr)shm; const lds_cptr kp0=shm3+LDS_K+hi*1024+r32*16; const lds_cptr vp0=shm3+LDS_V+((lane>>4)&1)*32+(lane&3)*8+(4*hi+((lane&15)>>2))*64;
  const int NT=(q0+QB)/KVBLK;
  DMA_K(0,0);DMA_V(0,0);DMA_K(1,SLOTB);
  bf16x8 qr[4];
  #pragma unroll
  for(int d0=0;d0<4;++d0)qr[d0]=*reinterpret_cast<const bf16x8*>(&Qw[(long)r32*PQ+d0*16+hi*8]);
  float mhat=0.f,l_reg=0.f;f32x16 o[2];o[0]=f32x16{};o[1]=f32x16{};f32x16 negm=f32x16{};asm volatile("":"+v"(negm));
  const int qrel=wid*QBLK+r32;
  #define CMASK(P0,P1,t) do{int jb_=(t)-(NT-4); if(jb_>=0)cmask(P0,P1,jb_,qrel,hi);}while(0)
  bool resc=false;
  #define START(P0,P1) do{ const float rm=rowmax(P0,P1); resc=false; \
    { const float dl=rm; mhat=fadd_s(mhat,dl); \
      _Pragma("unroll") for(int r=0;r<16;++r){P0[r]=fsub_s(P0[r],dl);P1[r]=fsub_s(P1[r],dl);} \
      _Pragma("unroll") for(int r=0;r<16;++r)negm[r]=-mhat; asm volatile("":"+v"(negm)); } \
    _Pragma("unroll") for(int r=0;r<16;++r)P0[r]=__builtin_amdgcn_exp2f(P0[r]); }while(0)
  #define RESC() do{ if(resc){ asm volatile("s_waitcnt lgkmcnt(0)":::"memory"); \
      _Pragma("unroll") for(int d_=0;d_<2;++d_) _Pragma("unroll") for(int r=0;r<16;++r)o[d_][r]*=wsf[crow(r,hi)]; } }while(0)
  f32x16 pA0,pA1,pB0,pB1;
  int sl_prev=0,sl_cur=0,sl_next=SLOTB;
  #define ROT() do{sl_prev=sl_cur;sl_cur=sl_next;sl_next=(sl_next==(NSLOT-1)*SLOTB)?0:sl_next+SLOTB;}while(0)
  DMA_K(2,2*SLOTB);
  WAIT_BAR(3);
  qkt(pA0,pA1,Kbase,qr,negm,r32,hi);asm volatile("s_nop 15\n\ts_nop 7":"+v"(pA0),"+v"(pA1));CMASK(pA0,pA1,0);
  START(pA0,pA1);
  _Pragma("unroll") for(int r=0;r<16;++r)pA1[r]=__builtin_amdgcn_exp2f(pA1[r]);
  WAIT_BAR(0);
  DMA_K(3,0);DMA_V(1,SLOTB);
  ROT();
  kload8(kf,kp0+sl_cur);
  WAIT_BAR(2);
  s16x4 vlo[8],vhi[8]; u32x4 pw0,pw1,pw2,pw3;
  #define PKW(P,B) cvtpk_s(P[B],P[B+1])
  #define PAF(k) __builtin_bit_cast(bf16x8,pw##k)
  #define VFR(i) (bf16x8){vlo[i][0],vlo[i][1],vlo[i][2],vlo[i][3],vhi[i][0],vhi[i][1],vhi[i][2],vhi[i][3]}
  #define PIN(x) asm volatile("":"+v"(x))
  #define MX3(a,b,c) __builtin_fmaxf(__builtin_fmaxf((a),(b)),(c))
  #define GAPA(MF,A0,A1,A2,A3,W0,W1,PW) do{ MF; sacc+=A0; sacc+=A1; sacc+=A2; sacc+=A3; PIN(sacc); W0; W1; PIN(PW); SBAR(); }while(0)
  #define EX(v) __builtin_amdgcn_exp2f(v)
  #define GAPB(MF,X,B) do{ MF; X[B]=EX(X[B]); X[B+1]=EX(X[B+1]); X[B+2]=EX(X[B+2]); X[B+3]=EX(X[B+3]); PIN(X); SBAR(); }while(0)
  #define VRD(i) do{ vlo[i]=vtr(vp_+(((i)>>2)*4096+((i)&3)*1024)); vhi[i]=vtr(vp_+(((i)>>2)*4096+((i)&3)*1024+512)); }while(0)
  #define KRD(G,j) do{ if(G){ kload2(kf,kp0+sl_next,j); SBAR(); } }while(0)
  #define STEP(C0,C1,P0,P1,t,GK,GV,GL) do{ SBAR(); \
    const lds_cptr vp_=vp0+sl_prev; \
    VRD(0); SBAR(); float sacc=(P0[0]+P0[1]); \
    GAPA(C0=__builtin_amdgcn_mfma_f32_32x32x16_bf16(kf[0],qr[0],negm,0,0,0), P0[2],P0[3],P0[4],P0[5],     pw0[0]=PKW(P0,0), pw0[1]=PKW(P0,2), pw0); \
    VRD(4); SBAR(); GAPA(C1=__builtin_amdgcn_mfma_f32_32x32x16_bf16(kf[1],qr[0],negm,0,0,0), P0[6],P0[7],P0[8],P0[9],     pw0[2]=PKW(P0,4), pw0[3]=PKW(P0,6), pw0); \
    VRD(1); SBAR(); GAPA(C0=__builtin_amdgcn_mfma_f32_32x32x16_bf16(kf[2],qr[1],C0,0,0,0),   P0[10],P0[11],P0[12],P0[13], pw1[0]=PKW(P0,8), pw1[1]=PKW(P0,10), pw1); \
    VRD(5); SBAR(); GAPA(C1=__builtin_amdgcn_mfma_f32_32x32x16_bf16(kf[3],qr[1],C1,0,0,0),   P0[14],P0[15],P1[0],P1[1],   pw1[2]=PKW(P0,12),pw1[3]=PKW(P0,14), pw1); \
    VRD(2); SBAR(); GAPA(C0=__builtin_amdgcn_mfma_f32_32x32x16_bf16(kf[4],qr[2],C0,0,0,0),   P1[2],P1[3],P1[4],P1[5],     pw2[0]=PKW(P1,0), pw2[1]=PKW(P1,2), pw2); \
    VRD(6); SBAR(); GAPA(C1=__builtin_amdgcn_mfma_f32_32x32x16_bf16(kf[5],qr[2],C1,0,0,0),   P1[6],P1[7],P1[8],P1[9],     pw2[2]=PKW(P1,4), pw2[3]=PKW(P1,6), pw2); \
    VRD(3); SBAR(); GAPA(C0=__builtin_amdgcn_mfma_f32_32x32x16_bf16(kf[6],qr[3],C0,0,0,0),   P1[10],P1[11],P1[12],P1[13], pw3[0]=PKW(P1,8), pw3[1]=PKW(P1,10), pw3); \
    VRD(7); SBAR(); GAPA(C1=__builtin_amdgcn_mfma_f32_32x32x16_bf16(kf[7],qr[3],C1,0,0,0),   P1[14],P1[15],0.f,0.f,       pw3[2]=PKW(P1,12),pw3[3]=PKW(P1,14), pw3); \
    l_reg+=sacc; \
    if(GK){DMA_K((t)+3,sl_cur);} if(GV){DMA_V((t)+1,sl_next);} \
    CMASK(C0,C1,t); \
    { float a=MX3(C0[0],C0[1],C1[0]),b=MX3(C0[2],C0[3],C1[1]); a=MX3(a,C1[2],C1[3]); \
      _Pragma("unroll") for(int r=4;r<16;r+=4){a=MX3(a,C0[r],C0[r+1]);b=MX3(b,C0[r+2],C0[r+3]);a=MX3(a,C1[r],C1[r+1]);b=MX3(b,C1[r+2],C1[r+3]);} \
      float rm=__builtin_fmaxf(a,b); { auto rr=__builtin_amdgcn_permlane32_swap(__float_as_uint(rm),__float_as_uint(rm),false,false); rm=__builtin_fmaxf(__uint_as_float(rr[0]),__uint_as_float(rr[1])); } \
      resc=false; \
      if(__builtin_expect(__any(rm>(float)THRL),0)){ const float dl=__builtin_fmaxf(rm,0.f); mhat+=dl; \
        _Pragma("unroll") for(int r=0;r<16;++r){C0[r]-=dl;C1[r]-=dl;} \
        _Pragma("unroll") for(int r=0;r<16;++r)negm[r]=-mhat; asm volatile("":"+v"(negm)); \
        const float f=__builtin_amdgcn_exp2f(-dl); l_reg*=f; if(hi==0)wsf[r32]=f; resc=true; } } \
    SBAR(); \
    GAPB(o[0]=__builtin_amdgcn_mfma_f32_32x32x16_bf16(PAF(0),VFR(0),o[0],0,0,0), C0,0); \
    GAPB(o[1]=__builtin_amdgcn_mfma_f32_32x32x16_bf16(PAF(0),VFR(4),o[1],0,0,0), C0,4); \
    KRD(GL,0); GAPB(o[0]=__builtin_amdgcn_mfma_f32_32x32x16_bf16(PAF(1),VFR(1),o[0],0,0,0), C0,8); \
    KRD(GL,1); GAPB(o[1]=__builtin_amdgcn_mfma_f32_32x32x16_bf16(PAF(1),VFR(5),o[1],0,0,0), C0,12); \
    KRD(GL,2); GAPB(o[0]=__builtin_amdgcn_mfma_f32_32x32x16_bf16(PAF(2),VFR(2),o[0],0,0,0), C1,0); \
    KRD(GL,3); GAPB(o[1]=__builtin_amdgcn_mfma_f32_32x32x16_bf16(PAF(2),VFR(6),o[1],0,0,0), C1,4); \
    GAPB(o[0]=__builtin_amdgcn_mfma_f32_32x32x16_bf16(PAF(3),VFR(3),o[0],0,0,0), C1,8); \
    GAPB(o[1]=__builtin_amdgcn_mfma_f32_32x32x16_bf16(PAF(3),VFR(7),o[1],0,0,0), C1,12); \
    }while(0)
  int t=1;
  #undef CMASK
  #define CMASK(P0,P1,t) do{}while(0)
  for(;t+5<NT;t+=2){
    STEP(pB0,pB1,pA0,pA1,t,true,true,true);     WAIT_BAR(2); RESC(); ROT();
    STEP(pA0,pA1,pB0,pB1,t+1,true,true,true);   WAIT_BAR(2); RESC(); ROT();
  }
  #undef CMASK
  #define CMASK(P0,P1,t) do{int jb_=(t)-(NT-4); if(jb_>=0)cmask(P0,P1,jb_,qrel,hi);}while(0)
  #define ENDW(tt) do{ if((tt)+3<NT){WAIT_BAR(2);} else if((tt)+2<NT){WAIT_BAR(1);} else {WAIT_BAR(0);} }while(0)
  for(;t+1<NT;t+=2){
    STEP(pB0,pB1,pA0,pA1,t,(t+3<NT),(t+1<NT),(t+1<NT));       ENDW(t);   RESC(); ROT();
    STEP(pA0,pA1,pB0,pB1,t+1,(t+4<NT),(t+2<NT),(t+2<NT));     ENDW(t+1); RESC(); ROT();
  }
  STEP(pB0,pB1,pA0,pA1,NT-1,false,false,false); RESC();
  { float sacc=pB0[0]+pB0[1]; _Pragma("unroll") for(int r=2;r<16;++r)sacc+=pB0[r]; _Pragma("unroll") for(int r=0;r<16;++r)sacc+=pB1[r]; l_reg+=sacc;
    pw0=(u32x4){PKW(pB0,0),PKW(pB0,2),PKW(pB0,4),PKW(pB0,6)};pw1=(u32x4){PKW(pB0,8),PKW(pB0,10),PKW(pB0,12),PKW(pB0,14)};pw2=(u32x4){PKW(pB1,0),PKW(pB1,2),PKW(pB1,4),PKW(pB1,6)};pw3=(u32x4){PKW(pB1,8),PKW(pB1,10),PKW(pB1,12),PKW(pB1,14)};
    SBAR(); pv(o,vb0+sl_cur,PAF(0),PAF(1),PAF(2),PAF(3)); }
  #undef PKW
  #undef PAF
  #undef VFR
  #undef PIN
  #undef MX3
  #undef GAPA
  #undef GAPB
  #undef EX
  #undef VRD
  #undef KRD
  #undef STEP
  #undef ENDW
  {auto rr=__builtin_amdgcn_permlane32_swap(__float_as_uint(l_reg),__float_as_uint(l_reg),false,false);l_reg=__uint_as_float(rr[0])+__uint_as_float(rr[1]);}
  if(hi==0)wsf[32+r32]=l_reg;asm volatile("s_waitcnt lgkmcnt(0)":::"memory");
  float rli[16];
  #pragma unroll
  for(int r=0;r<16;++r)rli[r]=__builtin_amdgcn_rcpf(wsf[32+crow(r,hi)]);
  bf16*Ow=O+(rowbase+q0+wid*QBLK)*PO+h*D;
  { bf16*stg=(bf16*)(shm+LDS_OST)+wid*2048;
    #pragma unroll
    for(int r=0;r<16;++r){const int orow=crow(r,hi);
      #pragma unroll
      for(int d0=0;d0<2;++d0)stg[orow*64+d0*32+r32]=__float2bfloat16(o[d0][r]*rli[r]);}
    asm volatile("s_waitcnt lgkmcnt(0)":::"memory");
    #pragma unroll
    for(int i=0;i<4;++i){const int row=i*8+(lane>>3),ch=lane&7; const u32x4 v=*(const u32x4*)(stg+row*64+ch*8); ATTN_STORE16(Ow+(long)row*PO+ch*8,v);} }
  asm volatile("s_waitcnt lgkmcnt(0)\n\ts_barrier":::"memory");
  #undef DMA_K
  #undef DMA_V
  #undef CMASK
  #undef START
  #undef RESC
  #undef ROT
}
constexpr int ATTN_LDS_BYTES=LDS_BYTES;
struct AttnTensors { const bf16* Q; const bf16* K; const bf16* V; bf16* O; };
struct AttnUnit { int bh; int qb; };
struct StaticOrder {
  int vcu;
  __device__ __forceinline__ explicit StaticOrder(int grid,int block):vcu((block%8)*(grid/8)+block/8){}
  __device__ __forceinline__ bool next(int i,AttnUnit&u)const{ if(i>=4)return false; const int s=vcu&3; u.bh=vcu>>2; u.qb=(i==0)?s:(i==1)?7-s:(i==2)?8+s:15-s; return true; }
  __device__ __forceinline__ void a_ready(const AttnUnit&)const{}
  __device__ __forceinline__ void done(const AttnUnit&)const{}
};
template<class Sched,int THRL=8> __device__ __forceinline__ void attn_phase(char*lds,const AttnTensors&T,const Sched&S){
  AttnUnit u;
  for(int i=0;S.next(i,u);++i){ S.a_ready(u); attn_unit<THRL>(u.bh/NHEAD,u.bh%NHEAD,u.qb,T.Q,T.K,T.V,T.O,lds); S.done(u); }
}
#undef SBAR
#undef WAIT_BAR
}

#define GAS __attribute__((address_space(1)))
#define LAS __attribute__((address_space(3)))
typedef unsigned short bf16;
typedef unsigned v4u __attribute__((ext_vector_type(4)));
typedef float f32x4 __attribute__((ext_vector_type(4)));
typedef short bf16x8 __attribute__((ext_vector_type(8)));
typedef GAS unsigned gu32;
typedef GAS unsigned long long gu64;
#define RLX_AGENT __ATOMIC_RELAXED, __HIP_MEMORY_SCOPE_AGENT
#define LDS_WAIT() asm volatile("s_waitcnt lgkmcnt(0)" ::: "memory")
#define VM_WAIT() asm volatile("s_waitcnt vmcnt(0)" ::: "memory")
__device__ __forceinline__ unsigned long long rt() { return __builtin_amdgcn_s_memrealtime(); }
__device__ __forceinline__ unsigned f2bf(float f) { unsigned u = __builtin_bit_cast(unsigned, f); return (u + 0x7fffu + ((u >> 16) & 1u)) >> 16; }
__device__ __forceinline__ unsigned pk2(float lo, float hi) { return f2bf(lo) | (f2bf(hi) << 16); }

#define XB_TMO      128
#define XB_XCNT(j)  (256  + 64 * (j))
#define XB_XSUB(j)  (1280 + 64 * (j))
#define XB_XGEN(j)  (2304 + 64 * (j))
#define XB_TOP      3328
#define XB_TOPGEN   3392
#define XCD_BAR_WORDS 3456
#define XB_SPIN_CAP (1u << 18)

__device__ __forceinline__ unsigned xb_ld(unsigned* p)              { return __hip_atomic_load(p, __ATOMIC_RELAXED, __HIP_MEMORY_SCOPE_AGENT); }
__device__ __forceinline__ unsigned xb_add(unsigned* p, unsigned v) { return __hip_atomic_fetch_add(p, v, __ATOMIC_RELAXED, __HIP_MEMORY_SCOPE_AGENT); }
__device__ __forceinline__ unsigned xb_xcc_id() { return (unsigned)__builtin_amdgcn_s_getreg((3 << 11) | 20) & 0xFu; }
#define XB_SPIN(cond, bar) do { unsigned _sp = 0; while (cond) { __builtin_amdgcn_s_sleep(1); \
    if ((++_sp & 255u) == 0u) { if (xb_ld(&(bar)[XB_TMO])) break; if (_sp > XB_SPIN_CAP) { atomicAdd(&(bar)[XB_TMO], 1u); break; } } } } while (0)

struct XcdBarrier {
    unsigned* bar; unsigned x;
    volatile LAS unsigned* st;
};

__device__ __forceinline__ XcdBarrier xcd_barrier_post(unsigned* bar, volatile LAS unsigned* st) {
    XcdBarrier b; b.bar = bar; b.x = xb_xcc_id(); b.st = st;
    if (threadIdx.x == 0) (void)xb_add(&bar[XB_XCNT(b.x)], 1u);
    return b;
}
__device__ __forceinline__ void xcd_barrier_complete(unsigned* bar, unsigned x, unsigned& nloc, unsigned& nx) {
    const unsigned G = gridDim.x * gridDim.y * gridDim.z;
    unsigned sum, cnt, mine, sp = 0u;
    for (;;) {
        sum = 0u; cnt = 0u; mine = 0u;
#pragma unroll
        for (unsigned j = 0; j < 16; ++j) { const unsigned c = xb_ld(&bar[XB_XCNT(j)]); sum += c; cnt += (c > 0u) ? 1u : 0u; mine = (j == x) ? c : mine; }
        if (sum == G) break;
        __builtin_amdgcn_s_sleep(1);
        if ((++sp & 255u) == 0u) { if (xb_ld(&bar[XB_TMO])) break; if (sp > XB_SPIN_CAP) { atomicAdd(&bar[XB_TMO], 1u); break; } }
    }
    nloc = mine > 0u ? mine : 1u; nx = cnt > 0u ? cnt : 1u;
}

__device__ __forceinline__ void xcd_barrier(const XcdBarrier& b) {
    asm volatile("s_waitcnt vmcnt(0)" ::: "memory");
    __syncthreads();
    if (threadIdx.x == 0) {
        unsigned* bar = b.bar;
        __builtin_amdgcn_s_waitcnt(0);
        unsigned nloc = b.st[0], nx = b.st[1];
        if (nloc == 0u) { xcd_barrier_complete(bar, b.x, nloc, nx); b.st[0] = nloc; b.st[1] = nx; }
        const unsigned old = xb_add(&bar[XB_XSUB(b.x)], 1u);
        const unsigned gen = old / nloc;
        if (old + 1u == (gen + 1u) * nloc) {
            __builtin_amdgcn_fence(__ATOMIC_RELEASE, "agent");
            asm volatile("s_waitcnt vmcnt(0)" ::: "memory");
            const unsigned og = xb_add(&bar[XB_TOP], 1u);
            const unsigned tg = og / nx;
            if (og + 1u == (tg + 1u) * nx) xb_add(&bar[XB_TOPGEN], 1u);
            else XB_SPIN(xb_ld(&bar[XB_TOPGEN]) == tg, bar);
            __builtin_amdgcn_fence(__ATOMIC_ACQUIRE, "agent");
            xb_add(&bar[XB_XGEN(b.x)], 1u);
            asm volatile("s_waitcnt vmcnt(0)" ::: "memory");
        } else {
            XB_SPIN(xb_ld(&bar[XB_XGEN(b.x)]) == gen, bar);
            __builtin_amdgcn_fence(__ATOMIC_ACQUIRE, "agent");
            asm volatile("s_waitcnt vmcnt(0)" ::: "memory");
        }
    }
    __syncthreads();
}


constexpr int NWAVES = 8;
constexpr int BATCH = 4, SEQ = 4096, DM = 1024, M = BATCH * SEQ, IN_COLS = 5632, NEXP = 32, EFF = 512;
constexpr float EPS = 1e-6f;
constexpr float LAM_INIT = 0.2f;
constexpr int MAXROWS = 2 * M + NEXP * 255;
#ifndef MK_PER_PHASE
#define MK_PER_PHASE 0
#endif
constexpr int N_PHASES = 12;
#ifndef PROBE_A
#define PROBE_A -1
#endif
#ifndef PROBE_B
#define PROBE_B -1
#endif
constexpr bool PROBING = (PROBE_A >= 0) || (PROBE_B >= 0);
constexpr int MI_TS = 128;

constexpr size_t MiB = 1u << 20;
constexpr size_t WS_CTL = 0, CTL_ZERO_BYTES = 1 * MiB;
constexpr size_t WS_WIN = 1 * MiB, WS_WA = 12 * MiB, WS_WB = 13 * MiB, WS_WOUT = 14 * MiB;
constexpr size_t WS_TABA = 16 * MiB, WS_TABB = 17 * MiB, WS_WRP = 25 * MiB;
constexpr size_t WS_SSQ = 16 * MiB;
constexpr size_t WS_H = 26 * MiB;
constexpr size_t WS_P = 58 * MiB, PBUF = 16 * MiB;
constexpr size_t WS_OA = 234 * MiB, WS_OB = 250 * MiB;
constexpr size_t WS_T = 58 * MiB, WS_MERGED = 122 * MiB;
constexpr size_t WS_Y = 58 * MiB;
constexpr size_t WS_XS = 58 * MiB, WS_HMID = 138 * MiB, WS_WGU = 178 * MiB, WS_WD = 242 * MiB;
constexpr size_t WS_ENT_TOK = 274 * MiB, WS_ENT_W = 276 * MiB, WS_ROW_TOK = 278 * MiB, WS_ROW_W = 278 * MiB + 512 * 1024, WS_END = 279 * MiB;
static_assert((size_t)MAXROWS * 1024 * 2 <= WS_HMID - WS_XS && (size_t)MAXROWS * 512 * 2 <= WS_WGU - WS_HMID && (size_t)MAXROWS * 4 <= 512 * 1024, "ws map");
constexpr int CW_TMO = 0, CW_CODE = 1, CW_CNT = 64, CW_BAR = 4096;

constexpr int RING_OFF = 0, RING_BYTES = 131072;
constexpr int LDSCTL_OFF = RING_BYTES, MISC_OFF = LDSCTL_OFF + 320;
constexpr int LDS_BYTES = 147456;
constexpr int MI_CNT = 16, MI_TP = 48;


struct Args { const void* in[24]; float* out; unsigned char* ws; int ph_lo, ph_hi; };
#define FIN(i) ((const float*)args.in[i])
struct Frame {
    LAS unsigned char* lds;
    volatile LAS unsigned* MISC;
    gu32* ctl;
    int tid, lane, wave;
    int vcu, G;
    float* out; unsigned char* ws;
};
__device__ __forceinline__ float bflo(unsigned w) { return __uint_as_float(w << 16); }
__device__ __forceinline__ float bfhi(unsigned w) { return __uint_as_float(w & 0xffff0000u); }
__device__ __forceinline__ float wave_sum(float v) {
#pragma unroll
    for (int o = 1; o < 64; o <<= 1) v += __shfl_xor(v, o);
    return v;
}
__device__ __forceinline__ float sigmoidf_(float x) { return 1.0f / (1.0f + __expf(-x)); }
__device__ __forceinline__ float siluf_(float x) { return x / (1.0f + __expf(-x)); }
__device__ __forceinline__ void unpack8(const v4u r, float (&x)[8]) {
    x[0] = bflo(r.x); x[1] = bfhi(r.x); x[2] = bflo(r.y); x[3] = bfhi(r.y); x[4] = bflo(r.z); x[5] = bfhi(r.z); x[6] = bflo(r.w); x[7] = bfhi(r.w);
}
__device__ __forceinline__ v4u pack8(const float (&x)[8]) { v4u o; o.x = pk2(x[0], x[1]); o.y = pk2(x[2], x[3]); o.z = pk2(x[4], x[5]); o.w = pk2(x[6], x[7]); return o; }

__device__ __forceinline__ int win_row(int n) {
    const int t = n >> 9, pr = n & 511; int pos = pr;
    if (t <= 1) { const int d = pr & 63; pos = (pr & ~63) | (d < 16 ? (2 * (d & 7) + (d >> 3)) : d); }
    else if (t == 3 || t == 4) { const int d = pr & 127; pos = (pr & ~127) | (2 * (d & 63) + (d >> 6)); }
    const int sc = t * 512 + pos, lc = sc & 255;
    const int pc = 128 * ((lc >> 5) & 1) + 32 * (lc >> 6) + (lc & 31);
    return (sc & ~255) | pc;
}
__device__ __forceinline__ void transpose_item(const float* W, int N, bf16* WT, int ldt, int mode, LAS unsigned* scr, int kb, int nb, int lane) {
    const int k0 = 64 * kb, n0 = 64 * nb, n4 = 4 * (lane & 15);
    f32x4 a[8], b[8];
#pragma unroll
    for (int i = 0; i < 8; ++i) { const int kp = 4 * i + (lane >> 4); const float* p = W + (size_t)(k0 + 2 * kp) * N + n0 + n4; a[i] = *(const GAS f32x4*)p; b[i] = *(const GAS f32x4*)(p + N); }
#pragma unroll
    for (int i = 0; i < 8; ++i) { const int kp = 4 * i + (lane >> 4);
#pragma unroll
        for (int t = 0; t < 4; ++t) scr[(n4 + t) * 36 + kp] = pk2(a[i][t], b[i][t]); }
    LDS_WAIT(); asm volatile("" ::: "memory");
    const int c = lane & 7;
#pragma unroll
    for (int j = 0; j < 8; ++j) { const int n = (lane >> 3) + 8 * j; const v4u o = *(const LAS v4u*)(scr + n * 36 + 4 * c);
        const int nn = n0 + n; const int row = mode == 0 ? nn : mode == 3 ? win_row(nn) : ((nn >> 2) * 8 + (mode == 2 ? 4 : 0) + (nn & 3));
        *(GAS v4u*)(WT + (size_t)row * ldt + k0 + 8 * c) = o; }
    LDS_WAIT(); asm volatile("" ::: "memory");
}
__device__ __forceinline__ void sincos_acc(float ang, float& s, float& c) {
    const double t = (double)ang * 0.15915494309189535; const double fr = t - __builtin_rint(t);
    const float r = (float)(fr * 6.283185307179586);
    s = sinf(r); c = cosf(r);
}
__device__ __forceinline__ void p0_prologue(Frame& F, const Args& args) {
    LAS unsigned* scr = (LAS unsigned*)(F.lds + RING_OFF + F.wave * 16384);
    const int gw = F.vcu * NWAVES + F.wave, NGW = F.G * NWAVES;
    unsigned char* ws = F.ws;
    constexpr int I_IN = (DM / 64) * (IN_COLS / 64), I_A = (512 / 64) * (DM / 64), I_OUT = (DM / 64) * (DM / 64);
    for (int it = gw; it < I_IN + 2 * I_A + I_OUT; it += NGW) {
        int r = it;
        if (r < I_IN) { transpose_item(FIN(3), IN_COLS, (bf16*)(ws + WS_WIN), DM, 3, scr, r / (IN_COLS / 64), r % (IN_COLS / 64), F.lane); continue; } r -= I_IN;
        if (r < I_A) { transpose_item(FIN(13), DM, (bf16*)(ws + WS_WA), 1024, 0, scr, r / (DM / 64), r % (DM / 64), F.lane); continue; } r -= I_A;
        if (r < I_A) { transpose_item(FIN(14), DM, (bf16*)(ws + WS_WA) + 512, 1024, 0, scr, r / (DM / 64), r % (DM / 64), F.lane); continue; } r -= I_A;
        transpose_item(FIN(15), DM, (bf16*)(ws + WS_WOUT), DM, 0, scr, r / (DM / 64), r % (DM / 64), F.lane);
    }
    {
        const float* wgr = FIN(17); const float* wer = FIN(19); const float* g2 = FIN(16); v4u* Wp16 = (v4u*)(ws + WS_WRP);
        for (int idx = gw * 64 + F.lane; idx < 32 * 3 * 64; idx += NGW * 64) {
            const int l = idx & 63, kt = idx >> 6, t = kt % 3, ks = kt / 3, col = l & 15, q = l >> 4;
            float hi[8], lo[8];
#pragma unroll
            for (int j = 0; j < 8; ++j) { const int k = 32 * ks + 8 * q + j; const float w = g2[k] * ((t == 0) ? (col < 4 ? wgr[k * 4 + col] : 0.f) : wer[k * 32 + (t - 1) * 16 + col]);
                hi[j] = __uint_as_float(f2bf(w) << 16); lo[j] = w - hi[j]; }
            Wp16[(size_t)(kt * 2 + 0) * 64 + l] = pack8(hi); Wp16[(size_t)(kt * 2 + 1) * 64 + l] = pack8(lo);
        }
    }
    {
        const int* pos = (const int*)FIN(1); float* tabA = (float*)(ws + WS_TABA); float* tabB = (float*)(ws + WS_TABB);
        const float fB = powf(10000.0f, -(float)F.lane * (1.0f / 64.0f)), fA = powf(500000.0f, -(float)(F.lane & 7) * 0.125f);
        for (int tk = gw; tk < M; tk += NGW) {
            const float p = (float)pos[tk]; float s, c;
            sincos_acc(p * fB, s, c); tabB[(size_t)tk * 128 + F.lane] = c; tabB[(size_t)tk * 128 + 64 + F.lane] = s;
            if (F.lane < 8) { sincos_acc(p * fA, s, c); tabA[(size_t)tk * 16 + F.lane] = c; tabA[(size_t)tk * 16 + 8 + F.lane] = s; }
        }
    }
    {
        const float* g = FIN(2); bf16* H = (bf16*)(ws + WS_H);
        f32x4 gv[4];
#pragma unroll
        for (int j = 0; j < 4; ++j) gv[j] = ((const f32x4*)g)[F.lane + 64 * j];
        for (int m0 = gw * 4; m0 < M; m0 += NGW * 4) {
            f32x4 v[4][4];
#pragma unroll
            for (int r = 0; r < 4; ++r) { const GAS f32x4* xr = (const GAS f32x4*)(FIN(0) + (size_t)(m0 + r) * DM) + F.lane;
#pragma unroll
                for (int j = 0; j < 4; ++j) v[r][j] = xr[64 * j]; }
#pragma unroll
            for (int r = 0; r < 4; ++r) { float s = 0.f;
#pragma unroll
                for (int j = 0; j < 4; ++j) s += (v[r][j].x * v[r][j].x + v[r][j].y * v[r][j].y) + (v[r][j].z * v[r][j].z + v[r][j].w * v[r][j].w);
                const float rstd = rsqrtf(wave_sum(s) * (1.f / DM) + EPS);
                GAS unsigned long long* o8 = (GAS unsigned long long*)(H + (size_t)(m0 + r) * DM) + F.lane;
#pragma unroll
                for (int j = 0; j < 4; ++j) o8[64 * j] = (unsigned long long)pk2(v[r][j].x * rstd * gv[j].x, v[r][j].y * rstd * gv[j].y) | ((unsigned long long)pk2(v[r][j].z * rstd * gv[j].z, v[r][j].w * rstd * gv[j].w) << 32); }
        }
    }
}

__device__ __forceinline__ int rt_off(int row, int kb) { return row * 256 + ((((kb >> 4) ^ (row & 15)) << 4) | (kb & 15)); }
__device__ __forceinline__ bf16x8 rt_frag(const LAS unsigned char* tile, int r0, int ks, int lane) {
    return *(const LAS bf16x8*)(tile + rt_off(r0 + (lane & 15), ks * 64 + 16 * (lane >> 4)));
}
__device__ __forceinline__ float log2_gamma(int h) { return log2f(1.0f - exp2f(-5.0f - (float)h)); }

__device__ __forceinline__ void ret_kv_item(Frame& F, const Args& args, int item) {
    const int bh = item >> 5, n = item & 31, b = bh >> 2, h = bh & 3, tid = F.tid, lane = F.lane, w = F.wave;
    const size_t tok0 = (size_t)b * SEQ + (size_t)n * 128;
    const bf16* kr = (const bf16*)(F.ws + WS_P + 4 * PBUF); const bf16* vr = (const bf16*)(F.ws + WS_P + 5 * PBUF);
    float* RS = F.out + (size_t)item * 16384;
    LAS unsigned char* Kt = F.lds; LAS unsigned char* Vt = F.lds + 32768;
    const float lg = log2_gamma(h);
#pragma unroll
    for (int it = 0; it < 4; ++it) {
        const int idx = tid + it * 512, j = idx & 127, ch = idx >> 7;
        const v4u kv = *(const GAS v4u*)(kr + (tok0 + j) * 512 + h * 128 + ch * 8);
        const v4u vv = *(const GAS v4u*)(vr + (tok0 + j) * 512 + h * 128 + ch * 8);
        float kx[8], vx[8]; unpack8(kv, kx); unpack8(vv, vx);
        const float z = exp2f((float)(127 - j) * lg);
#pragma unroll
        for (int t = 0; t < 8; ++t) {
            *(LAS unsigned short*)(Kt + rt_off(ch * 8 + t, j * 2)) = (unsigned short)f2bf(kx[t]);
            *(LAS unsigned short*)(Vt + rt_off(ch * 8 + t, j * 2)) = (unsigned short)f2bf(vx[t] * z);
        }
    }
    __syncthreads();
    f32x4 acc[8];
#pragma unroll
    for (int dt = 0; dt < 8; ++dt) acc[dt] = (f32x4){0.f, 0.f, 0.f, 0.f};
#pragma unroll
    for (int ks = 0; ks < 4; ++ks) {
        const bf16x8 a = rt_frag(Vt, 16 * w, ks, lane);
#pragma unroll
        for (int dt = 0; dt < 8; ++dt) { const bf16x8 bb = rt_frag(Kt, 16 * dt, ks, lane); acc[dt] = __builtin_amdgcn_mfma_f32_16x16x32_bf16(bb, a, acc[dt], 0, 0, 0); }
    }
    const int e = 16 * w + (lane & 15), q = lane >> 4;
#pragma unroll
    for (int dt = 0; dt < 8; ++dt) *(GAS f32x4*)(RS + (size_t)e * 128 + 16 * dt + 4 * q) = acc[dt];
    __syncthreads();
}
__device__ __forceinline__ void p4_scan(Frame& F, const Args& args) {
    const int gid = F.vcu * (NWAVES * 64) + F.tid, NT = F.G * NWAVES * 64;
    for (int idx = gid; idx < 16 * 4096; idx += NT) {
        const int bh = idx >> 12, off = idx & 4095, h = bh & 3;
        const float g = exp2f(128.0f * log2_gamma(h));
        f32x4 r = (f32x4){0.f, 0.f, 0.f, 0.f};
        GAS f32x4* p = (GAS f32x4*)(F.out + (size_t)bh * 32 * 16384) + off;
        for (int n = 0; n < 32; ++n) { const f32x4 t = p[(size_t)n * 4096]; p[(size_t)n * 4096] = r; r = r * g + t; }
    }
}
__device__ __forceinline__ void ret_out_item(Frame& F, const Args& args, int item) {
    const int bh = item >> 5, n = item & 31, b = bh >> 2, h = bh & 3, tid = F.tid, lane = F.lane, w = F.wave;
    const size_t tok0 = (size_t)b * SEQ + (size_t)n * 128;
    const bf16* qr = (const bf16*)(F.ws + WS_P + 3 * PBUF); const bf16* kr = (const bf16*)(F.ws + WS_P + 4 * PBUF); const bf16* vr = (const bf16*)(F.ws + WS_P + 5 * PBUF);
    const bf16* gb = (const bf16*)(F.ws + WS_P + 6 * PBUF); bf16* obg = (bf16*)(F.ws + WS_OA) + 512;
    const float* RS = F.out + (size_t)item * 16384;
    LAS unsigned char* Qs = F.lds; LAS unsigned char* Ks = F.lds + 32768; LAS unsigned char* Vt = F.lds + 65536; LAS unsigned char* Rt = F.lds + 98304;
    const float lg = log2_gamma(h);
#pragma unroll
    for (int it = 0; it < 4; ++it) {
        const int idx = tid + it * 512;
        { const int row = idx >> 4, ch = idx & 15;
          *(LAS v4u*)(Qs + rt_off(row, ch * 16)) = *(const GAS v4u*)(qr + (tok0 + row) * 512 + h * 128 + ch * 8);
          *(LAS v4u*)(Ks + rt_off(row, ch * 16)) = *(const GAS v4u*)(kr + (tok0 + row) * 512 + h * 128 + ch * 8);
          const f32x4 r0 = *(const GAS f32x4*)(RS + (size_t)row * 128 + ch * 8), r1 = *(const GAS f32x4*)(RS + (size_t)row * 128 + ch * 8 + 4);
          v4u o; o.x = pk2(r0.x, r0.y); o.y = pk2(r0.z, r0.w); o.z = pk2(r1.x, r1.y); o.w = pk2(r1.z, r1.w);
          *(LAS v4u*)(Rt + rt_off(row, ch * 16)) = o; }
        { const int j = idx & 127, ch = idx >> 7;
          const v4u vv = *(const GAS v4u*)(vr + (tok0 + j) * 512 + h * 128 + ch * 8);
          *(LAS unsigned short*)(Vt + rt_off(ch * 8 + 0, j * 2)) = (unsigned short)(vv.x & 0xffffu); *(LAS unsigned short*)(Vt + rt_off(ch * 8 + 1, j * 2)) = (unsigned short)(vv.x >> 16);
          *(LAS unsigned short*)(Vt + rt_off(ch * 8 + 2, j * 2)) = (unsigned short)(vv.y & 0xffffu); *(LAS unsigned short*)(Vt + rt_off(ch * 8 + 3, j * 2)) = (unsigned short)(vv.y >> 16);
          *(LAS unsigned short*)(Vt + rt_off(ch * 8 + 4, j * 2)) = (unsigned short)(vv.z & 0xffffu); *(LAS unsigned short*)(Vt + rt_off(ch * 8 + 5, j * 2)) = (unsigned short)(vv.z >> 16);
          *(LAS unsigned short*)(Vt + rt_off(ch * 8 + 6, j * 2)) = (unsigned short)(vv.w & 0xffffu); *(LAS unsigned short*)(Vt + rt_off(ch * 8 + 7, j * 2)) = (unsigned short)(vv.w >> 16); }
    }
    __syncthreads();
    const int i = 16 * w + (lane & 15), q = lane >> 4;
    f32x4 sacc[8];
#pragma unroll
    for (int jt = 0; jt < 8; ++jt) sacc[jt] = (f32x4){0.f, 0.f, 0.f, 0.f};
#pragma unroll
    for (int ks = 0; ks < 4; ++ks) {
        const bf16x8 a = rt_frag(Qs, 16 * w, ks, lane);
#pragma unroll
        for (int jt = 0; jt < 8; ++jt) { const bf16x8 bb = rt_frag(Ks, 16 * jt, ks, lane); sacc[jt] = __builtin_amdgcn_mfma_f32_16x16x32_bf16(bb, a, sacc[jt], 0, 0, 0); }
    }
    __syncthreads();
#pragma unroll
    for (int jt = 0; jt < 8; ++jt) {
        float v[4];
#pragma unroll
        for (int t = 0; t < 4; ++t) { const int j = 16 * jt + 4 * q + t; v[t] = (i >= j) ? sacc[jt][t] * exp2f((float)(i - j) * lg) : 0.f; }
        *(LAS unsigned long long*)(Ks + rt_off(i, (16 * jt + 4 * q) * 2)) = (unsigned long long)pk2(v[0], v[1]) | ((unsigned long long)pk2(v[2], v[3]) << 32);
    }
    __syncthreads();
    f32x4 a1[8], a2[8];
#pragma unroll
    for (int et = 0; et < 8; ++et) { a1[et] = (f32x4){0.f, 0.f, 0.f, 0.f}; a2[et] = (f32x4){0.f, 0.f, 0.f, 0.f}; }
#pragma unroll
    for (int ks = 0; ks < 4; ++ks) {
        const bf16x8 aS = rt_frag(Ks, 16 * w, ks, lane), aQ = rt_frag(Qs, 16 * w, ks, lane);
#pragma unroll
        for (int et = 0; et < 8; ++et) {
            const bf16x8 bV = rt_frag(Vt, 16 * et, ks, lane), bR = rt_frag(Rt, 16 * et, ks, lane);
            a1[et] = __builtin_amdgcn_mfma_f32_16x16x32_bf16(bV, aS, a1[et], 0, 0, 0);
            a2[et] = __builtin_amdgcn_mfma_f32_16x16x32_bf16(bR, aQ, a2[et], 0, 0, 0);
        }
    }
    const float xi = exp2f((float)(i + 1) * lg);
    float s = 0.f;
#pragma unroll
    for (int et = 0; et < 8; ++et) { a1[et] = a1[et] + a2[et] * xi; s += (a1[et][0] + a1[et][1]) + (a1[et][2] + a1[et][3]); }
    s += __shfl_xor(s, 16); s += __shfl_xor(s, 32);
    const float mu = s * (1.f / 128.f); float vq = 0.f;
#pragma unroll
    for (int et = 0; et < 8; ++et) { const f32x4 d = a1[et] - mu; vq += (d[0] * d[0] + d[1] * d[1]) + (d[2] * d[2] + d[3] * d[3]); }
    vq += __shfl_xor(vq, 16); vq += __shfl_xor(vq, 32);
    const float rstd = rsqrtf(vq * (1.f / 128.f) + EPS);
    const float* gng = FIN(11) + h * 128; const float* gnb = FIN(12) + h * 128;
#pragma unroll
    for (int et = 0; et < 8; ++et) {
        const int e = 16 * et + 4 * q;
        const f32x4 gg = *(const f32x4*)(gng + e), bb = *(const f32x4*)(gnb + e);
        const unsigned long long gw8 = *(const GAS unsigned long long*)(gb + (tok0 + i) * 512 + h * 128 + e);
        const float g0 = bflo((unsigned)gw8), g1 = bfhi((unsigned)gw8), g2 = bflo((unsigned)(gw8 >> 32)), g3 = bfhi((unsigned)(gw8 >> 32));
        const f32x4 y = (a1[et] - mu) * rstd * gg + bb;
        *(GAS unsigned long long*)(obg + (tok0 + i) * 1024 + h * 128 + e) =
            (unsigned long long)pk2(y[0] * siluf_(g0), y[1] * siluf_(g1)) | ((unsigned long long)pk2(y[2] * siluf_(g2), y[3] * siluf_(g3)) << 32);
    }
    __syncthreads();
}
__device__ __forceinline__ void p5_attn_combine(Frame& F, const Args& args) {
    const int gw = F.vcu * NWAVES + F.wave, NGW = F.G * NWAVES, lane = F.lane;
    const float s1 = wave_sum(FIN(6)[lane] * FIN(7)[lane]), s2 = wave_sum(FIN(8)[lane] * FIN(9)[lane]);
    const float lam = expf(s1) - expf(s2) + LAM_INIT;
    const bf16* AO = (const bf16*)(F.ws + WS_H); bf16* oa = (bf16*)(F.ws + WS_OA);
    const int h = lane >> 4, e0 = (lane & 15) * 8, vhalf = e0 >> 6, d = e0 & 63;
    float g[8];
#pragma unroll
    for (int t = 0; t < 8; ++t) g[t] = FIN(10)[e0 + t] * (1.0f - LAM_INIT);
    for (int tk0 = gw * 4; tk0 < M; tk0 += NGW * 4) {
        v4u r0[4], r1[4];
#pragma unroll
        for (int r = 0; r < 4; ++r) { r0[r] = *(const GAS v4u*)(AO + (size_t)(tk0 + r) * 1024 + (h * 4 + vhalf) * 64 + d); r1[r] = *(const GAS v4u*)(AO + (size_t)(tk0 + r) * 1024 + (h * 4 + 2 + vhalf) * 64 + d); }
#pragma unroll
        for (int r = 0; r < 4; ++r) {
            float x0[8], x1[8]; unpack8(r0[r], x0); unpack8(r1[r], x1);
            float y[8], ss = 0.f;
#pragma unroll
            for (int t = 0; t < 8; ++t) { y[t] = x0[t] - lam * x1[t]; ss += y[t] * y[t]; }
            ss += __shfl_xor(ss, 1); ss += __shfl_xor(ss, 2); ss += __shfl_xor(ss, 4); ss += __shfl_xor(ss, 8);
            const float rstd = rsqrtf(ss * (1.f / 128.f) + EPS);
#pragma unroll
            for (int t = 0; t < 8; ++t) y[t] = y[t] * rstd * g[t];
            *(GAS v4u*)(oa + (size_t)(tk0 + r) * 1024 + h * 128 + e0) = pack8(y);
        }
    }
}

struct EpiIn {
    static constexpr bool PERM = true, AFTER_DRAIN = false, MUTATES = false;
    bf16* P; const float* tabA; const float* tabB; const float* qg; const float* kg;
    __device__ __forceinline__ void operator()(const f32x4 (&acc)[2][2][4][2], const pg8::Unit& u, int wr, int wc, int fr, int fq) const {
        const int t = u.pn >> 1, row0 = u.pm * 256 + wr * 64 + fr, pos0 = (u.pn & 1) * 256 + 64 * wc + 8 * fq;
        bf16* base = P + (size_t)t * (PBUF / 2);
        constexpr float C2 = 0.125f * 1.4426950408889634f;
        if (t <= 1) {
            float g8[2][8];
            const float* gsrc = (t == 0) ? qg : kg;
#pragma unroll
            for (int bj = 0; bj < 2; ++bj)
#pragma unroll
                for (int i = 0; i < 8; ++i) { const int j = 32 * bj + 8 * fq + i; const int d = (j < 16) ? ((j >> 1) + 8 * (j & 1)) : j; g8[bj][i] = gsrc[d] * (t == 0 ? C2 : 1.0f); }
#pragma unroll
            for (int ai = 0; ai < 2; ++ai)
#pragma unroll
                for (int m = 0; m < 4; ++m) { const size_t row = (size_t)(row0 + ai * 128 + m * 16);
                    float ss = 0.f;
#pragma unroll
                    for (int bj = 0; bj < 2; ++bj)
#pragma unroll
                        for (int n = 0; n < 2; ++n) { const f32x4 v = acc[ai][bj][m][n]; ss += (v[0] * v[0] + v[1] * v[1]) + (v[2] * v[2] + v[3] * v[3]); }
                    ss += __shfl_xor(ss, 16); ss += __shfl_xor(ss, 32);
                    const float rstd = rsqrtf(ss * (1.f / 64.f) + EPS);
#pragma unroll
                    for (int bj = 0; bj < 2; ++bj) {
                        float y[8];
#pragma unroll
                        for (int i = 0; i < 8; ++i) y[i] = acc[ai][bj][m][i >> 2][i & 3] * rstd * g8[bj][i];
                        if (bj == 0 && fq < 2) {
                            const f32x4 cs = *(const GAS f32x4*)(tabA + row * 16 + 4 * fq), sn = *(const GAS f32x4*)(tabA + row * 16 + 8 + 4 * fq);
#pragma unroll
                            for (int p = 0; p < 4; ++p) { const float x1 = y[2 * p], x2 = y[2 * p + 1]; y[2 * p] = x1 * cs[p] - x2 * sn[p]; y[2 * p + 1] = x2 * cs[p] + x1 * sn[p]; }
                        }
                        *(GAS v4u*)(base + row * 512 + pos0 + 32 * bj) = pack8(y);
                    } }
        } else if (t == 3 || t == 4) {
            const float sc = (t == 4) ? 0.08838834764831845f : 1.0f;
#pragma unroll
            for (int ai = 0; ai < 2; ++ai)
#pragma unroll
                for (int m = 0; m < 4; ++m) { const size_t row = (size_t)(row0 + ai * 128 + m * 16);
#pragma unroll
                    for (int bj = 0; bj < 2; ++bj) {
                        const int rho0 = ((pos0 + 32 * bj) & 127) >> 1;
                        const f32x4 cs = *(const GAS f32x4*)(tabB + row * 128 + rho0), sn = *(const GAS f32x4*)(tabB + row * 128 + 64 + rho0);
                        float y[8];
#pragma unroll
                        for (int p = 0; p < 4; ++p) { const float x1 = acc[ai][bj][m][p >> 1][2 * (p & 1)], x2 = acc[ai][bj][m][p >> 1][2 * (p & 1) + 1];
                            y[2 * p] = (x1 * cs[p] - x2 * sn[p]) * sc; y[2 * p + 1] = (x2 * cs[p] + x1 * sn[p]) * sc; }
                        *(GAS v4u*)(base + row * 512 + pos0 + 32 * bj) = pack8(y);
                    } }
        } else {
#pragma unroll
            for (int ai = 0; ai < 2; ++ai)
#pragma unroll
                for (int m = 0; m < 4; ++m) { const size_t row = (size_t)(row0 + ai * 128 + m * 16);
#pragma unroll
                    for (int bj = 0; bj < 2; ++bj) { const f32x4 v0 = acc[ai][bj][m][0], v1 = acc[ai][bj][m][1];
                        v4u o; o.x = pk2(v0[0], v0[1]); o.y = pk2(v0[2], v0[3]); o.z = pk2(v1[0], v1[1]); o.w = pk2(v1[2], v1[3]);
                        *(GAS v4u*)(base + row * 512 + pos0 + 32 * bj) = o; } }
        }
    }
};
struct EpiMerge2 {
    static constexpr bool PERM = true, AFTER_DRAIN = false, MUTATES = true;
    bf16* O; const bf16* ga0; const bf16* ga1; const bf16* gb0; const bf16* gb1;
    __device__ __forceinline__ bool mut(f32x4 (&acc)[2][2][4][2], const pg8::Unit& u, int wr, int wc, int fr, int fq) const {
        const int row0 = u.pm * 256 + wr * 64 + fr, col0 = u.pn * 256 + wc * 32 + 8 * fq;
#pragma unroll
        for (int ai = 0; ai < 2; ++ai)
#pragma unroll
            for (int m = 0; m < 4; ++m) { const size_t row = (size_t)(row0 + ai * 128 + m * 16);
#pragma unroll
                for (int bj = 0; bj < 2; ++bj) { const int col = col0 + bj * 128;
                    float gb[8]; unpack8(*(const GAS v4u*)((col < 512 ? gb0 : gb1) + row * 512 + (col & 511)), gb);
                    if (u.kh == 0) {
                        float ga[8]; unpack8(*(const GAS v4u*)((col < 512 ? ga0 : ga1) + row * 512 + (col & 511)), ga);
#pragma unroll
                        for (int t = 0; t < 8; ++t) acc[ai][bj][m][t >> 2][t & 3] *= (1.0f + __expf(-gb[t])) / (1.0f + __expf(-ga[t]));
                    } else {
                        float v[8];
#pragma unroll
                        for (int t = 0; t < 8; ++t) v[t] = acc[ai][bj][m][t >> 2][t & 3] / (1.0f + __expf(-gb[t]));
                        *(GAS v4u*)(O + row * 1024 + col) = pack8(v);
                    } } }
        return u.kh == 0;
    }
};
struct EpiResid {
    static constexpr bool PERM = false, AFTER_DRAIN = false, MUTATES = false;
    const float* X; float* O; float* ssq;
    __device__ __forceinline__ void operator()(const f32x4 (&acc)[2][2][4][2], const pg8::Unit& u, int wr, int wc, int fr, int fq) const {
        const int row0 = u.pm * 256 + wr * 64 + fr, col0 = u.pn * 256 + wc * 32 + 4 * fq;
#pragma unroll
        for (int ai = 0; ai < 2; ++ai)
#pragma unroll
            for (int m = 0; m < 4; ++m) { const size_t row = (size_t)(row0 + ai * 128 + m * 16); float sq = 0.f;
#pragma unroll
                for (int bj = 0; bj < 2; ++bj)
#pragma unroll
                    for (int n = 0; n < 2; ++n) { const int col = col0 + bj * 128 + n * 16;
                        const f32x4 v = *(const GAS f32x4*)(X + row * 1024 + col) + acc[ai][bj][m][n];
                        sq += (v[0] * v[0] + v[1] * v[1]) + (v[2] * v[2] + v[3] * v[3]);
                        *(GAS f32x4*)(O + row * 1024 + col) = v; }
                sq += __shfl_xor(sq, 16); sq += __shfl_xor(sq, 32);
                if (fq == 0) ssq[row * 16 + u.pn * 4 + wc] = sq; }
    }
};
struct EpiSwiGLU {
    static constexpr bool PERM = true, AFTER_DRAIN = false, MUTATES = false;
    bf16* Hm;
    __device__ __forceinline__ void operator()(const f32x4 (&acc)[2][2][4][2], const pg8::Unit& u, int wr, int wc, int fr, int fq) const {
        const int row0 = u.pm * 256 + wr * 64 + fr, j0 = (u.pn & 3) * 128 + wc * 16 + 4 * fq;
#pragma unroll
        for (int ai = 0; ai < 2; ++ai)
#pragma unroll
            for (int m = 0; m < 4; ++m) { const size_t row = (size_t)(row0 + ai * 128 + m * 16);
#pragma unroll
                for (int bj = 0; bj < 2; ++bj) { const f32x4 a = acc[ai][bj][m][0], uu = acc[ai][bj][m][1];
                    *(GAS unsigned long long*)(Hm + row * 512 + j0 + bj * 64) =
                        (unsigned long long)pk2(siluf_(a[0]) * uu[0], siluf_(a[1]) * uu[1]) | ((unsigned long long)pk2(siluf_(a[2]) * uu[2], siluf_(a[3]) * uu[3]) << 32); } }
    }
};
struct EpiY {
    static constexpr bool PERM = true, AFTER_DRAIN = false, MUTATES = false;
    bf16* Y; const int* ent_tok; const float* ent_w; const volatile LAS unsigned* cntL;
    __device__ __forceinline__ void operator()(const f32x4 (&acc)[2][2][4][2], const pg8::Unit& u, int wr, int wc, int fr, int fq) const {
        const int r0 = u.ti * 256 + wr * 64 + fr, col0 = (u.pn & 3) * 256 + wc * 32 + 8 * fq, cnt = (int)cntL[u.e];
#pragma unroll
        for (int ai = 0; ai < 2; ++ai)
#pragma unroll
            for (int m = 0; m < 4; ++m) { const int ent = r0 + ai * 128 + m * 16;
                if (ent < cnt) { const int tk2 = ent_tok[(size_t)u.e * M + ent]; const float w = ent_w[(size_t)u.e * M + ent];
                    bf16* o = Y + ((size_t)(tk2 & 1) * M + (size_t)(tk2 >> 1)) * 1024 + col0;
#pragma unroll
                    for (int bj = 0; bj < 2; ++bj) { const f32x4 v0 = acc[ai][bj][m][0] * w, v1 = acc[ai][bj][m][1] * w;
                        v4u o4; o4.x = pk2(v0[0], v0[1]); o4.y = pk2(v0[2], v0[3]); o4.z = pk2(v1[0], v1[1]); o4.w = pk2(v1[2], v1[3]);
                        *(GAS v4u*)(o + bj * 128) = o4; } } }
    }
};
struct SplitKOrder : pg8::StaticOrder {
    __device__ __forceinline__ bool next(int i, pg8::Unit& u) const { if (!pg8::StaticOrder::next(i >> 1, u)) return false; u.kh = i & 1; u.kofs = (i & 1) * 512; return true; }
};
template <bool GA> struct GroupedOrderT {
    static constexpr bool GATHER = GA;
    const volatile LAS unsigned* tp; const volatile LAS unsigned* cntL; const int* ent_tok; int G, c;
    __device__ __forceinline__ bool next(int i, pg8::Unit& u) const {
        const int L = i * G + c; const int total = (int)tp[32] * 4; if (L >= total) return false;
        const int T = L >> 2; int e = 0;
#pragma unroll 1
        for (int k = 1; k < 32; ++k) e += (T >= (int)tp[k]) ? 1 : 0;
        u.pm = T; u.pn = e * 4 + (L & 3); u.e = e; u.ti = T - (int)tp[e]; u.kofs = 0; u.kh = 0; return true;
    }
    __device__ __forceinline__ unsigned arow_off(const pg8::Unit& u, int r) const {
        const int ent = u.ti * 256 + r; const int tk2 = (ent < (int)cntL[u.e]) ? ent_tok[(size_t)u.e * M + ent] : 0;
        return (unsigned)(tk2 >> 1) * (unsigned)(DM * 2);
    }
    __device__ __forceinline__ void a_ready(const pg8::Unit&) const {}
    __device__ __forceinline__ void done(const pg8::Unit&) const {}
};

__device__ __forceinline__ void p9_router(Frame& F, const Args& args) {
    const int gw = F.vcu * NWAVES + F.wave, NGW = F.G * NWAVES, lane = F.lane, tid = F.tid, w = F.wave;
    unsigned char* ws = F.ws;
    const float* X1 = F.out; bf16* H = (bf16*)(ws + WS_H); const float* g2 = FIN(16); const float* ssq = (const float*)(ws + WS_SSQ);
    const v4u* Wp16 = (const v4u*)(ws + WS_WRP);
    int* ent_tok = (int*)(ws + WS_ENT_TOK); float* ent_w = (float*)(ws + WS_ENT_W);
    LAS v4u* Wl = (LAS v4u*)(F.lds + RING_OFF); LAS float* G2L = (LAS float*)(F.lds + RING_OFF + 98304); LAS float* Lg = (LAS float*)(F.lds + RING_OFF + 102400 + w * 3072);
    LAS unsigned* LC = (LAS unsigned*)(F.lds + RING_OFF + 126976); LAS unsigned* LB = LC + 32;
    if (tid < 256) ((LAS f32x4*)G2L)[tid] = ((const f32x4*)g2)[tid];
    const int q = lane >> 4, ksub = w >> 2;
    for (int base = F.vcu * 4; base < M / 16; base += F.G * 4) {
        const int item = base + (w & 3), tok0 = item * 16, tok = tok0 + (lane & 15);
        const float* xrow = X1 + (size_t)tok * DM + 8 * q;
        float rstd;
        { const f32x4 p0 = *(const GAS f32x4*)(ssq + (size_t)tok * 16), p1 = *(const GAS f32x4*)(ssq + (size_t)tok * 16 + 4), p2 = *(const GAS f32x4*)(ssq + (size_t)tok * 16 + 8), p3 = *(const GAS f32x4*)(ssq + (size_t)tok * 16 + 12);
          const f32x4 ps = (p0 + p1) + (p2 + p3); rstd = rsqrtf(((ps[0] + ps[1]) + (ps[2] + ps[3])) * (1.f / DM) + EPS); }
        f32x4 acc[3];
#pragma unroll
        for (int t = 0; t < 3; ++t) acc[t] = (f32x4){0.f, 0.f, 0.f, 0.f};
#pragma unroll
        for (int r = 0; r < 2; ++r) {
            f32x4 xa[8][2];
#pragma unroll
            for (int i = 0; i < 8; ++i) { const int k = 32 * (16 * r + 8 * ksub + i); xa[i][0] = *(const GAS f32x4*)(xrow + k); xa[i][1] = *(const GAS f32x4*)(xrow + k + 4); }
            __syncthreads();
#pragma unroll 1
            for (int i0 = 0; i0 < 12; i0 += 4) {
#pragma unroll
                for (int i = i0; i < i0 + 4; ++i) Wl[tid + i * 512] = Wp16[(size_t)r * 6144 + tid + i * 512]; }
            __syncthreads();
#pragma unroll
            for (int i = 0; i < 8; ++i) {
                const int ksl = 8 * ksub + i, k = 32 * (16 * r + ksl) + 8 * q;
                float x[8] = {xa[i][0][0], xa[i][0][1], xa[i][0][2], xa[i][0][3], xa[i][1][0], xa[i][1][1], xa[i][1][2], xa[i][1][3]};
                float hi[8], lo[8], hh[8];
                const f32x4 ga = *(const LAS f32x4*)(G2L + k), gb = *(const LAS f32x4*)(G2L + k + 4);
                const float gg[8] = {ga[0], ga[1], ga[2], ga[3], gb[0], gb[1], gb[2], gb[3]};
#pragma unroll
                for (int j = 0; j < 8; ++j) { hi[j] = __uint_as_float(f2bf(x[j]) << 16); lo[j] = x[j] - hi[j]; hh[j] = x[j] * rstd * gg[j]; }
                const v4u ah = pack8(hi), al = pack8(lo);
                *(GAS v4u*)(H + (size_t)tok * DM + k) = pack8(hh);
                const bf16x8 ahi = __builtin_bit_cast(bf16x8, ah), alo = __builtin_bit_cast(bf16x8, al);
#pragma unroll
                for (int t = 0; t < 3; ++t) {
                    const bf16x8 bhi = __builtin_bit_cast(bf16x8, Wl[((ksl * 3 + t) * 2 + 0) * 64 + lane]), blo = __builtin_bit_cast(bf16x8, Wl[((ksl * 3 + t) * 2 + 1) * 64 + lane]);
                    acc[t] = __builtin_amdgcn_mfma_f32_16x16x32_bf16(ahi, bhi, acc[t], 0, 0, 0);
                    acc[t] = __builtin_amdgcn_mfma_f32_16x16x32_bf16(alo, bhi, acc[t], 0, 0, 0);
                    acc[t] = __builtin_amdgcn_mfma_f32_16x16x32_bf16(ahi, blo, acc[t], 0, 0, 0);
                }
            }
        }
        if (ksub == 1) {
#pragma unroll
            for (int t = 0; t < 3; ++t)
#pragma unroll
                for (int r = 0; r < 4; ++r) Lg[(4 * q + r) * 48 + t * 16 + (lane & 15)] = acc[t][r];
        }
        if (tid < 32) LC[tid] = 0u;
        __syncthreads();
        int e0 = 0, e1 = 0; float w0 = 0.f, w1 = 0.f; unsigned r0 = 0u, r1 = 0u;
        const bool router_lane = (ksub == 0) && (lane < 16);
        if (ksub == 0) {
            const LAS float* Lp = Lg + 4 * 768;
#pragma unroll
            for (int t = 0; t < 3; ++t)
#pragma unroll
                for (int r = 0; r < 4; ++r) { const int o = (4 * q + r) * 48 + t * 16 + (lane & 15); Lg[o] = acc[t][r] + Lp[o]; }
            LDS_WAIT(); asm volatile("" ::: "memory");
            if (lane < 16) {
                const LAS float* Lr = Lg + lane * 48;
                float gl[4];
#pragma unroll
                for (int k = 0; k < 4; ++k) gl[k] = rstd * Lr[k] + FIN(18)[k];
                int gi = 0; float mx = gl[0];
#pragma unroll
                for (int k = 1; k < 4; ++k) if (gl[k] > mx) { mx = gl[k]; gi = k; }
                float se = 0.f;
#pragma unroll
                for (int k = 0; k < 4; ++k) se += __expf(gl[k] - mx);
                const float pg = 1.0f / se;
                float v0 = -3.0e38f, v1 = -3.0e38f; int i0 = 0, i1 = 0;
#pragma unroll
                for (int k = 0; k < 8; ++k) { const float el = rstd * Lr[16 + gi * 8 + k] + FIN(20)[gi * 8 + k];
                    if (el > v0) { v1 = v0; i1 = i0; v0 = el; i0 = k; } else if (el > v1) { v1 = el; i1 = k; } }
                w0 = pg / (1.0f + __expf(v1 - v0)); w1 = pg - w0;
                e0 = gi * 8 + i0; e1 = gi * 8 + i1;
                r0 = __hip_atomic_fetch_add(LC + e0, 1u, __ATOMIC_RELAXED, __HIP_MEMORY_SCOPE_WORKGROUP);
                r1 = __hip_atomic_fetch_add(LC + e1, 1u, __ATOMIC_RELAXED, __HIP_MEMORY_SCOPE_WORKGROUP);
            }
        }
        __syncthreads();
        if (tid < 32) { const unsigned c = LC[tid]; LB[tid] = c ? atomicAdd((unsigned*)(F.ctl + CW_CNT) + tid, c) : 0u; }
        __syncthreads();
        if (router_lane) {
            const unsigned p0 = LB[e0] + r0, p1 = LB[e1] + r1;
            ent_tok[(size_t)e0 * M + p0] = tok * 2; ent_w[(size_t)e0 * M + p0] = w0;
            ent_tok[(size_t)e1 * M + p1] = tok * 2 + 1; ent_w[(size_t)e1 * M + p1] = w1;
        }
    }
}
__device__ __forceinline__ void p_expert_copies(Frame& F, const Args& args) {
    const int gw = F.vcu * NWAVES + F.wave, NGW = F.G * NWAVES, lane = F.lane; unsigned char* ws = F.ws;
    LAS unsigned* scr = (LAS unsigned*)(F.lds + RING_OFF + F.wave * 16384);
    for (int it = gw; it < NEXP * 256; it += NGW) {
        const int e = it >> 8, r = it & 255;
        if (r < 128) transpose_item(FIN(21) + (size_t)e * DM * EFF, EFF, (bf16*)(ws + WS_WGU) + (size_t)e * 1024 * 1024, 1024, 1, scr, r / 8, r % 8, lane);
        else transpose_item(FIN(22) + (size_t)e * DM * EFF, EFF, (bf16*)(ws + WS_WGU) + (size_t)e * 1024 * 1024, 1024, 2, scr, (r - 128) / 8, (r - 128) % 8, lane);
    }
}
__device__ __forceinline__ void p_wd_copies(Frame& F, const Args& args, int n_units) {
    const int lane = F.lane; unsigned char* ws = F.ws;
    LAS unsigned* scr = (LAS unsigned*)(F.lds + RING_OFF + F.wave * 16384);
    const int rounds = (n_units + F.G - 1) / F.G, nbusy = n_units - (rounds - 1) * F.G, c = (int)blockIdx.x;
    int first, stride;
    if (nbusy >= F.G) { first = c; stride = F.G; } else { if (c < nbusy) return; first = c - nbusy; stride = F.G - nbusy; }
    for (int wi = first; wi < NEXP * 128 / NWAVES; wi += stride) {
        const int it = wi * NWAVES + F.wave, e = it >> 7, r = it & 127;
        transpose_item(FIN(23) + (size_t)e * EFF * DM, DM, (bf16*)(ws + WS_WD) + (size_t)e * 1024 * 512, 512, 0, scr, r / 16, r % 16, lane);
    }
}
__device__ __forceinline__ void load_expert_tables(Frame& F) {
    if (F.tid < 32) F.MISC[MI_CNT + F.tid] = __hip_atomic_load(F.ctl + CW_CNT + F.tid, RLX_AGENT);
    __syncthreads();
    if (F.tid == 0) { unsigned a = 0; for (int e = 0; e < 32; ++e) { F.MISC[MI_TP + e] = a; a += (F.MISC[MI_CNT + e] + 255u) >> 8; } F.MISC[MI_TP + 32] = a; }
    __syncthreads();
}
__global__ void __launch_bounds__(NWAVES * 64, 2) mk_fwd(Args args) {
    extern __shared__ __attribute__((aligned(16))) unsigned char lds[];
    Frame F;
    F.lds = (LAS unsigned char*)lds;
    F.MISC = (volatile LAS unsigned*)(F.lds + MISC_OFF);
    F.tid = threadIdx.x; F.lane = F.tid & 63; F.wave = __builtin_amdgcn_readfirstlane(F.tid >> 6);
    F.G = gridDim.x; { const int bx = blockIdx.x; F.vcu = (F.G % 8 == 0) ? (bx % 8) * (F.G / 8) + bx / 8 : bx; }
    unsigned char* ws = args.ws; F.ws = ws; F.out = args.out;
    F.ctl = (gu32*)(ws + WS_CTL);
    for (int u = F.tid; u < (LDS_BYTES - LDSCTL_OFF) / 4; u += NWAVES * 64) ((LAS unsigned*)(F.lds + LDSCTL_OFF))[u] = 0u;
    __syncthreads();
    XcdBarrier bar; bar.bar = (unsigned*)(F.ctl + CW_BAR); bar.x = 0; bar.st = nullptr;
#if !MK_PER_PHASE
    bar = xcd_barrier_post((unsigned*)(F.ctl + CW_BAR), F.MISC + 8);
#endif
    const int lo = args.ph_lo, hi = args.ph_hi;
#define IN(k) (lo <= (k) && (k) < hi)
#define STAMP(k) do { if (PROBING && blockIdx.x == 0 && F.tid == 0) { const unsigned long long t_ = __builtin_amdgcn_s_memrealtime(); F.MISC[MI_TS + 2 * (k)] = (unsigned)t_; F.MISC[MI_TS + 2 * (k) + 1] = (unsigned)(t_ >> 32); } } while (0)
#define REFRESH() do { int t_ = threadIdx.x; asm volatile("" : "+v"(t_)); F.tid = t_; F.lane = t_ & 63; } while (0)
#define SEAM(k) do { if (IN(k) && IN((k) + 1)) xcd_barrier(bar); STAMP((k) + 1); REFRESH(); } while (0)
    STAMP(0);

    if (IN(0)) { p0_prologue(F, args); } SEAM(0);
    if (IN(1)) {
        pg8::Gemm g{(const pg8::bf16_t*)(ws + WS_H), (const pg8::bf16_t*)(ws + WS_WIN), M, IN_COLS, DM, DM}; pg8::StaticOrder S; S.init(M, IN_COLS, F.G, (int)blockIdx.x);
        EpiIn E{(bf16*)(ws + WS_P), (const float*)(ws + WS_TABA), (const float*)(ws + WS_TABB), FIN(4), FIN(5)};
        pg8::gemm_phase<EpiIn, pg8::StaticOrder, true, true>(F.lds + RING_OFF, g, S, E);
    } SEAM(1);
    if (IN(2)) {
        const attn_body::AttnTensors AT{(const attn_body::bf16*)(ws + WS_P), (const attn_body::bf16*)(ws + WS_P + PBUF), (const attn_body::bf16*)(ws + WS_P + 2 * PBUF), (attn_body::bf16*)(ws + WS_H)};
        const attn_body::StaticOrder S((int)F.G, (int)blockIdx.x);
        attn_body::attn_phase<attn_body::StaticOrder>((char*)lds + RING_OFF, AT, S);
        __syncthreads(); REFRESH();
        for (int item = F.vcu; item < 512; item += F.G) ret_kv_item(F, args, item);
    } SEAM(2);
    if (IN(3)) { p4_scan(F, args); } SEAM(3);
    if (IN(4)) { for (int item = F.vcu; item < 512; item += F.G) ret_out_item(F, args, item); p5_attn_combine(F, args); } SEAM(4);
    if (IN(5)) {
        pg8::Gemm g{(const pg8::bf16_t*)(ws + WS_OA), (const pg8::bf16_t*)(ws + WS_WA), M, DM, 512, 1024}; SplitKOrder S; S.init(M, DM, F.G, (int)blockIdx.x);
        EpiMerge2 E{(bf16*)(ws + WS_MERGED), (const bf16*)(ws + WS_P + 7 * PBUF), (const bf16*)(ws + WS_P + 8 * PBUF), (const bf16*)(ws + WS_P + 9 * PBUF), (const bf16*)(ws + WS_P + 10 * PBUF)};
        pg8::gemm_phase<EpiMerge2, SplitKOrder, true, true>(F.lds + RING_OFF, g, S, E);
    } SEAM(5);
    if (IN(6)) {
        pg8::Gemm g{(const pg8::bf16_t*)(ws + WS_MERGED), (const pg8::bf16_t*)(ws + WS_WOUT), M, DM, DM, DM}; pg8::StaticOrder S; S.init(M, DM, F.G, (int)blockIdx.x);
        EpiResid E{FIN(0), F.out, (float*)(ws + WS_SSQ)};
        pg8::gemm_phase<EpiResid, pg8::StaticOrder, true, true>(F.lds + RING_OFF, g, S, E);
    } SEAM(6);
    if (IN(7)) { p9_router(F, args); } SEAM(7);
    if (IN(8)) { p_expert_copies(F, args); } SEAM(8);
    if (IN(9)) {
        load_expert_tables(F);
        pg8::Gemm g{(const pg8::bf16_t*)(ws + WS_H), (const pg8::bf16_t*)(ws + WS_WGU), MAXROWS, NEXP * 1024, DM, DM};
        GroupedOrderT<true> S{F.MISC + MI_TP, F.MISC + MI_CNT, (const int*)(ws + WS_ENT_TOK), F.G, (int)blockIdx.x};
        EpiSwiGLU E{(bf16*)(ws + WS_HMID)};
        pg8::gemm_phase<EpiSwiGLU, GroupedOrderT<true>, true, true>(F.lds + RING_OFF, g, S, E);
        REFRESH(); p_wd_copies(F, args, (int)F.MISC[MI_TP + 32] * 4);
    } SEAM(9);
    if (IN(10)) {
        load_expert_tables(F);
        pg8::Gemm g{(const pg8::bf16_t*)(ws + WS_HMID), (const pg8::bf16_t*)(ws + WS_WD), MAXROWS, NEXP * 1024, EFF, EFF};
        GroupedOrderT<false> S{F.MISC + MI_TP, F.MISC + MI_CNT, (const int*)(ws + WS_ENT_TOK), F.G, (int)blockIdx.x};
        EpiY E{(bf16*)(ws + WS_Y), (const int*)(ws + WS_ENT_TOK), (const float*)(ws + WS_ENT_W), F.MISC + MI_CNT};
        pg8::gemm_phase<EpiY, GroupedOrderT<false>, true, true>(F.lds + RING_OFF, g, S, E);
    } SEAM(10);
    if (IN(11)) {
        const int gid = F.vcu * (NWAVES * 64) + F.tid, NT = F.G * NWAVES * 64;
        const bf16* Y0 = (const bf16*)(ws + WS_Y); const bf16* Y1 = Y0 + (size_t)M * 1024;
        for (int idx = gid; idx < M * 1024 / 8; idx += NT) {
            GAS f32x4* o = (GAS f32x4*)F.out + (size_t)idx * 2;
            f32x4 a = o[0], b2 = o[1]; float y0[8], y1[8];
            unpack8(*(const GAS v4u*)(Y0 + (size_t)idx * 8), y0); unpack8(*(const GAS v4u*)(Y1 + (size_t)idx * 8), y1);
            a[0] += y0[0] + y1[0]; a[1] += y0[1] + y1[1]; a[2] += y0[2] + y1[2]; a[3] += y0[3] + y1[3];
            b2[0] += y0[4] + y1[4]; b2[1] += y0[5] + y1[5]; b2[2] += y0[6] + y1[6]; b2[3] += y0[7] + y1[7];
            o[0] = a; o[1] = b2;
        }
    }
    if (PROBING) {
        xcd_barrier(bar); STAMP(N_PHASES);
        if (blockIdx.x == 0) {
            __syncthreads();
            float dA = 0.f, dB = 0.f;
            if (PROBE_A >= 0) { const unsigned long long t0 = ((unsigned long long)F.MISC[MI_TS + 2 * PROBE_A + 1] << 32) | F.MISC[MI_TS + 2 * PROBE_A], t1 = ((unsigned long long)F.MISC[MI_TS + 2 * PROBE_A + 3] << 32) | F.MISC[MI_TS + 2 * PROBE_A + 2]; dA = (float)(t1 - t0) * 0.01f; }
            if (PROBE_B == 99) dB = 1.0f;
            else if (PROBE_B >= 0) { const unsigned long long t0 = ((unsigned long long)F.MISC[MI_TS + 2 * PROBE_B + 1] << 32) | F.MISC[MI_TS + 2 * PROBE_B], t1 = ((unsigned long long)F.MISC[MI_TS + 2 * PROBE_B + 3] << 32) | F.MISC[MI_TS + 2 * PROBE_B + 2]; dB = (float)(t1 - t0) * 0.0001f; }
            if (F.tid == 0) F.out[0] += dA;
            for (int i = F.tid; i < 16384; i += NWAVES * 64) F.out[4096 + i] += 5.0f + dB;
        }
    }
#undef IN
#undef SEAM
}

extern "C" void kernel_launch(void* const* d_in, const int* in_sizes, int n_in, void* d_out, int out_size, void* d_ws, size_t ws_size, hipStream_t stream) {
    static int grid = 0;
    if (grid == 0) {
        if (n_in != 24 || in_sizes[0] != M * DM || out_size != M * DM || ws_size < WS_END) { fprintf(stderr, "kernel_launch: unexpected shapes/workspace (n_in %d, ws %zu); nothing launched\n", n_in, ws_size); grid = -1; return; }
        int dev = 0, cus = 0, per_cu = 0;
        if (hipGetDevice(&dev) != hipSuccess || hipDeviceGetAttribute(&cus, hipDeviceAttributeMultiprocessorCount, dev) != hipSuccess) { grid = -1; return; }
        if (hipFuncSetAttribute((const void*)mk_fwd, hipFuncAttributeMaxDynamicSharedMemorySize, LDS_BYTES) != hipSuccess) { fprintf(stderr, "kernel_launch: hipFuncSetAttribute failed\n"); grid = -1; return; }
        if (hipOccupancyMaxActiveBlocksPerMultiprocessor(&per_cu, (const void*)mk_fwd, NWAVES * 64, LDS_BYTES) != hipSuccess || per_cu < 1) fprintf(stderr, "kernel_launch: occupancy query reports %d\n", per_cu);
        (void)hipGetLastError();
        grid = cus;
    }
    if (grid < 0) return;
    if (hipMemsetAsync((char*)d_ws + WS_CTL, 0, CTL_ZERO_BYTES, stream) != hipSuccess) return;
    Args a{};
    for (int i = 0; i < 24; ++i) a.in[i] = d_in[i];
    a.out = (float*)d_out; a.ws = (unsigned char*)d_ws;
#if MK_PER_PHASE
    for (int p = 0; p < N_PHASES; ++p) { a.ph_lo = p; a.ph_hi = p + 1; hipLaunchKernelGGL(mk_fwd, dim3(grid), dim3(NWAVES * 64), LDS_BYTES, stream, a); }
#else
    a.ph_lo = 0; a.ph_hi = N_PHASES;
    hipLaunchKernelGGL(mk_fwd, dim3(grid), dim3(NWAVES * 64), LDS_BYTES, stream, a);
#endif
}
```
